# Optimizing an MI355X kernel written in HIP

```python
import math
import jax, jax.numpy as jnp
from jax import lax
import numpy as np

D_MODEL = 1024
BATCH = 8
SEQ = 2048
DEPTH = 1
DEC_BATCH = 32
DEC_SEQ = 8
PAST_LEN = 8192
PAGE_SIZE = 128

NSA_HEADS = 8
NSA_KV_HEADS = 2
NSA_HD = 64
CMP_BLOCK = 32
CMP_STRIDE = 16
SEL_BLOCK = 64
SEL_TOPN = 8
WINDOW = 512
Q_BLOCK = 128
FORCED_BONUS = 1e4
GDN_HEADS = 4
GDN_HD = 128
GDN_CONV = 4
GDN_CHUNK = 64
MEM_TOKENS = 256
XA_HEADS = 4
XA_HD = D_MODEL // XA_HEADS
D_FF = 2816
FFN_CONV = 3

ROPE_THETA = 10000.0
EPS = 1e-6
NEG = -1e30

NSA_Q_W = NSA_HEADS * NSA_HD
NSA_KV_W = 3 * 2 * NSA_KV_HEADS * NSA_HD
NSA_GATE_W = 3 * NSA_HEADS
GDN_W = GDN_HEADS * GDN_HD
MIX_W = NSA_Q_W + GDN_W
XA_W = XA_HEADS * XA_HD
IN_SPLITS = (NSA_Q_W, NSA_KV_W, NSA_GATE_W, 3 * GDN_W, GDN_W, GDN_HEADS, GDN_HEADS)
IN_COLS = NSA_Q_W + NSA_KV_W + NSA_GATE_W + 4 * GDN_W + 2 * GDN_HEADS

kernel_name = 'hymba_nsa_gdn_convffn_step'


def _rms(x, w):
    xf = x.astype(jnp.float32)
    y = xf * lax.rsqrt(jnp.mean(xf * xf, axis=-1, keepdims=True) + EPS)
    return (y * w.astype(jnp.float32)).astype(x.dtype)


def _l2n(x):
    xf = x.astype(jnp.float32)
    return xf * lax.rsqrt(jnp.sum(xf * xf, axis=-1, keepdims=True) + EPS)


def _rope(x, pos):
    half = x.shape[-1] // 2
    inv = jnp.power(ROPE_THETA, -jnp.arange(half, dtype=jnp.float32) / half)
    ang = pos.astype(jnp.float32)[:, None] * inv[None, :]
    cos = jnp.cos(ang)[None, :, None, :]
    sin = jnp.sin(ang)[None, :, None, :]
    xf = x.astype(jnp.float32)
    x1, x2 = xf[..., :half], xf[..., half:]
    return jnp.concatenate([x1 * cos - x2 * sin, x1 * sin + x2 * cos], axis=-1).astype(x.dtype)


def _causal_dwconv(x, buf, w):
    K = w.shape[0]
    T = x.shape[1]
    xp = jnp.concatenate([buf.astype(x.dtype), x], axis=1)
    y = xp[:, 0:T] * w[0]
    for i in range(1, K):
        y = y + xp[:, i:i + T] * w[i]
    return y, xp[:, xp.shape[1] - (K - 1):]


def _masked_probs(s, valid):
    s = jnp.where(valid, s, NEG)
    p = jnp.where(valid, jnp.exp(s - jnp.max(s, axis=-1, keepdims=True)), 0.0)
    return p / jnp.maximum(jnp.sum(p, axis=-1, keepdims=True), 1e-30)


def _compress(x, pe, w):
    B, L = x.shape[:2]
    n_chunk = L // CMP_STRIDE
    r = CMP_BLOCK // CMP_STRIDE
    n_cmp = n_chunk - r + 1
    ch = x.reshape(B, n_chunk, CMP_STRIDE, NSA_KV_HEADS, NSA_HD)
    blocks = jnp.concatenate([ch[:, i:i + n_cmp] for i in range(r)], axis=2)
    blocks = blocks + pe[None, None, :, None, :]
    return jnp.einsum('bcjkd,jde->bcke', blocks, w)


def _cmp_to_sel(n_cmp, n_sel):
    cs = jnp.arange(n_cmp)[:, None] * CMP_STRIDE
    ss = jnp.arange(n_sel)[None, :] * SEL_BLOCK
    return ((cs < ss + SEL_BLOCK) & (cs + CMP_BLOCK > ss)).astype(jnp.float32)


def _sel_blocks(x):
    B, L = x.shape[:2]
    return x.reshape(B, L // SEL_BLOCK, SEL_BLOCK, NSA_KV_HEADS, NSA_HD).transpose(0, 3, 1, 2, 4)


def _nsa_core(qc, qr, gates, q_pos, k_cmp, v_cmp, c2s, ks_b, vs_b, kw, vw, kw_pos):
    f32 = jnp.float32
    B, Tq = qc.shape[:2]
    K = NSA_KV_HEADS
    G = NSA_HEADS // K
    scale = NSA_HD ** -0.5
    qcg = qc.reshape(B, Tq, K, G, NSA_HD).astype(f32)
    qrg = qr.reshape(B, Tq, K, G, NSA_HD).astype(f32)
    n_cmp = k_cmp.shape[1]
    cmp_end = jnp.arange(n_cmp) * CMP_STRIDE + (CMP_BLOCK - 1)
    s = jnp.einsum('btkgd,bckd->bkgtc', qcg, k_cmp.astype(f32)) * scale
    p_cmp = _masked_probs(s, cmp_end[None, :] <= q_pos[:, None])
    o_cmp = jnp.einsum('bkgtc,bckd->btkgd', p_cmp, v_cmp.astype(f32))
    n_sel = ks_b.shape[2]
    imp = jnp.einsum('bkgtc,cs->bkts', p_cmp, c2s)
    blk = jnp.arange(n_sel)[None, :]
    q_blk = (q_pos // SEL_BLOCK)[:, None]
    visible = blk <= q_blk
    forced = (blk == 0) | (blk == q_blk) | (blk == q_blk - 1)
    score = jnp.where(visible, imp + jnp.where(forced, FORCED_BONUS, 0.0), NEG)
    n_top = min(SEL_TOPN, n_sel)
    top_val, top_idx = lax.top_k(score, n_top)
    bi = jnp.arange(B)[:, None, None, None]
    ki = jnp.arange(K)[None, :, None, None]
    k_sel = ks_b[bi, ki, top_idx].astype(f32)
    v_sel = vs_b[bi, ki, top_idx].astype(f32)
    key_pos = top_idx[..., None] * SEL_BLOCK + jnp.arange(SEL_BLOCK)
    sel_valid = (top_val > 0.5 * NEG)[..., None] & (key_pos <= q_pos[None, None, :, None, None])
    m = n_top * SEL_BLOCK
    s = jnp.einsum('btkgd,bktnjd->bkgtnj', qrg, k_sel).reshape(B, K, G, Tq, m) * scale
    p_sel = _masked_probs(s, sel_valid.reshape(B, K, 1, Tq, m))
    o_sel = jnp.einsum('bkgtm,bktmd->btkgd', p_sel, v_sel.reshape(B, K, Tq, m, NSA_HD))
    s = jnp.einsum('btkgd,blkd->bkgtl', qrg, kw.astype(f32)) * scale
    rel = q_pos[:, None] - kw_pos[None, :]
    p_win = _masked_probs(s, (rel >= 0) & (rel < WINDOW) & (kw_pos[None, :] >= 0))
    o_win = jnp.einsum('bkgtl,blkd->btkgd', p_win, vw.astype(f32))
    g = gates.reshape(B, Tq, K, G, 3).astype(f32)
    o = o_cmp * g[..., 0:1] + o_sel * g[..., 1:2] + o_win * g[..., 2:3]
    return o.reshape(B, Tq, NSA_Q_W).astype(qc.dtype)


def _nsa_prompt(qc, qr, gates, rows, wrows, cmp_pe, cmp_w):
    B, T = qc.shape[:2]
    k_cmp = _compress(rows[:, :, 0], cmp_pe[0], cmp_w[0])
    v_cmp = _compress(rows[:, :, 1], cmp_pe[1], cmp_w[1])
    ks_b = _sel_blocks(rows[:, :, 2])
    vs_b = _sel_blocks(rows[:, :, 3])
    c2s = _cmp_to_sel(k_cmp.shape[1], ks_b.shape[2])
    wpad = jnp.pad(wrows, ((0, 0), (WINDOW, 0), (0, 0), (0, 0), (0, 0)))
    n_blk = T // Q_BLOCK

    def one_block(args):
        b, qc_b, qr_b, g_b = args
        start = b * Q_BLOCK
        q_pos = start + jnp.arange(Q_BLOCK)
        band = lax.dynamic_slice_in_dim(wpad, start, WINDOW + Q_BLOCK, axis=1)
        kw_pos = start - WINDOW + jnp.arange(WINDOW + Q_BLOCK)
        return _nsa_core(qc_b, qr_b, g_b, q_pos, k_cmp, v_cmp, c2s, ks_b, vs_b,
                         band[:, :, 0], band[:, :, 1], kw_pos)

    def split(a):
        return a.reshape(B, n_blk, Q_BLOCK, *a.shape[2:]).swapaxes(0, 1)

    out = lax.map(one_block, (jnp.arange(n_blk), split(qc), split(qr), split(gates)))
    return out.swapaxes(0, 1).reshape(B, T, NSA_Q_W)


def _nsa_sample(qc, qr, gates, rows, wrows, past_rows, win_buf, cmp_pe, cmp_w):
    B, T = qc.shape[:2]
    past = past_rows.shape[1]
    full = jnp.concatenate([past_rows.astype(rows.dtype), rows], axis=1)
    L = full.shape[1]
    Lp = -(-L // SEL_BLOCK) * SEL_BLOCK
    full = jnp.pad(full, ((0, 0), (0, Lp - L), (0, 0), (0, 0), (0, 0)))
    k_cmp = _compress(full[:, :, 0], cmp_pe[0], cmp_w[0])
    v_cmp = _compress(full[:, :, 1], cmp_pe[1], cmp_w[1])
    ks_b = _sel_blocks(full[:, :, 2])
    vs_b = _sel_blocks(full[:, :, 3])
    c2s = _cmp_to_sel(k_cmp.shape[1], ks_b.shape[2])
    wb = win_buf.shape[1]
    wall = jnp.concatenate([win_buf.astype(wrows.dtype), wrows], axis=1)
    kw_pos = past - wb + jnp.arange(wb + T)
    q_pos = past + jnp.arange(T)
    o = _nsa_core(qc, qr, gates, q_pos, k_cmp, v_cmp, c2s, ks_b, vs_b,
                  wall[:, :, 0], wall[:, :, 1], kw_pos)
    keep = min(WINDOW, wb + T)
    return o, wall[:, wb + T - keep:]


def _gated_delta(q, k, v, beta, g, s0):
    f32 = jnp.float32
    B, T, H, dk = q.shape
    dv = v.shape[-1]
    C = GDN_CHUNK
    n = -(-T // C)
    pad = n * C - T

    def chunk(a):
        a = jnp.pad(a.astype(f32), [(0, 0), (0, pad)] + [(0, 0)] * (a.ndim - 2))
        return a.reshape(B, n, C, *a.shape[2:]).swapaxes(2, 3)

    qc, kc, vc, bc = chunk(q), chunk(k), chunk(v), chunk(beta)
    gc = jnp.cumsum(chunk(g), axis=-1)
    causal = jnp.tril(jnp.ones((C, C), bool))
    strict = jnp.tril(jnp.ones((C, C), bool), -1)
    diff = gc[..., :, None] - gc[..., None, :]
    decay = jnp.where(causal, jnp.exp(jnp.where(causal, diff, 0.0)), 0.0)
    kb = kc * bc[..., None]
    a_mat = jnp.where(strict, jnp.einsum('bnhid,bnhjd->bnhij', kb, kc) * decay, 0.0)
    rhs = jnp.concatenate([vc * bc[..., None], kb * jnp.exp(gc)[..., None]], axis=-1)
    sol = lax.linalg.triangular_solve(jnp.eye(C, dtype=f32) + a_mat, rhs, left_side=True,
                                      lower=True, unit_diagonal=True)
    u, w = sol[..., :dv], sol[..., dv:]
    qk = jnp.einsum('bnhid,bnhjd->bnhij', qc, kc) * decay
    q_dec = qc * jnp.exp(gc)[..., None]
    g_last = gc[..., -1]
    k_dec = kc * jnp.exp(g_last[..., None] - gc)[..., None]

    def step(S, xs):
        u_c, w_c, qd_c, qk_c, kd_c, gl_c = xs
        v_new = u_c - jnp.einsum('bhck,bhkv->bhcv', w_c, S)
        o_c = jnp.einsum('bhck,bhkv->bhcv', qd_c, S) + jnp.einsum('bhij,bhjv->bhiv', qk_c, v_new)
        S = S * jnp.exp(gl_c)[..., None, None] + jnp.einsum('bhck,bhcv->bhkv', kd_c, v_new)
        return S, o_c

    xs = tuple(a.swapaxes(0, 1) for a in (u, w, q_dec, qk, k_dec, g_last))
    S, o = lax.scan(step, s0.astype(f32), xs)
    o = o.transpose(1, 0, 3, 2, 4).reshape(B, n * C, H, dv)[:, :T]
    return o, S


def _gdn(qkv_pre, z_pre, b_pre, a_pre, conv_buf, s0, conv_w, a_log, dt_bias, norm_w):
    f32 = jnp.float32
    B, T = qkv_pre.shape[:2]
    qkv, buf_new = _causal_dwconv(qkv_pre, conv_buf, conv_w)
    qkv = jax.nn.silu(qkv)
    q, k, v = jnp.split(qkv, 3, axis=-1)
    shp = (B, T, GDN_HEADS, GDN_HD)
    q = _l2n(q.reshape(shp)) * (GDN_HD ** -0.5)
    k = _l2n(k.reshape(shp))
    v = v.reshape(shp).astype(f32)
    beta = jax.nn.sigmoid(b_pre.astype(f32))
    g = -jnp.exp(a_log.astype(f32)) * jax.nn.softplus(a_pre.astype(f32) + dt_bias.astype(f32))
    o, s_new = _gated_delta(q, k, v, beta, g, s0)
    o = _rms(o, norm_w) * jax.nn.silu(z_pre.reshape(shp).astype(f32))
    return o.reshape(B, T, GDN_W).astype(qkv_pre.dtype), buf_new, s_new.astype(s0.dtype)


def _mem_kv(mem, mem_norm_w, w_xk, w_xv, xk_norm_w):
    B, M = mem.shape[:2]
    mn = _rms(mem, mem_norm_w)
    k = _rms((mn @ w_xk).reshape(B, M, XA_HEADS, XA_HD), xk_norm_w)
    v = (mn @ w_xv).reshape(B, M, XA_HEADS, XA_HD)
    return jnp.stack([k, v], axis=2)


def _cross_attn(x, mem_kv, norm_w, w_xq, xq_norm_w, w_xo):
    f32 = jnp.float32
    B, T = x.shape[:2]
    q = _rms((_rms(x, norm_w) @ w_xq).reshape(B, T, XA_HEADS, XA_HD), xq_norm_w)
    s = jnp.einsum('bthd,bmhd->bhtm', q.astype(f32), mem_kv[:, :, 0].astype(f32)) * (XA_HD ** -0.5)
    p = jax.nn.softmax(s, axis=-1)
    o = jnp.einsum('bhtm,bmhd->bthd', p, mem_kv[:, :, 1].astype(f32))
    return o.reshape(B, T, XA_W).astype(x.dtype) @ w_xo


def _conv_ffn(x, buf, norm_w, w_up, conv_w, conv_b, w_down):
    up = _rms(x, norm_w) @ w_up
    h, buf_new = _causal_dwconv(up, buf, conv_w)
    a, u = jnp.split(h + conv_b, 2, axis=-1)
    return (jax.nn.silu(a) * u) @ w_down, buf_new


def _layer(x, pos, nsa_attend, gdn_buf, gdn_s0, mem_kv, ffn_buf,
           attn_norm_w, w_in, nsa_q_norm_w, nsa_k_norm_w, gdn_conv_w, gdn_a_log,
           gdn_dt_bias, gdn_norm_w, w_out, xattn_norm_w, w_xq, xq_norm_w, w_xo,
           ffn_norm_w, w_up, ffn_conv_w, ffn_conv_b, w_down):
    B, T = x.shape[:2]
    xn = _rms(x, attn_norm_w)
    cuts, acc = [], 0
    for width in IN_SPLITS[:-1]:
        acc += width
        cuts.append(acc)
    q_pre, kv_pre, gate_pre, qkv_pre, z_pre, b_pre, a_pre = jnp.split(xn @ w_in, cuts, axis=-1)
    q = _rms(q_pre.reshape(B, T, NSA_HEADS, NSA_HD), nsa_q_norm_w)
    qr = _rope(q, pos)
    kv = kv_pre.reshape(B, T, 3, 2, NSA_KV_HEADS, NSA_HD)
    k = _rms(kv[:, :, :, 0], nsa_k_norm_w[:, None, :])
    v = kv[:, :, :, 1]
    rows = jnp.stack([k[:, :, 0], v[:, :, 0], _rope(k[:, :, 1], pos), v[:, :, 1]], axis=2)
    wrows = jnp.stack([_rope(k[:, :, 2], pos), v[:, :, 2]], axis=2)
    gates = jax.nn.sigmoid(gate_pre.reshape(B, T, NSA_HEADS, 3))
    o_nsa, win_state = nsa_attend(q, qr, gates, rows, wrows)
    o_gdn, gdn_buf_new, gdn_s = _gdn(qkv_pre, z_pre, b_pre, a_pre, gdn_buf, gdn_s0,
                                     gdn_conv_w, gdn_a_log, gdn_dt_bias, gdn_norm_w)
    h = x + jnp.concatenate([o_nsa, o_gdn.astype(o_nsa.dtype)], axis=-1) @ w_out
    h = h + _cross_attn(h, mem_kv, xattn_norm_w, w_xq, xq_norm_w, w_xo)
    f, ffn_buf_new = _conv_ffn(h, ffn_buf, ffn_norm_w, w_up, ffn_conv_w, ffn_conv_b, w_down)
    return h + f, rows, win_state, gdn_s, gdn_buf_new, ffn_buf_new


def setup_inputs(seed: int = 0) -> dict:
    key = jax.random.key(seed)
    ks = iter(jax.random.split(key, 48))

    def nrm(shape, scale):
        return jax.random.normal(next(ks), shape, jnp.float32) * scale

    def gain(shape):
        return 1.0 + 0.02 * jax.random.normal(next(ks), shape, jnp.float32)

    n_pages = PAST_LEN // PAGE_SIZE
    n_used = DEC_BATCH * n_pages
    n_pool = n_used + n_used // 4
    win_len = min(WINDOW, PAST_LEN)
    page_table = jax.random.permutation(next(ks), n_pool)[:n_used].reshape(DEC_BATCH, n_pages).astype(jnp.int32)
    a_log = jnp.log(jax.random.uniform(next(ks), (DEPTH, GDN_HEADS), jnp.float32, 1.0, 16.0))
    dt = jnp.exp(jax.random.uniform(next(ks), (DEPTH, GDN_HEADS), jnp.float32,
                                    math.log(1e-3), math.log(1e-1)))
    dt_bias = dt + jnp.log(-jnp.expm1(-dt))
    return {
        'x_prompt': nrm((BATCH, SEQ, D_MODEL), 1.0),
        'x_sample': nrm((DEC_BATCH, DEC_SEQ, D_MODEL), 1.0),
        'mem_prompt': nrm((BATCH, MEM_TOKENS, D_MODEL), 1.0),
        'cache_nsa_kv': nrm((DEPTH, n_pool, PAGE_SIZE, 4, NSA_KV_HEADS, NSA_HD), 1.0),
        'cache_nsa_win': nrm((DEPTH, DEC_BATCH, win_len, 2, NSA_KV_HEADS, NSA_HD), 1.0),
        'state_gdn': nrm((DEPTH, DEC_BATCH, GDN_HEADS, GDN_HD, GDN_HD), 1.0),
        'cache_gdn_conv': nrm((DEPTH, DEC_BATCH, GDN_CONV - 1, 3 * GDN_W), 1.0),
        'cache_ffn_conv': nrm((DEPTH, DEC_BATCH, FFN_CONV - 1, 2 * D_FF), 1.0),
        'cache_mem_kv': nrm((DEPTH, DEC_BATCH, MEM_TOKENS, 2, XA_HEADS, XA_HD), 1.0),
        'page_table': page_table,
        'attn_norm_w': gain((DEPTH, D_MODEL)),
        'w_in': nrm((DEPTH, D_MODEL, IN_COLS), D_MODEL ** -0.5),
        'nsa_q_norm_w': gain((DEPTH, NSA_HD)),
        'nsa_k_norm_w': gain((DEPTH, 3, NSA_HD)),
        'cmp_pe': nrm((DEPTH, 2, CMP_BLOCK, NSA_HD), 0.1),
        'cmp_w': nrm((DEPTH, 2, CMP_BLOCK, NSA_HD, NSA_HD), (CMP_BLOCK * NSA_HD) ** -0.5),
        'gdn_conv_w': nrm((DEPTH, GDN_CONV, 3 * GDN_W), GDN_CONV ** -0.5),
        'gdn_a_log': a_log,
        'gdn_dt_bias': dt_bias,
        'gdn_norm_w': gain((DEPTH, GDN_HD)),
        'w_out': nrm((DEPTH, MIX_W, D_MODEL), MIX_W ** -0.5),
        'mem_norm_w': gain((DEPTH, D_MODEL)),
        'w_xk': nrm((DEPTH, D_MODEL, XA_W), D_MODEL ** -0.5),
        'w_xv': nrm((DEPTH, D_MODEL, XA_W), D_MODEL ** -0.5),
        'xk_norm_w': gain((DEPTH, XA_HD)),
        'xattn_norm_w': gain((DEPTH, D_MODEL)),
        'w_xq': nrm((DEPTH, D_MODEL, XA_W), D_MODEL ** -0.5),
        'xq_norm_w': gain((DEPTH, XA_HD)),
        'w_xo': nrm((DEPTH, XA_W, D_MODEL), XA_W ** -0.5),
        'ffn_norm_w': gain((DEPTH, D_MODEL)),
        'w_up': nrm((DEPTH, D_MODEL, 2 * D_FF), D_MODEL ** -0.5),
        'ffn_conv_w': nrm((DEPTH, FFN_CONV, 2 * D_FF), FFN_CONV ** -0.5),
        'ffn_conv_b': nrm((DEPTH, 2 * D_FF), 0.01),
        'w_down': nrm((DEPTH, D_FF, D_MODEL), D_FF ** -0.5),
    }


def reference(x_prompt, x_sample, mem_prompt, cache_nsa_kv, cache_nsa_win, state_gdn,
              cache_gdn_conv, cache_ffn_conv, cache_mem_kv, page_table,
              attn_norm_w, w_in, nsa_q_norm_w, nsa_k_norm_w, cmp_pe, cmp_w, gdn_conv_w,
              gdn_a_log, gdn_dt_bias, gdn_norm_w, w_out, mem_norm_w, w_xk, w_xv, xk_norm_w,
              xattn_norm_w, w_xq, xq_norm_w, w_xo, ffn_norm_w, w_up, ffn_conv_w, ffn_conv_b, w_down):
    B, T = x_prompt.shape[:2]
    Bs, Ts = x_sample.shape[:2]
    past_len = page_table.shape[1] * cache_nsa_kv.shape[2]
    pos_p = jnp.arange(T)
    pos_s = past_len + jnp.arange(Ts)
    hp, hs = x_prompt, x_sample
    kv_p, win_p, st_p, gc_p, fc_p, mkv_p = [], [], [], [], [], []
    kv_s, win_s, st_s, gc_s, fc_s = [], [], [], [], []
    for l in range(DEPTH):
        def run(x, pos, attend, gbuf, gs0, mkv, fbuf):
            return _layer(x, pos, attend, gbuf, gs0, mkv, fbuf,
                          attn_norm_w[l], w_in[l], nsa_q_norm_w[l], nsa_k_norm_w[l], gdn_conv_w[l],
                          gdn_a_log[l], gdn_dt_bias[l], gdn_norm_w[l], w_out[l], xattn_norm_w[l],
                          w_xq[l], xq_norm_w[l], w_xo[l], ffn_norm_w[l], w_up[l], ffn_conv_w[l],
                          ffn_conv_b[l], w_down[l])

        def attend_prompt(q, qr, g, rows, wrows):
            n = rows.shape[1]
            keep = min(WINDOW, n)
            return _nsa_prompt(q, qr, g, rows, wrows, cmp_pe[l], cmp_w[l]), wrows[:, n - keep:]

        past_rows = cache_nsa_kv[l][page_table].reshape(Bs, past_len, 4, NSA_KV_HEADS, NSA_HD)

        def attend_sample(q, qr, g, rows, wrows):
            return _nsa_sample(q, qr, g, rows, wrows, past_rows, cache_nsa_win[l], cmp_pe[l], cmp_w[l])

        mem_kv = _mem_kv(mem_prompt, mem_norm_w[l], w_xk[l], w_xv[l], xk_norm_w[l])
        hp, a1, a2, a3, a4, a5 = run(hp, pos_p, attend_prompt,
                                     jnp.zeros((B, GDN_CONV - 1, 3 * GDN_W), hp.dtype),
                                     jnp.zeros((B, GDN_HEADS, GDN_HD, GDN_HD), hp.dtype),
                                     mem_kv,
                                     jnp.zeros((B, FFN_CONV - 1, 2 * D_FF), hp.dtype))
        kv_p.append(a1); win_p.append(a2); st_p.append(a3); gc_p.append(a4); fc_p.append(a5)
        mkv_p.append(mem_kv)
        hs, b1, b2, b3, b4, b5 = run(hs, pos_s, attend_sample, cache_gdn_conv[l], state_gdn[l],
                                     cache_mem_kv[l], cache_ffn_conv[l])
        kv_s.append(b1); win_s.append(b2); st_s.append(b3); gc_s.append(b4); fc_s.append(b5)
    nsa_kv_p = jnp.stack(kv_p)
    nsa_win_p = jnp.stack(win_p)
    gdn_state_p = jnp.stack(st_p)
    gdn_conv_p = jnp.stack(gc_p)
    ffn_conv_p = jnp.stack(fc_p)
    mem_kv_p = jnp.stack(mkv_p)
    nsa_kv_s = jnp.stack(kv_s)
    nsa_win_s = jnp.stack(win_s)
    gdn_state_s = jnp.stack(st_s)
    gdn_conv_s = jnp.stack(gc_s)
    ffn_conv_s = jnp.stack(fc_s)
    return (hp, hs, nsa_kv_p, nsa_win_p, gdn_state_p, gdn_conv_p, ffn_conv_p, mem_kv_p,
            nsa_kv_s, nsa_win_s, gdn_state_s, gdn_conv_s, ffn_conv_s)
```

```cpp
#include <hip/hip_runtime.h>
#include <hip/hip_cooperative_groups.h>
#include <cstdio>
#include <cstdint>
namespace cg = cooperative_groups;
#define HD __host__ __device__ __forceinline__
#ifdef CFG_SMALL
constexpr int BATCH = 1, SEQ = 1024, DEC_BATCH = 2, PAST_LEN = 1024, MEM_TOKENS = 64, D_FF = 256;
#else
constexpr int BATCH = 8, SEQ = 2048, DEC_BATCH = 32, PAST_LEN = 8192, MEM_TOKENS = 256, D_FF = 2816;
#endif
constexpr int D_MODEL = 1024, DEC_SEQ = 8, PAGE_SIZE = 128;
constexpr int NSA_HEADS = 8, NSA_KVH = 2, NSA_HD = 64, NSA_G = 4;
constexpr int CMP_BLOCK = 32, CMP_STRIDE = 16, SEL_BLOCK = 64, SEL_TOPN = 8, WINDOW = 512;
constexpr int GDN_HEADS = 4, GDN_HD = 128, GDN_CONV = 4;
constexpr int XA_HEADS = 4, XA_HD = 256, FFN_CONV = 3;
constexpr float EPS = 1e-6f, NEGF = -1e30f, FORCED_BONUS = 1e4f;
constexpr int NSA_Q_W = 512, NSA_KV_W = 768, NSA_GATE_W = 24, GDN_W = 512;
constexpr int IN_COLS = 3360, LDP = 3584;
constexpr int OFF_Q = 0, OFF_KV = 512, OFF_GATE = 1280, OFF_QKV = 1304, OFF_Z = 2840, OFF_B = 3352, OFF_A = 3356;
constexpr int MP = BATCH * SEQ, MS = DEC_BATCH * DEC_SEQ, MTOT = MP + MS;
constexpr int MMEM = BATCH * MEM_TOKENS;
constexpr int NPAGES = PAST_LEN / PAGE_SIZE;
constexpr int NCP = SEQ / CMP_STRIDE - 1;
constexpr int NCS = PAST_LEN / CMP_STRIDE - 1;
constexpr int NCPS = 128, NCSS = 512;
constexpr int NSELP = SEQ / SEL_BLOCK;
constexpr int NSELS = PAST_LEN / SEL_BLOCK + 1;
constexpr int NSELMAX = 160;
constexpr int WINP = (WINDOW < SEQ ? WINDOW : SEQ);
constexpr int WBUF = (WINDOW < PAST_LEN ? WINDOW : PAST_LEN);
constexpr int WINS = (WINDOW < WBUF + DEC_SEQ ? WINDOW : WBUF + DEC_SEQ);
static_assert(NCP <= NCPS && NCS <= NCSS && NSELS <= NSELMAX && NSELP <= NSELMAX, "strides");
static_assert(WBUF == WINDOW && WINP == WINDOW && WINS == WINDOW, "window assumptions");

constexpr size_t O_YP = 0;
constexpr size_t O_YS = O_YP + (size_t)MP * D_MODEL;
constexpr size_t O_KVP = O_YS + (size_t)MS * D_MODEL;
constexpr size_t O_WINP = O_KVP + (size_t)MP * 512;
constexpr size_t O_STP = O_WINP + (size_t)BATCH * WINP * 256;
constexpr size_t O_GCP = O_STP + (size_t)BATCH * 4 * 128 * 128;
constexpr size_t O_FCP = O_GCP + (size_t)BATCH * 3 * 1536;
constexpr size_t O_MKVP = O_FCP + (size_t)BATCH * 2 * 2 * D_FF;
constexpr size_t O_KVS = O_MKVP + (size_t)MMEM * 2048;
constexpr size_t O_WINS = O_KVS + (size_t)MS * 512;
constexpr size_t O_STS = O_WINS + (size_t)DEC_BATCH * WINS * 256;
constexpr size_t O_GCS = O_STS + (size_t)DEC_BATCH * 4 * 128 * 128;
constexpr size_t O_FCS = O_GCS + (size_t)DEC_BATCH * 3 * 1536;
constexpr size_t O_END = O_FCS + (size_t)DEC_BATCH * 2 * 2 * D_FF;

typedef unsigned short bf16_t;
HD unsigned f2bf_u(float f) { unsigned u = __builtin_bit_cast(unsigned, f); return (u + 0x7fffu + ((u >> 16) & 1u)) >> 16; }
HD bf16_t f2bf(float f) { return (bf16_t)f2bf_u(f); }
HD float bf2f(bf16_t b) { return __builtin_bit_cast(float, (unsigned)b << 16); }
HD float sigmoidf_(float x) { return 1.f / (1.f + expf(-x)); }
HD float siluf_(float x) { return x / (1.f + expf(-x)); }
HD float softplusf_(float x) { return x > 20.f ? x : log1pf(expf(x)); }

struct Ctx {
  const float *x_prompt, *x_sample, *mem_prompt, *cache_nsa_kv, *cache_nsa_win, *state_gdn, *cache_gdn_conv, *cache_ffn_conv, *cache_mem_kv;
  const int* page_table;
  const float *attn_norm_w, *w_in, *nsa_q_norm_w, *nsa_k_norm_w, *cmp_pe, *cmp_w, *gdn_conv_w, *gdn_a_log, *gdn_dt_bias, *gdn_norm_w, *w_out,
      *mem_norm_w, *w_xk, *w_xv, *xk_norm_w, *xattn_norm_w, *w_xq, *xq_norm_w, *w_xo, *ffn_norm_w, *w_up, *ffn_conv_w, *ffn_conv_b, *w_down;
  float* out;
  bf16_t *XN, *MN, *CAT, *OX, *ACT;
  float *P, *MKV, *QC, *QR, *WR, *GATE, *GQ, *GK, *GV, *GB, *GG, *KCMP, *VCMP, *SCP, *SCS, *SCORE, *SS, *SW, *OG, *H1, *Q2, *SX, *H2, *UP;
  int* SIDX;
};

HD int row_b(int m) { return m < MP ? m / SEQ : (m - MP) / DEC_SEQ; }
HD int row_t(int m) { return m < MP ? m % SEQ : (m - MP) % DEC_SEQ; }
HD int row_pos(int m) { return m < MP ? m % SEQ : PAST_LEN + (m - MP) % DEC_SEQ; }
HD const float* x_row(const Ctx& c, int m) { return m < MP ? c.x_prompt + (size_t)m * D_MODEL : c.x_sample + (size_t)(m - MP) * D_MODEL; }
HD float* kvrow_out(const Ctx& c, int m) { return m < MP ? c.out + O_KVP + (size_t)m * 512 : c.out + O_KVS + (size_t)(m - MP) * 512; }

struct StRms0 { const Ctx& c; static constexpr long N = MTOT + MMEM;
  HD void operator()(long i) const {
    const float* src; const float* w; bf16_t* dst;
    if (i < MTOT) { src = x_row(c, (int)i); w = c.attn_norm_w; dst = c.XN + (size_t)i * D_MODEL; }
    else { const long mm = i - MTOT; src = c.mem_prompt + (size_t)mm * D_MODEL; w = c.mem_norm_w; dst = c.MN + (size_t)mm * D_MODEL; }
    float ss = 0.f; for (int d = 0; d < D_MODEL; ++d) ss += src[d] * src[d];
    const float r = 1.f / sqrtf(ss / D_MODEL + EPS);
    for (int d = 0; d < D_MODEL; ++d) dst[d] = f2bf(src[d] * r * w[d]);
  } };
struct StRmsRows { const float* src; const float* w; bf16_t* dst; static constexpr long N = MTOT;
  HD void operator()(long i) const {
    const float* s = src + (size_t)i * D_MODEL; bf16_t* o = dst + (size_t)i * D_MODEL;
    float ss = 0.f; for (int d = 0; d < D_MODEL; ++d) ss += s[d] * s[d];
    const float r = 1.f / sqrtf(ss / D_MODEL + EPS);
    for (int d = 0; d < D_MODEL; ++d) o[d] = f2bf(s[d] * r * w[d]);
  } };
HD void rope_pair(float x1, float x2, int i, int pos, float& o1, float& o2) {
  const float inv = powf(10000.f, -(float)i / 32.f); const float ang = (float)pos * inv;
  const float cs = cosf(ang), sn = sinf(ang); o1 = x1 * cs - x2 * sn; o2 = x1 * sn + x2 * cs;
}
struct StQ { const Ctx& c; static constexpr long N = (long)MTOT * NSA_HEADS;
  HD void operator()(long i) const {
    const int m = (int)(i / NSA_HEADS), h = (int)(i % NSA_HEADS); const float* p = c.P + (size_t)m * LDP + OFF_Q + h * 64;
    float ss = 0.f; for (int d = 0; d < 64; ++d) ss += p[d] * p[d];
    const float r = 1.f / sqrtf(ss / 64.f + EPS); const int pos = row_pos(m);
    float* qc = c.QC + (size_t)m * 512 + h * 64; float* qr = c.QR + (size_t)m * 512 + h * 64;
    for (int d = 0; d < 32; ++d) { const float a = p[d] * r * c.nsa_q_norm_w[d], b = p[d + 32] * r * c.nsa_q_norm_w[d + 32];
      qc[d] = a; qc[d + 32] = b; float o1, o2; rope_pair(a, b, d, pos, o1, o2); qr[d] = o1; qr[d + 32] = o2; }
  } };
struct StKV { const Ctx& c; static constexpr long N = (long)MTOT * 6;
  HD void operator()(long i) const {
    const int m = (int)(i / 6), br = (int)(i % 6) / 2, kvh = (int)(i % 2); const float* pk = c.P + (size_t)m * LDP + OFF_KV + ((br * 2 + 0) * 2 + kvh) * 64;
    const float* pv = c.P + (size_t)m * LDP + OFF_KV + ((br * 2 + 1) * 2 + kvh) * 64;
    float ss = 0.f; for (int d = 0; d < 64; ++d) ss += pk[d] * pk[d];
    const float r = 1.f / sqrtf(ss / 64.f + EPS); const int pos = row_pos(m); const float* w = c.nsa_k_norm_w + br * 64;
    float *ko, *vo;
    if (br < 2) { float* ro = kvrow_out(c, m); ko = ro + ((br * 2 + 0) * 2 + kvh) * 64; vo = ro + ((br * 2 + 1) * 2 + kvh) * 64; }
    else { float* wo = c.WR + (size_t)m * 256; ko = wo + (0 * 2 + kvh) * 64; vo = wo + (1 * 2 + kvh) * 64; }
    for (int d = 0; d < 32; ++d) { const float a = pk[d] * r * w[d], b = pk[d + 32] * r * w[d + 32];
      if (br == 0) { ko[d] = a; ko[d + 32] = b; } else { float o1, o2; rope_pair(a, b, d, pos, o1, o2); ko[d] = o1; ko[d + 32] = o2; } }
    for (int d = 0; d < 64; ++d) vo[d] = pv[d];
  } };
struct StWinOut { const Ctx& c; static constexpr long N = (long)(BATCH + DEC_BATCH) * WINDOW * 256;
  HD void operator()(long i) const {
    const int e = (int)(i % 256); const long r = i / 256; const int j = (int)(r % WINDOW), bb = (int)(r / WINDOW);
    if (bb < BATCH) c.out[O_WINP + ((size_t)bb * WINDOW + j) * 256 + e] = c.WR[((size_t)bb * SEQ + SEQ - WINDOW + j) * 256 + e];
    else { const int b = bb - BATCH; const int w = j + DEC_SEQ;
      const float v = w < WBUF ? c.cache_nsa_win[((size_t)b * WBUF + w) * 256 + e] : c.WR[((size_t)MP + b * DEC_SEQ + (w - WBUF)) * 256 + e];
      c.out[O_WINS + ((size_t)b * WINDOW + j) * 256 + e] = v; }
  } };
struct StGate { const Ctx& c; static constexpr long N = (long)MTOT * 24;
  HD void operator()(long i) const { const int m = (int)(i / 24), e = (int)(i % 24); c.GATE[(size_t)m * 24 + e] = sigmoidf_(c.P[(size_t)m * LDP + OFF_GATE + e]); } };
HD float gdn_pre(const Ctx& c, int m, int dt_back, int ch) {
  const int t = row_t(m) - dt_back;
  if (t >= 0) return c.P[(size_t)(m - dt_back) * LDP + OFF_QKV + ch];
  if (m < MP) return 0.f;
  const int b = (m - MP) / DEC_SEQ; return c.cache_gdn_conv[((size_t)b * 3 + (3 + t)) * 1536 + ch];
}
struct StGdnConv { const Ctx& c; static constexpr long N = (long)MTOT * 12;
  HD void operator()(long i) const {
    const int m = (int)(i / 12), part = (int)(i % 12), which = part / 4, h = part % 4; const int ch0 = which * 512 + h * 128;
    float* dst = (which == 0 ? c.GQ : which == 1 ? c.GK : c.GV) + (size_t)m * 512 + h * 128;
    float ss = 0.f;
    for (int d = 0; d < 128; ++d) { const int ch = ch0 + d; float y = 0.f;
      for (int k = 0; k < 4; ++k) y += c.gdn_conv_w[k * 1536 + ch] * gdn_pre(c, m, 3 - k, ch);
      y = siluf_(y); dst[d] = y; ss += y * y; }
    if (which < 2) { const float r = (1.f / sqrtf(ss + EPS)) * (which == 0 ? 0.08838834764831845f : 1.f); for (int d = 0; d < 128; ++d) dst[d] *= r; }
  } };
struct StGdnMisc { const Ctx& c; static constexpr long N = (long)MTOT * 4;
  HD void operator()(long i) const {
    const int m = (int)(i / 4), h = (int)(i % 4); const float* p = c.P + (size_t)m * LDP;
    c.GB[i] = sigmoidf_(p[OFF_B + h]); c.GG[i] = -expf(c.gdn_a_log[h]) * softplusf_(p[OFF_A + h] + c.gdn_dt_bias[h]);
  } };
struct StGdnConvOut { const Ctx& c; static constexpr long N = (long)(BATCH + DEC_BATCH) * 3 * 1536;
  HD void operator()(long i) const {
    const int ch = (int)(i % 1536); const int r = (int)((i / 1536) % 3), bb = (int)(i / (3 * 1536));
    if (bb < BATCH) c.out[O_GCP + i] = c.P[((size_t)bb * SEQ + SEQ - 3 + r) * LDP + OFF_QKV + ch];
    else { const int b = bb - BATCH; c.out[O_GCS + ((size_t)b * 3 + r) * 1536 + ch] = c.P[((size_t)MP + b * DEC_SEQ + DEC_SEQ - 3 + r) * LDP + OFF_QKV + ch]; }
  } };
HD const float* nsa_row(const Ctx& c, bool sample, int b, int pos, int r, int kvh) {
  if (!sample) return c.out + O_KVP + ((size_t)b * SEQ + pos) * 512 + (r * 2 + kvh) * 64;
  if (pos < PAST_LEN) { const int pg = c.page_table[b * NPAGES + pos / PAGE_SIZE]; return c.cache_nsa_kv + ((size_t)pg * PAGE_SIZE + pos % PAGE_SIZE) * 512 + (r * 2 + kvh) * 64; }
  return c.out + O_KVS + ((size_t)b * DEC_SEQ + (pos - PAST_LEN)) * 512 + (r * 2 + kvh) * 64;
}
constexpr long NCMP_ITEMS_P = (long)BATCH * NCP * 2 * 2 * 64, NCMP_ITEMS_S = (long)DEC_BATCH * NCS * 2 * 2 * 64;
struct StCompress { const Ctx& c; static constexpr long N = NCMP_ITEMS_P + NCMP_ITEMS_S;
  HD void operator()(long i) const {
    const bool sample = i >= NCMP_ITEMS_P; long r = sample ? i - NCMP_ITEMS_P : i; const int nc = sample ? NCS : NCP;
    const int e = (int)(r % 64); r /= 64; const int kv = (int)(r % 2); r /= 2; const int kvh = (int)(r % 2); r /= 2; const int cb = (int)(r % nc), b = (int)(r / nc);
    const float* W = c.cmp_w + (size_t)kv * 32 * 64 * 64; const float* pe = c.cmp_pe + (size_t)kv * 32 * 64;
    float acc = 0.f;
    for (int j = 0; j < 32; ++j) { const float* x = nsa_row(c, sample, b, 16 * cb + j, kv, kvh);
      for (int d = 0; d < 64; ++d) acc += (x[d] + pe[j * 64 + d]) * W[((size_t)j * 64 + d) * 64 + e]; }
    float* dst = (kv == 0 ? c.KCMP : c.VCMP) + (sample ? (size_t)BATCH * NCP * 128 : 0) + (((size_t)b * nc + cb) * 2 + kvh) * 64 + e;
    *dst = acc;
  } };
HD const float* cmp_ptr(const Ctx& c, const float* base, bool sample, int b, int cb, int kvh) {
  return base + (sample ? (size_t)BATCH * NCP * 128 : 0) + (((size_t)b * (sample ? NCS : NCP) + cb) * 2 + kvh) * 64; }
HD float* scmp_ptr(const Ctx& c, int m, int h) { return m < MP ? c.SCP + ((size_t)m * 8 + h) * NCPS : c.SCS + ((size_t)(m - MP) * 8 + h) * NCSS; }
constexpr long NSC_P = (long)MP * 8 * NCPS, NSC_S = (long)MS * 8 * NCSS;
struct StCmpScore { const Ctx& c; static constexpr long N = NSC_P + NSC_S;
  HD void operator()(long i) const {
    const bool sample = i >= NSC_P; const long r = sample ? i - NSC_P : i; const int st = sample ? NCSS : NCPS, nc = sample ? NCS : NCP;
    const int cb = (int)(r % st), h = (int)((r / st) % 8); const int m = (int)(r / st / 8) + (sample ? MP : 0);
    float* dst = scmp_ptr(c, m, h) + cb; const int pos = row_pos(m);
    if (cb >= nc || 16 * cb + 31 > pos) { *dst = -3e38f; return; }
    const float* q = c.QC + (size_t)m * 512 + h * 64; const float* k = cmp_ptr(c, c.KCMP, sample, row_b(m), cb, h / 4);
    float s = 0.f; for (int d = 0; d < 64; ++d) s += q[d] * k[d];
    *dst = s * 0.125f;
  } };
HD void softmax_inplace(float* s, int n) {
  float mx = -3e38f; for (int j = 0; j < n; ++j) mx = fmaxf(mx, s[j]);
  if (mx < -1e38f) { for (int j = 0; j < n; ++j) s[j] = 0.f; return; }
  float sum = 0.f; for (int j = 0; j < n; ++j) { const float v = s[j]; if (v > -1e38f) sum += expf(v - mx); }
  const float inv = 1.f / fmaxf(sum, 1e-30f);
  for (int j = 0; j < n; ++j) { const float v = s[j]; s[j] = v > -1e38f ? expf(v - mx) * inv : 0.f; }
}
struct StCmpSoftmax { const Ctx& c; static constexpr long N = (long)MTOT * 8;
  HD void operator()(long i) const { const int m = (int)(i / 8), h = (int)(i % 8); softmax_inplace(scmp_ptr(c, m, h), m < MP ? NCPS : NCSS); } };
struct StTopk { const Ctx& c; static constexpr long N = (long)MTOT * 2;
  HD void operator()(long i) const {
    const int m = (int)(i / 2), kvh = (int)(i % 2); const bool sample = m >= MP; const int nsel = sample ? NSELS : NSELP, nc = sample ? NCS : NCP;
    const int pos = row_pos(m), qblk = pos / SEL_BLOCK; float* sc = c.SCORE + (size_t)i * NSELMAX;
    for (int s = 0; s < nsel; ++s) {
      float imp = 0.f;
      for (int g = 0; g < 4; ++g) { const float* p = scmp_ptr(c, m, kvh * 4 + g);
        for (int cb = 4 * s - 1; cb <= 4 * s + 3; ++cb) if (cb >= 0 && cb < nc) imp += p[cb]; }
      const bool visible = s <= qblk, forced = (s == 0) || (s == qblk) || (s == qblk - 1);
      sc[s] = visible ? imp + (forced ? FORCED_BONUS : 0.f) : NEGF;
    }
    const int ntop = nsel < SEL_TOPN ? nsel : SEL_TOPN;
    for (int n = 0; n < SEL_TOPN; ++n) {
      int best = -1; float bv = -3e38f;
      if (n < ntop) { for (int s = 0; s < nsel; ++s) if (sc[s] > bv) { bv = sc[s]; best = s; } }
      if (best >= 0) sc[best] = -3.2e38f;
      c.SIDX[i * 8 + n] = (best >= 0 && bv > 0.5f * NEGF) ? best : -1;
    }
  } };
struct StSelScore { const Ctx& c; static constexpr long N = (long)MTOT * 8 * 512;
  HD void operator()(long i) const {
    const int j = (int)(i % 64), n = (int)((i / 64) % 8), h = (int)((i / 512) % 8), m = (int)(i / 4096); const bool sample = m >= MP;
    const int blk = c.SIDX[((size_t)m * 2 + h / 4) * 8 + n]; const int pos = row_pos(m), key = blk * 64 + j;
    if (blk < 0 || key > pos) { c.SS[i] = -3e38f; return; }
    const float* q = c.QR + (size_t)m * 512 + h * 64; const float* k = nsa_row(c, sample, row_b(m), key, 2, h / 4);
    float s = 0.f; for (int d = 0; d < 64; ++d) s += q[d] * k[d];
    c.SS[i] = s * 0.125f;
  } };
HD const float* win_row(const Ctx& c, int m, int j, int which, int kvh) {
  const int pos = row_pos(m), kp = pos - (WINDOW - 1) + j; if (kp < 0) return nullptr;
  if (m < MP) return c.WR + ((size_t)(m / SEQ) * SEQ + kp) * 256 + (which * 2 + kvh) * 64;
  const int b = (m - MP) / DEC_SEQ;
  if (kp < PAST_LEN) return c.cache_nsa_win + ((size_t)b * WBUF + (kp - (PAST_LEN - WBUF))) * 256 + (which * 2 + kvh) * 64;
  return c.WR + ((size_t)MP + b * DEC_SEQ + (kp - PAST_LEN)) * 256 + (which * 2 + kvh) * 64;
}
struct StWinScore { const Ctx& c; static constexpr long N = (long)MTOT * 8 * 512;
  HD void operator()(long i) const {
    const int j = (int)(i % 512), h = (int)((i / 512) % 8), m = (int)(i / 4096);
    const float* k = win_row(c, m, j, 0, h / 4); if (!k) { c.SW[i] = -3e38f; return; }
    const float* q = c.QR + (size_t)m * 512 + h * 64; float s = 0.f; for (int d = 0; d < 64; ++d) s += q[d] * k[d];
    c.SW[i] = s * 0.125f;
  } };
struct StSoftmax512 { float* buf; static constexpr long N = (long)MTOT * 8;
  HD void operator()(long i) const { softmax_inplace(buf + (size_t)i * 512, 512); } };
struct StNsaOut { const Ctx& c; static constexpr long N = (long)MTOT * 512;
  HD void operator()(long i) const {
    const int d = (int)(i % 64), h = (int)((i / 64) % 8), m = (int)(i / 512), kvh = h / 4; const bool sample = m >= MP; const int b = row_b(m);
    const float* pc = scmp_ptr(c, m, h); const int nc = sample ? NCS : NCP;
    float oc = 0.f; for (int cb = 0; cb < nc; ++cb) { const float p = pc[cb]; if (p != 0.f) oc += p * cmp_ptr(c, c.VCMP, sample, b, cb, kvh)[d]; }
    const float* ps = c.SS + ((size_t)m * 8 + h) * 512; float os = 0.f;
    for (int n = 0; n < 8; ++n) { const int blk = c.SIDX[((size_t)m * 2 + kvh) * 8 + n]; if (blk < 0) continue;
      for (int j = 0; j < 64; ++j) { const float p = ps[n * 64 + j]; if (p != 0.f) os += p * nsa_row(c, sample, b, blk * 64 + j, 3, kvh)[d]; } }
    const float* pw = c.SW + ((size_t)m * 8 + h) * 512; float ow = 0.f;
    for (int j = 0; j < 512; ++j) { const float p = pw[j]; if (p != 0.f) ow += p * win_row(c, m, j, 1, kvh)[d]; }
    const float* g = c.GATE + (size_t)m * 24 + h * 3;
    c.CAT[(size_t)m * D_MODEL + h * 64 + d] = f2bf(oc * g[0] + os * g[1] + ow * g[2]);
  } };
#if defined(__HIP_DEVICE_COMPILE__)
#define GDN_FENCE() asm volatile("" ::: "memory")
#else
#define GDN_FENCE() do {} while (0)
#endif
struct StGdnScan { const Ctx& c; static constexpr long N = (long)(BATCH + DEC_BATCH) * 4 * 128;
  HD void operator()(long i) const {
    const int dv = (int)(i % 128), h = (int)((i / 128) % 4), bb = (int)(i / 512); const bool sample = bb >= BATCH; const int b = sample ? bb - BATCH : bb;
    const int T = sample ? DEC_SEQ : SEQ; const int m0 = sample ? MP + b * DEC_SEQ : b * SEQ;
    float S[128];
#pragma unroll
    for (int k = 0; k < 128; ++k) S[k] = sample ? c.state_gdn[(((size_t)b * 4 + h) * 128 + k) * 128 + dv] : 0.f;
    for (int t = 0; t < T; ++t) { const int m = m0 + t;
      const float* kk = c.GK + (size_t)m * 512 + h * 128; const float* qq = c.GQ + (size_t)m * 512 + h * 128;
      const float v = c.GV[(size_t)m * 512 + h * 128 + dv], beta = c.GB[(size_t)m * 4 + h], a = expf(c.GG[(size_t)m * 4 + h]);
      float ks = 0.f;
#pragma unroll
      for (int k0 = 0; k0 < 128; k0 += 16) {
#pragma unroll
        for (int k = 0; k < 16; ++k) ks += kk[k0 + k] * S[k0 + k];
        GDN_FENCE(); }
      const float coef = beta * (v - a * ks); float o = 0.f;
#pragma unroll
      for (int k0 = 0; k0 < 128; k0 += 16) {
#pragma unroll
        for (int k = 0; k < 16; ++k) { S[k0 + k] = a * S[k0 + k] + kk[k0 + k] * coef; o += qq[k0 + k] * S[k0 + k]; }
        GDN_FENCE(); }
      c.OG[(size_t)m * 512 + h * 128 + dv] = o; }
    float* so = c.out + (sample ? O_STS : O_STP) + (((size_t)b * 4 + h) * 128) * 128 + dv;
#pragma unroll
    for (int k = 0; k < 128; ++k) so[(size_t)k * 128] = S[k];
  } };
struct StGdnNorm { const Ctx& c; static constexpr long N = (long)MTOT * 4;
  HD void operator()(long i) const {
    const int m = (int)(i / 4), h = (int)(i % 4); const float* o = c.OG + (size_t)m * 512 + h * 128; const float* z = c.P + (size_t)m * LDP + OFF_Z + h * 128;
    float ss = 0.f; for (int d = 0; d < 128; ++d) ss += o[d] * o[d];
    const float r = 1.f / sqrtf(ss / 128.f + EPS);
    for (int d = 0; d < 128; ++d) c.CAT[(size_t)m * D_MODEL + 512 + h * 128 + d] = f2bf(o[d] * r * c.gdn_norm_w[d] * siluf_(z[d]));
  } };
struct StMemKV { const Ctx& c; static constexpr long N = (long)MMEM * 4;
  HD void operator()(long i) const {
    const int mm = (int)(i / 4), h = (int)(i % 4); const float* k = c.MKV + (size_t)mm * 2048 + h * 256; const float* v = c.MKV + (size_t)mm * 2048 + 1024 + h * 256;
    float ss = 0.f; for (int d = 0; d < 256; ++d) ss += k[d] * k[d];
    const float r = 1.f / sqrtf(ss / 256.f + EPS); float* o = c.out + O_MKVP + (size_t)mm * 2048;
    for (int d = 0; d < 256; ++d) { o[h * 256 + d] = k[d] * r * c.xk_norm_w[d]; o[1024 + h * 256 + d] = v[d]; }
  } };
struct StXqNorm { const Ctx& c; static constexpr long N = (long)MTOT * 4;
  HD void operator()(long i) const {
    float* q = c.Q2 + (size_t)(i / 4) * D_MODEL + (i % 4) * 256; float ss = 0.f; for (int d = 0; d < 256; ++d) ss += q[d] * q[d];
    const float r = 1.f / sqrtf(ss / 256.f + EPS); for (int d = 0; d < 256; ++d) q[d] = q[d] * r * c.xq_norm_w[d];
  } };
HD const float* memkv_row(const Ctx& c, int m, int j, int which, int h) {
  if (m < MP) return c.out + O_MKVP + ((size_t)(m / SEQ) * MEM_TOKENS + j) * 2048 + which * 1024 + h * 256;
  return c.cache_mem_kv + ((size_t)((m - MP) / DEC_SEQ) * MEM_TOKENS + j) * 2048 + which * 1024 + h * 256;
}
struct StXScore { const Ctx& c; static constexpr long N = (long)MTOT * 4 * MEM_TOKENS;
  HD void operator()(long i) const {
    const int j = (int)(i % MEM_TOKENS), h = (int)((i / MEM_TOKENS) % 4), m = (int)(i / MEM_TOKENS / 4);
    const float* q = c.Q2 + (size_t)m * D_MODEL + h * 256; const float* k = memkv_row(c, m, j, 0, h);
    float s = 0.f; for (int d = 0; d < 256; ++d) s += q[d] * k[d];
    c.SX[i] = s * 0.0625f;
  } };
struct StXSoftmax { const Ctx& c; static constexpr long N = (long)MTOT * 4;
  HD void operator()(long i) const { softmax_inplace(c.SX + (size_t)i * MEM_TOKENS, MEM_TOKENS); } };
struct StXOut { const Ctx& c; static constexpr long N = (long)MTOT * D_MODEL;
  HD void operator()(long i) const {
    const int d = (int)(i % 256), h = (int)((i / 256) % 4), m = (int)(i / D_MODEL); const float* p = c.SX + ((size_t)m * 4 + h) * MEM_TOKENS;
    float o = 0.f; for (int j = 0; j < MEM_TOKENS; ++j) o += p[j] * memkv_row(c, m, j, 1, h)[d];
    c.OX[i] = f2bf(o);
  } };
HD float up_at(const Ctx& c, int m, int back, int col) {
  const int t = row_t(m) - back; if (t >= 0) return c.UP[(size_t)(m - back) * (2 * D_FF) + col];
  if (m < MP) return 0.f;
  return c.cache_ffn_conv[((size_t)((m - MP) / DEC_SEQ) * 2 + (2 + t)) * (2 * D_FF) + col];
}
struct StFfnAct { const Ctx& c; static constexpr long N = (long)MTOT * D_FF;
  HD void operator()(long i) const {
    const int col = (int)(i % D_FF), m = (int)(i / D_FF); float a = c.ffn_conv_b[col], u = c.ffn_conv_b[D_FF + col];
    for (int k = 0; k < 3; ++k) { a += c.ffn_conv_w[k * 2 * D_FF + col] * up_at(c, m, 2 - k, col); u += c.ffn_conv_w[k * 2 * D_FF + D_FF + col] * up_at(c, m, 2 - k, D_FF + col); }
    c.ACT[i] = f2bf(siluf_(a) * u);
  } };
struct StFfnConvOut { const Ctx& c; static constexpr long N = (long)(BATCH + DEC_BATCH) * 2 * 2 * D_FF;
  HD void operator()(long i) const {
    const int col = (int)(i % (2 * D_FF)), r = (int)((i / (2 * D_FF)) % 2), bb = (int)(i / (4 * D_FF));
    if (bb < BATCH) c.out[O_FCP + i] = c.UP[((size_t)bb * SEQ + SEQ - 2 + r) * (2 * D_FF) + col];
    else { const int b = bb - BATCH; c.out[O_FCS + ((size_t)b * 2 + r) * (2 * D_FF) + col] = c.UP[((size_t)MP + b * DEC_SEQ + DEC_SEQ - 2 + r) * (2 * D_FF) + col]; }
  } };

struct WsMap { size_t off; HD size_t take(size_t bytes) { const size_t o = off; off += (bytes + 255) & ~(size_t)255; return o; } };
inline size_t ws_carve(Ctx& c, unsigned char* ws, size_t base) {
  WsMap w{base};
  c.XN = (bf16_t*)(ws + w.take((size_t)MTOT * D_MODEL * 2)); c.MN = (bf16_t*)(ws + w.take((size_t)MMEM * D_MODEL * 2));
  c.CAT = (bf16_t*)(ws + w.take((size_t)MTOT * D_MODEL * 2)); c.OX = (bf16_t*)(ws + w.take((size_t)MTOT * D_MODEL * 2));
  c.ACT = (bf16_t*)(ws + w.take((size_t)MTOT * D_FF * 2));
  c.P = (float*)(ws + w.take((size_t)MTOT * LDP * 4)); c.MKV = (float*)(ws + w.take((size_t)MMEM * 2048 * 4));
  c.QC = (float*)(ws + w.take((size_t)MTOT * 512 * 4)); c.QR = (float*)(ws + w.take((size_t)MTOT * 512 * 4));
  c.WR = (float*)(ws + w.take((size_t)MTOT * 256 * 4)); c.GATE = (float*)(ws + w.take((size_t)MTOT * 24 * 4));
  c.GQ = (float*)(ws + w.take((size_t)MTOT * 512 * 4)); c.GK = (float*)(ws + w.take((size_t)MTOT * 512 * 4)); c.GV = (float*)(ws + w.take((size_t)MTOT * 512 * 4));
  c.GB = (float*)(ws + w.take((size_t)MTOT * 4 * 4)); c.GG = (float*)(ws + w.take((size_t)MTOT * 4 * 4));
  const size_t ncmp = ((size_t)BATCH * NCP + (size_t)DEC_BATCH * NCS) * 128 * 4;
  c.KCMP = (float*)(ws + w.take(ncmp)); c.VCMP = (float*)(ws + w.take(ncmp));
  c.SCP = (float*)(ws + w.take((size_t)MP * 8 * NCPS * 4)); c.SCS = (float*)(ws + w.take((size_t)MS * 8 * NCSS * 4));
  c.SCORE = (float*)(ws + w.take((size_t)MTOT * 2 * NSELMAX * 4)); c.SIDX = (int*)(ws + w.take((size_t)MTOT * 2 * 8 * 4));
  c.OG = (float*)(ws + w.take((size_t)MTOT * 512 * 4)); c.H1 = (float*)(ws + w.take((size_t)MTOT * D_MODEL * 4));
  c.Q2 = (float*)(ws + w.take((size_t)MTOT * D_MODEL * 4)); c.SX = (float*)(ws + w.take((size_t)MTOT * 4 * MEM_TOKENS * 4));
  c.H2 = (float*)(ws + w.take((size_t)MTOT * D_MODEL * 4));
  const size_t ssb = (size_t)MTOT * 8 * 512 * 4, upb = (size_t)MTOT * 2 * D_FF * 4; const size_t big = w.take(2 * ssb > upb ? 2 * ssb : upb);
  c.SS = (float*)(ws + big); c.SW = (float*)(ws + big + ssb); c.UP = (float*)(ws + big);
  return w.off;
}
namespace pg8 {
#define PG8_LAS __attribute__((address_space(3)))
typedef unsigned short bf16_t;
typedef short bf16x8 __attribute__((ext_vector_type(8)));
typedef float f32x4 __attribute__((ext_vector_type(4)));
typedef unsigned u32x4 __attribute__((ext_vector_type(4)));
constexpr int BM = 256, BK = 64, HALF = 128, HTB = HALF * BK * 2  , STAGE_BYTES = 8 * HTB, NXCD = 8, WGM = 8;

__host__ __device__ __forceinline__ int lds_byte(int r, int c) { const int st = (r >> 4) * 2 + (c >> 5), rr = r & 15, cc = c & 31, ob = rr * 64 + cc * 2; return st * 1024 + (ob ^ (((ob >> 9) & 1) << 5)); }
__host__ __device__ __forceinline__ void stage_rc(int b, int& R, int& C) { const int st = b / 1024, sb = b % 1024, swz = sb ^ (((sb >> 9) & 1) << 5); R = (st >> 1) * 16 + swz / 64; C = (st & 1) * 32 + (swz % 64) / 2; }
__host__ __device__ __forceinline__ int perm32(int rho) { const int n = rho >> 4, i = rho & 15; return 8 * (i >> 2) + 4 * n + (i & 3); }

struct Unit { int pm, pn; };
struct Gemm { const bf16_t* A; const bf16_t* Bt; int M, N, K; };

struct StaticOrder {
    int nM, nN, nwg, G, c;
    __host__ __device__ void init(int M, int N, int G_, int c_) { nM = M / BM; nN = N / BM; nwg = nM * nN; G = G_; c = c_; }
    __host__ __device__ bool next(int i, Unit& u) const {
        const long L = (long)i * G + c; if (L >= nwg) return false;
        int wgid = (int)L; { const int q = nwg / NXCD, r = nwg % NXCD, xcd = wgid % NXCD, off = wgid / NXCD; wgid = (xcd < r ? xcd * (q + 1) : r * (q + 1) + (xcd - r) * q) + off; }
        const int nig = WGM * nN, gid = wgid / nig, fm = gid * WGM, gsz = (nM - fm) < WGM ? (nM - fm) : WGM;
        u.pm = fm + ((wgid % nig) % gsz); u.pn = (wgid % nig) / gsz; return true;
    }
    __device__ __forceinline__ void a_ready(const Unit&) const {}
    __device__ __forceinline__ void done(const Unit&) const {}
};

struct EpiF32 { static constexpr bool PERM = false, AFTER_DRAIN = false;
  float* C; int ldc; const float* resP; const float* resS; int mp;
  __device__ __forceinline__ void operator()(const f32x4 (&acc)[2][2][4][2], const Unit& u, int wr, int wc, int fr, int fq) const {
#pragma unroll
    for (int ai = 0; ai < 2; ++ai)
#pragma unroll
      for (int m = 0; m < 4; ++m) {
        const int row = u.pm * BM + ai * HALF + wr * 64 + m * 16 + fr;
        float* crow = C + (size_t)row * ldc;
        const float* rrow = resP ? (row < mp ? resP + (size_t)row * 1024 : resS + (size_t)(row - mp) * 1024) : nullptr;
#pragma unroll
        for (int bj = 0; bj < 2; ++bj)
#pragma unroll
          for (int n = 0; n < 2; ++n) {
            const int col = u.pn * BM + bj * HALF + wc * 32 + n * 16 + 4 * fq;
            f32x4 v = acc[ai][bj][m][n]; if (rrow) v += *(const f32x4*)(rrow + col);
            *(f32x4*)(crow + col) = v;
          }
      }
  } };
template <class Epi, class Sched, bool ALIGN_EPI = false, bool SP2 = false>
__device__ __forceinline__ void gemm_phase(PG8_LAS unsigned char* lds, const Gemm g, const Sched& S, const Epi& E) {
    const int tid = threadIdx.x, wid = __builtin_amdgcn_readfirstlane(tid >> 6), lane = tid & 63, wr = wid >> 2, wc = wid & 3, fr = lane & 15, fq = lane >> 4;
    const int K = g.K, nt = K / BK;
    unsigned voffA[2], voffB[2];
#pragma unroll
    for (int i = 0; i < 2; ++i) { int R, C; stage_rc(tid * 16 + i * 8192, R, C); const int Rb = Epi::PERM ? ((R & ~31) + perm32(R & 31)) : R;
        voffA[i] = (unsigned)(R * K + C) * 2u; voffB[i] = (unsigned)(Rb * K + C) * 2u; }
    const size_t kstep = (size_t)(BK * 2);
    const size_t hstep = (size_t)HALF * K * 2;
    const size_t tstep = 2 * hstep;
    const unsigned ldsw = (unsigned)wid * 1024u;
    const int aoff = lds_byte(wr * 64 + fr, fq * 8), boff = lds_byte(wc * 32 + fr, fq * 8);
#define PG8_SA(b, h) (((b) * 2 + (h)) * HTB)
#define PG8_SB(b, h) ((4 + (b) * 2 + (h)) * HTB)
#define PG8_STAGE(bufoff, gbase, voff) do { _Pragma("unroll") for (int _i = 0; _i < 2; ++_i) \
        __builtin_amdgcn_global_load_lds((const unsigned*)((const char*)(gbase) + (voff)[_i]), (PG8_LAS unsigned*)(lds + (bufoff) + ldsw + _i * 8192), 16, 0, 0); } while (0)
#define PG8_LDA(dst, b, h) do { _Pragma("unroll") for (int m = 0; m < 4; ++m) _Pragma("unroll") for (int k = 0; k < 2; ++k) dst[m][k] = *(const PG8_LAS bf16x8*)(lds + PG8_SA(b, h) + aoff + m * 2048 + k * 1024); } while (0)
#define PG8_LDB(dst, b, h) do { _Pragma("unroll") for (int n = 0; n < 2; ++n) _Pragma("unroll") for (int k = 0; k < 2; ++k) dst[n][k] = *(const PG8_LAS bf16x8*)(lds + PG8_SB(b, h) + boff + n * 2048 + k * 1024); } while (0)
#define PG8_MMA(ai, bj, At, Bt) do { __builtin_amdgcn_s_setprio(1); _Pragma("unroll") for (int m = 0; m < 4; ++m) _Pragma("unroll") for (int n = 0; n < 2; ++n) _Pragma("unroll") for (int k = 0; k < 2; ++k) \
        acc[ai][bj][m][n] = __builtin_amdgcn_mfma_f32_16x16x32_bf16(Bt[n][k], At[m][k], acc[ai][bj][m][n], 0, 0, 0); __builtin_amdgcn_s_setprio(0); } while (0)
#define PG8_WAIT_V(n) asm volatile("s_waitcnt vmcnt(" #n ")" ::: "memory")
#define PG8_WAIT_L(n) asm volatile("s_waitcnt lgkmcnt(" #n ")" ::: "memory")
#define PG8_BAR __builtin_amdgcn_s_barrier()
#define PG8_SCHED __builtin_amdgcn_sched_barrier(0)
    Unit cur, nxt; int ui = 0;
    if (!S.next(0, cur)) return;
    f32x4 acc[2][2][4][2];
#pragma unroll
    for (int a = 0; a < 2; ++a)
#pragma unroll
        for (int b = 0; b < 2; ++b)
#pragma unroll
            for (int m = 0; m < 4; ++m)
#pragma unroll
                for (int n = 0; n < 2; ++n) acc[a][b][m][n] = (f32x4){0.f, 0.f, 0.f, 0.f};
    bf16x8 At[4][2], B0[2][2], B1[2][2];
    const char* cA = (const char*)g.A + (size_t)cur.pm * tstep; const char* cB = (const char*)g.Bt + (size_t)cur.pn * tstep;
    S.a_ready(cur);
    if constexpr (SP2) {
        PG8_STAGE(PG8_SB(0, 0), cB, voffB); PG8_STAGE(PG8_SB(0, 1), cB + hstep, voffB); PG8_STAGE(PG8_SA(0, 0), cA, voffA); PG8_STAGE(PG8_SA(0, 1), cA + hstep, voffA);
        if (wr == 1) PG8_BAR;
        PG8_WAIT_V(2); PG8_BAR;
        PG8_STAGE(PG8_SB(1, 0), cB + kstep, voffB); PG8_STAGE(PG8_SA(1, 0), cA + kstep, voffA); PG8_STAGE(PG8_SB(1, 1), cB + hstep + kstep, voffB);
        PG8_WAIT_V(6); PG8_BAR;
    } else {
        PG8_STAGE(PG8_SB(0, 0), cB, voffB); PG8_STAGE(PG8_SA(0, 0), cA, voffA); PG8_STAGE(PG8_SB(0, 1), cB + hstep, voffB); PG8_STAGE(PG8_SA(0, 1), cA + hstep, voffA);
        if (wr == 1) PG8_BAR;
        PG8_WAIT_V(4); PG8_BAR;
        PG8_STAGE(PG8_SB(1, 0), cB + kstep, voffB); PG8_STAGE(PG8_SA(1, 0), cA + kstep, voffA); PG8_STAGE(PG8_SB(1, 1), cB + hstep + kstep, voffB);
        PG8_WAIT_V(6); PG8_BAR;
    }
    for (;;) {
        const bool has_next = S.next(ui + 1, nxt);
        const char* nA = has_next ? (const char*)g.A + (size_t)nxt.pm * tstep : cA; const char* nB = has_next ? (const char*)g.Bt + (size_t)nxt.pn * tstep : cB;
        for (int t = 0; t < nt; t += 2) {
            const bool last = (t == nt - 2);
            const char* a1 = cA + (size_t)(t + 1) * kstep;
            const char* a2 = last ? nA : cA + (size_t)(t + 2) * kstep; const char* b2 = last ? nB : cB + (size_t)(t + 2) * kstep;
            const char* a3 = a2 + kstep; const char* b3 = b2 + kstep;
            if (last && has_next) S.a_ready(nxt);
            if constexpr (SP2) {
            PG8_LDB(B0, 0, 0); PG8_LDB(B1, 0, 1); PG8_SCHED; PG8_LDA(At, 0, 0); PG8_STAGE(PG8_SA(1, 1), a1 + hstep, voffA);
            PG8_WAIT_V(8); PG8_WAIT_L(0); PG8_BAR; PG8_MMA(0, 0, At, B0); PG8_MMA(0, 1, At, B1); PG8_BAR; PG8_SCHED;
            PG8_LDA(At, 0, 1); PG8_STAGE(PG8_SB(0, 0), b2, voffB); PG8_STAGE(PG8_SB(0, 1), b2 + hstep, voffB); PG8_STAGE(PG8_SA(0, 0), a2, voffA);
            PG8_WAIT_V(8); PG8_WAIT_L(0); PG8_BAR; PG8_MMA(1, 0, At, B0); PG8_MMA(1, 1, At, B1); PG8_BAR; PG8_SCHED;
            PG8_LDB(B0, 1, 0); PG8_LDB(B1, 1, 1); PG8_SCHED; PG8_LDA(At, 1, 0); PG8_STAGE(PG8_SA(0, 1), a2 + hstep, voffA);
            PG8_WAIT_V(8); PG8_WAIT_L(0); PG8_BAR; PG8_MMA(0, 0, At, B0); PG8_MMA(0, 1, At, B1); PG8_BAR; PG8_SCHED;
            PG8_LDA(At, 1, 1); PG8_STAGE(PG8_SB(1, 0), b3, voffB); PG8_STAGE(PG8_SB(1, 1), b3 + hstep, voffB); PG8_STAGE(PG8_SA(1, 0), a3, voffA);
            PG8_WAIT_V(8); PG8_WAIT_L(0); PG8_BAR; PG8_MMA(1, 0, At, B0); PG8_MMA(1, 1, At, B1); PG8_BAR; PG8_SCHED;
            } else {
            PG8_LDB(B0, 0, 0); PG8_SCHED; PG8_LDA(At, 0, 0); PG8_STAGE(PG8_SA(1, 1), a1 + hstep, voffA);
            PG8_WAIT_L(8); PG8_BAR; PG8_WAIT_L(0); PG8_MMA(0, 0, At, B0); PG8_BAR; PG8_SCHED;
            PG8_LDB(B1, 0, 1); PG8_STAGE(PG8_SB(0, 0), b2, voffB);
            PG8_BAR; PG8_WAIT_L(0); PG8_MMA(0, 1, At, B1); PG8_BAR;
            PG8_LDA(At, 0, 1); PG8_STAGE(PG8_SA(0, 0), a2, voffA);
            PG8_BAR; PG8_WAIT_L(0); PG8_MMA(1, 0, At, B0); PG8_BAR; PG8_SCHED;
            PG8_STAGE(PG8_SB(0, 1), b2 + hstep, voffB);
            PG8_WAIT_V(6); PG8_BAR; PG8_MMA(1, 1, At, B1); PG8_BAR;
            PG8_LDB(B0, 1, 0); PG8_SCHED; PG8_LDA(At, 1, 0); PG8_STAGE(PG8_SA(0, 1), a2 + hstep, voffA);
            PG8_WAIT_L(8); PG8_BAR; PG8_WAIT_L(0); PG8_MMA(0, 0, At, B0); PG8_BAR; PG8_SCHED;
            PG8_LDB(B1, 1, 1); PG8_STAGE(PG8_SB(1, 0), b3, voffB);
            PG8_BAR; PG8_WAIT_L(0); PG8_MMA(0, 1, At, B1); PG8_BAR;
            PG8_LDA(At, 1, 1); PG8_STAGE(PG8_SA(1, 0), a3, voffA);
            PG8_BAR; PG8_WAIT_L(0); PG8_MMA(1, 0, At, B0); PG8_BAR; PG8_SCHED;
            PG8_STAGE(PG8_SB(1, 1), b3 + hstep, voffB);
            PG8_WAIT_V(6); PG8_BAR; PG8_MMA(1, 1, At, B1); PG8_BAR;
            }
        }
        if constexpr (ALIGN_EPI) { if (wr == 0) PG8_BAR; }
        if constexpr (!Epi::AFTER_DRAIN) { E(acc, cur, wr, wc, fr, fq); S.done(cur); }
        if (!has_next) break;
#pragma unroll
        for (int a = 0; a < 2; ++a)
#pragma unroll
            for (int b = 0; b < 2; ++b)
#pragma unroll
                for (int m = 0; m < 4; ++m)
#pragma unroll
                    for (int n = 0; n < 2; ++n) acc[a][b][m][n] = (f32x4){0.f, 0.f, 0.f, 0.f};
        cur = nxt; cA = nA; cB = nB; ++ui;
        if constexpr (ALIGN_EPI) { if (wr == 1) PG8_BAR; }
    }
    PG8_WAIT_V(0);
    if constexpr (!ALIGN_EPI) { if (wr == 0) PG8_BAR; }
    PG8_BAR;
    if constexpr (Epi::AFTER_DRAIN) { E.fused(acc, cur, wr, wc, fr, fq, lds, wid, lane); S.done(cur); }
#undef PG8_SA
#undef PG8_SB
#undef PG8_STAGE
#undef PG8_LDA
#undef PG8_LDB
#undef PG8_MMA
#undef PG8_WAIT_V
#undef PG8_WAIT_L
#undef PG8_BAR
#undef PG8_SCHED
}
}
#define GAS __attribute__((address_space(1)))
#define LAS __attribute__((address_space(3)))
typedef unsigned v4u __attribute__((ext_vector_type(4)));
#define LDS_WAIT() asm volatile("s_waitcnt lgkmcnt(0)" ::: "memory")
__device__ __forceinline__ unsigned pk2(float lo, float hi) { return f2bf_u(lo) | (f2bf_u(hi) << 16); }
constexpr int LDS_BYTES = 147456;
constexpr int NWAVES = 8;
__device__ __forceinline__ void p0_transpose_item(const float* W, int K, int N, bf16_t* WT, int row_off, LAS float* scr, int item, int lane) {
    const int nblk = N / 32, kb = item / nblk, nb = item % nblk, k0 = 64 * kb, n0 = 32 * nb;
#pragma unroll 8
    for (int i = 0; i < 32; ++i) { const int kk = 2 * i + (lane >> 5); scr[kk * 33 + (lane & 31)] = W[(size_t)(k0 + kk) * N + n0 + (lane & 31)]; }
    LDS_WAIT(); asm volatile("" ::: "memory");
    const int c = lane & 7;
#pragma unroll
    for (int j = 0; j < 4; ++j) { const int n = (lane >> 3) + 8 * j; const LAS float* s = scr + (8 * c) * 33 + n;
        v4u o; o.x = pk2(s[0 * 33], s[1 * 33]); o.y = pk2(s[2 * 33], s[3 * 33]); o.z = pk2(s[4 * 33], s[5 * 33]); o.w = pk2(s[6 * 33], s[7 * 33]);
        *(GAS v4u*)(WT + (size_t)(row_off + n0 + n) * K + k0 + 8 * c) = o; }
    LDS_WAIT(); asm volatile("" ::: "memory");
}
struct Args { Ctx c; bf16_t *WinT, *WkvT, *WoutT, *WxqT, *WxoT, *WupT, *WdownT; int ph_lo, ph_hi; };
template <class F> __device__ __forceinline__ void run_stage(const F& f) {
  const long stride = (long)gridDim.x * 512;
  for (long i = (long)blockIdx.x * 512 + threadIdx.x; i < F::N; i += stride) f(i);
}
constexpr int N_PHASES = 23;
__global__ void __launch_bounds__(512, 2) mega(Args a) {
  extern __shared__ __attribute__((aligned(16))) unsigned char lds_raw[];
  LAS unsigned char* lds = (LAS unsigned char*)lds_raw;
  cg::grid_group grid = cg::this_grid();
  const Ctx& c = a.c;
  const int tid = threadIdx.x, lane = tid & 63, wave = __builtin_amdgcn_readfirstlane(tid >> 6);
#define PH(k) if (a.ph_lo <= (k) && (k) < a.ph_hi)
#define SYNC(k) do { if ((k) + 1 < a.ph_hi) grid.sync(); } while (0)
#define GEMM(A_, B_, M_, N_, K_, C_, LDC_, RP_, RS_) do { __syncthreads(); pg8::Gemm g{A_, B_, M_, N_, K_}; pg8::StaticOrder S; S.init(M_, N_, (int)gridDim.x, (int)blockIdx.x); \
      pg8::EpiF32 E{C_, LDC_, RP_, RS_, MP}; pg8::gemm_phase<pg8::EpiF32, pg8::StaticOrder, true, true>(lds, g, S, E); } while (0)
  PH(0) {
    LAS float* scr = (LAS float*)(lds + wave * 16384);
    const int gw = blockIdx.x * NWAVES + wave, NGW = gridDim.x * NWAVES;
    constexpr int I_IN = (D_MODEL / 64) * (IN_COLS / 32), I_SQ = (D_MODEL / 64) * (D_MODEL / 32), I_UP = (D_MODEL / 64) * (2 * D_FF / 32), I_DN = (D_FF / 64) * (D_MODEL / 32);
    constexpr int NIT = I_IN + 5 * I_SQ + I_UP + I_DN;
    for (int it = gw; it < NIT; it += NGW) { int r = it;
      if (r < I_IN) { p0_transpose_item(c.w_in, D_MODEL, IN_COLS, a.WinT, 0, scr, r, lane); continue; } r -= I_IN;
      if (r < I_SQ) { p0_transpose_item(c.w_xk, D_MODEL, D_MODEL, a.WkvT, 0, scr, r, lane); continue; } r -= I_SQ;
      if (r < I_SQ) { p0_transpose_item(c.w_xv, D_MODEL, D_MODEL, a.WkvT, D_MODEL, scr, r, lane); continue; } r -= I_SQ;
      if (r < I_SQ) { p0_transpose_item(c.w_out, D_MODEL, D_MODEL, a.WoutT, 0, scr, r, lane); continue; } r -= I_SQ;
      if (r < I_SQ) { p0_transpose_item(c.w_xq, D_MODEL, D_MODEL, a.WxqT, 0, scr, r, lane); continue; } r -= I_SQ;
      if (r < I_SQ) { p0_transpose_item(c.w_xo, D_MODEL, D_MODEL, a.WxoT, 0, scr, r, lane); continue; } r -= I_SQ;
      if (r < I_UP) { p0_transpose_item(c.w_up, D_MODEL, 2 * D_FF, a.WupT, 0, scr, r, lane); continue; } r -= I_UP;
      p0_transpose_item(c.w_down, D_FF, D_MODEL, a.WdownT, 0, scr, r, lane); }
    run_stage(StRms0{c}); SYNC(0); }
  PH(1) { GEMM(c.XN, a.WinT, MTOT, LDP, D_MODEL, c.P, LDP, nullptr, nullptr); SYNC(1); }
  PH(2) { GEMM(c.MN, a.WkvT, MMEM, 2048, D_MODEL, c.MKV, 2048, nullptr, nullptr); SYNC(2); }
  PH(3) { run_stage(StQ{c}); run_stage(StKV{c}); run_stage(StGate{c}); run_stage(StGdnConv{c}); run_stage(StGdnMisc{c}); run_stage(StGdnConvOut{c}); run_stage(StMemKV{c}); SYNC(3); }
  PH(4) { run_stage(StGdnScan{c}); run_stage(StWinOut{c}); run_stage(StCompress{c}); SYNC(4); }
  PH(5) { run_stage(StCmpScore{c}); SYNC(5); }
  PH(6) { run_stage(StCmpSoftmax{c}); SYNC(6); }
  PH(7) { run_stage(StTopk{c}); run_stage(StWinScore{c}); SYNC(7); }
  PH(8) { run_stage(StSelScore{c}); SYNC(8); }
  PH(9) { run_stage(StSoftmax512{c.SS}); run_stage(StSoftmax512{c.SW}); run_stage(StGdnNorm{c}); SYNC(9); }
  PH(10) { run_stage(StNsaOut{c}); SYNC(10); }
  PH(11) { GEMM(c.CAT, a.WoutT, MTOT, D_MODEL, D_MODEL, c.H1, D_MODEL, c.x_prompt, c.x_sample); SYNC(11); }
  PH(12) { run_stage(StRmsRows{c.H1, c.xattn_norm_w, c.XN}); SYNC(12); }
  PH(13) { GEMM(c.XN, a.WxqT, MTOT, D_MODEL, D_MODEL, c.Q2, D_MODEL, nullptr, nullptr); SYNC(13); }
  PH(14) { run_stage(StXqNorm{c}); SYNC(14); }
  PH(15) { run_stage(StXScore{c}); SYNC(15); }
  PH(16) { run_stage(StXSoftmax{c}); SYNC(16); }
  PH(17) { run_stage(StXOut{c}); SYNC(17); }
  PH(18) { GEMM(c.OX, a.WxoT, MTOT, D_MODEL, D_MODEL, c.H2, D_MODEL, c.H1, c.H1 + (size_t)MP * D_MODEL); SYNC(18); }
  PH(19) { run_stage(StRmsRows{c.H2, c.ffn_norm_w, c.XN}); SYNC(19); }
  PH(20) { GEMM(c.XN, a.WupT, MTOT, 2 * D_FF, D_MODEL, c.UP, 2 * D_FF, nullptr, nullptr); SYNC(20); }
  PH(21) { run_stage(StFfnAct{c}); run_stage(StFfnConvOut{c}); SYNC(21); }
  PH(22) { GEMM(c.ACT, a.WdownT, MTOT, D_MODEL, D_FF, c.out + O_YP, D_MODEL, c.H2, c.H2 + (size_t)MP * D_MODEL); }
}
#ifndef MK_MULTI
#define MK_MULTI 0
#endif
extern "C" void kernel_launch(void* const* d_in, const int* in_sizes, int n_in, void* d_out, int out_size, void* d_ws, size_t ws_size, hipStream_t stream) {
  static int grid = 0;
  if (grid == 0) {
    int dev = 0, cus = 0, per_cu = 0;
    if (hipGetDevice(&dev) != hipSuccess || hipDeviceGetAttribute(&cus, hipDeviceAttributeMultiprocessorCount, dev) != hipSuccess) { fprintf(stderr, "kernel_launch: device query failed\n"); grid = -1; return; }
    if (hipFuncSetAttribute((const void*)mega, hipFuncAttributeMaxDynamicSharedMemorySize, LDS_BYTES) != hipSuccess) { fprintf(stderr, "kernel_launch: hipFuncSetAttribute failed\n"); grid = -1; return; }
    if (hipOccupancyMaxActiveBlocksPerMultiprocessor(&per_cu, (const void*)mega, 512, LDS_BYTES) != hipSuccess || per_cu < 1) { fprintf(stderr, "kernel_launch: occupancy query says %d blocks/CU\n", per_cu); (void)hipGetLastError(); }
    grid = cus;
    if (n_in != 34 || (size_t)out_size != O_END) fprintf(stderr, "kernel_launch: unexpected n_in %d / out_size %d (want 34 / %zu)\n", n_in, out_size, (size_t)O_END);
  }
  if (grid < 0) return;
  Args a{}; Ctx& c = a.c; int k = 0;
  c.x_prompt = (const float*)d_in[k++]; c.x_sample = (const float*)d_in[k++]; c.mem_prompt = (const float*)d_in[k++]; c.cache_nsa_kv = (const float*)d_in[k++]; c.cache_nsa_win = (const float*)d_in[k++];
  c.state_gdn = (const float*)d_in[k++]; c.cache_gdn_conv = (const float*)d_in[k++]; c.cache_ffn_conv = (const float*)d_in[k++]; c.cache_mem_kv = (const float*)d_in[k++]; c.page_table = (const int*)d_in[k++];
  c.attn_norm_w = (const float*)d_in[k++]; c.w_in = (const float*)d_in[k++]; c.nsa_q_norm_w = (const float*)d_in[k++]; c.nsa_k_norm_w = (const float*)d_in[k++]; c.cmp_pe = (const float*)d_in[k++]; c.cmp_w = (const float*)d_in[k++];
  c.gdn_conv_w = (const float*)d_in[k++]; c.gdn_a_log = (const float*)d_in[k++]; c.gdn_dt_bias = (const float*)d_in[k++]; c.gdn_norm_w = (const float*)d_in[k++]; c.w_out = (const float*)d_in[k++];
  c.mem_norm_w = (const float*)d_in[k++]; c.w_xk = (const float*)d_in[k++]; c.w_xv = (const float*)d_in[k++]; c.xk_norm_w = (const float*)d_in[k++]; c.xattn_norm_w = (const float*)d_in[k++]; c.w_xq = (const float*)d_in[k++];
  c.xq_norm_w = (const float*)d_in[k++]; c.w_xo = (const float*)d_in[k++]; c.ffn_norm_w = (const float*)d_in[k++]; c.w_up = (const float*)d_in[k++]; c.ffn_conv_w = (const float*)d_in[k++]; c.ffn_conv_b = (const float*)d_in[k++]; c.w_down = (const float*)d_in[k++];
  c.out = (float*)d_out;
  unsigned char* ws = (unsigned char*)d_ws; WsMap w{0};
  a.WinT = (bf16_t*)(ws + w.take((size_t)LDP * D_MODEL * 2)); a.WkvT = (bf16_t*)(ws + w.take((size_t)2048 * D_MODEL * 2));
  a.WoutT = (bf16_t*)(ws + w.take((size_t)D_MODEL * D_MODEL * 2)); a.WxqT = (bf16_t*)(ws + w.take((size_t)D_MODEL * D_MODEL * 2)); a.WxoT = (bf16_t*)(ws + w.take((size_t)D_MODEL * D_MODEL * 2));
  a.WupT = (bf16_t*)(ws + w.take((size_t)2 * D_FF * D_MODEL * 2)); a.WdownT = (bf16_t*)(ws + w.take((size_t)D_MODEL * D_FF * 2));
  const size_t need = ws_carve(c, ws, w.off);
  if (need > ws_size) { fprintf(stderr, "kernel_launch: workspace too small: need %zu, have %zu\n", need, ws_size); return; }
#if MK_MULTI
  for (int ph = 0; ph < N_PHASES; ++ph) { a.ph_lo = ph; a.ph_hi = ph + 1; void* args[] = {&a};
    hipError_t e = hipLaunchCooperativeKernel((const void*)mega, dim3(grid), dim3(512), args, LDS_BYTES, stream);
    if (e != hipSuccess) { fprintf(stderr, "kernel_launch: cooperative launch failed: %s\n", hipGetErrorString(e)); return; } }
#else
  a.ph_lo = 0; a.ph_hi = N_PHASES; void* args[] = {&a};
  hipError_t e = hipLaunchCooperativeKernel((const void*)mega, dim3(grid), dim3(512), args, LDS_BYTES, stream);
  if (e != hipSuccess) fprintf(stderr, "kernel_launch: cooperative launch failed: %s (grid %d)\n", hipGetErrorString(e), grid);
#endif
}
```

```cpp
#include <hip/hip_runtime.h>
#include <hip/hip_cooperative_groups.h>
#include <cstdio>
#include <cstdint>
namespace cg = cooperative_groups;
#define HD __host__ __device__ __forceinline__
#ifdef CFG_SMALL
constexpr int BATCH = 1, SEQ = 1024, DEC_BATCH = 2, PAST_LEN = 1024, MEM_TOKENS = 64, D_FF = 256;
#else
constexpr int BATCH = 8, SEQ = 2048, DEC_BATCH = 32, PAST_LEN = 8192, MEM_TOKENS = 256, D_FF = 2816;
#endif
constexpr int D_MODEL = 1024, DEC_SEQ = 8, PAGE_SIZE = 128;
constexpr int NSA_HEADS = 8, NSA_KVH = 2, NSA_HD = 64, NSA_G = 4;
constexpr int CMP_BLOCK = 32, CMP_STRIDE = 16, SEL_BLOCK = 64, SEL_TOPN = 8, WINDOW = 512;
constexpr int GDN_HEADS = 4, GDN_HD = 128, GDN_CONV = 4;
constexpr int XA_HEADS = 4, XA_HD = 256, FFN_CONV = 3;
constexpr float EPS = 1e-6f, NEGF = -1e30f, FORCED_BONUS = 1e4f;
constexpr int NSA_Q_W = 512, NSA_KV_W = 768, NSA_GATE_W = 24, GDN_W = 512;
constexpr int IN_COLS = 3360, LDP = 3584;
constexpr int OFF_Q = 0, OFF_KV = 512, OFF_GATE = 1280, OFF_QKV = 1304, OFF_Z = 2840, OFF_B = 3352, OFF_A = 3356;
constexpr int MP = BATCH * SEQ, MS = DEC_BATCH * DEC_SEQ, MTOT = MP + MS;
constexpr int MMEM = BATCH * MEM_TOKENS;
constexpr int NPAGES = PAST_LEN / PAGE_SIZE;
constexpr int NCP = SEQ / CMP_STRIDE - 1;
constexpr int NCS = PAST_LEN / CMP_STRIDE - 1;
constexpr int NCPS = 128, NCSS = 512;
constexpr int NSELP = SEQ / SEL_BLOCK;
constexpr int NSELS = PAST_LEN / SEL_BLOCK + 1;
constexpr int NSELMAX = 160;
constexpr int WINP = (WINDOW < SEQ ? WINDOW : SEQ);
constexpr int WBUF = (WINDOW < PAST_LEN ? WINDOW : PAST_LEN);
constexpr int WINS = (WINDOW < WBUF + DEC_SEQ ? WINDOW : WBUF + DEC_SEQ);
static_assert(NCP <= NCPS && NCS <= NCSS && NSELS <= NSELMAX && NSELP <= NSELMAX, "strides");
static_assert(WBUF == WINDOW && WINP == WINDOW && WINS == WINDOW, "window assumptions");

constexpr size_t O_YP = 0;
constexpr size_t O_YS = O_YP + (size_t)MP * D_MODEL;
constexpr size_t O_KVP = O_YS + (size_t)MS * D_MODEL;
constexpr size_t O_WINP = O_KVP + (size_t)MP * 512;
constexpr size_t O_STP = O_WINP + (size_t)BATCH * WINP * 256;
constexpr size_t O_GCP = O_STP + (size_t)BATCH * 4 * 128 * 128;
constexpr size_t O_FCP = O_GCP + (size_t)BATCH * 3 * 1536;
constexpr size_t O_MKVP = O_FCP + (size_t)BATCH * 2 * 2 * D_FF;
constexpr size_t O_KVS = O_MKVP + (size_t)MMEM * 2048;
constexpr size_t O_WINS = O_KVS + (size_t)MS * 512;
constexpr size_t O_STS = O_WINS + (size_t)DEC_BATCH * WINS * 256;
constexpr size_t O_GCS = O_STS + (size_t)DEC_BATCH * 4 * 128 * 128;
constexpr size_t O_FCS = O_GCS + (size_t)DEC_BATCH * 3 * 1536;
constexpr size_t O_END = O_FCS + (size_t)DEC_BATCH * 2 * 2 * D_FF;

typedef unsigned short bf16_t;
HD unsigned f2bf_u(float f) { unsigned u = __builtin_bit_cast(unsigned, f); return (u + 0x7fffu + ((u >> 16) & 1u)) >> 16; }
HD bf16_t f2bf(float f) { return (bf16_t)f2bf_u(f); }
HD float bf2f(bf16_t b) { return __builtin_bit_cast(float, (unsigned)b << 16); }
HD float sigmoidf_(float x) { return 1.f / (1.f + expf(-x)); }
HD float siluf_(float x) { return x / (1.f + expf(-x)); }
HD float softplusf_(float x) { return x > 20.f ? x : log1pf(expf(x)); }

struct Ctx {
  const float *x_prompt, *x_sample, *mem_prompt, *cache_nsa_kv, *cache_nsa_win, *state_gdn, *cache_gdn_conv, *cache_ffn_conv, *cache_mem_kv;
  const int* page_table;
  const float *attn_norm_w, *w_in, *nsa_q_norm_w, *nsa_k_norm_w, *cmp_pe, *cmp_w, *gdn_conv_w, *gdn_a_log, *gdn_dt_bias, *gdn_norm_w, *w_out,
      *mem_norm_w, *w_xk, *w_xv, *xk_norm_w, *xattn_norm_w, *w_xq, *xq_norm_w, *w_xo, *ffn_norm_w, *w_up, *ffn_conv_w, *ffn_conv_b, *w_down;
  float* out;
  bf16_t *XN, *MN, *CAT, *OX, *ACT;
  float *P, *MKV, *QC, *QR, *WR, *GATE, *GQ, *GK, *GV, *GB, *GG, *KCMP, *VCMP, *SCP, *SCS, *SCORE, *SS, *SW, *OG, *H1, *Q2, *SX, *H2, *UP;
  int* SIDX;
  bf16_t *QCb, *QRb, *KSb, *VSTb, *KWb, *VWTb, *KWsb, *VWTsb, *KCb, *VCTb, *KXb, *VXTb, *Q2b, *GWp, *GQKp, *GQDp, *GKDTp;
  float *GS, *GL;
};

HD int row_b(int m) { return m < MP ? m / SEQ : (m - MP) / DEC_SEQ; }
HD int row_t(int m) { return m < MP ? m % SEQ : (m - MP) % DEC_SEQ; }
HD int row_pos(int m) { return m < MP ? m % SEQ : PAST_LEN + (m - MP) % DEC_SEQ; }
HD const float* x_row(const Ctx& c, int m) { return m < MP ? c.x_prompt + (size_t)m * D_MODEL : c.x_sample + (size_t)(m - MP) * D_MODEL; }
HD float* kvrow_out(const Ctx& c, int m) { return m < MP ? c.out + O_KVP + (size_t)m * 512 : c.out + O_KVS + (size_t)(m - MP) * 512; }

struct StRms0 { const Ctx& c; static constexpr long N = MTOT + MMEM;
  HD void operator()(long i) const {
    const float* src; const float* w; bf16_t* dst;
    if (i < MTOT) { src = x_row(c, (int)i); w = c.attn_norm_w; dst = c.XN + (size_t)i * D_MODEL; }
    else { const long mm = i - MTOT; src = c.mem_prompt + (size_t)mm * D_MODEL; w = c.mem_norm_w; dst = c.MN + (size_t)mm * D_MODEL; }
    float ss = 0.f; for (int d = 0; d < D_MODEL; ++d) ss += src[d] * src[d];
    const float r = 1.f / sqrtf(ss / D_MODEL + EPS);
    for (int d = 0; d < D_MODEL; ++d) dst[d] = f2bf(src[d] * r * w[d]);
  } };
struct StRmsRows { const float* src; const float* w; bf16_t* dst; static constexpr long N = MTOT;
  HD void operator()(long i) const {
    const float* s = src + (size_t)i * D_MODEL; bf16_t* o = dst + (size_t)i * D_MODEL;
    float ss = 0.f; for (int d = 0; d < D_MODEL; ++d) ss += s[d] * s[d];
    const float r = 1.f / sqrtf(ss / D_MODEL + EPS);
    for (int d = 0; d < D_MODEL; ++d) o[d] = f2bf(s[d] * r * w[d]);
  } };
HD void rope_pair(float x1, float x2, int i, int pos, float& o1, float& o2) {
  const float inv = powf(10000.f, -(float)i / 32.f); const float ang = (float)pos * inv;
  const float cs = cosf(ang), sn = sinf(ang); o1 = x1 * cs - x2 * sn; o2 = x1 * sn + x2 * cs;
}
struct StQ { const Ctx& c; static constexpr long N = (long)MTOT * NSA_HEADS;
  HD void operator()(long i) const {
    const int m = (int)(i / NSA_HEADS), h = (int)(i % NSA_HEADS); const float* p = c.P + (size_t)m * LDP + OFF_Q + h * 64;
    float ss = 0.f; for (int d = 0; d < 64; ++d) ss += p[d] * p[d];
    const float r = 1.f / sqrtf(ss / 64.f + EPS); const int pos = row_pos(m);
    float* qc = c.QC + (size_t)m * 512 + h * 64; float* qr = c.QR + (size_t)m * 512 + h * 64;
    for (int d = 0; d < 32; ++d) { const float a = p[d] * r * c.nsa_q_norm_w[d], b = p[d + 32] * r * c.nsa_q_norm_w[d + 32];
      qc[d] = a; qc[d + 32] = b; float o1, o2; rope_pair(a, b, d, pos, o1, o2); qr[d] = o1; qr[d + 32] = o2; }
  } };
struct StKV { const Ctx& c; static constexpr long N = (long)MTOT * 6;
  HD void operator()(long i) const {
    const int m = (int)(i / 6), br = (int)(i % 6) / 2, kvh = (int)(i % 2); const float* pk = c.P + (size_t)m * LDP + OFF_KV + ((br * 2 + 0) * 2 + kvh) * 64;
    const float* pv = c.P + (size_t)m * LDP + OFF_KV + ((br * 2 + 1) * 2 + kvh) * 64;
    float ss = 0.f; for (int d = 0; d < 64; ++d) ss += pk[d] * pk[d];
    const float r = 1.f / sqrtf(ss / 64.f + EPS); const int pos = row_pos(m); const float* w = c.nsa_k_norm_w + br * 64;
    float *ko, *vo;
    if (br < 2) { float* ro = kvrow_out(c, m); ko = ro + ((br * 2 + 0) * 2 + kvh) * 64; vo = ro + ((br * 2 + 1) * 2 + kvh) * 64; }
    else { float* wo = c.WR + (size_t)m * 256; ko = wo + (0 * 2 + kvh) * 64; vo = wo + (1 * 2 + kvh) * 64; }
    for (int d = 0; d < 32; ++d) { const float a = pk[d] * r * w[d], b = pk[d + 32] * r * w[d + 32];
      if (br == 0) { ko[d] = a; ko[d + 32] = b; } else { float o1, o2; rope_pair(a, b, d, pos, o1, o2); ko[d] = o1; ko[d + 32] = o2; } }
    for (int d = 0; d < 64; ++d) vo[d] = pv[d];
  } };
struct StWinOut { const Ctx& c; static constexpr long N = (long)(BATCH + DEC_BATCH) * WINDOW * 256;
  HD void operator()(long i) const {
    const int e = (int)(i % 256); const long r = i / 256; const int j = (int)(r % WINDOW), bb = (int)(r / WINDOW);
    if (bb < BATCH) c.out[O_WINP + ((size_t)bb * WINDOW + j) * 256 + e] = c.WR[((size_t)bb * SEQ + SEQ - WINDOW + j) * 256 + e];
    else { const int b = bb - BATCH; const int w = j + DEC_SEQ;
      const float v = w < WBUF ? c.cache_nsa_win[((size_t)b * WBUF + w) * 256 + e] : c.WR[((size_t)MP + b * DEC_SEQ + (w - WBUF)) * 256 + e];
      c.out[O_WINS + ((size_t)b * WINDOW + j) * 256 + e] = v; }
  } };
struct StGate { const Ctx& c; static constexpr long N = (long)MTOT * 24;
  HD void operator()(long i) const { const int m = (int)(i / 24), e = (int)(i % 24); c.GATE[(size_t)m * 24 + e] = sigmoidf_(c.P[(size_t)m * LDP + OFF_GATE + e]); } };
HD float gdn_pre(const Ctx& c, int m, int dt_back, int ch) {
  const int t = row_t(m) - dt_back;
  if (t >= 0) return c.P[(size_t)(m - dt_back) * LDP + OFF_QKV + ch];
  if (m < MP) return 0.f;
  const int b = (m - MP) / DEC_SEQ; return c.cache_gdn_conv[((size_t)b * 3 + (3 + t)) * 1536 + ch];
}
struct StGdnConv { const Ctx& c; static constexpr long N = (long)MTOT * 12;
  HD void operator()(long i) const {
    const int m = (int)(i / 12), part = (int)(i % 12), which = part / 4, h = part % 4; const int ch0 = which * 512 + h * 128;
    float* dst = (which == 0 ? c.GQ : which == 1 ? c.GK : c.GV) + (size_t)m * 512 + h * 128;
    float ss = 0.f;
    for (int d = 0; d < 128; ++d) { const int ch = ch0 + d; float y = 0.f;
      for (int k = 0; k < 4; ++k) y += c.gdn_conv_w[k * 1536 + ch] * gdn_pre(c, m, 3 - k, ch);
      y = siluf_(y); dst[d] = y; ss += y * y; }
    if (which < 2) { const float r = (1.f / sqrtf(ss + EPS)) * (which == 0 ? 0.08838834764831845f : 1.f); for (int d = 0; d < 128; ++d) dst[d] *= r; }
  } };
struct StGdnMisc { const Ctx& c; static constexpr long N = (long)MTOT * 4;
  HD void operator()(long i) const {
    const int m = (int)(i / 4), h = (int)(i % 4); const float* p = c.P + (size_t)m * LDP;
    c.GB[i] = sigmoidf_(p[OFF_B + h]); c.GG[i] = -expf(c.gdn_a_log[h]) * softplusf_(p[OFF_A + h] + c.gdn_dt_bias[h]);
  } };
struct StGdnConvOut { const Ctx& c; static constexpr long N = (long)(BATCH + DEC_BATCH) * 3 * 1536;
  HD void operator()(long i) const {
    const int ch = (int)(i % 1536); const int r = (int)((i / 1536) % 3), bb = (int)(i / (3 * 1536));
    if (bb < BATCH) c.out[O_GCP + i] = c.P[((size_t)bb * SEQ + SEQ - 3 + r) * LDP + OFF_QKV + ch];
    else { const int b = bb - BATCH; c.out[O_GCS + ((size_t)b * 3 + r) * 1536 + ch] = c.P[((size_t)MP + b * DEC_SEQ + DEC_SEQ - 3 + r) * LDP + OFF_QKV + ch]; }
  } };
HD const float* nsa_row(const Ctx& c, bool sample, int b, int pos, int r, int kvh) {
  if (!sample) return c.out + O_KVP + ((size_t)b * SEQ + pos) * 512 + (r * 2 + kvh) * 64;
  if (pos < PAST_LEN) { const int pg = c.page_table[b * NPAGES + pos / PAGE_SIZE]; return c.cache_nsa_kv + ((size_t)pg * PAGE_SIZE + pos % PAGE_SIZE) * 512 + (r * 2 + kvh) * 64; }
  return c.out + O_KVS + ((size_t)b * DEC_SEQ + (pos - PAST_LEN)) * 512 + (r * 2 + kvh) * 64;
}
constexpr long NCMP_ITEMS_P = (long)BATCH * NCP * 2 * 2 * 64, NCMP_ITEMS_S = (long)DEC_BATCH * NCS * 2 * 2 * 64;
struct StCompress { const Ctx& c; static constexpr long N = NCMP_ITEMS_P + NCMP_ITEMS_S;
  HD void operator()(long i) const {
    const bool sample = i >= NCMP_ITEMS_P; long r = sample ? i - NCMP_ITEMS_P : i; const int nc = sample ? NCS : NCP;
    const int e = (int)(r % 64); r /= 64; const int kv = (int)(r % 2); r /= 2; const int kvh = (int)(r % 2); r /= 2; const int cb = (int)(r % nc), b = (int)(r / nc);
    const float* W = c.cmp_w + (size_t)kv * 32 * 64 * 64; const float* pe = c.cmp_pe + (size_t)kv * 32 * 64;
    float acc = 0.f;
    for (int j = 0; j < 32; ++j) { const float* x = nsa_row(c, sample, b, 16 * cb + j, kv, kvh);
      for (int d = 0; d < 64; ++d) acc += (x[d] + pe[j * 64 + d]) * W[((size_t)j * 64 + d) * 64 + e]; }
    float* dst = (kv == 0 ? c.KCMP : c.VCMP) + (sample ? (size_t)BATCH * NCP * 128 : 0) + (((size_t)b * nc + cb) * 2 + kvh) * 64 + e;
    *dst = acc;
  } };
HD const float* cmp_ptr(const Ctx& c, const float* base, bool sample, int b, int cb, int kvh) {
  return base + (sample ? (size_t)BATCH * NCP * 128 : 0) + (((size_t)b * (sample ? NCS : NCP) + cb) * 2 + kvh) * 64; }
HD float* scmp_ptr(const Ctx& c, int m, int h) { return m < MP ? c.SCP + ((size_t)m * 8 + h) * NCPS : c.SCS + ((size_t)(m - MP) * 8 + h) * NCSS; }
constexpr long NSC_P = (long)MP * 8 * NCPS, NSC_S = (long)MS * 8 * NCSS;
struct StCmpScore { const Ctx& c; static constexpr long N = NSC_P + NSC_S;
  HD void operator()(long i) const {
    const bool sample = i >= NSC_P; const long r = sample ? i - NSC_P : i; const int st = sample ? NCSS : NCPS, nc = sample ? NCS : NCP;
    const int cb = (int)(r % st), h = (int)((r / st) % 8); const int m = (int)(r / st / 8) + (sample ? MP : 0);
    float* dst = scmp_ptr(c, m, h) + cb; const int pos = row_pos(m);
    if (cb >= nc || 16 * cb + 31 > pos) { *dst = -3e38f; return; }
    const float* q = c.QC + (size_t)m * 512 + h * 64; const float* k = cmp_ptr(c, c.KCMP, sample, row_b(m), cb, h / 4);
    float s = 0.f; for (int d = 0; d < 64; ++d) s += q[d] * k[d];
    *dst = s * 0.125f;
  } };
HD void softmax_inplace(float* s, int n) {
  float mx = -3e38f; for (int j = 0; j < n; ++j) mx = fmaxf(mx, s[j]);
  if (mx < -1e38f) { for (int j = 0; j < n; ++j) s[j] = 0.f; return; }
  float sum = 0.f; for (int j = 0; j < n; ++j) { const float v = s[j]; if (v > -1e38f) sum += expf(v - mx); }
  const float inv = 1.f / fmaxf(sum, 1e-30f);
  for (int j = 0; j < n; ++j) { const float v = s[j]; s[j] = v > -1e38f ? expf(v - mx) * inv : 0.f; }
}
struct StCmpSoftmax { const Ctx& c; static constexpr long N = (long)MTOT * 8;
  HD void operator()(long i) const { const int m = (int)(i / 8), h = (int)(i % 8); softmax_inplace(scmp_ptr(c, m, h), m < MP ? NCPS : NCSS); } };
struct StTopk { const Ctx& c; static constexpr long N = (long)MTOT * 2;
  HD void operator()(long i) const {
    const int m = (int)(i / 2), kvh = (int)(i % 2); const bool sample = m >= MP; const int nsel = sample ? NSELS : NSELP, nc = sample ? NCS : NCP;
    const int pos = row_pos(m), qblk = pos / SEL_BLOCK; float* sc = c.SCORE + (size_t)i * NSELMAX;
    for (int s = 0; s < nsel; ++s) {
      float imp = 0.f;
      for (int g = 0; g < 4; ++g) { const float* p = scmp_ptr(c, m, kvh * 4 + g);
        for (int cb = 4 * s - 1; cb <= 4 * s + 3; ++cb) if (cb >= 0 && cb < nc) imp += p[cb]; }
      const bool visible = s <= qblk, forced = (s == 0) || (s == qblk) || (s == qblk - 1);
      sc[s] = visible ? imp + (forced ? FORCED_BONUS : 0.f) : NEGF;
    }
    const int ntop = nsel < SEL_TOPN ? nsel : SEL_TOPN;
    for (int n = 0; n < SEL_TOPN; ++n) {
      int best = -1; float bv = -3e38f;
      if (n < ntop) { for (int s = 0; s < nsel; ++s) if (sc[s] > bv) { bv = sc[s]; best = s; } }
      if (best >= 0) sc[best] = -3.2e38f;
      c.SIDX[i * 8 + n] = (best >= 0 && bv > 0.5f * NEGF) ? best : -1;
    }
  } };
struct StSelScore { const Ctx& c; static constexpr long N = (long)MTOT * 8 * 512;
  HD void operator()(long i) const {
    const int j = (int)(i % 64), n = (int)((i / 64) % 8), h = (int)((i / 512) % 8), m = (int)(i / 4096); const bool sample = m >= MP;
    const int blk = c.SIDX[((size_t)m * 2 + h / 4) * 8 + n]; const int pos = row_pos(m), key = blk * 64 + j;
    if (blk < 0 || key > pos) { c.SS[i] = -3e38f; return; }
    const float* q = c.QR + (size_t)m * 512 + h * 64; const float* k = nsa_row(c, sample, row_b(m), key, 2, h / 4);
    float s = 0.f; for (int d = 0; d < 64; ++d) s += q[d] * k[d];
    c.SS[i] = s * 0.125f;
  } };
HD const float* win_row(const Ctx& c, int m, int j, int which, int kvh) {
  const int pos = row_pos(m), kp = pos - (WINDOW - 1) + j; if (kp < 0) return nullptr;
  if (m < MP) return c.WR + ((size_t)(m / SEQ) * SEQ + kp) * 256 + (which * 2 + kvh) * 64;
  const int b = (m - MP) / DEC_SEQ;
  if (kp < PAST_LEN) return c.cache_nsa_win + ((size_t)b * WBUF + (kp - (PAST_LEN - WBUF))) * 256 + (which * 2 + kvh) * 64;
  return c.WR + ((size_t)MP + b * DEC_SEQ + (kp - PAST_LEN)) * 256 + (which * 2 + kvh) * 64;
}
struct StWinScore { const Ctx& c; static constexpr long N = (long)MTOT * 8 * 512;
  HD void operator()(long i) const {
    const int j = (int)(i % 512), h = (int)((i / 512) % 8), m = (int)(i / 4096);
    const float* k = win_row(c, m, j, 0, h / 4); if (!k) { c.SW[i] = -3e38f; return; }
    const float* q = c.QR + (size_t)m * 512 + h * 64; float s = 0.f; for (int d = 0; d < 64; ++d) s += q[d] * k[d];
    c.SW[i] = s * 0.125f;
  } };
struct StSoftmax512 { float* buf; static constexpr long N = (long)MTOT * 8;
  HD void operator()(long i) const { softmax_inplace(buf + (size_t)i * 512, 512); } };
struct StNsaOut { const Ctx& c; static constexpr long N = (long)MTOT * 512;
  HD void operator()(long i) const {
    const int d = (int)(i % 64), h = (int)((i / 64) % 8), m = (int)(i / 512), kvh = h / 4; const bool sample = m >= MP; const int b = row_b(m);
    const float* pc = scmp_ptr(c, m, h); const int nc = sample ? NCS : NCP;
    float oc = 0.f; for (int cb = 0; cb < nc; ++cb) { const float p = pc[cb]; if (p != 0.f) oc += p * cmp_ptr(c, c.VCMP, sample, b, cb, kvh)[d]; }
    const float* ps = c.SS + ((size_t)m * 8 + h) * 512; float os = 0.f;
    for (int n = 0; n < 8; ++n) { const int blk = c.SIDX[((size_t)m * 2 + kvh) * 8 + n]; if (blk < 0) continue;
      for (int j = 0; j < 64; ++j) { const float p = ps[n * 64 + j]; if (p != 0.f) os += p * nsa_row(c, sample, b, blk * 64 + j, 3, kvh)[d]; } }
    const float* pw = c.SW + ((size_t)m * 8 + h) * 512; float ow = 0.f;
    for (int j = 0; j < 512; ++j) { const float p = pw[j]; if (p != 0.f) ow += p * win_row(c, m, j, 1, kvh)[d]; }
    const float* g = c.GATE + (size_t)m * 24 + h * 3;
    c.CAT[(size_t)m * D_MODEL + h * 64 + d] = f2bf(oc * g[0] + os * g[1] + ow * g[2]);
  } };
#if defined(__HIP_DEVICE_COMPILE__)
#define GDN_FENCE() asm volatile("" ::: "memory")
#else
#define GDN_FENCE() do {} while (0)
#endif
struct StGdnScan { const Ctx& c; static constexpr long N = (long)(BATCH + DEC_BATCH) * 4 * 128;
  HD void operator()(long i) const {
    const int dv = (int)(i % 128), h = (int)((i / 128) % 4), bb = (int)(i / 512); const bool sample = bb >= BATCH; const int b = sample ? bb - BATCH : bb;
    const int T = sample ? DEC_SEQ : SEQ; const int m0 = sample ? MP + b * DEC_SEQ : b * SEQ;
    float S[128];
#pragma unroll
    for (int k = 0; k < 128; ++k) S[k] = sample ? c.state_gdn[(((size_t)b * 4 + h) * 128 + k) * 128 + dv] : 0.f;
    for (int t = 0; t < T; ++t) { const int m = m0 + t;
      const float* kk = c.GK + (size_t)m * 512 + h * 128; const float* qq = c.GQ + (size_t)m * 512 + h * 128;
      const float v = c.GV[(size_t)m * 512 + h * 128 + dv], beta = c.GB[(size_t)m * 4 + h], a = expf(c.GG[(size_t)m * 4 + h]);
      float ks = 0.f;
#pragma unroll
      for (int k0 = 0; k0 < 128; k0 += 16) {
#pragma unroll
        for (int k = 0; k < 16; ++k) ks += kk[k0 + k] * S[k0 + k];
        GDN_FENCE(); }
      const float coef = beta * (v - a * ks); float o = 0.f;
#pragma unroll
      for (int k0 = 0; k0 < 128; k0 += 16) {
#pragma unroll
        for (int k = 0; k < 16; ++k) { S[k0 + k] = a * S[k0 + k] + kk[k0 + k] * coef; o += qq[k0 + k] * S[k0 + k]; }
        GDN_FENCE(); }
      c.OG[(size_t)m * 512 + h * 128 + dv] = o; }
    float* so = c.out + (sample ? O_STS : O_STP) + (((size_t)b * 4 + h) * 128) * 128 + dv;
#pragma unroll
    for (int k = 0; k < 128; ++k) so[(size_t)k * 128] = S[k];
  } };
struct StGdnNorm { const Ctx& c; static constexpr long N = (long)MTOT * 4;
  HD void operator()(long i) const {
    const int m = (int)(i / 4), h = (int)(i % 4); const float* o = c.OG + (size_t)m * 512 + h * 128; const float* z = c.P + (size_t)m * LDP + OFF_Z + h * 128;
    float ss = 0.f; for (int d = 0; d < 128; ++d) ss += o[d] * o[d];
    const float r = 1.f / sqrtf(ss / 128.f + EPS);
    for (int d = 0; d < 128; ++d) c.CAT[(size_t)m * D_MODEL + 512 + h * 128 + d] = f2bf(o[d] * r * c.gdn_norm_w[d] * siluf_(z[d]));
  } };
struct StMemKV { const Ctx& c; static constexpr long N = (long)MMEM * 4;
  HD void operator()(long i) const {
    const int mm = (int)(i / 4), h = (int)(i % 4); const float* k = c.MKV + (size_t)mm * 2048 + h * 256; const float* v = c.MKV + (size_t)mm * 2048 + 1024 + h * 256;
    float ss = 0.f; for (int d = 0; d < 256; ++d) ss += k[d] * k[d];
    const float r = 1.f / sqrtf(ss / 256.f + EPS); float* o = c.out + O_MKVP + (size_t)mm * 2048;
    for (int d = 0; d < 256; ++d) { o[h * 256 + d] = k[d] * r * c.xk_norm_w[d]; o[1024 + h * 256 + d] = v[d]; }
  } };
struct StXqNorm { const Ctx& c; static constexpr long N = (long)MTOT * 4;
  HD void operator()(long i) const {
    float* q = c.Q2 + (size_t)(i / 4) * D_MODEL + (i % 4) * 256; float ss = 0.f; for (int d = 0; d < 256; ++d) ss += q[d] * q[d];
    const float r = 1.f / sqrtf(ss / 256.f + EPS); for (int d = 0; d < 256; ++d) q[d] = q[d] * r * c.xq_norm_w[d];
  } };
HD const float* memkv_row(const Ctx& c, int m, int j, int which, int h) {
  if (m < MP) return c.out + O_MKVP + ((size_t)(m / SEQ) * MEM_TOKENS + j) * 2048 + which * 1024 + h * 256;
  return c.cache_mem_kv + ((size_t)((m - MP) / DEC_SEQ) * MEM_TOKENS + j) * 2048 + which * 1024 + h * 256;
}
struct StXScore { const Ctx& c; static constexpr long N = (long)MTOT * 4 * MEM_TOKENS;
  HD void operator()(long i) const {
    const int j = (int)(i % MEM_TOKENS), h = (int)((i / MEM_TOKENS) % 4), m = (int)(i / MEM_TOKENS / 4);
    const float* q = c.Q2 + (size_t)m * D_MODEL + h * 256; const float* k = memkv_row(c, m, j, 0, h);
    float s = 0.f; for (int d = 0; d < 256; ++d) s += q[d] * k[d];
    c.SX[i] = s * 0.0625f;
  } };
struct StXSoftmax { const Ctx& c; static constexpr long N = (long)MTOT * 4;
  HD void operator()(long i) const { softmax_inplace(c.SX + (size_t)i * MEM_TOKENS, MEM_TOKENS); } };
struct StXOut { const Ctx& c; static constexpr long N = (long)MTOT * D_MODEL;
  HD void operator()(long i) const {
    const int d = (int)(i % 256), h = (int)((i / 256) % 4), m = (int)(i / D_MODEL); const float* p = c.SX + ((size_t)m * 4 + h) * MEM_TOKENS;
    float o = 0.f; for (int j = 0; j < MEM_TOKENS; ++j) o += p[j] * memkv_row(c, m, j, 1, h)[d];
    c.OX[i] = f2bf(o);
  } };
HD float up_at(const Ctx& c, int m, int back, int col) {
  const int t = row_t(m) - back; if (t >= 0) return c.UP[(size_t)(m - back) * (2 * D_FF) + col];
  if (m < MP) return 0.f;
  return c.cache_ffn_conv[((size_t)((m - MP) / DEC_SEQ) * 2 + (2 + t)) * (2 * D_FF) + col];
}
struct StFfnAct { const Ctx& c; static constexpr long N = (long)MTOT * D_FF;
  HD void operator()(long i) const {
    const int col = (int)(i % D_FF), m = (int)(i / D_FF); float a = c.ffn_conv_b[col], u = c.ffn_conv_b[D_FF + col];
    for (int k = 0; k < 3; ++k) { a += c.ffn_conv_w[k * 2 * D_FF + col] * up_at(c, m, 2 - k, col); u += c.ffn_conv_w[k * 2 * D_FF + D_FF + col] * up_at(c, m, 2 - k, D_FF + col); }
    c.ACT[i] = f2bf(siluf_(a) * u);
  } };
struct StFfnConvOut { const Ctx& c; static constexpr long N = (long)(BATCH + DEC_BATCH) * 2 * 2 * D_FF;
  HD void operator()(long i) const {
    const int col = (int)(i % (2 * D_FF)), r = (int)((i / (2 * D_FF)) % 2), bb = (int)(i / (4 * D_FF));
    if (bb < BATCH) c.out[O_FCP + i] = c.UP[((size_t)bb * SEQ + SEQ - 2 + r) * (2 * D_FF) + col];
    else { const int b = bb - BATCH; c.out[O_FCS + ((size_t)b * 2 + r) * (2 * D_FF) + col] = c.UP[((size_t)MP + b * DEC_SEQ + DEC_SEQ - 2 + r) * (2 * D_FF) + col]; }
  } };

struct WsMap { size_t off; HD size_t take(size_t bytes) { const size_t o = off; off += (bytes + 255) & ~(size_t)255; return o; } };
inline size_t ws_carve(Ctx& c, unsigned char* ws, size_t base) {
  WsMap w{base};
  c.XN = (bf16_t*)(ws + w.take((size_t)MTOT * D_MODEL * 2)); c.MN = (bf16_t*)(ws + w.take((size_t)MMEM * D_MODEL * 2));
  c.CAT = (bf16_t*)(ws + w.take((size_t)MTOT * D_MODEL * 2)); c.OX = (bf16_t*)(ws + w.take((size_t)MTOT * D_MODEL * 2));
  c.ACT = (bf16_t*)(ws + w.take((size_t)MTOT * D_FF * 2));
  c.P = (float*)(ws + w.take((size_t)MTOT * LDP * 4)); c.MKV = (float*)(ws + w.take((size_t)MMEM * 2048 * 4));
  c.QC = (float*)(ws + w.take((size_t)MTOT * 512 * 4)); c.QR = (float*)(ws + w.take((size_t)MTOT * 512 * 4));
  c.WR = (float*)(ws + w.take((size_t)MTOT * 256 * 4)); c.GATE = (float*)(ws + w.take((size_t)MTOT * 24 * 4));
  c.GQ = (float*)(ws + w.take((size_t)MTOT * 512 * 4)); c.GK = (float*)(ws + w.take((size_t)MTOT * 512 * 4)); c.GV = (float*)(ws + w.take((size_t)MTOT * 512 * 4));
  c.GB = (float*)(ws + w.take((size_t)MTOT * 4 * 4)); c.GG = (float*)(ws + w.take((size_t)MTOT * 4 * 4));
  const size_t ncmp = ((size_t)BATCH * NCP + (size_t)DEC_BATCH * NCS) * 128 * 4;
  c.KCMP = (float*)(ws + w.take(ncmp)); c.VCMP = (float*)(ws + w.take(ncmp));
  c.SCP = (float*)(ws + w.take((size_t)MP * 8 * NCPS * 4)); c.SCS = (float*)(ws + w.take((size_t)MS * 8 * NCSS * 4));
  c.SCORE = (float*)(ws + w.take((size_t)MTOT * 2 * NSELMAX * 4)); c.SIDX = (int*)(ws + w.take((size_t)MTOT * 2 * 8 * 4));
  c.OG = (float*)(ws + w.take((size_t)MTOT * 512 * 4)); c.H1 = (float*)(ws + w.take((size_t)MTOT * D_MODEL * 4));
  c.Q2 = (float*)(ws + w.take((size_t)MTOT * D_MODEL * 4)); c.SX = (float*)(ws + w.take((size_t)MTOT * 4 * MEM_TOKENS * 4));
  c.H2 = (float*)(ws + w.take((size_t)MTOT * D_MODEL * 4));
  c.QCb = (bf16_t*)(ws + w.take((size_t)MTOT * 512 * 2)); c.QRb = (bf16_t*)(ws + w.take((size_t)MTOT * 512 * 2));
  c.KSb = (bf16_t*)(ws + w.take((size_t)BATCH * 2 * SEQ * 64 * 2)); c.VSTb = (bf16_t*)(ws + w.take((size_t)BATCH * 2 * SEQ * 64 * 2));
  c.KWb = (bf16_t*)(ws + w.take((size_t)BATCH * 2 * SEQ * 64 * 2)); c.VWTb = (bf16_t*)(ws + w.take((size_t)BATCH * 2 * SEQ * 64 * 2));
  c.KWsb = (bf16_t*)(ws + w.take((size_t)DEC_BATCH * 2 * 544 * 64 * 2)); c.VWTsb = (bf16_t*)(ws + w.take((size_t)DEC_BATCH * 2 * 544 * 64 * 2));
  { const size_t nb = ((size_t)BATCH * 2 * 128 + (size_t)DEC_BATCH * 2 * 512) * 64 * 2; c.KCb = (bf16_t*)(ws + w.take(nb)); c.VCTb = (bf16_t*)(ws + w.take(nb)); }
  { const size_t nb = (size_t)(BATCH + DEC_BATCH) * 4 * MEM_TOKENS * 256 * 2; c.KXb = (bf16_t*)(ws + w.take(nb)); c.VXTb = (bf16_t*)(ws + w.take(nb)); c.Q2b = (bf16_t*)(ws + w.take((size_t)MTOT * D_MODEL * 2)); }
  { constexpr size_t nchunk = (size_t)BATCH * 4 * (SEQ / 64) + (size_t)DEC_BATCH * 4;
    c.GS = (float*)(ws + w.take(nchunk * 64 * 256 * 4)); c.GWp = (bf16_t*)(ws + w.take(nchunk * 64 * 128 * 2)); c.GQKp = (bf16_t*)(ws + w.take(nchunk * 64 * 64 * 2));
    c.GQDp = (bf16_t*)(ws + w.take(nchunk * 64 * 128 * 2)); c.GKDTp = (bf16_t*)(ws + w.take(nchunk * 128 * 64 * 2)); c.GL = (float*)(ws + w.take(nchunk * 4)); }
  const size_t ssb = (size_t)MTOT * 8 * 512 * 4, upb = (size_t)MTOT * 2 * D_FF * 4; const size_t big = w.take(2 * ssb > upb ? 2 * ssb : upb);
  c.SS = (float*)(ws + big); c.SW = (float*)(ws + big + ssb); c.UP = (float*)(ws + big);
  return w.off;
}
typedef short bf16x8 __attribute__((ext_vector_type(8)));
typedef float f32x16 __attribute__((ext_vector_type(16)));
typedef float f32x4v __attribute__((ext_vector_type(4)));
typedef unsigned u32x4v __attribute__((ext_vector_type(4)));
typedef unsigned u32x2v __attribute__((ext_vector_type(2)));
#ifdef HOST_TEST
#include <ucontext.h>
struct EmuSlot { short a[8]; short b[8]; float c[16]; unsigned u; };
struct EmuWave {
  ucontext_t main_ctx; ucontext_t ctx[64]; char* stacks; int cur; int ndone; bool done[64]; int gen[64];
  EmuSlot slot[2][64]; void (*fn)(void*, int); void* arg;
};
static thread_local EmuWave* tl_emu = nullptr;
static void emu_trampoline(int lane) { EmuWave* e = tl_emu; e->fn(e->arg, lane); e->done[lane] = true; e->ndone++; swapcontext(&e->ctx[lane], &e->main_ctx); }
static void emu_run_wave(void (*fn)(void*, int), void* arg) {
  static thread_local EmuWave* e = nullptr; constexpr size_t STK = 256 * 1024;
  if (!e) { e = new EmuWave; e->stacks = (char*)malloc(64 * STK); }
  tl_emu = e; e->fn = fn; e->arg = arg; e->ndone = 0;
  for (int l = 0; l < 64; ++l) { e->done[l] = false; e->gen[l] = 0; getcontext(&e->ctx[l]); e->ctx[l].uc_stack.ss_sp = e->stacks + l * STK; e->ctx[l].uc_stack.ss_size = STK; e->ctx[l].uc_link = nullptr;
    makecontext(&e->ctx[l], (void (*)())emu_trampoline, 1, l); }
  while (e->ndone < 64) for (int l = 0; l < 64; ++l) if (!e->done[l]) { e->cur = l; swapcontext(&e->main_ctx, &e->ctx[l]); }
}
static inline EmuSlot* emu_my_slot() { EmuWave* e = tl_emu; return &e->slot[e->gen[e->cur] & 1][e->cur]; }
static inline EmuSlot* emu_exchange() { EmuWave* e = tl_emu; const int l = e->cur; swapcontext(&e->ctx[l], &e->main_ctx); e = tl_emu; EmuSlot* s = e->slot[e->gen[l] & 1]; e->gen[l]++; return s; }
static inline int wv_lane() { return tl_emu->cur; }
static inline float bfbits2f(short s) { return __builtin_bit_cast(float, (unsigned)(unsigned short)s << 16); }
static inline f32x16 wv_mfma32(bf16x8 a, bf16x8 b, f32x16 c) {
  EmuSlot* m = emu_my_slot(); for (int j = 0; j < 8; ++j) { m->a[j] = a[j]; m->b[j] = b[j]; }
  EmuSlot* s = emu_exchange(); const int l = wv_lane(), col = l & 31, hi = l >> 5; f32x16 d;
  for (int r = 0; r < 16; ++r) { const int row = (r & 3) + 8 * (r >> 2) + 4 * hi; float acc = c[r];
    for (int k = 0; k < 16; ++k) acc += bfbits2f(s[row + 32 * (k >> 3)].a[k & 7]) * bfbits2f(s[col + 32 * (k >> 3)].b[k & 7]);
    d[r] = acc; }
  return d;
}
static inline unsigned wv_shfl_xor_u(unsigned v, int mask) { emu_my_slot()->u = v; EmuSlot* s = emu_exchange(); return s[wv_lane() ^ mask].u; }
static inline unsigned wv_shfl_u(unsigned v, int src) { emu_my_slot()->u = v; EmuSlot* s = emu_exchange(); return s[src & 63].u; }
static inline unsigned long long wv_ballot(bool p) { emu_my_slot()->u = p ? 1u : 0u; EmuSlot* s = emu_exchange(); unsigned long long r = 0; for (int l = 0; l < 64; ++l) if (s[l].u) r |= 1ull << l; return r; }
static inline float wv_exp2(float x) { return exp2f(x); }
static inline float wv_rcp(float x) { return 1.f / x; }
static inline unsigned wv_pk_bf16(float lo, float hi) { return f2bf_u(lo) | (f2bf_u(hi) << 16); }
#define WV_DEV inline
static inline void wv_fence() { emu_my_slot()->u = 0; (void)emu_exchange(); }
#else
#define WV_DEV __device__ __forceinline__
WV_DEV int wv_lane() { return (int)(threadIdx.x & 63); }
WV_DEV void wv_fence() { asm volatile("s_waitcnt vmcnt(0) lgkmcnt(0)" ::: "memory"); }
WV_DEV f32x16 wv_mfma32(bf16x8 a, bf16x8 b, f32x16 c) { return __builtin_amdgcn_mfma_f32_32x32x16_bf16(a, b, c, 0, 0, 0); }
WV_DEV unsigned wv_shfl_xor_u(unsigned v, int mask) { return (unsigned)__shfl_xor((int)v, mask); }
WV_DEV unsigned wv_shfl_u(unsigned v, int src) { return (unsigned)__shfl((int)v, src); }
WV_DEV unsigned long long wv_ballot(bool p) { return __ballot(p); }
WV_DEV float wv_exp2(float x) { return __builtin_amdgcn_exp2f(x); }
WV_DEV float wv_rcp(float x) { return __builtin_amdgcn_rcpf(x); }
typedef float wv_f32x2 __attribute__((ext_vector_type(2))); typedef __bf16 wv_bf16x2 __attribute__((ext_vector_type(2)));
WV_DEV unsigned wv_pk_bf16(float lo, float hi) { wv_f32x2 v = {lo, hi}; wv_bf16x2 b = __builtin_convertvector(v, wv_bf16x2); return __builtin_bit_cast(unsigned, b); }
#endif
WV_DEV float wv_shfl_xor_f(float v, int mask) { return __builtin_bit_cast(float, wv_shfl_xor_u(__builtin_bit_cast(unsigned, v), mask)); }
WV_DEV bf16x8 wv_pack8(float a0, float a1, float a2, float a3, float a4, float a5, float a6, float a7) {
  u32x4v w; w.x = wv_pk_bf16(a0, a1); w.y = wv_pk_bf16(a2, a3); w.z = wv_pk_bf16(a4, a5); w.w = wv_pk_bf16(a6, a7); return __builtin_bit_cast(bf16x8, w); }
WV_DEV bf16x8 wv_ld8(const bf16_t* p) { return *(const bf16x8*)p; }
WV_DEV bf16x8 wv_ld8_f32(const float* p) { const f32x4v a = *(const f32x4v*)p, b = *(const f32x4v*)(p + 4); return wv_pack8(a.x, a.y, a.z, a.w, b.x, b.y, b.z, b.w); }
constexpr int WKS = 544;
HD int vperm16(int k) { const int w = k & 15; return (k & ~15) | ((((w >> 2) & 1) << 3) + ((w >> 3) << 2) + (w & 3)); }
HD size_t kc_off(bool sample, int b, int kvh) { return sample ? (size_t)BATCH * 2 * 128 * 64 + ((size_t)b * 2 + kvh) * 512 * 64 : ((size_t)b * 2 + kvh) * 128 * 64; }
struct StPackQ { const Ctx& c; static constexpr long N = (long)MTOT * 512;
  HD void operator()(long i) const { c.QCb[i] = f2bf(c.QC[i]); c.QRb[i] = f2bf(c.QR[i]); } };
struct StPackKV { const Ctx& c; static constexpr long N = (long)BATCH * 2 * SEQ * 64;
  HD void operator()(long i) const {
    const int d = (int)(i % 64), t = (int)((i / 64) % SEQ), kvh = (int)((i / 64 / SEQ) % 2), b = (int)(i / 64 / SEQ / 2);
    const float* row = c.out + O_KVP + ((size_t)b * SEQ + t) * 512; const float* wr = c.WR + ((size_t)b * SEQ + t) * 256;
    const size_t bk = (size_t)b * 2 + kvh;
    c.KSb[(bk * SEQ + t) * 64 + d] = f2bf(row[(2 * 2 + kvh) * 64 + d]); c.VSTb[(bk * 64 + d) * SEQ + vperm16(t)] = f2bf(row[(3 * 2 + kvh) * 64 + d]);
    c.KWb[(bk * SEQ + t) * 64 + d] = f2bf(wr[(0 * 2 + kvh) * 64 + d]); c.VWTb[(bk * 64 + d) * SEQ + vperm16(t)] = f2bf(wr[(1 * 2 + kvh) * 64 + d]);
  } };
struct StPackWinS { const Ctx& c; static constexpr long N = (long)DEC_BATCH * 2 * WKS * 64;
  HD void operator()(long i) const {
    const int d = (int)(i % 64), w = (int)((i / 64) % WKS), kvh = (int)((i / 64 / WKS) % 2), b = (int)(i / 64 / WKS / 2);
    float k = 0.f, v = 0.f;
    if (w < WBUF) { const float* r = c.cache_nsa_win + ((size_t)b * WBUF + w) * 256; k = r[(0 * 2 + kvh) * 64 + d]; v = r[(1 * 2 + kvh) * 64 + d]; }
    else if (w < WBUF + DEC_SEQ) { const float* r = c.WR + ((size_t)MP + b * DEC_SEQ + (w - WBUF)) * 256; k = r[(0 * 2 + kvh) * 64 + d]; v = r[(1 * 2 + kvh) * 64 + d]; }
    const size_t bk = (size_t)b * 2 + kvh;
    c.KWsb[(bk * WKS + w) * 64 + d] = f2bf(k); c.VWTsb[(bk * 64 + d) * WKS + vperm16(w)] = f2bf(v);
  } };
constexpr long NPC_P = (long)BATCH * 2 * 128 * 64, NPC_S = (long)DEC_BATCH * 2 * 512 * 64;
struct StPackCmp { const Ctx& c; static constexpr long N = NPC_P + NPC_S;
  HD void operator()(long i) const {
    const bool sample = i >= NPC_P; long r = sample ? i - NPC_P : i; const int cpad = sample ? 512 : 128, nc = sample ? NCS : NCP;
    const int d = (int)(r % 64); r /= 64; const int cb = (int)(r % cpad); r /= cpad; const int kvh = (int)(r % 2), b = (int)(r / 2);
    float k = 0.f, v = 0.f; if (cb < nc) { k = cmp_ptr(c, c.KCMP, sample, b, cb, kvh)[d]; v = cmp_ptr(c, c.VCMP, sample, b, cb, kvh)[d]; }
    const size_t o = kc_off(sample, b, kvh);
    c.KCb[o + (size_t)cb * 64 + d] = f2bf(k); c.VCTb[o + (size_t)d * cpad + vperm16(cb)] = f2bf(v);
  } };

HD int crow16(int r, int hi) { return (r & 3) + 8 * (r >> 2) + 4 * hi; }
struct SoftSt { float m, l; f32x16 o[2]; };
constexpr float NSA_SCL = 0.125f * 1.4426950408889634f;
WV_DEV void soft_step(SoftSt& st, const f32x16& S, unsigned vm, bf16x8 v00, bf16x8 v01, bf16x8 v10, bf16x8 v11) {
  float sc[16]; float mx = -3e38f;
#pragma unroll
  for (int r = 0; r < 16; ++r) { sc[r] = ((vm >> r) & 1u) ? S[r] * NSA_SCL : -3e38f; mx = fmaxf(mx, sc[r]); }
  mx = fmaxf(mx, wv_shfl_xor_f(mx, 32));
  const float mn = fmaxf(st.m, mx), alpha = wv_exp2(st.m - mn); st.m = mn;
  float p[16]; float sum = 0.f;
#pragma unroll
  for (int r = 0; r < 16; ++r) { p[r] = ((vm >> r) & 1u) ? wv_exp2(sc[r] - mn) : 0.f; sum += p[r]; }
  st.l = st.l * alpha + sum; st.o[0] = st.o[0] * alpha; st.o[1] = st.o[1] * alpha;
  const bf16x8 p0 = wv_pack8(p[0], p[1], p[2], p[3], p[4], p[5], p[6], p[7]), p1 = wv_pack8(p[8], p[9], p[10], p[11], p[12], p[13], p[14], p[15]);
  st.o[0] = wv_mfma32(v00, p0, st.o[0]); st.o[0] = wv_mfma32(v01, p1, st.o[0]);
  st.o[1] = wv_mfma32(v10, p0, st.o[1]); st.o[1] = wv_mfma32(v11, p1, st.o[1]);
}
WV_DEV void soft_finish(SoftSt& st, float gate, f32x16 (&ot)[2]) {
  const float l = st.l + wv_shfl_xor_f(st.l, 32); const float f = l > 0.f ? gate * wv_rcp(l) : 0.f;
  ot[0] = ot[0] + st.o[0] * f; ot[1] = ot[1] + st.o[1] * f;
}
WV_DEV f32x16 qk_tile(const bf16_t* krow  , const bf16x8 (&q)[4]) {
  f32x16 S = {};
#pragma unroll
  for (int ks = 0; ks < 4; ++ks) S = wv_mfma32(wv_ld8(krow + 16 * ks), q[ks], S);
  return S;
}
WV_DEV void cmp_tile2(const bf16_t* kcb, const bf16_t* vcb, int cpad, int tile, int r32, int hi, int ncv, float mc, float invc, const bf16x8 (&qc)[4], f32x16 (&oc)[2],
                      bool need_imp, float& prevLp, float (&v4)[4]) {
  const f32x16 S = qk_tile(kcb + (size_t)(tile * 32 + r32) * 64 + 8 * hi, qc);
  float p[16];
#pragma unroll
  for (int r = 0; r < 16; ++r) p[r] = (tile * 32 + crow16(r, hi) < ncv) ? wv_exp2(S[r] * NSA_SCL - mc) * invc : 0.f;
  if (need_imp) {
#pragma unroll
    for (int u = 0; u < 4; ++u) {
      const float lp = wv_shfl_xor_f(p[4 * u + 3], 32); float v = (p[4 * u] + p[4 * u + 1]) + (p[4 * u + 2] + p[4 * u + 3]) + (hi ? lp : prevLp); prevLp = lp;
      v += wv_shfl_xor_f(v, 1); v += wv_shfl_xor_f(v, 2); v4[u] = v; }
  }
  const bf16x8 p0 = wv_pack8(p[0], p[1], p[2], p[3], p[4], p[5], p[6], p[7]), p1 = wv_pack8(p[8], p[9], p[10], p[11], p[12], p[13], p[14], p[15]);
  const bf16_t* vb = vcb + (size_t)r32 * cpad + tile * 32 + 8 * hi;
  oc[0] = wv_mfma32(wv_ld8(vb), p0, oc[0]); oc[0] = wv_mfma32(wv_ld8(vb + 16), p1, oc[0]);
  oc[1] = wv_mfma32(wv_ld8(vb + (size_t)32 * cpad), p0, oc[1]); oc[1] = wv_mfma32(wv_ld8(vb + (size_t)32 * cpad + 16), p1, oc[1]);
}
HD const float* sample_row(const Ctx& c, int b, int kp) {
  if (kp < PAST_LEN) { const int pg = c.page_table[b * NPAGES + kp / PAGE_SIZE]; return c.cache_nsa_kv + ((size_t)pg * PAGE_SIZE + kp % PAGE_SIZE) * 512; }
  int j = kp - PAST_LEN; if (j > DEC_SEQ - 1) j = DEC_SEQ - 1; return c.out + O_KVS + ((size_t)b * DEC_SEQ + j) * 512;
}
template <bool SAMPLE> WV_DEV void nsa_unit(const Ctx& c, int unit, float* wscr  ) {
  constexpr int NC = SAMPLE ? NCS : NCP, CPAD = SAMPLE ? 512 : 128, NCT = CPAD / 32, NI = NCT * 4;
  const int lane = wv_lane(), r32 = lane & 31, hi = lane >> 5, tt = r32 >> 2, g = r32 & 3;
  int b, kvh, t0;
  if (SAMPLE) { b = unit >> 1; kvh = unit & 1; t0 = 0; } else { const int tile = unit % (SEQ / 8), bk = unit / (SEQ / 8); t0 = tile * 8; kvh = bk & 1; b = bk >> 1; }
  const int m = (SAMPLE ? MP + b * DEC_SEQ : b * SEQ + t0) + tt, pos = (SAMPLE ? PAST_LEN : t0) + tt, h = kvh * 4 + g;
  const int pos_last = (SAMPLE ? PAST_LEN : t0) + 7;
  bf16x8 qc[4], qr[4];
#pragma unroll
  for (int ks = 0; ks < 4; ++ks) { qc[ks] = wv_ld8(c.QCb + (size_t)m * 512 + h * 64 + 16 * ks + 8 * hi); qr[ks] = wv_ld8(c.QRb + (size_t)m * 512 + h * 64 + 16 * ks + 8 * hi); }
  const float* gate = c.GATE + (size_t)m * 24 + h * 3;
  f32x16 ot[2]; ot[0] = f32x16{}; ot[1] = f32x16{};
  const bf16_t* kcb = c.KCb + kc_off(SAMPLE, b, kvh); const bf16_t* vcb = c.VCTb + kc_off(SAMPLE, b, kvh);
  const int ncv = pos >= 31 ? ((pos - 31) / 16 + 1 < NC ? (pos - 31) / 16 + 1 : NC) : 0;
  const int ncv_last = pos_last >= 31 ? ((pos_last - 31) / 16 + 1 < NC ? (pos_last - 31) / 16 + 1 : NC) : 0;
  const int ntc = (ncv_last + 31) / 32;
  float mc = -3e38f, lc = 0.f;
  for (int tile = 0; tile < ntc; ++tile) {
    const f32x16 S = qk_tile(kcb + (size_t)(tile * 32 + r32) * 64 + 8 * hi, qc);
    float sc[16]; float mx = -3e38f;
#pragma unroll
    for (int r = 0; r < 16; ++r) { const bool v = tile * 32 + crow16(r, hi) < ncv; sc[r] = v ? S[r] * NSA_SCL : -3e38f; mx = fmaxf(mx, sc[r]); }
    mx = fmaxf(mx, wv_shfl_xor_f(mx, 32));
    const float mn = fmaxf(mc, mx); float sum = 0.f;
#pragma unroll
    for (int r = 0; r < 16; ++r) sum += (tile * 32 + crow16(r, hi) < ncv) ? wv_exp2(sc[r] - mn) : 0.f;
    lc = lc * wv_exp2(mc - mn) + sum; mc = mn;
  }
  lc = lc + wv_shfl_xor_f(lc, 32);
  const float invc = lc > 0.f ? wv_rcp(lc) : 0.f;
  const int qblk = pos >> 6;
  const bool need_imp = SAMPLE || qblk > 7;
  unsigned long long sel0 = 0ull, sel1 = 0ull;
  float prevLp = 0.f; f32x16 oc[2]; oc[0] = f32x16{}; oc[1] = f32x16{};
  if constexpr (!SAMPLE) {
    float imp[NI];
#pragma unroll
    for (int i = 0; i < NI; ++i) imp[i] = -1.f;
#pragma unroll
    for (int tile = 0; tile < NCT; ++tile) {
      if (tile < ntc) { float v4[4] = {0.f, 0.f, 0.f, 0.f};
        cmp_tile2(kcb, vcb, CPAD, tile, r32, hi, ncv, mc, invc, qc, oc, need_imp, prevLp, v4);
#pragma unroll
        for (int u = 0; u < 4; ++u) { const int s = 2 * (tile * 4 + u) + hi; imp[tile * 4 + u] = (need_imp && s >= 1 && s <= qblk - 2) ? v4[u] : -1.f; } }
    }
    if (!need_imp) sel0 = (2ull << qblk) - 1ull;
    else {
      for (int round = 0; round < 5; ++round) {
        float bv = -1.f; int bs = 1 << 20;
#pragma unroll
        for (int i = 0; i < NI; ++i) if (imp[i] > bv) { bv = imp[i]; bs = 2 * i + hi; }
        const float pv = wv_shfl_xor_f(bv, 32); const int ps = (int)wv_shfl_xor_u((unsigned)bs, 32);
        const int ws = (pv > bv || (pv == bv && ps < bs)) ? ps : bs;
        sel0 |= 1ull << ws;
#pragma unroll
        for (int i = 0; i < NI; ++i) if (2 * i + hi == ws) imp[i] = -1.f;
      }
      sel0 |= 1ull | (1ull << qblk) | (1ull << (qblk - 1));
    }
  } else {
    for (int tile = 0; tile < ntc; ++tile) { float v4[4] = {0.f, 0.f, 0.f, 0.f};
      cmp_tile2(kcb, vcb, CPAD, tile, r32, hi, ncv, mc, invc, qc, oc, true, prevLp, v4);
      if (g == 0) {
#pragma unroll
        for (int u = 0; u < 4; ++u) wscr[tt * 128 + 2 * (tile * 4 + u) + hi] = v4[u]; }
    }
    wv_fence();
    const int sl = (g * 2 + hi) * 16; int w0 = -1, w1 = -1, w2 = -1, w3 = -1;
    for (int round = 0; round < 5; ++round) {
      float bv = -1.f; int bs = 1 << 20;
      for (int j = 0; j < 16; ++j) { const int s = sl + j; const float v = wscr[tt * 128 + s];
        const bool cand = s >= 1 && s <= qblk - 2 && s != w0 && s != w1 && s != w2 && s != w3;
        if (cand && v > bv) { bv = v; bs = s; } }
#pragma unroll
      for (int sh = 0; sh < 3; ++sh) { const int msk = sh == 0 ? 1 : sh == 1 ? 2 : 32;
        const float pv = wv_shfl_xor_f(bv, msk); const int ps = (int)wv_shfl_xor_u((unsigned)bs, msk);
        if (pv > bv || (pv == bv && ps < bs)) { bv = pv; bs = ps; } }
      if (bs < 64) sel0 |= 1ull << bs; else if (bs < 128) sel1 |= 1ull << (bs - 64);
      w3 = w2; w2 = w1; w1 = w0; w0 = bs;
    }
    sel0 |= 1ull;
    if (qblk < 64) sel0 |= 1ull << qblk; else if (qblk < 128) sel1 |= 1ull << (qblk - 64);
    if (qblk - 1 < 64) sel0 |= 1ull << (qblk - 1); else if (qblk - 1 < 128) sel1 |= 1ull << (qblk - 1 - 64);
  }
  { const float g0 = gate[0]; ot[0] = oc[0] * g0; ot[1] = oc[1] * g0; }
  unsigned long long un0 = sel0, un1 = sel1;
#pragma unroll
  for (int sh = 4; sh <= 16; sh <<= 1) {
    un0 |= (unsigned long long)wv_shfl_xor_u((unsigned)un0, sh) | ((unsigned long long)wv_shfl_xor_u((unsigned)(un0 >> 32), sh) << 32);
    if (SAMPLE) un1 |= (unsigned long long)wv_shfl_xor_u((unsigned)un1, sh) | ((unsigned long long)wv_shfl_xor_u((unsigned)(un1 >> 32), sh) << 32);
  }
  { SoftSt st; st.m = -3e38f; st.l = 0.f; st.o[0] = f32x16{}; st.o[1] = f32x16{};
    const int nblk = SAMPLE ? NSELS : qblk + 1;
    for (int s = 0; s < nblk; ++s) {
      const bool in_union = SAMPLE ? (s == NSELS - 1 || (s < 64 ? (un0 >> s) & 1ull : (un1 >> (s - 64)) & 1ull)) : ((un0 >> s) & 1ull);
      if (!in_union) continue;
      const bool mine = SAMPLE ? (s == NSELS - 1 || (s < 64 ? (sel0 >> s) & 1ull : (sel1 >> (s - 64)) & 1ull)) : ((sel0 >> s) & 1ull);
      for (int half = 0; half < 2; ++half) {
        const int kb = s * 64 + half * 32; if (kb > pos_last) break;
        unsigned vm = 0u;
#pragma unroll
        for (int r = 0; r < 16; ++r) if (mine && kb + crow16(r, hi) <= pos) vm |= 1u << r;
        if (!SAMPLE) {
          const size_t bk = (size_t)b * 2 + kvh;
          const f32x16 S = qk_tile(c.KSb + (bk * SEQ + kb + r32) * 64 + 8 * hi, qr);
          const bf16_t* vb = c.VSTb + (bk * 64 + r32) * SEQ + kb + 8 * hi;
          soft_step(st, S, vm, wv_ld8(vb), wv_ld8(vb + 16), wv_ld8(vb + (size_t)32 * SEQ), wv_ld8(vb + (size_t)32 * SEQ + 16));
        } else {
          const float* krow = sample_row(c, b, kb + r32) + (2 * 2 + kvh) * 64 + 8 * hi;
          f32x16 S = {};
#pragma unroll
          for (int ks = 0; ks < 4; ++ks) S = wv_mfma32(wv_ld8_f32(krow + 16 * ks), qr[ks], S);
          bf16x8 vf[2][2];
#pragma unroll
          for (int ks = 0; ks < 2; ++ks) { float v0[8], v1[8];
#pragma unroll
            for (int j = 0; j < 8; ++j) { const float* vr = sample_row(c, b, kb + 16 * ks + 8 * (j >> 2) + 4 * hi + (j & 3)) + (3 * 2 + kvh) * 64; v0[j] = vr[r32]; v1[j] = vr[32 + r32]; }
            vf[0][ks] = wv_pack8(v0[0], v0[1], v0[2], v0[3], v0[4], v0[5], v0[6], v0[7]); vf[1][ks] = wv_pack8(v1[0], v1[1], v1[2], v1[3], v1[4], v1[5], v1[6], v1[7]); }
          soft_step(st, S, vm, vf[0][0], vf[0][1], vf[1][0], vf[1][1]);
        }
      }
    }
    soft_finish(st, gate[1], ot); }
  { SoftSt st; st.m = -3e38f; st.l = 0.f; st.o[0] = f32x16{}; st.o[1] = f32x16{};
    if (!SAMPLE) {
      const size_t bk = (size_t)b * 2 + kvh; const int lo = t0 - (WINDOW - 1) > 0 ? t0 - (WINDOW - 1) : 0;
      for (int kb = lo & ~31; kb <= pos_last; kb += 32) {
        unsigned vm = 0u;
#pragma unroll
        for (int r = 0; r < 16; ++r) { const int key = kb + crow16(r, hi); if (key <= pos && key > pos - WINDOW) vm |= 1u << r; }
        const f32x16 S = qk_tile(c.KWb + (bk * SEQ + kb + r32) * 64 + 8 * hi, qr);
        const bf16_t* vb = c.VWTb + (bk * 64 + r32) * SEQ + kb + 8 * hi;
        soft_step(st, S, vm, wv_ld8(vb), wv_ld8(vb + 16), wv_ld8(vb + (size_t)32 * SEQ), wv_ld8(vb + (size_t)32 * SEQ + 16));
      }
    } else {
      const size_t bk = (size_t)b * 2 + kvh;
      for (int kb = 0; kb < WKS; kb += 32) {
        unsigned vm = 0u;
#pragma unroll
        for (int r = 0; r < 16; ++r) { const int i = kb + crow16(r, hi); if (i >= tt + 1 && i <= WBUF + tt) vm |= 1u << r; }
        const f32x16 S = qk_tile(c.KWsb + (bk * WKS + kb + r32) * 64 + 8 * hi, qr);
        const bf16_t* vb = c.VWTsb + (bk * 64 + r32) * WKS + kb + 8 * hi;
        soft_step(st, S, vm, wv_ld8(vb), wv_ld8(vb + 16), wv_ld8(vb + (size_t)32 * WKS), wv_ld8(vb + (size_t)32 * WKS + 16));
      }
    }
    soft_finish(st, gate[2], ot); }
  bf16_t* orow = c.CAT + (size_t)m * D_MODEL + h * 64 + 4 * hi;
#pragma unroll
  for (int db = 0; db < 2; ++db)
#pragma unroll
    for (int u = 0; u < 4; ++u) { u32x2v w; w.x = wv_pk_bf16(ot[db][4 * u], ot[db][4 * u + 1]); w.y = wv_pk_bf16(ot[db][4 * u + 2], ot[db][4 * u + 3]); *(u32x2v*)(orow + db * 32 + 8 * u) = w; }
}
constexpr int NSA_UNITS_P = BATCH * 2 * (SEQ / 8), NSA_UNITS_S = DEC_BATCH * 2;
constexpr int XNT = MEM_TOKENS / 32;
HD int bb_row0(int bb) { return bb < BATCH ? bb * SEQ : MP + (bb - BATCH) * DEC_SEQ; }
struct StPackX { const Ctx& c; static constexpr long N = (long)(BATCH + DEC_BATCH) * 4 * MEM_TOKENS * 256;
  HD void operator()(long i) const {
    const int d = (int)(i % 256), j = (int)((i / 256) % MEM_TOKENS), h = (int)((i / 256 / MEM_TOKENS) % 4), bb = (int)(i / 256 / MEM_TOKENS / 4);
    const int m = bb_row0(bb); const size_t bh = (size_t)bb * 4 + h;
    c.KXb[(bh * MEM_TOKENS + j) * 256 + d] = f2bf(memkv_row(c, m, j, 0, h)[d]); c.VXTb[(bh * 256 + d) * MEM_TOKENS + vperm16(j)] = f2bf(memkv_row(c, m, j, 1, h)[d]);
  } };
struct StXqNormB { const Ctx& c; static constexpr long N = (long)MTOT * 4;
  HD void operator()(long i) const {
    const float* q = c.Q2 + (size_t)(i / 4) * D_MODEL + (i % 4) * 256; bf16_t* o = c.Q2b + (size_t)(i / 4) * D_MODEL + (i % 4) * 256;
    float ss = 0.f; for (int d = 0; d < 256; ++d) ss += q[d] * q[d];
    const float r = 1.f / sqrtf(ss / 256.f + EPS); for (int d = 0; d < 256; ++d) o[d] = f2bf(q[d] * r * c.xq_norm_w[d]);
  } };
constexpr int XA_UNITS_P = BATCH * 4 * (SEQ / 32), XA_UNITS_S = DEC_BATCH * 4;
template <bool SAMPLE> WV_DEV void xattn_unit(const Ctx& c, int unit) {
  const int lane = wv_lane(), r32 = lane & 31, hi = lane >> 5;
  int h, bb, m; bool valid = true;
  if (!SAMPLE) { const int tile = unit % (SEQ / 32), bh = unit / (SEQ / 32); h = bh & 3; bb = bh >> 2; m = bb * SEQ + tile * 32 + r32; }
  else { h = unit & 3; const int b = unit >> 2; bb = BATCH + b; m = MP + b * DEC_SEQ + (r32 & (DEC_SEQ - 1)); valid = r32 < DEC_SEQ; }
  const bf16_t* qrow = c.Q2b + (size_t)m * D_MODEL + h * 256 + 8 * hi;
  const bf16_t* kb = c.KXb + ((size_t)bb * 4 + h) * MEM_TOKENS * 256 + (size_t)r32 * 256 + 8 * hi;
  const bf16_t* vb = c.VXTb + ((size_t)bb * 4 + h) * 256 * MEM_TOKENS + (size_t)r32 * MEM_TOKENS + 8 * hi;
  f32x16 S[XNT];
#pragma unroll
  for (int t = 0; t < XNT; ++t) S[t] = f32x16{};
#pragma unroll 2
  for (int ks = 0; ks < 16; ++ks) { const bf16x8 qf = wv_ld8(qrow + 16 * ks);
#pragma unroll
    for (int t = 0; t < XNT; ++t) S[t] = wv_mfma32(wv_ld8(kb + (size_t)t * 32 * 256 + 16 * ks), qf, S[t]); }
  constexpr float SC = 0.0625f * 1.4426950408889634f;
  float mx = -3e38f;
#pragma unroll
  for (int t = 0; t < XNT; ++t)
#pragma unroll
    for (int r = 0; r < 16; ++r) mx = fmaxf(mx, S[t][r]);
  mx = fmaxf(mx, wv_shfl_xor_f(mx, 32));
  float sum = 0.f; bf16x8 pf[XNT][2];
#pragma unroll
  for (int t = 0; t < XNT; ++t) { float p[16];
#pragma unroll
    for (int r = 0; r < 16; ++r) { p[r] = wv_exp2((S[t][r] - mx) * SC); sum += p[r]; }
    pf[t][0] = wv_pack8(p[0], p[1], p[2], p[3], p[4], p[5], p[6], p[7]); pf[t][1] = wv_pack8(p[8], p[9], p[10], p[11], p[12], p[13], p[14], p[15]); }
  sum += wv_shfl_xor_f(sum, 32);
  const float inv = wv_rcp(sum);
  bf16_t* orow = c.OX + (size_t)m * D_MODEL + h * 256 + 4 * hi;
  for (int db = 0; db < 8; ++db) { f32x16 o = {};
#pragma unroll
    for (int t = 0; t < XNT; ++t) { o = wv_mfma32(wv_ld8(vb + (size_t)db * 32 * MEM_TOKENS + t * 32), pf[t][0], o); o = wv_mfma32(wv_ld8(vb + (size_t)db * 32 * MEM_TOKENS + t * 32 + 16), pf[t][1], o); }
    if (valid) {
#pragma unroll
      for (int u = 0; u < 4; ++u) { u32x2v w; w.x = wv_pk_bf16(o[4 * u] * inv, o[4 * u + 1] * inv); w.y = wv_pk_bf16(o[4 * u + 2] * inv, o[4 * u + 3] * inv); *(u32x2v*)(orow + db * 32 + 8 * u) = w; } }
  }
}
constexpr int NCH = SEQ / 64;
constexpr int NCHUNK_P = BATCH * 4 * NCH, NCHUNK = NCHUNK_P + DEC_BATCH * 4;
constexpr int GDN_PREP_UNITS = NCHUNK * 4, GDN_SCAN_UNITS = (BATCH + DEC_BATCH) * 4 * 4;
constexpr int GDN_WSCR_FLOATS = 64 * 64 + 128;
HD void chunk_decode(int ch, int& b, int& h, int& m0, int& nvalid) {
  if (ch < NCHUNK_P) { const int n = ch % NCH, bh = ch / NCH; h = bh & 3; b = bh >> 2; m0 = b * SEQ + n * 64; nvalid = 64; }
  else { const int r = ch - NCHUNK_P; h = r & 3; b = r >> 2; m0 = MP + b * DEC_SEQ; nvalid = DEC_SEQ; }
}
WV_DEV bf16x8 ldrow8(const float* buf, int m0, int i, int nvalid, int off) {
  if (i < nvalid) return wv_ld8_f32(buf + (size_t)(m0 + i) * 512 + off);
  return bf16x8{};
}
WV_DEV void gdn_prep_unit(const Ctx& c, int unit, float* wscr) {
  const int lane = wv_lane(), r32 = lane & 31, hi = lane >> 5, ch = unit >> 2, quarter = unit & 3;
  int b, h, m0, nvalid; chunk_decode(ch, b, h, m0, nvalid);
  float* At = wscr; float* gcs = wscr + 4096; float* bts = wscr + 4160;
  const float gi = lane < nvalid ? c.GG[(size_t)(m0 + lane) * 4 + h] : 0.f, bi = lane < nvalid ? c.GB[(size_t)(m0 + lane) * 4 + h] : 0.f;
  float gc = gi;
#pragma unroll
  for (int off = 1; off < 64; off <<= 1) { const float t = __builtin_bit_cast(float, wv_shfl_u(__builtin_bit_cast(unsigned, gc), lane - off)); if (lane >= off) gc += t; }
  gcs[lane] = gc; bts[lane] = bi;
  const float g_last = __builtin_bit_cast(float, wv_shfl_u(__builtin_bit_cast(unsigned, gc), 63));
  wv_fence();
#pragma unroll
  for (int bp = 0; bp < 3; ++bp) { const int ib = bp == 0 ? 0 : 1, jb = bp == 2 ? 1 : 0;
    f32x16 S = {};
#pragma unroll 2
    for (int ks = 0; ks < 8; ++ks) S = wv_mfma32(ldrow8(c.GK, m0, ib * 32 + r32, nvalid, h * 128 + 16 * ks + 8 * hi), ldrow8(c.GK, m0, jb * 32 + r32, nvalid, h * 128 + 16 * ks + 8 * hi), S);
    const int j = jb * 32 + r32; const float gcj = gcs[j];
#pragma unroll
    for (int r = 0; r < 16; ++r) { const int i = ib * 32 + crow16(r, hi); At[j * 64 + i] = (j < i) ? bts[i] * S[r] * expf(gcs[i] - gcj) : 0.f; }
  }
#pragma unroll
  for (int r = 0; r < 16; ++r) At[(32 + r32) * 64 + crow16(r, hi)] = 0.f;
  wv_fence();
  { const int col = quarter * 64 + lane; const bool isu = col < 128; const int dcol = isu ? col : col - 128; const float* src = isu ? c.GV : c.GK;
    float* solm = c.GS + (size_t)ch * 64 * 256 + col; const int slot = vperm16(dcol);
    for (int rb = 0; rb < 4; ++rb) {
      float acc[16];
#pragma unroll
      for (int i = 0; i < 16; ++i) { const int row = rb * 16 + i; const float x = row < nvalid ? src[(size_t)(m0 + row) * 512 + h * 128 + dcol] : 0.f; acc[i] = x * bts[row] * (isu ? 1.f : expf(gcs[row])); }
      for (int j = 0; j < rb * 16; ++j) { const float sj = solm[(size_t)j * 256]; const float* at = At + j * 64 + rb * 16;
#pragma unroll
        for (int i = 0; i < 16; ++i) acc[i] -= at[i] * sj; }
#pragma unroll
      for (int j = 0; j < 16; ++j) { const float sj = acc[j]; const float* at = At + (rb * 16 + j) * 64 + rb * 16;
#pragma unroll
        for (int i = 0; i < 16; ++i) if (i > j) acc[i] -= at[i] * sj; }
#pragma unroll
      for (int i = 0; i < 16; ++i) { solm[(size_t)(rb * 16 + i) * 256] = acc[i]; if (!isu) c.GWp[((size_t)ch * 64 + rb * 16 + i) * 128 + slot] = f2bf(-acc[i]); }
      wv_fence();
    }
  }
  if (quarter == 0) {
#pragma unroll
    for (int bp = 0; bp < 3; ++bp) { const int ib = bp == 0 ? 0 : 1, jb = bp == 2 ? 1 : 0;
      f32x16 S = {};
#pragma unroll 2
      for (int ks = 0; ks < 8; ++ks) S = wv_mfma32(ldrow8(c.GQ, m0, ib * 32 + r32, nvalid, h * 128 + 16 * ks + 8 * hi), ldrow8(c.GK, m0, jb * 32 + r32, nvalid, h * 128 + 16 * ks + 8 * hi), S);
      const int j = jb * 32 + r32; const float gcj = gcs[j]; const int slot = vperm16(j);
#pragma unroll
      for (int r = 0; r < 16; ++r) { const int i = ib * 32 + crow16(r, hi); c.GQKp[((size_t)ch * 64 + i) * 64 + slot] = f2bf((j <= i) ? S[r] * expf(gcs[i] - gcj) : 0.f); }
    }
  } else if (quarter == 1) {
    const float e = expf(gc); const float* q = c.GQ + (size_t)(m0 + lane) * 512 + h * 128;
#pragma unroll
    for (int g16 = 0; g16 < 8; ++g16)
#pragma unroll
      for (int h2 = 0; h2 < 2; ++h2) { f32x4v lo = {0.f, 0.f, 0.f, 0.f}, hv = {0.f, 0.f, 0.f, 0.f};
        if (lane < nvalid) { lo = *(const f32x4v*)(q + g16 * 16 + 4 * h2); hv = *(const f32x4v*)(q + g16 * 16 + 8 + 4 * h2); }
        *(bf16x8*)(c.GQDp + ((size_t)ch * 64 + lane) * 128 + g16 * 16 + h2 * 8) = wv_pack8(lo.x * e, lo.y * e, lo.z * e, lo.w * e, hv.x * e, hv.y * e, hv.z * e, hv.w * e); }
  } else if (quarter == 2) {
#pragma unroll 1
    for (int pass = 0; pass < 2; ++pass) { const int dk = lane + 64 * pass; const float* kcol = c.GK + (size_t)m0 * 512 + h * 128 + dk;
#pragma unroll 1
      for (int g8 = 0; g8 < 8; ++g8) { const int g16 = g8 >> 1, h2 = g8 & 1; float v[8];
#pragma unroll
        for (int j = 0; j < 8; ++j) { const int i = g16 * 16 + 8 * (j >> 2) + 4 * h2 + (j & 3); v[j] = i < nvalid ? kcol[(size_t)i * 512] * expf(g_last - gcs[i]) : 0.f; }
        *(bf16x8*)(c.GKDTp + ((size_t)ch * 128 + dk) * 64 + g16 * 16 + h2 * 8) = wv_pack8(v[0], v[1], v[2], v[3], v[4], v[5], v[6], v[7]); } }
  } else { if (lane == 0) c.GL[ch] = g_last; }
  wv_fence();
}
WV_DEV void gdn_scan_unit(const Ctx& c, int unit) {
  const int lane = wv_lane(), r32 = lane & 31, hi = lane >> 5, bbh = unit >> 2, dv0 = (unit & 3) * 32;
  const bool sample = bbh >= BATCH * 4; const int idx = sample ? bbh - BATCH * 4 : bbh, b = idx >> 2, h = idx & 3;
  const int nch = sample ? 1 : NCH, chunk0 = sample ? NCHUNK_P + idx : idx * NCH, nvalid = sample ? DEC_SEQ : 64;
  f32x16 S[4];
#pragma unroll
  for (int kb = 0; kb < 4; ++kb)
#pragma unroll
    for (int r = 0; r < 16; ++r) S[kb][r] = sample ? c.state_gdn[(((size_t)b * 4 + h) * 128 + kb * 32 + crow16(r, hi)) * 128 + dv0 + r32] : 0.f;
  for (int n = 0; n < nch; ++n) { const int ch = chunk0 + n; const int m0 = sample ? MP + b * DEC_SEQ : b * SEQ + n * 64;
    bf16x8 sf[4][2];
#pragma unroll
    for (int kb = 0; kb < 4; ++kb)
#pragma unroll
      for (int s = 0; s < 2; ++s) sf[kb][s] = wv_pack8(S[kb][8 * s], S[kb][8 * s + 1], S[kb][8 * s + 2], S[kb][8 * s + 3], S[kb][8 * s + 4], S[kb][8 * s + 5], S[kb][8 * s + 6], S[kb][8 * s + 7]);
    f32x16 vn[2], o[2];
#pragma unroll
    for (int cb = 0; cb < 2; ++cb) {
#pragma unroll
      for (int r = 0; r < 16; ++r) vn[cb][r] = c.GS[((size_t)ch * 64 + cb * 32 + crow16(r, hi)) * 256 + dv0 + r32];
      o[cb] = f32x16{};
      const bf16_t* wrow = c.GWp + ((size_t)ch * 64 + cb * 32 + r32) * 128 + 8 * hi; const bf16_t* qrow = c.GQDp + ((size_t)ch * 64 + cb * 32 + r32) * 128 + 8 * hi;
#pragma unroll
      for (int kb = 0; kb < 4; ++kb)
#pragma unroll
        for (int s = 0; s < 2; ++s) { vn[cb] = wv_mfma32(wv_ld8(wrow + kb * 32 + 16 * s), sf[kb][s], vn[cb]); o[cb] = wv_mfma32(wv_ld8(qrow + kb * 32 + 16 * s), sf[kb][s], o[cb]); }
    }
    bf16x8 vf[2][2];
#pragma unroll
    for (int kc = 0; kc < 2; ++kc)
#pragma unroll
      for (int s = 0; s < 2; ++s) vf[kc][s] = wv_pack8(vn[kc][8 * s], vn[kc][8 * s + 1], vn[kc][8 * s + 2], vn[kc][8 * s + 3], vn[kc][8 * s + 4], vn[kc][8 * s + 5], vn[kc][8 * s + 6], vn[kc][8 * s + 7]);
#pragma unroll
    for (int bp = 0; bp < 3; ++bp) { const int cb = bp == 0 ? 0 : 1, kc = bp == 2 ? 1 : 0;
      const bf16_t* arow = c.GQKp + ((size_t)ch * 64 + cb * 32 + r32) * 64 + kc * 32 + 8 * hi;
      o[cb] = wv_mfma32(wv_ld8(arow), vf[kc][0], o[cb]); o[cb] = wv_mfma32(wv_ld8(arow + 16), vf[kc][1], o[cb]); }
#pragma unroll
    for (int cb = 0; cb < 2; ++cb)
#pragma unroll
      for (int r = 0; r < 16; ++r) { const int i = cb * 32 + crow16(r, hi); if (i < nvalid) c.OG[(size_t)(m0 + i) * 512 + h * 128 + dv0 + r32] = o[cb][r]; }
    const float e = expf(c.GL[ch]);
#pragma unroll
    for (int kb = 0; kb < 4; ++kb) { S[kb] = S[kb] * e;
      const bf16_t* krow = c.GKDTp + ((size_t)ch * 128 + kb * 32 + r32) * 64 + 8 * hi;
#pragma unroll
      for (int kc = 0; kc < 2; ++kc)
#pragma unroll
        for (int s = 0; s < 2; ++s) S[kb] = wv_mfma32(wv_ld8(krow + kc * 32 + 16 * s), vf[kc][s], S[kb]); }
  }
  float* so = c.out + (sample ? O_STS : O_STP) + ((size_t)b * 4 + h) * 128 * 128;
#pragma unroll
  for (int kb = 0; kb < 4; ++kb)
#pragma unroll
    for (int r = 0; r < 16; ++r) so[(size_t)(kb * 32 + crow16(r, hi)) * 128 + dv0 + r32] = S[kb][r];
}
namespace pg8 {
#define PG8_LAS __attribute__((address_space(3)))
typedef unsigned short bf16_t;
typedef short bf16x8 __attribute__((ext_vector_type(8)));
typedef float f32x4 __attribute__((ext_vector_type(4)));
typedef unsigned u32x4 __attribute__((ext_vector_type(4)));
constexpr int BM = 256, BK = 64, HALF = 128, HTB = HALF * BK * 2  , STAGE_BYTES = 8 * HTB, NXCD = 8, WGM = 8;

__host__ __device__ __forceinline__ int lds_byte(int r, int c) { const int st = (r >> 4) * 2 + (c >> 5), rr = r & 15, cc = c & 31, ob = rr * 64 + cc * 2; return st * 1024 + (ob ^ (((ob >> 9) & 1) << 5)); }
__host__ __device__ __forceinline__ void stage_rc(int b, int& R, int& C) { const int st = b / 1024, sb = b % 1024, swz = sb ^ (((sb >> 9) & 1) << 5); R = (st >> 1) * 16 + swz / 64; C = (st & 1) * 32 + (swz % 64) / 2; }
__host__ __device__ __forceinline__ int perm32(int rho) { const int n = rho >> 4, i = rho & 15; return 8 * (i >> 2) + 4 * n + (i & 3); }

struct Unit { int pm, pn; };
struct Gemm { const bf16_t* A; const bf16_t* Bt; int M, N, K; };

struct StaticOrder {
    int nM, nN, nwg, G, c;
    __host__ __device__ void init(int M, int N, int G_, int c_) { nM = M / BM; nN = N / BM; nwg = nM * nN; G = G_; c = c_; }
    __host__ __device__ bool next(int i, Unit& u) const {
        const long L = (long)i * G + c; if (L >= nwg) return false;
        int wgid = (int)L; { const int q = nwg / NXCD, r = nwg % NXCD, xcd = wgid % NXCD, off = wgid / NXCD; wgid = (xcd < r ? xcd * (q + 1) : r * (q + 1) + (xcd - r) * q) + off; }
        const int nig = WGM * nN, gid = wgid / nig, fm = gid * WGM, gsz = (nM - fm) < WGM ? (nM - fm) : WGM;
        u.pm = fm + ((wgid % nig) % gsz); u.pn = (wgid % nig) / gsz; return true;
    }
    __device__ __forceinline__ void a_ready(const Unit&) const {}
    __device__ __forceinline__ void done(const Unit&) const {}
};

struct EpiF32 { static constexpr bool PERM = false, AFTER_DRAIN = false;
  float* C; int ldc; const float* resP; const float* resS; int mp;
  __device__ __forceinline__ void operator()(const f32x4 (&acc)[2][2][4][2], const Unit& u, int wr, int wc, int fr, int fq) const {
#pragma unroll
    for (int ai = 0; ai < 2; ++ai)
#pragma unroll
      for (int m = 0; m < 4; ++m) {
        const int row = u.pm * BM + ai * HALF + wr * 64 + m * 16 + fr;
        float* crow = C + (size_t)row * ldc;
        const float* rrow = resP ? (row < mp ? resP + (size_t)row * 1024 : resS + (size_t)(row - mp) * 1024) : nullptr;
#pragma unroll
        for (int bj = 0; bj < 2; ++bj)
#pragma unroll
          for (int n = 0; n < 2; ++n) {
            const int col = u.pn * BM + bj * HALF + wc * 32 + n * 16 + 4 * fq;
            f32x4 v = acc[ai][bj][m][n]; if (rrow) v += *(const f32x4*)(rrow + col);
            *(f32x4*)(crow + col) = v;
          }
      }
  } };
template <class Epi, class Sched, bool ALIGN_EPI = false, bool SP2 = false>
__device__ __forceinline__ void gemm_phase(PG8_LAS unsigned char* lds, const Gemm g, const Sched& S, const Epi& E) {
    const int tid = threadIdx.x, wid = __builtin_amdgcn_readfirstlane(tid >> 6), lane = tid & 63, wr = wid >> 2, wc = wid & 3, fr = lane & 15, fq = lane >> 4;
    const int K = g.K, nt = K / BK;
    unsigned voffA[2], voffB[2];
#pragma unroll
    for (int i = 0; i < 2; ++i) { int R, C; stage_rc(tid * 16 + i * 8192, R, C); const int Rb = Epi::PERM ? ((R & ~31) + perm32(R & 31)) : R;
        voffA[i] = (unsigned)(R * K + C) * 2u; voffB[i] = (unsigned)(Rb * K + C) * 2u; }
    const size_t kstep = (size_t)(BK * 2);
    const size_t hstep = (size_t)HALF * K * 2;
    const size_t tstep = 2 * hstep;
    const unsigned ldsw = (unsigned)wid * 1024u;
    const int aoff = lds_byte(wr * 64 + fr, fq * 8), boff = lds_byte(wc * 32 + fr, fq * 8);
#define PG8_SA(b, h) (((b) * 2 + (h)) * HTB)
#define PG8_SB(b, h) ((4 + (b) * 2 + (h)) * HTB)
#define PG8_STAGE(bufoff, gbase, voff) do { _Pragma("unroll") for (int _i = 0; _i < 2; ++_i) \
        __builtin_amdgcn_global_load_lds((const unsigned*)((const char*)(gbase) + (voff)[_i]), (PG8_LAS unsigned*)(lds + (bufoff) + ldsw + _i * 8192), 16, 0, 0); } while (0)
#define PG8_LDA(dst, b, h) do { _Pragma("unroll") for (int m = 0; m < 4; ++m) _Pragma("unroll") for (int k = 0; k < 2; ++k) dst[m][k] = *(const PG8_LAS bf16x8*)(lds + PG8_SA(b, h) + aoff + m * 2048 + k * 1024); } while (0)
#define PG8_LDB(dst, b, h) do { _Pragma("unroll") for (int n = 0; n < 2; ++n) _Pragma("unroll") for (int k = 0; k < 2; ++k) dst[n][k] = *(const PG8_LAS bf16x8*)(lds + PG8_SB(b, h) + boff + n * 2048 + k * 1024); } while (0)
#define PG8_MMA(ai, bj, At, Bt) do { __builtin_amdgcn_s_setprio(1); _Pragma("unroll") for (int m = 0; m < 4; ++m) _Pragma("unroll") for (int n = 0; n < 2; ++n) _Pragma("unroll") for (int k = 0; k < 2; ++k) \
        acc[ai][bj][m][n] = __builtin_amdgcn_mfma_f32_16x16x32_bf16(Bt[n][k], At[m][k], acc[ai][bj][m][n], 0, 0, 0); __builtin_amdgcn_s_setprio(0); } while (0)
#define PG8_WAIT_V(n) asm volatile("s_waitcnt vmcnt(" #n ")" ::: "memory")
#define PG8_WAIT_L(n) asm volatile("s_waitcnt lgkmcnt(" #n ")" ::: "memory")
#define PG8_BAR __builtin_amdgcn_s_barrier()
#define PG8_SCHED __builtin_amdgcn_sched_barrier(0)
    Unit cur, nxt; int ui = 0;
    if (!S.next(0, cur)) return;
    f32x4 acc[2][2][4][2];
#pragma unroll
    for (int a = 0; a < 2; ++a)
#pragma unroll
        for (int b = 0; b < 2; ++b)
#pragma unroll
            for (int m = 0; m < 4; ++m)
#pragma unroll
                for (int n = 0; n < 2; ++n) acc[a][b][m][n] = (f32x4){0.f, 0.f, 0.f, 0.f};
    bf16x8 At[4][2], B0[2][2], B1[2][2];
    const char* cA = (const char*)g.A + (size_t)cur.pm * tstep; const char* cB = (const char*)g.Bt + (size_t)cur.pn * tstep;
    S.a_ready(cur);
    if constexpr (SP2) {
        PG8_STAGE(PG8_SB(0, 0), cB, voffB); PG8_STAGE(PG8_SB(0, 1), cB + hstep, voffB); PG8_STAGE(PG8_SA(0, 0), cA, voffA); PG8_STAGE(PG8_SA(0, 1), cA + hstep, voffA);
        if (wr == 1) PG8_BAR;
        PG8_WAIT_V(2); PG8_BAR;
        PG8_STAGE(PG8_SB(1, 0), cB + kstep, voffB); PG8_STAGE(PG8_SA(1, 0), cA + kstep, voffA); PG8_STAGE(PG8_SB(1, 1), cB + hstep + kstep, voffB);
        PG8_WAIT_V(6); PG8_BAR;
    } else {
        PG8_STAGE(PG8_SB(0, 0), cB, voffB); PG8_STAGE(PG8_SA(0, 0), cA, voffA); PG8_STAGE(PG8_SB(0, 1), cB + hstep, voffB); PG8_STAGE(PG8_SA(0, 1), cA + hstep, voffA);
        if (wr == 1) PG8_BAR;
        PG8_WAIT_V(4); PG8_BAR;
        PG8_STAGE(PG8_SB(1, 0), cB + kstep, voffB); PG8_STAGE(PG8_SA(1, 0), cA + kstep, voffA); PG8_STAGE(PG8_SB(1, 1), cB + hstep + kstep, voffB);
        PG8_WAIT_V(6); PG8_BAR;
    }
    for (;;) {
        const bool has_next = S.next(ui + 1, nxt);
        const char* nA = has_next ? (const char*)g.A + (size_t)nxt.pm * tstep : cA; const char* nB = has_next ? (const char*)g.Bt + (size_t)nxt.pn * tstep : cB;
        for (int t = 0; t < nt; t += 2) {
            const bool last = (t == nt - 2);
            const char* a1 = cA + (size_t)(t + 1) * kstep;
            const char* a2 = last ? nA : cA + (size_t)(t + 2) * kstep; const char* b2 = last ? nB : cB + (size_t)(t + 2) * kstep;
            const char* a3 = a2 + kstep; const char* b3 = b2 + kstep;
            if (last && has_next) S.a_ready(nxt);
            if constexpr (SP2) {
            PG8_LDB(B0, 0, 0); PG8_LDB(B1, 0, 1); PG8_SCHED; PG8_LDA(At, 0, 0); PG8_STAGE(PG8_SA(1, 1), a1 + hstep, voffA);
            PG8_WAIT_V(8); PG8_WAIT_L(0); PG8_BAR; PG8_MMA(0, 0, At, B0); PG8_MMA(0, 1, At, B1); PG8_BAR; PG8_SCHED;
            PG8_LDA(At, 0, 1); PG8_STAGE(PG8_SB(0, 0), b2, voffB); PG8_STAGE(PG8_SB(0, 1), b2 + hstep, voffB); PG8_STAGE(PG8_SA(0, 0), a2, voffA);
            PG8_WAIT_V(8); PG8_WAIT_L(0); PG8_BAR; PG8_MMA(1, 0, At, B0); PG8_MMA(1, 1, At, B1); PG8_BAR; PG8_SCHED;
            PG8_LDB(B0, 1, 0); PG8_LDB(B1, 1, 1); PG8_SCHED; PG8_LDA(At, 1, 0); PG8_STAGE(PG8_SA(0, 1), a2 + hstep, voffA);
            PG8_WAIT_V(8); PG8_WAIT_L(0); PG8_BAR; PG8_MMA(0, 0, At, B0); PG8_MMA(0, 1, At, B1); PG8_BAR; PG8_SCHED;
            PG8_LDA(At, 1, 1); PG8_STAGE(PG8_SB(1, 0), b3, voffB); PG8_STAGE(PG8_SB(1, 1), b3 + hstep, voffB); PG8_STAGE(PG8_SA(1, 0), a3, voffA);
            PG8_WAIT_V(8); PG8_WAIT_L(0); PG8_BAR; PG8_MMA(1, 0, At, B0); PG8_MMA(1, 1, At, B1); PG8_BAR; PG8_SCHED;
            } else {
            PG8_LDB(B0, 0, 0); PG8_SCHED; PG8_LDA(At, 0, 0); PG8_STAGE(PG8_SA(1, 1), a1 + hstep, voffA);
            PG8_WAIT_L(8); PG8_BAR; PG8_WAIT_L(0); PG8_MMA(0, 0, At, B0); PG8_BAR; PG8_SCHED;
            PG8_LDB(B1, 0, 1); PG8_STAGE(PG8_SB(0, 0), b2, voffB);
            PG8_BAR; PG8_WAIT_L(0); PG8_MMA(0, 1, At, B1); PG8_BAR;
            PG8_LDA(At, 0, 1); PG8_STAGE(PG8_SA(0, 0), a2, voffA);
            PG8_BAR; PG8_WAIT_L(0); PG8_MMA(1, 0, At, B0); PG8_BAR; PG8_SCHED;
            PG8_STAGE(PG8_SB(0, 1), b2 + hstep, voffB);
            PG8_WAIT_V(6); PG8_BAR; PG8_MMA(1, 1, At, B1); PG8_BAR;
            PG8_LDB(B0, 1, 0); PG8_SCHED; PG8_LDA(At, 1, 0); PG8_STAGE(PG8_SA(0, 1), a2 + hstep, voffA);
            PG8_WAIT_L(8); PG8_BAR; PG8_WAIT_L(0); PG8_MMA(0, 0, At, B0); PG8_BAR; PG8_SCHED;
            PG8_LDB(B1, 1, 1); PG8_STAGE(PG8_SB(1, 0), b3, voffB);
            PG8_BAR; PG8_WAIT_L(0); PG8_MMA(0, 1, At, B1); PG8_BAR;
            PG8_LDA(At, 1, 1); PG8_STAGE(PG8_SA(1, 0), a3, voffA);
            PG8_BAR; PG8_WAIT_L(0); PG8_MMA(1, 0, At, B0); PG8_BAR; PG8_SCHED;
            PG8_STAGE(PG8_SB(1, 1), b3 + hstep, voffB);
            PG8_WAIT_V(6); PG8_BAR; PG8_MMA(1, 1, At, B1); PG8_BAR;
            }
        }
        if constexpr (ALIGN_EPI) { if (wr == 0) PG8_BAR; }
        if constexpr (!Epi::AFTER_DRAIN) { E(acc, cur, wr, wc, fr, fq); S.done(cur); }
        if (!has_next) break;
#pragma unroll
        for (int a = 0; a < 2; ++a)
#pragma unroll
            for (int b = 0; b < 2; ++b)
#pragma unroll
                for (int m = 0; m < 4; ++m)
#pragma unroll
                    for (int n = 0; n < 2; ++n) acc[a][b][m][n] = (f32x4){0.f, 0.f, 0.f, 0.f};
        cur = nxt; cA = nA; cB = nB; ++ui;
        if constexpr (ALIGN_EPI) { if (wr == 1) PG8_BAR; }
    }
    PG8_WAIT_V(0);
    if constexpr (!ALIGN_EPI) { if (wr == 0) PG8_BAR; }
    PG8_BAR;
    if constexpr (Epi::AFTER_DRAIN) { E.fused(acc, cur, wr, wc, fr, fq, lds, wid, lane); S.done(cur); }
#undef PG8_SA
#undef PG8_SB
#undef PG8_STAGE
#undef PG8_LDA
#undef PG8_LDB
#undef PG8_MMA
#undef PG8_WAIT_V
#undef PG8_WAIT_L
#undef PG8_BAR
#undef PG8_SCHED
}
}
#define GAS __attribute__((address_space(1)))
#define LAS __attribute__((address_space(3)))
typedef unsigned v4u __attribute__((ext_vector_type(4)));
#define LDS_WAIT() asm volatile("s_waitcnt lgkmcnt(0)" ::: "memory")
__device__ __forceinline__ unsigned pk2(float lo, float hi) { return f2bf_u(lo) | (f2bf_u(hi) << 16); }
constexpr int LDS_BYTES = 147456;
constexpr int NWAVES = 8;
__device__ __forceinline__ void p0_transpose_item(const float* W, int K, int N, bf16_t* WT, int row_off, LAS float* scr, int item, int lane) {
    const int nblk = N / 32, kb = item / nblk, nb = item % nblk, k0 = 64 * kb, n0 = 32 * nb;
#pragma unroll 8
    for (int i = 0; i < 32; ++i) { const int kk = 2 * i + (lane >> 5); scr[kk * 33 + (lane & 31)] = W[(size_t)(k0 + kk) * N + n0 + (lane & 31)]; }
    LDS_WAIT(); asm volatile("" ::: "memory");
    const int c = lane & 7;
#pragma unroll
    for (int j = 0; j < 4; ++j) { const int n = (lane >> 3) + 8 * j; const LAS float* s = scr + (8 * c) * 33 + n;
        v4u o; o.x = pk2(s[0 * 33], s[1 * 33]); o.y = pk2(s[2 * 33], s[3 * 33]); o.z = pk2(s[4 * 33], s[5 * 33]); o.w = pk2(s[6 * 33], s[7 * 33]);
        *(GAS v4u*)(WT + (size_t)(row_off + n0 + n) * K + k0 + 8 * c) = o; }
    LDS_WAIT(); asm volatile("" ::: "memory");
}
struct Args { Ctx c; bf16_t *WinT, *WkvT, *WoutT, *WxqT, *WxoT, *WupT, *WdownT; unsigned* ctr; int ph_lo, ph_hi; };
template <class F> __device__ __forceinline__ void run_stage(const F& f) {
  const long stride = (long)gridDim.x * 512;
  for (long i = (long)blockIdx.x * 512 + threadIdx.x; i < F::N; i += stride) f(i);
}
constexpr int N_PHASES = 18;
__global__ void __launch_bounds__(512, 2) mega(Args a) {
  extern __shared__ __attribute__((aligned(16))) unsigned char lds_raw[];
  LAS unsigned char* lds = (LAS unsigned char*)lds_raw;
  cg::grid_group grid = cg::this_grid();
  const Ctx& c = a.c;
  const int tid = threadIdx.x, lane = tid & 63, wave = __builtin_amdgcn_readfirstlane(tid >> 6);
#define PH(k) if (a.ph_lo <= (k) && (k) < a.ph_hi)
#define SYNC(k) do { if ((k) + 1 < a.ph_hi) grid.sync(); } while (0)
#define GEMM(A_, B_, M_, N_, K_, C_, LDC_, RP_, RS_) do { __syncthreads(); pg8::Gemm g{A_, B_, M_, N_, K_}; pg8::StaticOrder S; S.init(M_, N_, (int)gridDim.x, (int)blockIdx.x); \
      pg8::EpiF32 E{C_, LDC_, RP_, RS_, MP}; pg8::gemm_phase<pg8::EpiF32, pg8::StaticOrder, true, true>(lds, g, S, E); } while (0)
  PH(0) {
    LAS float* scr = (LAS float*)(lds + wave * 16384);
    const int gw = blockIdx.x * NWAVES + wave, NGW = gridDim.x * NWAVES;
    constexpr int I_IN = (D_MODEL / 64) * (IN_COLS / 32), I_SQ = (D_MODEL / 64) * (D_MODEL / 32), I_UP = (D_MODEL / 64) * (2 * D_FF / 32), I_DN = (D_FF / 64) * (D_MODEL / 32);
    constexpr int NIT = I_IN + 5 * I_SQ + I_UP + I_DN;
    for (int it = gw; it < NIT; it += NGW) { int r = it;
      if (r < I_IN) { p0_transpose_item(c.w_in, D_MODEL, IN_COLS, a.WinT, 0, scr, r, lane); continue; } r -= I_IN;
      if (r < I_SQ) { p0_transpose_item(c.w_xk, D_MODEL, D_MODEL, a.WkvT, 0, scr, r, lane); continue; } r -= I_SQ;
      if (r < I_SQ) { p0_transpose_item(c.w_xv, D_MODEL, D_MODEL, a.WkvT, D_MODEL, scr, r, lane); continue; } r -= I_SQ;
      if (r < I_SQ) { p0_transpose_item(c.w_out, D_MODEL, D_MODEL, a.WoutT, 0, scr, r, lane); continue; } r -= I_SQ;
      if (r < I_SQ) { p0_transpose_item(c.w_xq, D_MODEL, D_MODEL, a.WxqT, 0, scr, r, lane); continue; } r -= I_SQ;
      if (r < I_SQ) { p0_transpose_item(c.w_xo, D_MODEL, D_MODEL, a.WxoT, 0, scr, r, lane); continue; } r -= I_SQ;
      if (r < I_UP) { p0_transpose_item(c.w_up, D_MODEL, 2 * D_FF, a.WupT, 0, scr, r, lane); continue; } r -= I_UP;
      p0_transpose_item(c.w_down, D_FF, D_MODEL, a.WdownT, 0, scr, r, lane); }
    if (blockIdx.x == 0 && tid < 8) a.ctr[64 * tid] = 0u;
    run_stage(StRms0{c}); SYNC(0); }
  PH(1) { GEMM(c.XN, a.WinT, MTOT, LDP, D_MODEL, c.P, LDP, nullptr, nullptr); SYNC(1); }
  PH(2) { GEMM(c.MN, a.WkvT, MMEM, 2048, D_MODEL, c.MKV, 2048, nullptr, nullptr); SYNC(2); }
  PH(3) { run_stage(StQ{c}); run_stage(StKV{c}); run_stage(StGate{c}); run_stage(StGdnConv{c}); run_stage(StGdnMisc{c}); run_stage(StGdnConvOut{c}); run_stage(StMemKV{c}); SYNC(3); }
  PH(4) {
    { const int G8 = (int)gridDim.x * NWAVES, local = (int)blockIdx.x * NWAVES + wave; float* wscr = (float*)(lds_raw + wave * 18432);
      for (int u = local; u < GDN_PREP_UNITS; u += G8) gdn_prep_unit(c, u, wscr); }
    run_stage(StWinOut{c}); run_stage(StCompress{c}); run_stage(StPackQ{c}); run_stage(StPackKV{c}); run_stage(StPackWinS{c}); run_stage(StPackX{c}); SYNC(4); }
  PH(5) { run_stage(StPackCmp{c}); SYNC(5); }
  PH(6) {
    { const int local = (int)blockIdx.x * NWAVES + wave; if (local < GDN_SCAN_UNITS) gdn_scan_unit(c, local); }
    if (wave == 0 && blockIdx.x >= 128 && blockIdx.x < 128 + NSA_UNITS_S) nsa_unit<true>(c, (int)blockIdx.x - 128, (float*)lds_raw);
    const int xq = (int)blockIdx.x & 7; constexpr int PERQ = NSA_UNITS_P / 8;
    for (;;) { int k = 0; if (lane == 0) k = (int)atomicAdd(a.ctr + 64 * xq, 1u); k = __builtin_amdgcn_readfirstlane(k); if (k >= PERQ) break;
      const int tile = (SEQ / 8 - 1) - (k >> 1), bk = 2 * xq + (k & 1); nsa_unit<false>(c, bk * (SEQ / 8) + tile, nullptr); }
    SYNC(6); }
  PH(7) { run_stage(StGdnNorm{c}); SYNC(7); }
  PH(8) { GEMM(c.CAT, a.WoutT, MTOT, D_MODEL, D_MODEL, c.H1, D_MODEL, c.x_prompt, c.x_sample); SYNC(8); }
  PH(9) { run_stage(StRmsRows{c.H1, c.xattn_norm_w, c.XN}); SYNC(9); }
  PH(10) { GEMM(c.XN, a.WxqT, MTOT, D_MODEL, D_MODEL, c.Q2, D_MODEL, nullptr, nullptr); SYNC(10); }
  PH(11) { run_stage(StXqNormB{c}); SYNC(11); }
  PH(12) {
    const int G8 = (int)gridDim.x * NWAVES, local = (int)blockIdx.x * NWAVES + wave;
    for (int u = local; u < XA_UNITS_P; u += G8) xattn_unit<false>(c, u);
    for (int u = local; u < XA_UNITS_S; u += G8) xattn_unit<true>(c, u);
    SYNC(12); }
  PH(13) { GEMM(c.OX, a.WxoT, MTOT, D_MODEL, D_MODEL, c.H2, D_MODEL, c.H1, c.H1 + (size_t)MP * D_MODEL); SYNC(13); }
  PH(14) { run_stage(StRmsRows{c.H2, c.ffn_norm_w, c.XN}); SYNC(14); }
  PH(15) { GEMM(c.XN, a.WupT, MTOT, 2 * D_FF, D_MODEL, c.UP, 2 * D_FF, nullptr, nullptr); SYNC(15); }
  PH(16) { run_stage(StFfnAct{c}); run_stage(StFfnConvOut{c}); SYNC(16); }
  PH(17) { GEMM(c.ACT, a.WdownT, MTOT, D_MODEL, D_FF, c.out + O_YP, D_MODEL, c.H2, c.H2 + (size_t)MP * D_MODEL); }
}
#ifndef MK_MULTI
#define MK_MULTI 0
#endif
extern "C" void kernel_launch(void* const* d_in, const int* in_sizes, int n_in, void* d_out, int out_size, void* d_ws, size_t ws_size, hipStream_t stream) {
  static int grid = 0;
  if (grid == 0) {
    int dev = 0, cus = 0, per_cu = 0;
    if (hipGetDevice(&dev) != hipSuccess || hipDeviceGetAttribute(&cus, hipDeviceAttributeMultiprocessorCount, dev) != hipSuccess) { fprintf(stderr, "kernel_launch: device query failed\n"); grid = -1; return; }
    if (hipFuncSetAttribute((const void*)mega, hipFuncAttributeMaxDynamicSharedMemorySize, LDS_BYTES) != hipSuccess) { fprintf(stderr, "kernel_launch: hipFuncSetAttribute failed\n"); grid = -1; return; }
    if (hipOccupancyMaxActiveBlocksPerMultiprocessor(&per_cu, (const void*)mega, 512, LDS_BYTES) != hipSuccess || per_cu < 1) { fprintf(stderr, "kernel_launch: occupancy query says %d blocks/CU\n", per_cu); (void)hipGetLastError(); }
    grid = cus;
    if (n_in != 34 || (size_t)out_size != O_END) fprintf(stderr, "kernel_launch: unexpected n_in %d / out_size %d (want 34 / %zu)\n", n_in, out_size, (size_t)O_END);
  }
  if (grid < 0) return;
  Args a{}; Ctx& c = a.c; int k = 0;
  c.x_prompt = (const float*)d_in[k++]; c.x_sample = (const float*)d_in[k++]; c.mem_prompt = (const float*)d_in[k++]; c.cache_nsa_kv = (const float*)d_in[k++]; c.cache_nsa_win = (const float*)d_in[k++];
  c.state_gdn = (const float*)d_in[k++]; c.cache_gdn_conv = (const float*)d_in[k++]; c.cache_ffn_conv = (const float*)d_in[k++]; c.cache_mem_kv = (const float*)d_in[k++]; c.page_table = (const int*)d_in[k++];
  c.attn_norm_w = (const float*)d_in[k++]; c.w_in = (const float*)d_in[k++]; c.nsa_q_norm_w = (const float*)d_in[k++]; c.nsa_k_norm_w = (const float*)d_in[k++]; c.cmp_pe = (const float*)d_in[k++]; c.cmp_w = (const float*)d_in[k++];
  c.gdn_conv_w = (const float*)d_in[k++]; c.gdn_a_log = (const float*)d_in[k++]; c.gdn_dt_bias = (const float*)d_in[k++]; c.gdn_norm_w = (const float*)d_in[k++]; c.w_out = (const float*)d_in[k++];
  c.mem_norm_w = (const float*)d_in[k++]; c.w_xk = (const float*)d_in[k++]; c.w_xv = (const float*)d_in[k++]; c.xk_norm_w = (const float*)d_in[k++]; c.xattn_norm_w = (const float*)d_in[k++]; c.w_xq = (const float*)d_in[k++];
  c.xq_norm_w = (const float*)d_in[k++]; c.w_xo = (const float*)d_in[k++]; c.ffn_norm_w = (const float*)d_in[k++]; c.w_up = (const float*)d_in[k++]; c.ffn_conv_w = (const float*)d_in[k++]; c.ffn_conv_b = (const float*)d_in[k++]; c.w_down = (const float*)d_in[k++];
  c.out = (float*)d_out;
  unsigned char* ws = (unsigned char*)d_ws; WsMap w{0};
  a.ctr = (unsigned*)(ws + w.take(4096));
  a.WinT = (bf16_t*)(ws + w.take((size_t)LDP * D_MODEL * 2)); a.WkvT = (bf16_t*)(ws + w.take((size_t)2048 * D_MODEL * 2));
  a.WoutT = (bf16_t*)(ws + w.take((size_t)D_MODEL * D_MODEL * 2)); a.WxqT = (bf16_t*)(ws + w.take((size_t)D_MODEL * D_MODEL * 2)); a.WxoT = (bf16_t*)(ws + w.take((size_t)D_MODEL * D_MODEL * 2));
  a.WupT = (bf16_t*)(ws + w.take((size_t)2 * D_FF * D_MODEL * 2)); a.WdownT = (bf16_t*)(ws + w.take((size_t)D_MODEL * D_FF * 2));
  const size_t need = ws_carve(c, ws, w.off);
  if (need > ws_size) { fprintf(stderr, "kernel_launch: workspace too small: need %zu, have %zu\n", need, ws_size); return; }
#if MK_MULTI
  for (int ph = 0; ph < N_PHASES; ++ph) { a.ph_lo = ph; a.ph_hi = ph + 1; void* args[] = {&a};
    hipError_t e = hipLaunchCooperativeKernel((const void*)mega, dim3(grid), dim3(512), args, LDS_BYTES, stream);
    if (e != hipSuccess) { fprintf(stderr, "kernel_launch: cooperative launch failed: %s\n", hipGetErrorString(e)); return; } }
#else
  a.ph_lo = 0; a.ph_hi = N_PHASES; void* args[] = {&a};
  hipError_t e = hipLaunchCooperativeKernel((const void*)mega, dim3(grid), dim3(512), args, LDS_BYTES, stream);
  if (e != hipSuccess) fprintf(stderr, "kernel_launch: cooperative launch failed: %s (grid %d)\n", hipGetErrorString(e), grid);
#endif
}
```

```cpp
#include <hip/hip_runtime.h>
#include <hip/hip_cooperative_groups.h>
#include <cstdio>
#include <cstdint>
namespace cg = cooperative_groups;
#define HD __host__ __device__ __forceinline__
#ifdef CFG_SMALL
constexpr int BATCH = 1, SEQ = 1024, DEC_BATCH = 2, PAST_LEN = 1024, MEM_TOKENS = 64, D_FF = 256;
#else
constexpr int BATCH = 8, SEQ = 2048, DEC_BATCH = 32, PAST_LEN = 8192, MEM_TOKENS = 256, D_FF = 2816;
#endif
constexpr int D_MODEL = 1024, DEC_SEQ = 8, PAGE_SIZE = 128;
constexpr int NSA_HEADS = 8, NSA_KVH = 2, NSA_HD = 64, NSA_G = 4;
constexpr int CMP_BLOCK = 32, CMP_STRIDE = 16, SEL_BLOCK = 64, SEL_TOPN = 8, WINDOW = 512;
constexpr int GDN_HEADS = 4, GDN_HD = 128, GDN_CONV = 4;
constexpr int XA_HEADS = 4, XA_HD = 256, FFN_CONV = 3;
constexpr float EPS = 1e-6f, NEGF = -1e30f, FORCED_BONUS = 1e4f;
constexpr int NSA_Q_W = 512, NSA_KV_W = 768, NSA_GATE_W = 24, GDN_W = 512;
constexpr int IN_COLS = 3360, LDP = 3584;
constexpr int OFF_Q = 0, OFF_KV = 512, OFF_GATE = 1280, OFF_QKV = 1304, OFF_Z = 2840, OFF_B = 3352, OFF_A = 3356;
constexpr int MP = BATCH * SEQ, MS = DEC_BATCH * DEC_SEQ, MTOT = MP + MS;
constexpr int MMEM = BATCH * MEM_TOKENS;
constexpr int NPAGES = PAST_LEN / PAGE_SIZE;
constexpr int NCP = SEQ / CMP_STRIDE - 1;
constexpr int NCS = PAST_LEN / CMP_STRIDE - 1;
constexpr int NCPS = 128, NCSS = 512;
constexpr int NSELP = SEQ / SEL_BLOCK;
constexpr int NSELS = PAST_LEN / SEL_BLOCK + 1;
constexpr int NSELMAX = 160;
constexpr int WINP = (WINDOW < SEQ ? WINDOW : SEQ);
constexpr int WBUF = (WINDOW < PAST_LEN ? WINDOW : PAST_LEN);
constexpr int WINS = (WINDOW < WBUF + DEC_SEQ ? WINDOW : WBUF + DEC_SEQ);
static_assert(NCP <= NCPS && NCS <= NCSS && NSELS <= NSELMAX && NSELP <= NSELMAX, "strides");
static_assert(WBUF == WINDOW && WINP == WINDOW && WINS == WINDOW, "window assumptions");

constexpr size_t O_YP = 0;
constexpr size_t O_YS = O_YP + (size_t)MP * D_MODEL;
constexpr size_t O_KVP = O_YS + (size_t)MS * D_MODEL;
constexpr size_t O_WINP = O_KVP + (size_t)MP * 512;
constexpr size_t O_STP = O_WINP + (size_t)BATCH * WINP * 256;
constexpr size_t O_GCP = O_STP + (size_t)BATCH * 4 * 128 * 128;
constexpr size_t O_FCP = O_GCP + (size_t)BATCH * 3 * 1536;
constexpr size_t O_MKVP = O_FCP + (size_t)BATCH * 2 * 2 * D_FF;
constexpr size_t O_KVS = O_MKVP + (size_t)MMEM * 2048;
constexpr size_t O_WINS = O_KVS + (size_t)MS * 512;
constexpr size_t O_STS = O_WINS + (size_t)DEC_BATCH * WINS * 256;
constexpr size_t O_GCS = O_STS + (size_t)DEC_BATCH * 4 * 128 * 128;
constexpr size_t O_FCS = O_GCS + (size_t)DEC_BATCH * 3 * 1536;
constexpr size_t O_END = O_FCS + (size_t)DEC_BATCH * 2 * 2 * D_FF;

typedef unsigned short bf16_t;
HD unsigned f2bf_u(float f) { unsigned u = __builtin_bit_cast(unsigned, f); return (u + 0x7fffu + ((u >> 16) & 1u)) >> 16; }
HD bf16_t f2bf(float f) { return (bf16_t)f2bf_u(f); }
HD float bf2f(bf16_t b) { return __builtin_bit_cast(float, (unsigned)b << 16); }
HD float sigmoidf_(float x) { return 1.f / (1.f + expf(-x)); }
HD float siluf_(float x) { return x / (1.f + expf(-x)); }
HD float softplusf_(float x) { return x > 20.f ? x : log1pf(expf(x)); }

struct Ctx {
  const float *x_prompt, *x_sample, *mem_prompt, *cache_nsa_kv, *cache_nsa_win, *state_gdn, *cache_gdn_conv, *cache_ffn_conv, *cache_mem_kv;
  const int* page_table;
  const float *attn_norm_w, *w_in, *nsa_q_norm_w, *nsa_k_norm_w, *cmp_pe, *cmp_w, *gdn_conv_w, *gdn_a_log, *gdn_dt_bias, *gdn_norm_w, *w_out,
      *mem_norm_w, *w_xk, *w_xv, *xk_norm_w, *xattn_norm_w, *w_xq, *xq_norm_w, *w_xo, *ffn_norm_w, *w_up, *ffn_conv_w, *ffn_conv_b, *w_down;
  float* out;
  bf16_t *XN, *MN, *CAT, *OX, *ACT;
  float *P, *MKV, *QC, *QR, *WR, *GATE, *GQ, *GK, *GV, *GB, *GG, *KCMP, *VCMP, *SCP, *SCS, *SCORE, *SS, *SW, *OG, *H1, *Q2, *SX, *H2, *UP;
  int* SIDX;
  bf16_t *QCb, *QRb, *KSb, *VSTb, *KWb, *VWTb, *KWsb, *VWTsb, *KCb, *VCTb, *KXb, *VXTb, *Q2b, *GWp, *GQKp, *GQDp, *GKDTp, *WcT;
  float *GS, *GL, *PP, *CBIAS;
};

HD int row_b(int m) { return m < MP ? m / SEQ : (m - MP) / DEC_SEQ; }
HD int row_t(int m) { return m < MP ? m % SEQ : (m - MP) % DEC_SEQ; }
HD int row_pos(int m) { return m < MP ? m % SEQ : PAST_LEN + (m - MP) % DEC_SEQ; }
HD const float* x_row(const Ctx& c, int m) { return m < MP ? c.x_prompt + (size_t)m * D_MODEL : c.x_sample + (size_t)(m - MP) * D_MODEL; }
HD float* kvrow_out(const Ctx& c, int m) { return m < MP ? c.out + O_KVP + (size_t)m * 512 : c.out + O_KVS + (size_t)(m - MP) * 512; }

struct StRms0 { const Ctx& c; static constexpr long N = MTOT + MMEM;
  HD void operator()(long i) const {
    const float* src; const float* w; bf16_t* dst;
    if (i < MTOT) { src = x_row(c, (int)i); w = c.attn_norm_w; dst = c.XN + (size_t)i * D_MODEL; }
    else { const long mm = i - MTOT; src = c.mem_prompt + (size_t)mm * D_MODEL; w = c.mem_norm_w; dst = c.MN + (size_t)mm * D_MODEL; }
    float ss = 0.f; for (int d = 0; d < D_MODEL; ++d) ss += src[d] * src[d];
    const float r = 1.f / sqrtf(ss / D_MODEL + EPS);
    for (int d = 0; d < D_MODEL; ++d) dst[d] = f2bf(src[d] * r * w[d]);
  } };
struct StRmsRows { const float* src; const float* w; bf16_t* dst; static constexpr long N = MTOT;
  HD void operator()(long i) const {
    const float* s = src + (size_t)i * D_MODEL; bf16_t* o = dst + (size_t)i * D_MODEL;
    float ss = 0.f; for (int d = 0; d < D_MODEL; ++d) ss += s[d] * s[d];
    const float r = 1.f / sqrtf(ss / D_MODEL + EPS);
    for (int d = 0; d < D_MODEL; ++d) o[d] = f2bf(s[d] * r * w[d]);
  } };
HD void rope_pair(float x1, float x2, int i, int pos, float& o1, float& o2) {
  const float inv = powf(10000.f, -(float)i / 32.f); const float ang = (float)pos * inv;
  const float cs = cosf(ang), sn = sinf(ang); o1 = x1 * cs - x2 * sn; o2 = x1 * sn + x2 * cs;
}
struct StQ { const Ctx& c; static constexpr long N = (long)MTOT * NSA_HEADS;
  HD void operator()(long i) const {
    const int m = (int)(i / NSA_HEADS), h = (int)(i % NSA_HEADS); const float* p = c.P + (size_t)m * LDP + OFF_Q + h * 64;
    float ss = 0.f; for (int d = 0; d < 64; ++d) ss += p[d] * p[d];
    const float r = 1.f / sqrtf(ss / 64.f + EPS); const int pos = row_pos(m);
    float* qc = c.QC + (size_t)m * 512 + h * 64; float* qr = c.QR + (size_t)m * 512 + h * 64;
    for (int d = 0; d < 32; ++d) { const float a = p[d] * r * c.nsa_q_norm_w[d], b = p[d + 32] * r * c.nsa_q_norm_w[d + 32];
      qc[d] = a; qc[d + 32] = b; float o1, o2; rope_pair(a, b, d, pos, o1, o2); qr[d] = o1; qr[d + 32] = o2; }
  } };
struct StKV { const Ctx& c; static constexpr long N = (long)MTOT * 6;
  HD void operator()(long i) const {
    const int m = (int)(i / 6), br = (int)(i % 6) / 2, kvh = (int)(i % 2); const float* pk = c.P + (size_t)m * LDP + OFF_KV + ((br * 2 + 0) * 2 + kvh) * 64;
    const float* pv = c.P + (size_t)m * LDP + OFF_KV + ((br * 2 + 1) * 2 + kvh) * 64;
    float ss = 0.f; for (int d = 0; d < 64; ++d) ss += pk[d] * pk[d];
    const float r = 1.f / sqrtf(ss / 64.f + EPS); const int pos = row_pos(m); const float* w = c.nsa_k_norm_w + br * 64;
    float *ko, *vo;
    if (br < 2) { float* ro = kvrow_out(c, m); ko = ro + ((br * 2 + 0) * 2 + kvh) * 64; vo = ro + ((br * 2 + 1) * 2 + kvh) * 64; }
    else { float* wo = c.WR + (size_t)m * 256; ko = wo + (0 * 2 + kvh) * 64; vo = wo + (1 * 2 + kvh) * 64; }
    for (int d = 0; d < 32; ++d) { const float a = pk[d] * r * w[d], b = pk[d + 32] * r * w[d + 32];
      if (br == 0) { ko[d] = a; ko[d + 32] = b; } else { float o1, o2; rope_pair(a, b, d, pos, o1, o2); ko[d] = o1; ko[d + 32] = o2; } }
    for (int d = 0; d < 64; ++d) vo[d] = pv[d];
  } };
struct StWinOut { const Ctx& c; static constexpr long N = (long)(BATCH + DEC_BATCH) * WINDOW * 256;
  HD void operator()(long i) const {
    const int e = (int)(i % 256); const long r = i / 256; const int j = (int)(r % WINDOW), bb = (int)(r / WINDOW);
    if (bb < BATCH) c.out[O_WINP + ((size_t)bb * WINDOW + j) * 256 + e] = c.WR[((size_t)bb * SEQ + SEQ - WINDOW + j) * 256 + e];
    else { const int b = bb - BATCH; const int w = j + DEC_SEQ;
      const float v = w < WBUF ? c.cache_nsa_win[((size_t)b * WBUF + w) * 256 + e] : c.WR[((size_t)MP + b * DEC_SEQ + (w - WBUF)) * 256 + e];
      c.out[O_WINS + ((size_t)b * WINDOW + j) * 256 + e] = v; }
  } };
struct StGate { const Ctx& c; static constexpr long N = (long)MTOT * 24;
  HD void operator()(long i) const { const int m = (int)(i / 24), e = (int)(i % 24); c.GATE[(size_t)m * 24 + e] = sigmoidf_(c.P[(size_t)m * LDP + OFF_GATE + e]); } };
HD float gdn_pre(const Ctx& c, int m, int dt_back, int ch) {
  const int t = row_t(m) - dt_back;
  if (t >= 0) return c.P[(size_t)(m - dt_back) * LDP + OFF_QKV + ch];
  if (m < MP) return 0.f;
  const int b = (m - MP) / DEC_SEQ; return c.cache_gdn_conv[((size_t)b * 3 + (3 + t)) * 1536 + ch];
}
struct StGdnConv { const Ctx& c; static constexpr long N = (long)MTOT * 12;
  HD void operator()(long i) const {
    const int m = (int)(i / 12), part = (int)(i % 12), which = part / 4, h = part % 4; const int ch0 = which * 512 + h * 128;
    float* dst = (which == 0 ? c.GQ : which == 1 ? c.GK : c.GV) + (size_t)m * 512 + h * 128;
    float ss = 0.f;
    for (int d = 0; d < 128; ++d) { const int ch = ch0 + d; float y = 0.f;
      for (int k = 0; k < 4; ++k) y += c.gdn_conv_w[k * 1536 + ch] * gdn_pre(c, m, 3 - k, ch);
      y = siluf_(y); dst[d] = y; ss += y * y; }
    if (which < 2) { const float r = (1.f / sqrtf(ss + EPS)) * (which == 0 ? 0.08838834764831845f : 1.f); for (int d = 0; d < 128; ++d) dst[d] *= r; }
  } };
struct StGdnMisc { const Ctx& c; static constexpr long N = (long)MTOT * 4;
  HD void operator()(long i) const {
    const int m = (int)(i / 4), h = (int)(i % 4); const float* p = c.P + (size_t)m * LDP;
    c.GB[i] = sigmoidf_(p[OFF_B + h]); c.GG[i] = -expf(c.gdn_a_log[h]) * softplusf_(p[OFF_A + h] + c.gdn_dt_bias[h]);
  } };
struct StGdnConvOut { const Ctx& c; static constexpr long N = (long)(BATCH + DEC_BATCH) * 3 * 1536;
  HD void operator()(long i) const {
    const int ch = (int)(i % 1536); const int r = (int)((i / 1536) % 3), bb = (int)(i / (3 * 1536));
    if (bb < BATCH) c.out[O_GCP + i] = c.P[((size_t)bb * SEQ + SEQ - 3 + r) * LDP + OFF_QKV + ch];
    else { const int b = bb - BATCH; c.out[O_GCS + ((size_t)b * 3 + r) * 1536 + ch] = c.P[((size_t)MP + b * DEC_SEQ + DEC_SEQ - 3 + r) * LDP + OFF_QKV + ch]; }
  } };
HD const float* nsa_row(const Ctx& c, bool sample, int b, int pos, int r, int kvh) {
  if (!sample) return c.out + O_KVP + ((size_t)b * SEQ + pos) * 512 + (r * 2 + kvh) * 64;
  if (pos < PAST_LEN) { const int pg = c.page_table[b * NPAGES + pos / PAGE_SIZE]; return c.cache_nsa_kv + ((size_t)pg * PAGE_SIZE + pos % PAGE_SIZE) * 512 + (r * 2 + kvh) * 64; }
  return c.out + O_KVS + ((size_t)b * DEC_SEQ + (pos - PAST_LEN)) * 512 + (r * 2 + kvh) * 64;
}
constexpr long NCMP_ITEMS_P = (long)BATCH * NCP * 2 * 2 * 64, NCMP_ITEMS_S = (long)DEC_BATCH * NCS * 2 * 2 * 64;
struct StCompress { const Ctx& c; static constexpr long N = NCMP_ITEMS_P + NCMP_ITEMS_S;
  HD void operator()(long i) const {
    const bool sample = i >= NCMP_ITEMS_P; long r = sample ? i - NCMP_ITEMS_P : i; const int nc = sample ? NCS : NCP;
    const int e = (int)(r % 64); r /= 64; const int kv = (int)(r % 2); r /= 2; const int kvh = (int)(r % 2); r /= 2; const int cb = (int)(r % nc), b = (int)(r / nc);
    const float* W = c.cmp_w + (size_t)kv * 32 * 64 * 64; const float* pe = c.cmp_pe + (size_t)kv * 32 * 64;
    float acc = 0.f;
    for (int j = 0; j < 32; ++j) { const float* x = nsa_row(c, sample, b, 16 * cb + j, kv, kvh);
      for (int d = 0; d < 64; ++d) acc += (x[d] + pe[j * 64 + d]) * W[((size_t)j * 64 + d) * 64 + e]; }
    float* dst = (kv == 0 ? c.KCMP : c.VCMP) + (sample ? (size_t)BATCH * NCP * 128 : 0) + (((size_t)b * nc + cb) * 2 + kvh) * 64 + e;
    *dst = acc;
  } };
HD const float* cmp_ptr(const Ctx& c, const float* base, bool sample, int b, int cb, int kvh) {
  return base + (sample ? (size_t)BATCH * NCP * 128 : 0) + (((size_t)b * (sample ? NCS : NCP) + cb) * 2 + kvh) * 64; }
HD float* scmp_ptr(const Ctx& c, int m, int h) { return m < MP ? c.SCP + ((size_t)m * 8 + h) * NCPS : c.SCS + ((size_t)(m - MP) * 8 + h) * NCSS; }
constexpr long NSC_P = (long)MP * 8 * NCPS, NSC_S = (long)MS * 8 * NCSS;
struct StCmpScore { const Ctx& c; static constexpr long N = NSC_P + NSC_S;
  HD void operator()(long i) const {
    const bool sample = i >= NSC_P; const long r = sample ? i - NSC_P : i; const int st = sample ? NCSS : NCPS, nc = sample ? NCS : NCP;
    const int cb = (int)(r % st), h = (int)((r / st) % 8); const int m = (int)(r / st / 8) + (sample ? MP : 0);
    float* dst = scmp_ptr(c, m, h) + cb; const int pos = row_pos(m);
    if (cb >= nc || 16 * cb + 31 > pos) { *dst = -3e38f; return; }
    const float* q = c.QC + (size_t)m * 512 + h * 64; const float* k = cmp_ptr(c, c.KCMP, sample, row_b(m), cb, h / 4);
    float s = 0.f; for (int d = 0; d < 64; ++d) s += q[d] * k[d];
    *dst = s * 0.125f;
  } };
HD void softmax_inplace(float* s, int n) {
  float mx = -3e38f; for (int j = 0; j < n; ++j) mx = fmaxf(mx, s[j]);
  if (mx < -1e38f) { for (int j = 0; j < n; ++j) s[j] = 0.f; return; }
  float sum = 0.f; for (int j = 0; j < n; ++j) { const float v = s[j]; if (v > -1e38f) sum += expf(v - mx); }
  const float inv = 1.f / fmaxf(sum, 1e-30f);
  for (int j = 0; j < n; ++j) { const float v = s[j]; s[j] = v > -1e38f ? expf(v - mx) * inv : 0.f; }
}
struct StCmpSoftmax { const Ctx& c; static constexpr long N = (long)MTOT * 8;
  HD void operator()(long i) const { const int m = (int)(i / 8), h = (int)(i % 8); softmax_inplace(scmp_ptr(c, m, h), m < MP ? NCPS : NCSS); } };
struct StTopk { const Ctx& c; static constexpr long N = (long)MTOT * 2;
  HD void operator()(long i) const {
    const int m = (int)(i / 2), kvh = (int)(i % 2); const bool sample = m >= MP; const int nsel = sample ? NSELS : NSELP, nc = sample ? NCS : NCP;
    const int pos = row_pos(m), qblk = pos / SEL_BLOCK; float* sc = c.SCORE + (size_t)i * NSELMAX;
    for (int s = 0; s < nsel; ++s) {
      float imp = 0.f;
      for (int g = 0; g < 4; ++g) { const float* p = scmp_ptr(c, m, kvh * 4 + g);
        for (int cb = 4 * s - 1; cb <= 4 * s + 3; ++cb) if (cb >= 0 && cb < nc) imp += p[cb]; }
      const bool visible = s <= qblk, forced = (s == 0) || (s == qblk) || (s == qblk - 1);
      sc[s] = visible ? imp + (forced ? FORCED_BONUS : 0.f) : NEGF;
    }
    const int ntop = nsel < SEL_TOPN ? nsel : SEL_TOPN;
    for (int n = 0; n < SEL_TOPN; ++n) {
      int best = -1; float bv = -3e38f;
      if (n < ntop) { for (int s = 0; s < nsel; ++s) if (sc[s] > bv) { bv = sc[s]; best = s; } }
      if (best >= 0) sc[best] = -3.2e38f;
      c.SIDX[i * 8 + n] = (best >= 0 && bv > 0.5f * NEGF) ? best : -1;
    }
  } };
struct StSelScore { const Ctx& c; static constexpr long N = (long)MTOT * 8 * 512;
  HD void operator()(long i) const {
    const int j = (int)(i % 64), n = (int)((i / 64) % 8), h = (int)((i / 512) % 8), m = (int)(i / 4096); const bool sample = m >= MP;
    const int blk = c.SIDX[((size_t)m * 2 + h / 4) * 8 + n]; const int pos = row_pos(m), key = blk * 64 + j;
    if (blk < 0 || key > pos) { c.SS[i] = -3e38f; return; }
    const float* q = c.QR + (size_t)m * 512 + h * 64; const float* k = nsa_row(c, sample, row_b(m), key, 2, h / 4);
    float s = 0.f; for (int d = 0; d < 64; ++d) s += q[d] * k[d];
    c.SS[i] = s * 0.125f;
  } };
HD const float* win_row(const Ctx& c, int m, int j, int which, int kvh) {
  const int pos = row_pos(m), kp = pos - (WINDOW - 1) + j; if (kp < 0) return nullptr;
  if (m < MP) return c.WR + ((size_t)(m / SEQ) * SEQ + kp) * 256 + (which * 2 + kvh) * 64;
  const int b = (m - MP) / DEC_SEQ;
  if (kp < PAST_LEN) return c.cache_nsa_win + ((size_t)b * WBUF + (kp - (PAST_LEN - WBUF))) * 256 + (which * 2 + kvh) * 64;
  return c.WR + ((size_t)MP + b * DEC_SEQ + (kp - PAST_LEN)) * 256 + (which * 2 + kvh) * 64;
}
struct StWinScore { const Ctx& c; static constexpr long N = (long)MTOT * 8 * 512;
  HD void operator()(long i) const {
    const int j = (int)(i % 512), h = (int)((i / 512) % 8), m = (int)(i / 4096);
    const float* k = win_row(c, m, j, 0, h / 4); if (!k) { c.SW[i] = -3e38f; return; }
    const float* q = c.QR + (size_t)m * 512 + h * 64; float s = 0.f; for (int d = 0; d < 64; ++d) s += q[d] * k[d];
    c.SW[i] = s * 0.125f;
  } };
struct StSoftmax512 { float* buf; static constexpr long N = (long)MTOT * 8;
  HD void operator()(long i) const { softmax_inplace(buf + (size_t)i * 512, 512); } };
struct StNsaOut { const Ctx& c; static constexpr long N = (long)MTOT * 512;
  HD void operator()(long i) const {
    const int d = (int)(i % 64), h = (int)((i / 64) % 8), m = (int)(i / 512), kvh = h / 4; const bool sample = m >= MP; const int b = row_b(m);
    const float* pc = scmp_ptr(c, m, h); const int nc = sample ? NCS : NCP;
    float oc = 0.f; for (int cb = 0; cb < nc; ++cb) { const float p = pc[cb]; if (p != 0.f) oc += p * cmp_ptr(c, c.VCMP, sample, b, cb, kvh)[d]; }
    const float* ps = c.SS + ((size_t)m * 8 + h) * 512; float os = 0.f;
    for (int n = 0; n < 8; ++n) { const int blk = c.SIDX[((size_t)m * 2 + kvh) * 8 + n]; if (blk < 0) continue;
      for (int j = 0; j < 64; ++j) { const float p = ps[n * 64 + j]; if (p != 0.f) os += p * nsa_row(c, sample, b, blk * 64 + j, 3, kvh)[d]; } }
    const float* pw = c.SW + ((size_t)m * 8 + h) * 512; float ow = 0.f;
    for (int j = 0; j < 512; ++j) { const float p = pw[j]; if (p != 0.f) ow += p * win_row(c, m, j, 1, kvh)[d]; }
    const float* g = c.GATE + (size_t)m * 24 + h * 3;
    c.CAT[(size_t)m * D_MODEL + h * 64 + d] = f2bf(oc * g[0] + os * g[1] + ow * g[2]);
  } };
#if defined(__HIP_DEVICE_COMPILE__)
#define GDN_FENCE() asm volatile("" ::: "memory")
#else
#define GDN_FENCE() do {} while (0)
#endif
struct StGdnScan { const Ctx& c; static constexpr long N = (long)(BATCH + DEC_BATCH) * 4 * 128;
  HD void operator()(long i) const {
    const int dv = (int)(i % 128), h = (int)((i / 128) % 4), bb = (int)(i / 512); const bool sample = bb >= BATCH; const int b = sample ? bb - BATCH : bb;
    const int T = sample ? DEC_SEQ : SEQ; const int m0 = sample ? MP + b * DEC_SEQ : b * SEQ;
    float S[128];
#pragma unroll
    for (int k = 0; k < 128; ++k) S[k] = sample ? c.state_gdn[(((size_t)b * 4 + h) * 128 + k) * 128 + dv] : 0.f;
    for (int t = 0; t < T; ++t) { const int m = m0 + t;
      const float* kk = c.GK + (size_t)m * 512 + h * 128; const float* qq = c.GQ + (size_t)m * 512 + h * 128;
      const float v = c.GV[(size_t)m * 512 + h * 128 + dv], beta = c.GB[(size_t)m * 4 + h], a = expf(c.GG[(size_t)m * 4 + h]);
      float ks = 0.f;
#pragma unroll
      for (int k0 = 0; k0 < 128; k0 += 16) {
#pragma unroll
        for (int k = 0; k < 16; ++k) ks += kk[k0 + k] * S[k0 + k];
        GDN_FENCE(); }
      const float coef = beta * (v - a * ks); float o = 0.f;
#pragma unroll
      for (int k0 = 0; k0 < 128; k0 += 16) {
#pragma unroll
        for (int k = 0; k < 16; ++k) { S[k0 + k] = a * S[k0 + k] + kk[k0 + k] * coef; o += qq[k0 + k] * S[k0 + k]; }
        GDN_FENCE(); }
      c.OG[(size_t)m * 512 + h * 128 + dv] = o; }
    float* so = c.out + (sample ? O_STS : O_STP) + (((size_t)b * 4 + h) * 128) * 128 + dv;
#pragma unroll
    for (int k = 0; k < 128; ++k) so[(size_t)k * 128] = S[k];
  } };
struct StGdnNorm { const Ctx& c; static constexpr long N = (long)MTOT * 4;
  HD void operator()(long i) const {
    const int m = (int)(i / 4), h = (int)(i % 4); const float* o = c.OG + (size_t)m * 512 + h * 128; const float* z = c.P + (size_t)m * LDP + OFF_Z + h * 128;
    float ss = 0.f; for (int d = 0; d < 128; ++d) ss += o[d] * o[d];
    const float r = 1.f / sqrtf(ss / 128.f + EPS);
    for (int d = 0; d < 128; ++d) c.CAT[(size_t)m * D_MODEL + 512 + h * 128 + d] = f2bf(o[d] * r * c.gdn_norm_w[d] * siluf_(z[d]));
  } };
struct StMemKV { const Ctx& c; static constexpr long N = (long)MMEM * 4;
  HD void operator()(long i) const {
    const int mm = (int)(i / 4), h = (int)(i % 4); const float* k = c.MKV + (size_t)mm * 2048 + h * 256; const float* v = c.MKV + (size_t)mm * 2048 + 1024 + h * 256;
    float ss = 0.f; for (int d = 0; d < 256; ++d) ss += k[d] * k[d];
    const float r = 1.f / sqrtf(ss / 256.f + EPS); float* o = c.out + O_MKVP + (size_t)mm * 2048;
    for (int d = 0; d < 256; ++d) { o[h * 256 + d] = k[d] * r * c.xk_norm_w[d]; o[1024 + h * 256 + d] = v[d]; }
  } };
struct StXqNorm { const Ctx& c; static constexpr long N = (long)MTOT * 4;
  HD void operator()(long i) const {
    float* q = c.Q2 + (size_t)(i / 4) * D_MODEL + (i % 4) * 256; float ss = 0.f; for (int d = 0; d < 256; ++d) ss += q[d] * q[d];
    const float r = 1.f / sqrtf(ss / 256.f + EPS); for (int d = 0; d < 256; ++d) q[d] = q[d] * r * c.xq_norm_w[d];
  } };
HD const float* memkv_row(const Ctx& c, int m, int j, int which, int h) {
  if (m < MP) return c.out + O_MKVP + ((size_t)(m / SEQ) * MEM_TOKENS + j) * 2048 + which * 1024 + h * 256;
  return c.cache_mem_kv + ((size_t)((m - MP) / DEC_SEQ) * MEM_TOKENS + j) * 2048 + which * 1024 + h * 256;
}
struct StXScore { const Ctx& c; static constexpr long N = (long)MTOT * 4 * MEM_TOKENS;
  HD void operator()(long i) const {
    const int j = (int)(i % MEM_TOKENS), h = (int)((i / MEM_TOKENS) % 4), m = (int)(i / MEM_TOKENS / 4);
    const float* q = c.Q2 + (size_t)m * D_MODEL + h * 256; const float* k = memkv_row(c, m, j, 0, h);
    float s = 0.f; for (int d = 0; d < 256; ++d) s += q[d] * k[d];
    c.SX[i] = s * 0.0625f;
  } };
struct StXSoftmax { const Ctx& c; static constexpr long N = (long)MTOT * 4;
  HD void operator()(long i) const { softmax_inplace(c.SX + (size_t)i * MEM_TOKENS, MEM_TOKENS); } };
struct StXOut { const Ctx& c; static constexpr long N = (long)MTOT * D_MODEL;
  HD void operator()(long i) const {
    const int d = (int)(i % 256), h = (int)((i / 256) % 4), m = (int)(i / D_MODEL); const float* p = c.SX + ((size_t)m * 4 + h) * MEM_TOKENS;
    float o = 0.f; for (int j = 0; j < MEM_TOKENS; ++j) o += p[j] * memkv_row(c, m, j, 1, h)[d];
    c.OX[i] = f2bf(o);
  } };
HD float up_at(const Ctx& c, int m, int back, int col) {
  const int t = row_t(m) - back; if (t >= 0) return c.UP[(size_t)(m - back) * (2 * D_FF) + col];
  if (m < MP) return 0.f;
  return c.cache_ffn_conv[((size_t)((m - MP) / DEC_SEQ) * 2 + (2 + t)) * (2 * D_FF) + col];
}
struct StFfnAct { const Ctx& c; static constexpr long N = (long)MTOT * D_FF;
  HD void operator()(long i) const {
    const int col = (int)(i % D_FF), m = (int)(i / D_FF); float a = c.ffn_conv_b[col], u = c.ffn_conv_b[D_FF + col];
    for (int k = 0; k < 3; ++k) { a += c.ffn_conv_w[k * 2 * D_FF + col] * up_at(c, m, 2 - k, col); u += c.ffn_conv_w[k * 2 * D_FF + D_FF + col] * up_at(c, m, 2 - k, D_FF + col); }
    c.ACT[i] = f2bf(siluf_(a) * u);
  } };
struct StFfnConvOut { const Ctx& c; static constexpr long N = (long)(BATCH + DEC_BATCH) * 2 * 2 * D_FF;
  HD void operator()(long i) const {
    const int col = (int)(i % (2 * D_FF)), r = (int)((i / (2 * D_FF)) % 2), bb = (int)(i / (4 * D_FF));
    if (bb < BATCH) c.out[O_FCP + i] = c.UP[((size_t)bb * SEQ + SEQ - 2 + r) * (2 * D_FF) + col];
    else { const int b = bb - BATCH; c.out[O_FCS + ((size_t)b * 2 + r) * (2 * D_FF) + col] = c.UP[((size_t)MP + b * DEC_SEQ + DEC_SEQ - 2 + r) * (2 * D_FF) + col]; }
  } };

struct WsMap { size_t off; HD size_t take(size_t bytes) { const size_t o = off; off += (bytes + 255) & ~(size_t)255; return o; } };
inline size_t ws_carve(Ctx& c, unsigned char* ws, size_t base) {
  WsMap w{base};
  c.XN = (bf16_t*)(ws + w.take((size_t)MTOT * D_MODEL * 2)); c.MN = (bf16_t*)(ws + w.take((size_t)MMEM * D_MODEL * 2));
  c.CAT = (bf16_t*)(ws + w.take((size_t)MTOT * D_MODEL * 2)); c.OX = (bf16_t*)(ws + w.take((size_t)MTOT * D_MODEL * 2));
  c.ACT = (bf16_t*)(ws + w.take((size_t)MTOT * D_FF * 2));
  c.P = (float*)(ws + w.take((size_t)MTOT * LDP * 4)); c.MKV = (float*)(ws + w.take((size_t)MMEM * 2048 * 4));
  c.QC = (float*)(ws + w.take((size_t)MTOT * 512 * 4)); c.QR = (float*)(ws + w.take((size_t)MTOT * 512 * 4));
  c.WR = (float*)(ws + w.take((size_t)MTOT * 256 * 4)); c.GATE = (float*)(ws + w.take((size_t)MTOT * 24 * 4));
  c.GQ = (float*)(ws + w.take((size_t)MTOT * 512 * 4)); c.GK = (float*)(ws + w.take((size_t)MTOT * 512 * 4)); c.GV = (float*)(ws + w.take((size_t)MTOT * 512 * 4));
  c.GB = (float*)(ws + w.take((size_t)MTOT * 4 * 4)); c.GG = (float*)(ws + w.take((size_t)MTOT * 4 * 4));
  const size_t ncmp = ((size_t)BATCH * NCP + (size_t)DEC_BATCH * NCS) * 128 * 4;
  c.KCMP = (float*)(ws + w.take(ncmp)); c.VCMP = (float*)(ws + w.take(ncmp));
  c.SCP = (float*)(ws + w.take((size_t)MP * 8 * NCPS * 4)); c.SCS = (float*)(ws + w.take((size_t)MS * 8 * NCSS * 4));
  c.SCORE = (float*)(ws + w.take((size_t)MTOT * 2 * NSELMAX * 4)); c.SIDX = (int*)(ws + w.take((size_t)MTOT * 2 * 8 * 4));
  c.OG = (float*)(ws + w.take((size_t)MTOT * 512 * 4)); c.H1 = (float*)(ws + w.take((size_t)MTOT * D_MODEL * 4));
  c.Q2 = (float*)(ws + w.take((size_t)MTOT * D_MODEL * 4)); c.SX = (float*)(ws + w.take((size_t)MTOT * 4 * MEM_TOKENS * 4));
  c.H2 = (float*)(ws + w.take((size_t)MTOT * D_MODEL * 4));
  c.QCb = (bf16_t*)(ws + w.take((size_t)MTOT * 512 * 2)); c.QRb = (bf16_t*)(ws + w.take((size_t)MTOT * 512 * 2));
  c.KSb = (bf16_t*)(ws + w.take((size_t)BATCH * 2 * SEQ * 64 * 2)); c.VSTb = (bf16_t*)(ws + w.take((size_t)BATCH * 2 * SEQ * 64 * 2));
  c.KWb = (bf16_t*)(ws + w.take((size_t)BATCH * 2 * SEQ * 64 * 2)); c.VWTb = (bf16_t*)(ws + w.take((size_t)BATCH * 2 * SEQ * 64 * 2));
  c.KWsb = (bf16_t*)(ws + w.take((size_t)DEC_BATCH * 2 * 544 * 64 * 2)); c.VWTsb = (bf16_t*)(ws + w.take((size_t)DEC_BATCH * 2 * 544 * 64 * 2));
  { const size_t nb = ((size_t)BATCH * 2 * 128 + (size_t)DEC_BATCH * 2 * 512) * 64 * 2; c.KCb = (bf16_t*)(ws + w.take(nb)); c.VCTb = (bf16_t*)(ws + w.take(nb)); }
  { const size_t nb = (size_t)(BATCH + DEC_BATCH) * 4 * MEM_TOKENS * 256 * 2; c.KXb = (bf16_t*)(ws + w.take(nb)); c.VXTb = (bf16_t*)(ws + w.take(nb)); c.Q2b = (bf16_t*)(ws + w.take((size_t)MTOT * D_MODEL * 2)); }
  { constexpr size_t nchunk = (size_t)BATCH * 4 * (SEQ / 64) + (size_t)DEC_BATCH * 4;
    c.GS = (float*)(ws + w.take(nchunk * 64 * 256 * 4)); c.GWp = (bf16_t*)(ws + w.take(nchunk * 64 * 128 * 2)); c.GQKp = (bf16_t*)(ws + w.take(nchunk * 64 * 64 * 2));
    c.GQDp = (bf16_t*)(ws + w.take(nchunk * 64 * 128 * 2)); c.GKDTp = (bf16_t*)(ws + w.take(nchunk * 128 * 64 * 2)); c.GL = (float*)(ws + w.take(nchunk * 4)); }
  c.WcT = (bf16_t*)(ws + w.take((size_t)2 * 2 * 64 * 1024 * 2)); c.CBIAS = (float*)(ws + w.take(128 * 4));
  c.PP = (float*)(ws + w.take(((size_t)2 * BATCH * 2 * (SEQ / 16) + (size_t)2 * DEC_BATCH * 2 * (PAST_LEN / 16)) * 128 * 4));
  const size_t ssb = (size_t)MTOT * 8 * 512 * 4, upb = (size_t)MTOT * 2 * D_FF * 4; const size_t big = w.take(2 * ssb > upb ? 2 * ssb : upb);
  c.SS = (float*)(ws + big); c.SW = (float*)(ws + big + ssb); c.UP = (float*)(ws + big);
  return w.off;
}
typedef short bf16x8 __attribute__((ext_vector_type(8)));
typedef float f32x16 __attribute__((ext_vector_type(16)));
typedef float f32x4v __attribute__((ext_vector_type(4)));
typedef unsigned u32x4v __attribute__((ext_vector_type(4)));
typedef unsigned u32x2v __attribute__((ext_vector_type(2)));
#ifdef HOST_TEST
#include <ucontext.h>
struct EmuSlot { short a[8]; short b[8]; float c[16]; unsigned u; };
struct EmuWave {
  ucontext_t main_ctx; ucontext_t ctx[64]; char* stacks; int cur; int ndone; bool done[64]; int gen[64];
  EmuSlot slot[2][64]; void (*fn)(void*, int); void* arg;
};
static thread_local EmuWave* tl_emu = nullptr;
static void emu_trampoline(int lane) { EmuWave* e = tl_emu; e->fn(e->arg, lane); e->done[lane] = true; e->ndone++; swapcontext(&e->ctx[lane], &e->main_ctx); }
static void emu_run_wave(void (*fn)(void*, int), void* arg) {
  static thread_local EmuWave* e = nullptr; constexpr size_t STK = 256 * 1024;
  if (!e) { e = new EmuWave; e->stacks = (char*)malloc(64 * STK); }
  tl_emu = e; e->fn = fn; e->arg = arg; e->ndone = 0;
  for (int l = 0; l < 64; ++l) { e->done[l] = false; e->gen[l] = 0; getcontext(&e->ctx[l]); e->ctx[l].uc_stack.ss_sp = e->stacks + l * STK; e->ctx[l].uc_stack.ss_size = STK; e->ctx[l].uc_link = nullptr;
    makecontext(&e->ctx[l], (void (*)())emu_trampoline, 1, l); }
  while (e->ndone < 64) for (int l = 0; l < 64; ++l) if (!e->done[l]) { e->cur = l; swapcontext(&e->main_ctx, &e->ctx[l]); }
}
static inline EmuSlot* emu_my_slot() { EmuWave* e = tl_emu; return &e->slot[e->gen[e->cur] & 1][e->cur]; }
static inline EmuSlot* emu_exchange() { EmuWave* e = tl_emu; const int l = e->cur; swapcontext(&e->ctx[l], &e->main_ctx); e = tl_emu; EmuSlot* s = e->slot[e->gen[l] & 1]; e->gen[l]++; return s; }
static inline int wv_lane() { return tl_emu->cur; }
static inline float bfbits2f(short s) { return __builtin_bit_cast(float, (unsigned)(unsigned short)s << 16); }
static inline f32x16 wv_mfma32(bf16x8 a, bf16x8 b, f32x16 c) {
  EmuSlot* m = emu_my_slot(); for (int j = 0; j < 8; ++j) { m->a[j] = a[j]; m->b[j] = b[j]; }
  EmuSlot* s = emu_exchange(); const int l = wv_lane(), col = l & 31, hi = l >> 5; f32x16 d;
  for (int r = 0; r < 16; ++r) { const int row = (r & 3) + 8 * (r >> 2) + 4 * hi; float acc = c[r];
    for (int k = 0; k < 16; ++k) acc += bfbits2f(s[row + 32 * (k >> 3)].a[k & 7]) * bfbits2f(s[col + 32 * (k >> 3)].b[k & 7]);
    d[r] = acc; }
  return d;
}
static inline unsigned wv_shfl_xor_u(unsigned v, int mask) { emu_my_slot()->u = v; EmuSlot* s = emu_exchange(); return s[wv_lane() ^ mask].u; }
static inline unsigned wv_shfl_u(unsigned v, int src) { emu_my_slot()->u = v; EmuSlot* s = emu_exchange(); return s[src & 63].u; }
static inline unsigned long long wv_ballot(bool p) { emu_my_slot()->u = p ? 1u : 0u; EmuSlot* s = emu_exchange(); unsigned long long r = 0; for (int l = 0; l < 64; ++l) if (s[l].u) r |= 1ull << l; return r; }
static inline float wv_exp2(float x) { return exp2f(x); }
static inline float wv_rcp(float x) { return 1.f / x; }
static inline unsigned wv_pk_bf16(float lo, float hi) { return f2bf_u(lo) | (f2bf_u(hi) << 16); }
#define WV_DEV inline
static inline void wv_fence() { emu_my_slot()->u = 0; (void)emu_exchange(); }
#else
#define WV_DEV __device__ __forceinline__
WV_DEV int wv_lane() { return (int)(threadIdx.x & 63); }
WV_DEV void wv_fence() { asm volatile("s_waitcnt vmcnt(0) lgkmcnt(0)" ::: "memory"); }
WV_DEV f32x16 wv_mfma32(bf16x8 a, bf16x8 b, f32x16 c) { return __builtin_amdgcn_mfma_f32_32x32x16_bf16(a, b, c, 0, 0, 0); }
WV_DEV unsigned wv_shfl_xor_u(unsigned v, int mask) { return (unsigned)__shfl_xor((int)v, mask); }
WV_DEV unsigned wv_shfl_u(unsigned v, int src) { return (unsigned)__shfl((int)v, src); }
WV_DEV unsigned long long wv_ballot(bool p) { return __ballot(p); }
WV_DEV float wv_exp2(float x) { return __builtin_amdgcn_exp2f(x); }
WV_DEV float wv_rcp(float x) { return __builtin_amdgcn_rcpf(x); }
typedef float wv_f32x2 __attribute__((ext_vector_type(2))); typedef __bf16 wv_bf16x2 __attribute__((ext_vector_type(2)));
WV_DEV unsigned wv_pk_bf16(float lo, float hi) { wv_f32x2 v = {lo, hi}; wv_bf16x2 b = __builtin_convertvector(v, wv_bf16x2); return __builtin_bit_cast(unsigned, b); }
#endif
WV_DEV float wv_shfl_xor_f(float v, int mask) { return __builtin_bit_cast(float, wv_shfl_xor_u(__builtin_bit_cast(unsigned, v), mask)); }
WV_DEV bf16x8 wv_pack8(float a0, float a1, float a2, float a3, float a4, float a5, float a6, float a7) {
  u32x4v w; w.x = wv_pk_bf16(a0, a1); w.y = wv_pk_bf16(a2, a3); w.z = wv_pk_bf16(a4, a5); w.w = wv_pk_bf16(a6, a7); return __builtin_bit_cast(bf16x8, w); }
WV_DEV bf16x8 wv_ld8(const bf16_t* p) { return *(const bf16x8*)p; }
WV_DEV bf16x8 wv_ld8_f32(const float* p) { const f32x4v a = *(const f32x4v*)p, b = *(const f32x4v*)(p + 4); return wv_pack8(a.x, a.y, a.z, a.w, b.x, b.y, b.z, b.w); }
constexpr int WKS = 544;
HD int vperm16(int k) { const int w = k & 15; return (k & ~15) | ((((w >> 2) & 1) << 3) + ((w >> 3) << 2) + (w & 3)); }
HD size_t kc_off(bool sample, int b, int kvh) { return sample ? (size_t)BATCH * 2 * 128 * 64 + ((size_t)b * 2 + kvh) * 512 * 64 : ((size_t)b * 2 + kvh) * 128 * 64; }
struct StPackQ { const Ctx& c; static constexpr long N = (long)MTOT * 512;
  HD void operator()(long i) const { c.QCb[i] = f2bf(c.QC[i]); c.QRb[i] = f2bf(c.QR[i]); } };
struct StPackKV { const Ctx& c; static constexpr long N = (long)BATCH * 2 * SEQ * 64;
  HD void operator()(long i) const {
    const int d = (int)(i % 64), t = (int)((i / 64) % SEQ), kvh = (int)((i / 64 / SEQ) % 2), b = (int)(i / 64 / SEQ / 2);
    const float* row = c.out + O_KVP + ((size_t)b * SEQ + t) * 512; const float* wr = c.WR + ((size_t)b * SEQ + t) * 256;
    const size_t bk = (size_t)b * 2 + kvh;
    c.KSb[(bk * SEQ + t) * 64 + d] = f2bf(row[(2 * 2 + kvh) * 64 + d]); c.VSTb[(bk * 64 + d) * SEQ + vperm16(t)] = f2bf(row[(3 * 2 + kvh) * 64 + d]);
    c.KWb[(bk * SEQ + t) * 64 + d] = f2bf(wr[(0 * 2 + kvh) * 64 + d]); c.VWTb[(bk * 64 + d) * SEQ + vperm16(t)] = f2bf(wr[(1 * 2 + kvh) * 64 + d]);
  } };
struct StPackWinS { const Ctx& c; static constexpr long N = (long)DEC_BATCH * 2 * WKS * 64;
  HD void operator()(long i) const {
    const int d = (int)(i % 64), w = (int)((i / 64) % WKS), kvh = (int)((i / 64 / WKS) % 2), b = (int)(i / 64 / WKS / 2);
    float k = 0.f, v = 0.f;
    if (w < WBUF) { const float* r = c.cache_nsa_win + ((size_t)b * WBUF + w) * 256; k = r[(0 * 2 + kvh) * 64 + d]; v = r[(1 * 2 + kvh) * 64 + d]; }
    else if (w < WBUF + DEC_SEQ) { const float* r = c.WR + ((size_t)MP + b * DEC_SEQ + (w - WBUF)) * 256; k = r[(0 * 2 + kvh) * 64 + d]; v = r[(1 * 2 + kvh) * 64 + d]; }
    const size_t bk = (size_t)b * 2 + kvh;
    c.KWsb[(bk * WKS + w) * 64 + d] = f2bf(k); c.VWTsb[(bk * 64 + d) * WKS + vperm16(w)] = f2bf(v);
  } };
constexpr long NPC_P = (long)BATCH * 2 * 128 * 64, NPC_S = (long)DEC_BATCH * 2 * 512 * 64;
struct StPackCmp { const Ctx& c; static constexpr long N = NPC_P + NPC_S;
  HD void operator()(long i) const {
    const bool sample = i >= NPC_P; long r = sample ? i - NPC_P : i; const int cpad = sample ? 512 : 128, nc = sample ? NCS : NCP;
    const int d = (int)(r % 64); r /= 64; const int cb = (int)(r % cpad); r /= cpad; const int kvh = (int)(r % 2), b = (int)(r / 2);
    float k = 0.f, v = 0.f; if (cb < nc) { k = cmp_ptr(c, c.KCMP, sample, b, cb, kvh)[d]; v = cmp_ptr(c, c.VCMP, sample, b, cb, kvh)[d]; }
    const size_t o = kc_off(sample, b, kvh);
    c.KCb[o + (size_t)cb * 64 + d] = f2bf(k); c.VCTb[o + (size_t)d * cpad + vperm16(cb)] = f2bf(v);
  } };

HD int crow16(int r, int hi) { return (r & 3) + 8 * (r >> 2) + 4 * hi; }
struct SoftSt { float m, l; f32x16 o[2]; };
constexpr float NSA_SCL = 0.125f * 1.4426950408889634f;
WV_DEV void soft_step(SoftSt& st, const f32x16& S, unsigned vm, bf16x8 v00, bf16x8 v01, bf16x8 v10, bf16x8 v11) {
  float sc[16]; float mx = -3e38f;
#pragma unroll
  for (int r = 0; r < 16; ++r) { sc[r] = ((vm >> r) & 1u) ? S[r] * NSA_SCL : -3e38f; mx = fmaxf(mx, sc[r]); }
  mx = fmaxf(mx, wv_shfl_xor_f(mx, 32));
  const float mn = fmaxf(st.m, mx), alpha = wv_exp2(st.m - mn); st.m = mn;
  float p[16]; float sum = 0.f;
#pragma unroll
  for (int r = 0; r < 16; ++r) { p[r] = ((vm >> r) & 1u) ? wv_exp2(sc[r] - mn) : 0.f; sum += p[r]; }
  st.l = st.l * alpha + sum; st.o[0] = st.o[0] * alpha; st.o[1] = st.o[1] * alpha;
  const bf16x8 p0 = wv_pack8(p[0], p[1], p[2], p[3], p[4], p[5], p[6], p[7]), p1 = wv_pack8(p[8], p[9], p[10], p[11], p[12], p[13], p[14], p[15]);
  st.o[0] = wv_mfma32(v00, p0, st.o[0]); st.o[0] = wv_mfma32(v01, p1, st.o[0]);
  st.o[1] = wv_mfma32(v10, p0, st.o[1]); st.o[1] = wv_mfma32(v11, p1, st.o[1]);
}
WV_DEV void soft_finish(SoftSt& st, float gate, f32x16 (&ot)[2]) {
  const float l = st.l + wv_shfl_xor_f(st.l, 32); const float f = l > 0.f ? gate * wv_rcp(l) : 0.f;
  ot[0] = ot[0] + st.o[0] * f; ot[1] = ot[1] + st.o[1] * f;
}
WV_DEV f32x16 qk_tile(const bf16_t* krow  , const bf16x8 (&q)[4]) {
  f32x16 S = {};
#pragma unroll
  for (int ks = 0; ks < 4; ++ks) S = wv_mfma32(wv_ld8(krow + 16 * ks), q[ks], S);
  return S;
}
WV_DEV void cmp_tile2(const bf16_t* kcb, const bf16_t* vcb, int cpad, int tile, int r32, int hi, int ncv, float mc, float invc, const bf16x8 (&qc)[4], f32x16 (&oc)[2],
                      bool need_imp, float& prevLp, float (&v4)[4]) {
  const f32x16 S = qk_tile(kcb + (size_t)(tile * 32 + r32) * 64 + 8 * hi, qc);
  float p[16];
#pragma unroll
  for (int r = 0; r < 16; ++r) p[r] = (tile * 32 + crow16(r, hi) < ncv) ? wv_exp2(S[r] * NSA_SCL - mc) * invc : 0.f;
  if (need_imp) {
#pragma unroll
    for (int u = 0; u < 4; ++u) {
      const float lp = wv_shfl_xor_f(p[4 * u + 3], 32); float v = (p[4 * u] + p[4 * u + 1]) + (p[4 * u + 2] + p[4 * u + 3]) + (hi ? lp : prevLp); prevLp = lp;
      v += wv_shfl_xor_f(v, 1); v += wv_shfl_xor_f(v, 2); v4[u] = v; }
  }
  const bf16x8 p0 = wv_pack8(p[0], p[1], p[2], p[3], p[4], p[5], p[6], p[7]), p1 = wv_pack8(p[8], p[9], p[10], p[11], p[12], p[13], p[14], p[15]);
  const bf16_t* vb = vcb + (size_t)r32 * cpad + tile * 32 + 8 * hi;
  oc[0] = wv_mfma32(wv_ld8(vb), p0, oc[0]); oc[0] = wv_mfma32(wv_ld8(vb + 16), p1, oc[0]);
  oc[1] = wv_mfma32(wv_ld8(vb + (size_t)32 * cpad), p0, oc[1]); oc[1] = wv_mfma32(wv_ld8(vb + (size_t)32 * cpad + 16), p1, oc[1]);
}
HD const float* sample_row(const Ctx& c, int b, int kp) {
  if (kp < PAST_LEN) { const int pg = c.page_table[b * NPAGES + kp / PAGE_SIZE]; return c.cache_nsa_kv + ((size_t)pg * PAGE_SIZE + kp % PAGE_SIZE) * 512; }
  int j = kp - PAST_LEN; if (j > DEC_SEQ - 1) j = DEC_SEQ - 1; return c.out + O_KVS + ((size_t)b * DEC_SEQ + j) * 512;
}
template <bool SAMPLE> WV_DEV void nsa_unit(const Ctx& c, int unit, float* wscr  ) {
  constexpr int NC = SAMPLE ? NCS : NCP, CPAD = SAMPLE ? 512 : 128, NCT = CPAD / 32, NI = NCT * 4;
  const int lane = wv_lane(), r32 = lane & 31, hi = lane >> 5, tt = r32 >> 2, g = r32 & 3;
  int b, kvh, t0;
  if (SAMPLE) { b = unit >> 1; kvh = unit & 1; t0 = 0; } else { const int tile = unit % (SEQ / 8), bk = unit / (SEQ / 8); t0 = tile * 8; kvh = bk & 1; b = bk >> 1; }
  const int m = (SAMPLE ? MP + b * DEC_SEQ : b * SEQ + t0) + tt, pos = (SAMPLE ? PAST_LEN : t0) + tt, h = kvh * 4 + g;
  const int pos_last = (SAMPLE ? PAST_LEN : t0) + 7;
  bf16x8 qc[4], qr[4];
#pragma unroll
  for (int ks = 0; ks < 4; ++ks) { qc[ks] = wv_ld8(c.QCb + (size_t)m * 512 + h * 64 + 16 * ks + 8 * hi); qr[ks] = wv_ld8(c.QRb + (size_t)m * 512 + h * 64 + 16 * ks + 8 * hi); }
  const float* gate = c.GATE + (size_t)m * 24 + h * 3;
  f32x16 ot[2]; ot[0] = f32x16{}; ot[1] = f32x16{};
  const bf16_t* kcb = c.KCb + kc_off(SAMPLE, b, kvh); const bf16_t* vcb = c.VCTb + kc_off(SAMPLE, b, kvh);
  const int ncv = pos >= 31 ? ((pos - 31) / 16 + 1 < NC ? (pos - 31) / 16 + 1 : NC) : 0;
  const int ncv_last = pos_last >= 31 ? ((pos_last - 31) / 16 + 1 < NC ? (pos_last - 31) / 16 + 1 : NC) : 0;
  const int ntc = (ncv_last + 31) / 32;
  float mc = -3e38f, lc = 0.f;
  for (int tile = 0; tile < ntc; ++tile) {
    const f32x16 S = qk_tile(kcb + (size_t)(tile * 32 + r32) * 64 + 8 * hi, qc);
    float sc[16]; float mx = -3e38f;
#pragma unroll
    for (int r = 0; r < 16; ++r) { const bool v = tile * 32 + crow16(r, hi) < ncv; sc[r] = v ? S[r] * NSA_SCL : -3e38f; mx = fmaxf(mx, sc[r]); }
    mx = fmaxf(mx, wv_shfl_xor_f(mx, 32));
    const float mn = fmaxf(mc, mx); float sum = 0.f;
#pragma unroll
    for (int r = 0; r < 16; ++r) sum += (tile * 32 + crow16(r, hi) < ncv) ? wv_exp2(sc[r] - mn) : 0.f;
    lc = lc * wv_exp2(mc - mn) + sum; mc = mn;
  }
  lc = lc + wv_shfl_xor_f(lc, 32);
  const float invc = lc > 0.f ? wv_rcp(lc) : 0.f;
  const int qblk = pos >> 6;
  const bool need_imp = SAMPLE || qblk > 7;
  unsigned long long sel0 = 0ull, sel1 = 0ull;
  float prevLp = 0.f; f32x16 oc[2]; oc[0] = f32x16{}; oc[1] = f32x16{};
  if constexpr (!SAMPLE) {
    float imp[NI];
#pragma unroll
    for (int i = 0; i < NI; ++i) imp[i] = -1.f;
#pragma unroll
    for (int tile = 0; tile < NCT; ++tile) {
      if (tile < ntc) { float v4[4] = {0.f, 0.f, 0.f, 0.f};
        cmp_tile2(kcb, vcb, CPAD, tile, r32, hi, ncv, mc, invc, qc, oc, need_imp, prevLp, v4);
#pragma unroll
        for (int u = 0; u < 4; ++u) { const int s = 2 * (tile * 4 + u) + hi; imp[tile * 4 + u] = (need_imp && s >= 1 && s <= qblk - 2) ? v4[u] : -1.f; } }
    }
    if (!need_imp) sel0 = (2ull << qblk) - 1ull;
    else {
      for (int round = 0; round < 5; ++round) {
        float bv = -1.f; int bs = 1 << 20;
#pragma unroll
        for (int i = 0; i < NI; ++i) if (imp[i] > bv) { bv = imp[i]; bs = 2 * i + hi; }
        const float pv = wv_shfl_xor_f(bv, 32); const int ps = (int)wv_shfl_xor_u((unsigned)bs, 32);
        const int ws = (pv > bv || (pv == bv && ps < bs)) ? ps : bs;
        sel0 |= 1ull << ws;
#pragma unroll
        for (int i = 0; i < NI; ++i) if (2 * i + hi == ws) imp[i] = -1.f;
      }
      sel0 |= 1ull | (1ull << qblk) | (1ull << (qblk - 1));
    }
  } else {
    for (int tile = 0; tile < ntc; ++tile) { float v4[4] = {0.f, 0.f, 0.f, 0.f};
      cmp_tile2(kcb, vcb, CPAD, tile, r32, hi, ncv, mc, invc, qc, oc, true, prevLp, v4);
      if (g == 0) {
#pragma unroll
        for (int u = 0; u < 4; ++u) wscr[tt * 128 + 2 * (tile * 4 + u) + hi] = v4[u]; }
    }
    wv_fence();
    const int sl = (g * 2 + hi) * 16; int w0 = -1, w1 = -1, w2 = -1, w3 = -1;
    for (int round = 0; round < 5; ++round) {
      float bv = -1.f; int bs = 1 << 20;
      for (int j = 0; j < 16; ++j) { const int s = sl + j; const float v = wscr[tt * 128 + s];
        const bool cand = s >= 1 && s <= qblk - 2 && s != w0 && s != w1 && s != w2 && s != w3;
        if (cand && v > bv) { bv = v; bs = s; } }
#pragma unroll
      for (int sh = 0; sh < 3; ++sh) { const int msk = sh == 0 ? 1 : sh == 1 ? 2 : 32;
        const float pv = wv_shfl_xor_f(bv, msk); const int ps = (int)wv_shfl_xor_u((unsigned)bs, msk);
        if (pv > bv || (pv == bv && ps < bs)) { bv = pv; bs = ps; } }
      if (bs < 64) sel0 |= 1ull << bs; else if (bs < 128) sel1 |= 1ull << (bs - 64);
      w3 = w2; w2 = w1; w1 = w0; w0 = bs;
    }
    sel0 |= 1ull;
    if (qblk < 64) sel0 |= 1ull << qblk; else if (qblk < 128) sel1 |= 1ull << (qblk - 64);
    if (qblk - 1 < 64) sel0 |= 1ull << (qblk - 1); else if (qblk - 1 < 128) sel1 |= 1ull << (qblk - 1 - 64);
  }
  { const float g0 = gate[0]; ot[0] = oc[0] * g0; ot[1] = oc[1] * g0; }
  unsigned long long un0 = sel0, un1 = sel1;
#pragma unroll
  for (int sh = 4; sh <= 16; sh <<= 1) {
    un0 |= (unsigned long long)wv_shfl_xor_u((unsigned)un0, sh) | ((unsigned long long)wv_shfl_xor_u((unsigned)(un0 >> 32), sh) << 32);
    if (SAMPLE) un1 |= (unsigned long long)wv_shfl_xor_u((unsigned)un1, sh) | ((unsigned long long)wv_shfl_xor_u((unsigned)(un1 >> 32), sh) << 32);
  }
  { SoftSt st; st.m = -3e38f; st.l = 0.f; st.o[0] = f32x16{}; st.o[1] = f32x16{};
    const int nblk = SAMPLE ? NSELS : qblk + 1;
    for (int s = 0; s < nblk; ++s) {
      const bool in_union = SAMPLE ? (s == NSELS - 1 || (s < 64 ? (un0 >> s) & 1ull : (un1 >> (s - 64)) & 1ull)) : ((un0 >> s) & 1ull);
      if (!in_union) continue;
      const bool mine = SAMPLE ? (s == NSELS - 1 || (s < 64 ? (sel0 >> s) & 1ull : (sel1 >> (s - 64)) & 1ull)) : ((sel0 >> s) & 1ull);
      for (int half = 0; half < 2; ++half) {
        const int kb = s * 64 + half * 32; if (kb > pos_last) break;
        unsigned vm = 0u;
#pragma unroll
        for (int r = 0; r < 16; ++r) if (mine && kb + crow16(r, hi) <= pos) vm |= 1u << r;
        if (!SAMPLE) {
          const size_t bk = (size_t)b * 2 + kvh;
          const f32x16 S = qk_tile(c.KSb + (bk * SEQ + kb + r32) * 64 + 8 * hi, qr);
          const bf16_t* vb = c.VSTb + (bk * 64 + r32) * SEQ + kb + 8 * hi;
          soft_step(st, S, vm, wv_ld8(vb), wv_ld8(vb + 16), wv_ld8(vb + (size_t)32 * SEQ), wv_ld8(vb + (size_t)32 * SEQ + 16));
        } else {
          const float* blk; int rmax;
          if (s < NSELS - 1) { const int pg = c.page_table[b * NPAGES + (s >> 1)]; blk = c.cache_nsa_kv + ((size_t)pg * PAGE_SIZE + (s & 1) * 64) * 512; rmax = 63; }
          else { blk = c.out + O_KVS + (size_t)b * DEC_SEQ * 512; rmax = DEC_SEQ - 1; }
          const int kr = half * 32 + r32; const float* krow = blk + (size_t)(kr < rmax ? kr : rmax) * 512 + (2 * 2 + kvh) * 64 + 8 * hi;
          f32x16 S = {};
#pragma unroll
          for (int ks = 0; ks < 4; ++ks) S = wv_mfma32(wv_ld8_f32(krow + 16 * ks), qr[ks], S);
          bf16x8 vf[2][2];
#pragma unroll
          for (int ks = 0; ks < 2; ++ks) { float v0[8], v1[8];
#pragma unroll
            for (int j = 0; j < 8; ++j) { const int vr = half * 32 + 16 * ks + 8 * (j >> 2) + 4 * hi + (j & 3); const float* vp = blk + (size_t)(vr < rmax ? vr : rmax) * 512 + (3 * 2 + kvh) * 64; v0[j] = vp[r32]; v1[j] = vp[32 + r32]; }
            vf[0][ks] = wv_pack8(v0[0], v0[1], v0[2], v0[3], v0[4], v0[5], v0[6], v0[7]); vf[1][ks] = wv_pack8(v1[0], v1[1], v1[2], v1[3], v1[4], v1[5], v1[6], v1[7]); }
          soft_step(st, S, vm, vf[0][0], vf[0][1], vf[1][0], vf[1][1]);
        }
      }
    }
    soft_finish(st, gate[1], ot); }
  { SoftSt st; st.m = -3e38f; st.l = 0.f; st.o[0] = f32x16{}; st.o[1] = f32x16{};
    if (!SAMPLE) {
      const size_t bk = (size_t)b * 2 + kvh; const int lo = t0 - (WINDOW - 1) > 0 ? t0 - (WINDOW - 1) : 0;
      for (int kb = lo & ~31; kb <= pos_last; kb += 32) {
        unsigned vm = 0u;
#pragma unroll
        for (int r = 0; r < 16; ++r) { const int key = kb + crow16(r, hi); if (key <= pos && key > pos - WINDOW) vm |= 1u << r; }
        const f32x16 S = qk_tile(c.KWb + (bk * SEQ + kb + r32) * 64 + 8 * hi, qr);
        const bf16_t* vb = c.VWTb + (bk * 64 + r32) * SEQ + kb + 8 * hi;
        soft_step(st, S, vm, wv_ld8(vb), wv_ld8(vb + 16), wv_ld8(vb + (size_t)32 * SEQ), wv_ld8(vb + (size_t)32 * SEQ + 16));
      }
    } else {
      const size_t bk = (size_t)b * 2 + kvh;
      for (int kb = 0; kb < WKS; kb += 32) {
        unsigned vm = 0u;
#pragma unroll
        for (int r = 0; r < 16; ++r) { const int i = kb + crow16(r, hi); if (i >= tt + 1 && i <= WBUF + tt) vm |= 1u << r; }
        const f32x16 S = qk_tile(c.KWsb + (bk * WKS + kb + r32) * 64 + 8 * hi, qr);
        const bf16_t* vb = c.VWTsb + (bk * 64 + r32) * WKS + kb + 8 * hi;
        soft_step(st, S, vm, wv_ld8(vb), wv_ld8(vb + 16), wv_ld8(vb + (size_t)32 * WKS), wv_ld8(vb + (size_t)32 * WKS + 16));
      }
    }
    soft_finish(st, gate[2], ot); }
  bf16_t* orow = c.CAT + (size_t)m * D_MODEL + h * 64 + 4 * hi;
#pragma unroll
  for (int db = 0; db < 2; ++db)
#pragma unroll
    for (int u = 0; u < 4; ++u) { u32x2v w; w.x = wv_pk_bf16(ot[db][4 * u], ot[db][4 * u + 1]); w.y = wv_pk_bf16(ot[db][4 * u + 2], ot[db][4 * u + 3]); *(u32x2v*)(orow + db * 32 + 8 * u) = w; }
}
constexpr int NSA_UNITS_P = BATCH * 2 * (SEQ / 8), NSA_UNITS_S = DEC_BATCH * 2;
constexpr int XNT = MEM_TOKENS / 32;
HD int bb_row0(int bb) { return bb < BATCH ? bb * SEQ : MP + (bb - BATCH) * DEC_SEQ; }
struct StPackX { const Ctx& c; static constexpr long N = (long)(BATCH + DEC_BATCH) * 4 * MEM_TOKENS * 256;
  HD void operator()(long i) const {
    const int d = (int)(i % 256), j = (int)((i / 256) % MEM_TOKENS), h = (int)((i / 256 / MEM_TOKENS) % 4), bb = (int)(i / 256 / MEM_TOKENS / 4);
    const int m = bb_row0(bb); const size_t bh = (size_t)bb * 4 + h;
    c.KXb[(bh * MEM_TOKENS + j) * 256 + d] = f2bf(memkv_row(c, m, j, 0, h)[d]); c.VXTb[(bh * 256 + d) * MEM_TOKENS + vperm16(j)] = f2bf(memkv_row(c, m, j, 1, h)[d]);
  } };
struct StXqNormB { const Ctx& c; static constexpr long N = (long)MTOT * 4;
  HD void operator()(long i) const {
    const float* q = c.Q2 + (size_t)(i / 4) * D_MODEL + (i % 4) * 256; bf16_t* o = c.Q2b + (size_t)(i / 4) * D_MODEL + (i % 4) * 256;
    float ss = 0.f; for (int d = 0; d < 256; ++d) ss += q[d] * q[d];
    const float r = 1.f / sqrtf(ss / 256.f + EPS); for (int d = 0; d < 256; ++d) o[d] = f2bf(q[d] * r * c.xq_norm_w[d]);
  } };
constexpr int XA_UNITS_P = BATCH * 4 * (SEQ / 32), XA_UNITS_S = DEC_BATCH * 4;
template <bool SAMPLE> WV_DEV void xattn_unit(const Ctx& c, int unit) {
  const int lane = wv_lane(), r32 = lane & 31, hi = lane >> 5;
  int h, bb, m; bool valid = true;
  if (!SAMPLE) { const int tile = unit % (SEQ / 32), bh = unit / (SEQ / 32); h = bh & 3; bb = bh >> 2; m = bb * SEQ + tile * 32 + r32; }
  else { h = unit & 3; const int b = unit >> 2; bb = BATCH + b; m = MP + b * DEC_SEQ + (r32 & (DEC_SEQ - 1)); valid = r32 < DEC_SEQ; }
  const bf16_t* qrow = c.Q2b + (size_t)m * D_MODEL + h * 256 + 8 * hi;
  const bf16_t* kb = c.KXb + ((size_t)bb * 4 + h) * MEM_TOKENS * 256 + (size_t)r32 * 256 + 8 * hi;
  const bf16_t* vb = c.VXTb + ((size_t)bb * 4 + h) * 256 * MEM_TOKENS + (size_t)r32 * MEM_TOKENS + 8 * hi;
  f32x16 S[XNT];
#pragma unroll
  for (int t = 0; t < XNT; ++t) S[t] = f32x16{};
#pragma unroll 2
  for (int ks = 0; ks < 16; ++ks) { const bf16x8 qf = wv_ld8(qrow + 16 * ks);
#pragma unroll
    for (int t = 0; t < XNT; ++t) S[t] = wv_mfma32(wv_ld8(kb + (size_t)t * 32 * 256 + 16 * ks), qf, S[t]); }
  constexpr float SC = 0.0625f * 1.4426950408889634f;
  float mx = -3e38f;
#pragma unroll
  for (int t = 0; t < XNT; ++t)
#pragma unroll
    for (int r = 0; r < 16; ++r) mx = fmaxf(mx, S[t][r]);
  mx = fmaxf(mx, wv_shfl_xor_f(mx, 32));
  float sum = 0.f; bf16x8 pf[XNT][2];
#pragma unroll
  for (int t = 0; t < XNT; ++t) { float p[16];
#pragma unroll
    for (int r = 0; r < 16; ++r) { p[r] = wv_exp2((S[t][r] - mx) * SC); sum += p[r]; }
    pf[t][0] = wv_pack8(p[0], p[1], p[2], p[3], p[4], p[5], p[6], p[7]); pf[t][1] = wv_pack8(p[8], p[9], p[10], p[11], p[12], p[13], p[14], p[15]); }
  sum += wv_shfl_xor_f(sum, 32);
  const float inv = wv_rcp(sum);
  bf16_t* orow = c.OX + (size_t)m * D_MODEL + h * 256 + 4 * hi;
  for (int db = 0; db < 8; ++db) { f32x16 o = {};
#pragma unroll
    for (int t = 0; t < XNT; ++t) { o = wv_mfma32(wv_ld8(vb + (size_t)db * 32 * MEM_TOKENS + t * 32), pf[t][0], o); o = wv_mfma32(wv_ld8(vb + (size_t)db * 32 * MEM_TOKENS + t * 32 + 16), pf[t][1], o); }
    if (valid) {
#pragma unroll
      for (int u = 0; u < 4; ++u) { u32x2v w; w.x = wv_pk_bf16(o[4 * u] * inv, o[4 * u + 1] * inv); w.y = wv_pk_bf16(o[4 * u + 2] * inv, o[4 * u + 3] * inv); *(u32x2v*)(orow + db * 32 + 8 * u) = w; } }
  }
}
constexpr int NCH = SEQ / 64;
constexpr int NCHUNK_P = BATCH * 4 * NCH, NCHUNK = NCHUNK_P + DEC_BATCH * 4;
constexpr int GDN_PREP_UNITS = NCHUNK * 4, GDN_SCAN_UNITS = (BATCH + DEC_BATCH) * 4 * 4;
constexpr int GDN_WSCR_FLOATS = 64 * 64 + 128;
HD void chunk_decode(int ch, int& b, int& h, int& m0, int& nvalid) {
  if (ch < NCHUNK_P) { const int n = ch % NCH, bh = ch / NCH; h = bh & 3; b = bh >> 2; m0 = b * SEQ + n * 64; nvalid = 64; }
  else { const int r = ch - NCHUNK_P; h = r & 3; b = r >> 2; m0 = MP + b * DEC_SEQ; nvalid = DEC_SEQ; }
}
WV_DEV bf16x8 ldrow8(const float* buf, int m0, int i, int nvalid, int off) {
  if (i < nvalid) return wv_ld8_f32(buf + (size_t)(m0 + i) * 512 + off);
  return bf16x8{};
}
WV_DEV void gdn_prep_unit(const Ctx& c, int unit, float* wscr) {
  const int lane = wv_lane(), r32 = lane & 31, hi = lane >> 5, ch = unit >> 2, quarter = unit & 3;
  int b, h, m0, nvalid; chunk_decode(ch, b, h, m0, nvalid);
  float* At = wscr; float* gcs = wscr + 4096; float* bts = wscr + 4160;
  const float gi = lane < nvalid ? c.GG[(size_t)(m0 + lane) * 4 + h] : 0.f, bi = lane < nvalid ? c.GB[(size_t)(m0 + lane) * 4 + h] : 0.f;
  float gc = gi;
#pragma unroll
  for (int off = 1; off < 64; off <<= 1) { const float t = __builtin_bit_cast(float, wv_shfl_u(__builtin_bit_cast(unsigned, gc), lane - off)); if (lane >= off) gc += t; }
  gcs[lane] = gc; bts[lane] = bi;
  const float g_last = __builtin_bit_cast(float, wv_shfl_u(__builtin_bit_cast(unsigned, gc), 63));
  wv_fence();
#pragma unroll 1
  for (int bp = 0; bp < 3; ++bp) { const int ib = bp == 0 ? 0 : 1, jb = bp == 2 ? 1 : 0;
    f32x16 S = {};
#pragma unroll 2
    for (int ks = 0; ks < 8; ++ks) S = wv_mfma32(ldrow8(c.GK, m0, ib * 32 + r32, nvalid, h * 128 + 16 * ks + 8 * hi), ldrow8(c.GK, m0, jb * 32 + r32, nvalid, h * 128 + 16 * ks + 8 * hi), S);
    const int j = jb * 32 + r32; const float gcj = gcs[j];
#pragma unroll
    for (int r = 0; r < 16; ++r) { const int i = ib * 32 + crow16(r, hi); At[j * 64 + i] = (j < i) ? bts[i] * S[r] * expf(gcs[i] - gcj) : 0.f; }
  }
#pragma unroll
  for (int r = 0; r < 16; ++r) At[(32 + r32) * 64 + crow16(r, hi)] = 0.f;
  wv_fence();
  { const int col = quarter * 64 + lane; const bool isu = col < 128; const int dcol = isu ? col : col - 128; const float* src = isu ? c.GV : c.GK;
    float* solm = c.GS + (size_t)ch * 64 * 256 + col; const int slot = vperm16(dcol);
#pragma unroll 1
    for (int rb = 0; rb < 4; ++rb) {
      float acc[16];
#pragma unroll
      for (int i = 0; i < 16; ++i) { const int row = rb * 16 + i; const float x = row < nvalid ? src[(size_t)(m0 + row) * 512 + h * 128 + dcol] : 0.f; acc[i] = x * bts[row] * (isu ? 1.f : expf(gcs[row])); }
      for (int j = 0; j < rb * 16; ++j) { const float sj = solm[(size_t)j * 256]; const float* at = At + j * 64 + rb * 16;
#pragma unroll
        for (int i = 0; i < 16; ++i) acc[i] -= at[i] * sj; }
#pragma unroll
      for (int j = 0; j < 16; ++j) { const float sj = acc[j]; const float* at = At + (rb * 16 + j) * 64 + rb * 16;
#pragma unroll
        for (int i = 0; i < 16; ++i) if (i > j) acc[i] -= at[i] * sj; }
#pragma unroll
      for (int i = 0; i < 16; ++i) { solm[(size_t)(rb * 16 + i) * 256] = acc[i]; if (!isu) c.GWp[((size_t)ch * 64 + rb * 16 + i) * 128 + slot] = f2bf(-acc[i]); }
      wv_fence();
    }
  }
  if (quarter == 0) {
#pragma unroll 1
    for (int bp = 0; bp < 3; ++bp) { const int ib = bp == 0 ? 0 : 1, jb = bp == 2 ? 1 : 0;
      f32x16 S = {};
#pragma unroll 2
      for (int ks = 0; ks < 8; ++ks) S = wv_mfma32(ldrow8(c.GQ, m0, ib * 32 + r32, nvalid, h * 128 + 16 * ks + 8 * hi), ldrow8(c.GK, m0, jb * 32 + r32, nvalid, h * 128 + 16 * ks + 8 * hi), S);
      const int j = jb * 32 + r32; const float gcj = gcs[j]; const int slot = vperm16(j);
#pragma unroll
      for (int r = 0; r < 16; ++r) { const int i = ib * 32 + crow16(r, hi); c.GQKp[((size_t)ch * 64 + i) * 64 + slot] = f2bf((j <= i) ? S[r] * expf(gcs[i] - gcj) : 0.f); }
    }
  } else if (quarter == 1) {
    const float e = expf(gc); const float* q = c.GQ + (size_t)(m0 + lane) * 512 + h * 128;
#pragma unroll
    for (int g16 = 0; g16 < 8; ++g16)
#pragma unroll
      for (int h2 = 0; h2 < 2; ++h2) { f32x4v lo = {0.f, 0.f, 0.f, 0.f}, hv = {0.f, 0.f, 0.f, 0.f};
        if (lane < nvalid) { lo = *(const f32x4v*)(q + g16 * 16 + 4 * h2); hv = *(const f32x4v*)(q + g16 * 16 + 8 + 4 * h2); }
        *(bf16x8*)(c.GQDp + ((size_t)ch * 64 + lane) * 128 + g16 * 16 + h2 * 8) = wv_pack8(lo.x * e, lo.y * e, lo.z * e, lo.w * e, hv.x * e, hv.y * e, hv.z * e, hv.w * e); }
  } else if (quarter == 2) {
#pragma unroll 1
    for (int pass = 0; pass < 2; ++pass) { const int dk = lane + 64 * pass; const float* kcol = c.GK + (size_t)m0 * 512 + h * 128 + dk;
#pragma unroll 1
      for (int g8 = 0; g8 < 8; ++g8) { const int g16 = g8 >> 1, h2 = g8 & 1; float v[8];
#pragma unroll
        for (int j = 0; j < 8; ++j) { const int i = g16 * 16 + 8 * (j >> 2) + 4 * h2 + (j & 3); v[j] = i < nvalid ? kcol[(size_t)i * 512] * expf(g_last - gcs[i]) : 0.f; }
        *(bf16x8*)(c.GKDTp + ((size_t)ch * 128 + dk) * 64 + g16 * 16 + h2 * 8) = wv_pack8(v[0], v[1], v[2], v[3], v[4], v[5], v[6], v[7]); } }
  } else { if (lane == 0) c.GL[ch] = g_last; }
  wv_fence();
}
WV_DEV float warm_lines(const void* base, int nlines, size_t pitch, int lane) { float acc = 0.f; for (int k = lane; k < nlines; k += 64) acc += *(const float*)((const char*)base + (size_t)k * pitch); return acc; }
WV_DEV void gdn_scan_unit(const Ctx& c, int unit) {
  const int lane = wv_lane(), r32 = lane & 31, hi = lane >> 5, bbh = unit >> 2, dv0 = (unit & 3) * 32;
  const bool sample = bbh >= BATCH * 4; const int idx = sample ? bbh - BATCH * 4 : bbh, b = idx >> 2, h = idx & 3;
  const int nch = sample ? 1 : NCH, chunk0 = sample ? NCHUNK_P + idx : idx * NCH, nvalid = sample ? DEC_SEQ : 64;
  f32x16 S[4];
#pragma unroll
  for (int kb = 0; kb < 4; ++kb)
#pragma unroll
    for (int r = 0; r < 16; ++r) S[kb][r] = sample ? c.state_gdn[(((size_t)b * 4 + h) * 128 + kb * 32 + crow16(r, hi)) * 128 + dv0 + r32] : 0.f;
  float warm = 0.f;
  for (int n = 0; n < nch; ++n) { const int ch = chunk0 + n; const int m0 = sample ? MP + b * DEC_SEQ : b * SEQ + n * 64;
    if (n + 2 < nch) { const size_t cw = (size_t)(ch + 2);
      warm += warm_lines(c.GS + cw * 64 * 256 + dv0, 64, 1024, lane) + warm_lines(c.GWp + cw * 64 * 128, 128, 128, lane) + warm_lines(c.GQDp + cw * 64 * 128, 128, 128, lane)
            + warm_lines(c.GQKp + cw * 64 * 64, 64, 128, lane) + warm_lines(c.GKDTp + cw * 128 * 64, 128, 128, lane); }
    bf16x8 sf[4][2];
#pragma unroll
    for (int kb = 0; kb < 4; ++kb)
#pragma unroll
      for (int s = 0; s < 2; ++s) sf[kb][s] = wv_pack8(S[kb][8 * s], S[kb][8 * s + 1], S[kb][8 * s + 2], S[kb][8 * s + 3], S[kb][8 * s + 4], S[kb][8 * s + 5], S[kb][8 * s + 6], S[kb][8 * s + 7]);
    f32x16 vn[2], o[2];
#pragma unroll
    for (int cb = 0; cb < 2; ++cb) {
#pragma unroll
      for (int r = 0; r < 16; ++r) vn[cb][r] = c.GS[((size_t)ch * 64 + cb * 32 + crow16(r, hi)) * 256 + dv0 + r32];
      o[cb] = f32x16{};
      const bf16_t* wrow = c.GWp + ((size_t)ch * 64 + cb * 32 + r32) * 128 + 8 * hi; const bf16_t* qrow = c.GQDp + ((size_t)ch * 64 + cb * 32 + r32) * 128 + 8 * hi;
#pragma unroll
      for (int kb = 0; kb < 4; ++kb)
#pragma unroll
        for (int s = 0; s < 2; ++s) { vn[cb] = wv_mfma32(wv_ld8(wrow + kb * 32 + 16 * s), sf[kb][s], vn[cb]); o[cb] = wv_mfma32(wv_ld8(qrow + kb * 32 + 16 * s), sf[kb][s], o[cb]); }
    }
    bf16x8 vf[2][2];
#pragma unroll
    for (int kc = 0; kc < 2; ++kc)
#pragma unroll
      for (int s = 0; s < 2; ++s) vf[kc][s] = wv_pack8(vn[kc][8 * s], vn[kc][8 * s + 1], vn[kc][8 * s + 2], vn[kc][8 * s + 3], vn[kc][8 * s + 4], vn[kc][8 * s + 5], vn[kc][8 * s + 6], vn[kc][8 * s + 7]);
#pragma unroll
    for (int bp = 0; bp < 3; ++bp) { const int cb = bp == 0 ? 0 : 1, kc = bp == 2 ? 1 : 0;
      const bf16_t* arow = c.GQKp + ((size_t)ch * 64 + cb * 32 + r32) * 64 + kc * 32 + 8 * hi;
      o[cb] = wv_mfma32(wv_ld8(arow), vf[kc][0], o[cb]); o[cb] = wv_mfma32(wv_ld8(arow + 16), vf[kc][1], o[cb]); }
#pragma unroll
    for (int cb = 0; cb < 2; ++cb)
#pragma unroll
      for (int r = 0; r < 16; ++r) { const int i = cb * 32 + crow16(r, hi); if (i < nvalid) c.OG[(size_t)(m0 + i) * 512 + h * 128 + dv0 + r32] = o[cb][r]; }
    const float e = expf(c.GL[ch]);
#pragma unroll
    for (int kb = 0; kb < 4; ++kb) { S[kb] = S[kb] * e;
      const bf16_t* krow = c.GKDTp + ((size_t)ch * 128 + kb * 32 + r32) * 64 + 8 * hi;
#pragma unroll
      for (int kc = 0; kc < 2; ++kc)
#pragma unroll
        for (int s = 0; s < 2; ++s) S[kb] = wv_mfma32(wv_ld8(krow + kc * 32 + 16 * s), vf[kc][s], S[kb]); }
  }
  if (warm == 1.2345678e-30f) c.GL[chunk0] = warm;
  float* so = c.out + (sample ? O_STS : O_STP) + ((size_t)b * 4 + h) * 128 * 128;
#pragma unroll
  for (int kb = 0; kb < 4; ++kb)
#pragma unroll
    for (int r = 0; r < 16; ++r) so[(size_t)(kb * 32 + crow16(r, hi)) * 128 + dv0 + r32] = S[kb][r];
}
WV_DEV float wv_allsum(float v) {
#pragma unroll
  for (int o = 1; o < 64; o <<= 1) v += wv_shfl_xor_f(v, o);
  return v;
}
WV_DEV void st_pk4(bf16_t* p, f32x4v v) { u32x2v w; w.x = wv_pk_bf16(v.x, v.y); w.y = wv_pk_bf16(v.z, v.w); *(u32x2v*)p = w; }
WV_DEV void rms_row_unit(const float* src, const float* w, bf16_t* dst) {
  const int lane = wv_lane(); f32x4v v[4]; float ss = 0.f;
#pragma unroll
  for (int j = 0; j < 4; ++j) { v[j] = *(const f32x4v*)(src + lane * 4 + 256 * j); ss += (v[j].x * v[j].x + v[j].y * v[j].y) + (v[j].z * v[j].z + v[j].w * v[j].w); }
  ss = wv_allsum(ss); const float r = 1.f / sqrtf(ss / D_MODEL + EPS);
#pragma unroll
  for (int j = 0; j < 4; ++j) { const f32x4v ww = *(const f32x4v*)(w + lane * 4 + 256 * j); st_pk4(dst + lane * 4 + 256 * j, v[j] * ww * r); }
}
WV_DEV void xq_norm_unit(const Ctx& c, int m) {
  const int lane = wv_lane(); const float* q = c.Q2 + (size_t)m * D_MODEL + lane * 16; f32x4v v[4]; float ss = 0.f;
#pragma unroll
  for (int j = 0; j < 4; ++j) { v[j] = *(const f32x4v*)(q + 4 * j); ss += (v[j].x * v[j].x + v[j].y * v[j].y) + (v[j].z * v[j].z + v[j].w * v[j].w); }
  ss += wv_shfl_xor_f(ss, 1); ss += wv_shfl_xor_f(ss, 2); ss += wv_shfl_xor_f(ss, 4); ss += wv_shfl_xor_f(ss, 8);
  const float r = 1.f / sqrtf(ss / 256.f + EPS); const float* w = c.xq_norm_w + (lane & 15) * 16;
#pragma unroll
  for (int j = 0; j < 4; ++j) { const f32x4v ww = *(const f32x4v*)(w + 4 * j); st_pk4(c.Q2b + (size_t)m * D_MODEL + lane * 16 + 4 * j, v[j] * ww * r); }
}
WV_DEV void gdn_norm_unit(const Ctx& c, int m) {
  const int lane = wv_lane(); const float* o = c.OG + (size_t)m * 512 + lane * 8; const float* z = c.P + (size_t)m * LDP + OFF_Z + lane * 8;
  const f32x4v a = *(const f32x4v*)o, b = *(const f32x4v*)(o + 4); float ss = (a.x * a.x + a.y * a.y) + (a.z * a.z + a.w * a.w) + (b.x * b.x + b.y * b.y) + (b.z * b.z + b.w * b.w);
  ss += wv_shfl_xor_f(ss, 1); ss += wv_shfl_xor_f(ss, 2); ss += wv_shfl_xor_f(ss, 4); ss += wv_shfl_xor_f(ss, 8);
  const float r = 1.f / sqrtf(ss / 128.f + EPS); const float* w = c.gdn_norm_w + (lane & 15) * 8;
  const f32x4v za = *(const f32x4v*)z, zb = *(const f32x4v*)(z + 4), wa = *(const f32x4v*)w, wb = *(const f32x4v*)(w + 4);
  *(bf16x8*)(c.CAT + (size_t)m * D_MODEL + 512 + lane * 8) = wv_pack8(a.x * r * wa.x * siluf_(za.x), a.y * r * wa.y * siluf_(za.y), a.z * r * wa.z * siluf_(za.z), a.w * r * wa.w * siluf_(za.w),
                                                                          b.x * r * wb.x * siluf_(zb.x), b.y * r * wb.y * siluf_(zb.y), b.z * r * wb.z * siluf_(zb.z), b.w * r * wb.w * siluf_(zb.w));
}
WV_DEV void postproc_unit(const Ctx& c, int m) {
  const int lane = wv_lane(), j = lane & 7; const float* p = c.P + (size_t)m * LDP; const int pos = row_pos(m);
  float cs[8], sn[8];
#pragma unroll
  for (int i = 0; i < 8; ++i) { const float inv = powf(10000.f, -(float)((8 * j + i) & 31) / 32.f), ang = (float)pos * inv; cs[i] = cosf(ang); sn[i] = sinf(ang); }
  const bool lowhalf = j < 4;
  { const int h = lane >> 3; const f32x4v a = *(const f32x4v*)(p + h * 64 + j * 8), b = *(const f32x4v*)(p + h * 64 + j * 8 + 4);
    float x[8] = {a.x, a.y, a.z, a.w, b.x, b.y, b.z, b.w}; float ss = 0.f;
#pragma unroll
    for (int i = 0; i < 8; ++i) ss += x[i] * x[i];
    ss += wv_shfl_xor_f(ss, 1); ss += wv_shfl_xor_f(ss, 2); ss += wv_shfl_xor_f(ss, 4);
    const float r = 1.f / sqrtf(ss / 64.f + EPS); float o[8];
#pragma unroll
    for (int i = 0; i < 8; ++i) x[i] = x[i] * r * c.nsa_q_norm_w[j * 8 + i];
#pragma unroll
    for (int i = 0; i < 8; ++i) { const float pa = wv_shfl_xor_f(x[i], 4); o[i] = lowhalf ? x[i] * cs[i] - pa * sn[i] : pa * sn[i] + x[i] * cs[i]; }
    *(bf16x8*)(c.QCb + (size_t)m * 512 + h * 64 + j * 8) = wv_pack8(x[0], x[1], x[2], x[3], x[4], x[5], x[6], x[7]);
    *(bf16x8*)(c.QRb + (size_t)m * 512 + h * 64 + j * 8) = wv_pack8(o[0], o[1], o[2], o[3], o[4], o[5], o[6], o[7]); }
#pragma unroll
  for (int pass = 0; pass < 2; ++pass) {
    const int s = pass * 8 + (lane >> 3); const bool act = s < 12; const int sc = act ? s : 11, kv = (sc >> 1) & 1, br = sc >> 2, kvh = sc & 1;
    const f32x4v a = *(const f32x4v*)(p + OFF_KV + sc * 64 + j * 8), b = *(const f32x4v*)(p + OFF_KV + sc * 64 + j * 8 + 4);
    float x[8] = {a.x, a.y, a.z, a.w, b.x, b.y, b.z, b.w}; float ss = 0.f;
#pragma unroll
    for (int i = 0; i < 8; ++i) ss += x[i] * x[i];
    ss += wv_shfl_xor_f(ss, 1); ss += wv_shfl_xor_f(ss, 2); ss += wv_shfl_xor_f(ss, 4);
    const float r = 1.f / sqrtf(ss / 64.f + EPS);
    if (kv == 0) {
#pragma unroll
      for (int i = 0; i < 8; ++i) x[i] = x[i] * r * c.nsa_k_norm_w[br * 64 + j * 8 + i]; }
    float o[8];
#pragma unroll
    for (int i = 0; i < 8; ++i) { const float pa = wv_shfl_xor_f(x[i], 4); o[i] = (kv == 0 && br >= 1) ? (lowhalf ? x[i] * cs[i] - pa * sn[i] : pa * sn[i] + x[i] * cs[i]) : x[i]; }
    if (act) {
      float* dst = sc < 8 ? kvrow_out(c, m) + sc * 64 + j * 8 : c.WR + (size_t)m * 256 + (sc - 8) * 64 + j * 8;
      *(f32x4v*)dst = f32x4v{o[0], o[1], o[2], o[3]}; *(f32x4v*)(dst + 4) = f32x4v{o[4], o[5], o[6], o[7]};
      if (kv == 0 && br >= 1 && m < MP) { bf16_t* kb = (br == 1 ? c.KSb : c.KWb) + (((size_t)(m / SEQ) * 2 + kvh) * SEQ + m % SEQ) * 64 + j * 8;
        *(bf16x8*)kb = wv_pack8(o[0], o[1], o[2], o[3], o[4], o[5], o[6], o[7]); }
    }
  }
  if (lane < 24) c.GATE[(size_t)m * 24 + lane] = sigmoidf_(p[OFF_GATE + lane]);
  if (lane < 4) { c.GB[(size_t)m * 4 + lane] = sigmoidf_(p[OFF_B + lane]); c.GG[(size_t)m * 4 + lane] = -expf(c.gdn_a_log[lane]) * softplusf_(p[OFF_A + lane] + c.gdn_dt_bias[lane]); }
}
WV_DEV void gdn_conv_unit(const Ctx& c, int m) {
  const int lane = wv_lane(); const int t = row_t(m);
#pragma unroll
  for (int seg = 0; seg < 3; ++seg) { const int ch = seg * 512 + lane * 8; float y[8] = {0.f, 0.f, 0.f, 0.f, 0.f, 0.f, 0.f, 0.f};
#pragma unroll
    for (int k = 0; k < 4; ++k) { const int back = 3 - k; const float* src;
      if (t - back >= 0) src = c.P + (size_t)(m - back) * LDP + OFF_QKV + ch;
      else if (m >= MP) src = c.cache_gdn_conv + ((size_t)((m - MP) / DEC_SEQ) * 3 + (3 + t - back)) * 1536 + ch;
      else src = nullptr;
      if (src) { const f32x4v a = *(const f32x4v*)src, b = *(const f32x4v*)(src + 4), wa = *(const f32x4v*)(c.gdn_conv_w + k * 1536 + ch), wb = *(const f32x4v*)(c.gdn_conv_w + k * 1536 + ch + 4);
        y[0] += wa.x * a.x; y[1] += wa.y * a.y; y[2] += wa.z * a.z; y[3] += wa.w * a.w; y[4] += wb.x * b.x; y[5] += wb.y * b.y; y[6] += wb.z * b.z; y[7] += wb.w * b.w; } }
    float ss = 0.f;
#pragma unroll
    for (int i = 0; i < 8; ++i) { y[i] = siluf_(y[i]); ss += y[i] * y[i]; }
    ss += wv_shfl_xor_f(ss, 1); ss += wv_shfl_xor_f(ss, 2); ss += wv_shfl_xor_f(ss, 4); ss += wv_shfl_xor_f(ss, 8);
    const float r = seg == 2 ? 1.f : (1.f / sqrtf(ss + EPS)) * (seg == 0 ? 0.08838834764831845f : 1.f);
    float* dst = (seg == 0 ? c.GQ : seg == 1 ? c.GK : c.GV) + (size_t)m * 512 + lane * 8;
    *(f32x4v*)dst = f32x4v{y[0] * r, y[1] * r, y[2] * r, y[3] * r}; *(f32x4v*)(dst + 4) = f32x4v{y[4] * r, y[5] * r, y[6] * r, y[7] * r};
  }
}
constexpr int VT_UNITS = 2 * BATCH * 2 * (SEQ / 16);
WV_DEV void vt_unit(const Ctx& c, int unit) {
  const int lane = wv_lane(); const int g16 = unit % (SEQ / 16); int r = unit / (SEQ / 16); const int kvh = r & 1; r >>= 1; const int b = r % BATCH, img = r / BATCH;
  const int col = OFF_KV + (((img + 1) * 2 + 1) * 2 + kvh) * 64 + lane; const float* src = c.P + ((size_t)b * SEQ + g16 * 16) * LDP + col; float v[16];
#pragma unroll
  for (int i = 0; i < 16; ++i) v[i] = src[(size_t)i * LDP];
  bf16_t* dst = (img == 0 ? c.VSTb : c.VWTb) + (((size_t)b * 2 + kvh) * 64 + lane) * SEQ + g16 * 16;
  *(bf16x8*)dst = wv_pack8(v[0], v[1], v[2], v[3], v[8], v[9], v[10], v[11]); *(bf16x8*)(dst + 8) = wv_pack8(v[4], v[5], v[6], v[7], v[12], v[13], v[14], v[15]);
}
constexpr int NCHK_P = SEQ / 16, NCHK_S = PAST_LEN / 16;
constexpr int CMP_UNITS_P = 2 * BATCH * 2 * (NCHK_P / 32), CMP_UNITS_S = 2 * DEC_BATCH * 2 * (NCHK_S / 32);
HD size_t pp_off(bool sample, int kv, int bk  , int n) {
  return sample ? ((size_t)2 * BATCH * 2 * NCHK_P + ((size_t)(kv * DEC_BATCH * 2 + bk)) * NCHK_S + n) * 128 : (((size_t)(kv * BATCH * 2 + bk)) * NCHK_P + n) * 128; }
struct StCmpWT { const Ctx& c; static constexpr long N = 2 * 2 * 64 * 1024;
  HD void operator()(long i) const { const int k = (int)(i % 1024), e = (int)((i / 1024) % 64), half = (int)((i / 65536) % 2), kv = (int)(i / 131072);
    c.WcT[i] = f2bf(c.cmp_w[(((size_t)kv * 32 + half * 16 + k / 64) * 64 + k % 64) * 64 + e]); } };
struct StCmpBias { const Ctx& c; static constexpr long N = 128;
  HD void operator()(long i) const { const int e = (int)(i % 64), kv = (int)(i / 64); float s = 0.f;
    for (int jd = 0; jd < 2048; ++jd) s += c.cmp_pe[(size_t)kv * 2048 + jd] * c.cmp_w[((size_t)kv * 2048 + jd) * 64 + e];
    c.CBIAS[i] = s; } };
template <bool SAMPLE> WV_DEV void compress_unit(const Ctx& c, int unit) {
  constexpr int NG = (SAMPLE ? NCHK_S : NCHK_P) / 32, NB = SAMPLE ? DEC_BATCH : BATCH;
  const int lane = wv_lane(), r32 = lane & 31, hi = lane >> 5;
  const int grp = unit % NG; int r = unit / NG; const int kvh = r & 1; r >>= 1; const int b = r % NB, kv = r / NB;
  const int n = grp * 32 + r32;
  const float* arow;
  if (!SAMPLE) arow = c.out + O_KVP + ((size_t)b * SEQ + 16 * n) * 512 + (kv * 2 + kvh) * 64 + 8 * hi;
  else { const int pos = 16 * n, pg = c.page_table[b * NPAGES + pos / PAGE_SIZE]; arow = c.cache_nsa_kv + ((size_t)pg * PAGE_SIZE + pos % PAGE_SIZE) * 512 + (kv * 2 + kvh) * 64 + 8 * hi; }
  const bf16_t* wt = c.WcT + (size_t)kv * 2 * 64 * 1024 + (size_t)r32 * 1024 + 8 * hi;
  f32x16 acc[4];
#pragma unroll
  for (int t = 0; t < 4; ++t) acc[t] = f32x16{};
#pragma unroll 2
  for (int ks = 0; ks < 64; ++ks) {
    const bf16x8 af = wv_ld8_f32(arow + (size_t)(ks >> 2) * 512 + (ks & 3) * 16);
#pragma unroll
    for (int t = 0; t < 4; ++t) acc[t] = wv_mfma32(af, wv_ld8(wt + (size_t)t * 32 * 1024 + 16 * ks), acc[t]);
  }
  float* pp = c.PP + pp_off(SAMPLE, kv, b * 2 + kvh, grp * 32);
#pragma unroll
  for (int t = 0; t < 4; ++t)
#pragma unroll
    for (int rr = 0; rr < 16; ++rr) pp[(size_t)crow16(rr, hi) * 128 + t * 32 + r32] = acc[t][rr];
}
struct StPackCmp2 { const Ctx& c; static constexpr long N = NPC_P + NPC_S;
  HD void operator()(long i) const {
    const bool sample = i >= NPC_P; long r = sample ? i - NPC_P : i; const int cpad = sample ? 512 : 128, nc = sample ? NCS : NCP;
    const int d = (int)(r % 64); r /= 64; const int cb = (int)(r % cpad); r /= cpad; const int kvh = (int)(r % 2), b = (int)(r / 2);
    float k = 0.f, v = 0.f;
    if (cb < nc) { k = c.PP[pp_off(sample, 0, b * 2 + kvh, cb) + d] + c.PP[pp_off(sample, 0, b * 2 + kvh, cb + 1) + 64 + d] + c.CBIAS[d];
                   v = c.PP[pp_off(sample, 1, b * 2 + kvh, cb) + d] + c.PP[pp_off(sample, 1, b * 2 + kvh, cb + 1) + 64 + d] + c.CBIAS[64 + d]; }
    const size_t o = kc_off(sample, b, kvh);
    c.KCb[o + (size_t)cb * 64 + d] = f2bf(k); c.VCTb[o + (size_t)d * cpad + vperm16(cb)] = f2bf(v);
  } };
WV_DEV void memkv_unit(const Ctx& c, int mm) {
  const int lane = wv_lane(), h = lane >> 4, dd = (lane & 15) * 16; const float* k = c.MKV + (size_t)mm * 2048 + lane * 16; const float* v = k + 1024;
  f32x4v kv[4], vv[4]; float ss = 0.f;
#pragma unroll
  for (int j = 0; j < 4; ++j) { kv[j] = *(const f32x4v*)(k + 4 * j); vv[j] = *(const f32x4v*)(v + 4 * j); ss += (kv[j].x * kv[j].x + kv[j].y * kv[j].y) + (kv[j].z * kv[j].z + kv[j].w * kv[j].w); }
  ss += wv_shfl_xor_f(ss, 1); ss += wv_shfl_xor_f(ss, 2); ss += wv_shfl_xor_f(ss, 4); ss += wv_shfl_xor_f(ss, 8);
  const float r = 1.f / sqrtf(ss / 256.f + EPS); float* o = c.out + O_MKVP + (size_t)mm * 2048 + lane * 16;
#pragma unroll
  for (int j = 0; j < 4; ++j) { kv[j] = kv[j] * *(const f32x4v*)(c.xk_norm_w + dd + 4 * j) * r; *(f32x4v*)(o + 4 * j) = kv[j]; *(f32x4v*)(o + 1024 + 4 * j) = vv[j]; }
  const int bb = mm / MEM_TOKENS, jj = mm % MEM_TOKENS; bf16_t* kb = c.KXb + (((size_t)bb * 4 + h) * MEM_TOKENS + jj) * 256 + dd;
  *(bf16x8*)kb = wv_pack8(kv[0].x, kv[0].y, kv[0].z, kv[0].w, kv[1].x, kv[1].y, kv[1].z, kv[1].w); *(bf16x8*)(kb + 8) = wv_pack8(kv[2].x, kv[2].y, kv[2].z, kv[2].w, kv[3].x, kv[3].y, kv[3].z, kv[3].w);
}
WV_DEV void xk_pack_unit(const Ctx& c, int row  ) {
  const int lane = wv_lane(), h = lane >> 4, dd = (lane & 15) * 16; const float* k = c.cache_mem_kv + (size_t)row * 2048 + lane * 16;
  const f32x4v a = *(const f32x4v*)k, b = *(const f32x4v*)(k + 4), e = *(const f32x4v*)(k + 8), f = *(const f32x4v*)(k + 12);
  const int bb = BATCH + row / MEM_TOKENS, jj = row % MEM_TOKENS; bf16_t* kb = c.KXb + (((size_t)bb * 4 + h) * MEM_TOKENS + jj) * 256 + dd;
  *(bf16x8*)kb = wv_pack8(a.x, a.y, a.z, a.w, b.x, b.y, b.z, b.w); *(bf16x8*)(kb + 8) = wv_pack8(e.x, e.y, e.z, e.w, f.x, f.y, f.z, f.w);
}
constexpr int XVT_UNITS = (BATCH + DEC_BATCH) * 4 * (MEM_TOKENS / 16) * 4;
WV_DEV void xvt_unit(const Ctx& c, int unit) {
  const int lane = wv_lane(); const int dblk = unit & 3; int r = unit >> 2; const int g16 = r % (MEM_TOKENS / 16); r /= (MEM_TOKENS / 16); const int h = r & 3, bb = r >> 2;
  const int d = dblk * 64 + lane;
  const float* src = (bb < BATCH ? c.MKV + ((size_t)bb * MEM_TOKENS + g16 * 16) * 2048 : c.cache_mem_kv + ((size_t)(bb - BATCH) * MEM_TOKENS + g16 * 16) * 2048) + 1024 + h * 256 + d; float v[16];
#pragma unroll
  for (int i = 0; i < 16; ++i) v[i] = src[(size_t)i * 2048];
  bf16_t* dst = c.VXTb + (((size_t)bb * 4 + h) * 256 + d) * MEM_TOKENS + g16 * 16;
  *(bf16x8*)dst = wv_pack8(v[0], v[1], v[2], v[3], v[8], v[9], v[10], v[11]); *(bf16x8*)(dst + 8) = wv_pack8(v[4], v[5], v[6], v[7], v[12], v[13], v[14], v[15]);
}
HD const float* wall_row(const Ctx& c, int b, int w) {
  if (w < WBUF) return c.cache_nsa_win + ((size_t)b * WBUF + w) * 256;
  if (w < WBUF + DEC_SEQ) return c.WR + ((size_t)MP + b * DEC_SEQ + (w - WBUF)) * 256;
  return nullptr;
}
constexpr int WKS_UNITS = DEC_BATCH * 2 * (WKS / 8), WVS_UNITS = DEC_BATCH * 2 * (WKS / 16);
WV_DEV void winks_unit(const Ctx& c, int unit) {
  const int lane = wv_lane(); const int g8 = unit % (WKS / 8); int r = unit / (WKS / 8); const int kvh = r & 1, b = r >> 1; const int w = g8 * 8 + (lane >> 3), j = lane & 7;
  const float* src = wall_row(c, b, w); f32x4v a = {0.f, 0.f, 0.f, 0.f}, e = {0.f, 0.f, 0.f, 0.f};
  if (src) { a = *(const f32x4v*)(src + (0 * 2 + kvh) * 64 + j * 8); e = *(const f32x4v*)(src + (0 * 2 + kvh) * 64 + j * 8 + 4); }
  *(bf16x8*)(c.KWsb + (((size_t)b * 2 + kvh) * WKS + w) * 64 + j * 8) = wv_pack8(a.x, a.y, a.z, a.w, e.x, e.y, e.z, e.w);
}
WV_DEV void winvs_unit(const Ctx& c, int unit) {
  const int lane = wv_lane(); const int g16 = unit % (WKS / 16); int r = unit / (WKS / 16); const int kvh = r & 1, b = r >> 1; float v[16];
#pragma unroll
  for (int i = 0; i < 16; ++i) { const float* src = wall_row(c, b, g16 * 16 + i); v[i] = src ? src[(1 * 2 + kvh) * 64 + lane] : 0.f; }
  bf16_t* dst = c.VWTsb + (((size_t)b * 2 + kvh) * 64 + lane) * WKS + g16 * 16;
  *(bf16x8*)dst = wv_pack8(v[0], v[1], v[2], v[3], v[8], v[9], v[10], v[11]); *(bf16x8*)(dst + 8) = wv_pack8(v[4], v[5], v[6], v[7], v[12], v[13], v[14], v[15]);
}
struct StWinOut4 { const Ctx& c; static constexpr long N = (long)(BATCH + DEC_BATCH) * WINDOW * 64;
  HD void operator()(long i) const {
    const int e = (int)(i % 64) * 4; const long r = i / 64; const int j = (int)(r % WINDOW), bb = (int)(r / WINDOW);
    if (bb < BATCH) *(f32x4v*)(c.out + O_WINP + ((size_t)bb * WINDOW + j) * 256 + e) = *(const f32x4v*)(c.WR + ((size_t)bb * SEQ + SEQ - WINDOW + j) * 256 + e);
    else { const int b = bb - BATCH; *(f32x4v*)(c.out + O_WINS + ((size_t)b * WINDOW + j) * 256 + e) = *(const f32x4v*)(wall_row(c, b, j + DEC_SEQ) + e); }
  } };
constexpr int FFN_CB = D_FF / 256, FFN_UNITS = (BATCH * (SEQ / 8) + DEC_BATCH) * FFN_CB;
WV_DEV void ffn_act_unit(const Ctx& c, int unit) {
  const int lane = wv_lane(); const int cb = unit % FFN_CB, sg = unit / FFN_CB; const int col = cb * 256 + lane * 4;
  const bool sample = sg >= BATCH * (SEQ / 8); const int m0 = sample ? MP + (sg - BATCH * (SEQ / 8)) * DEC_SEQ : sg * 8; const int t0 = sample ? 0 : (sg % (SEQ / 8)) * 8;
  f32x4v wa[3], wu[3];
#pragma unroll
  for (int k = 0; k < 3; ++k) { wa[k] = *(const f32x4v*)(c.ffn_conv_w + (size_t)k * 2 * D_FF + col); wu[k] = *(const f32x4v*)(c.ffn_conv_w + (size_t)k * 2 * D_FF + D_FF + col); }
  const f32x4v ba = *(const f32x4v*)(c.ffn_conv_b + col), bu = *(const f32x4v*)(c.ffn_conv_b + D_FF + col);
  f32x4v a2 = {0.f, 0.f, 0.f, 0.f}, a1 = a2, u2 = a2, u1 = a2;
  if (t0 >= 2) { const float* p2 = c.UP + (size_t)(m0 - 2) * (2 * D_FF) + col; a2 = *(const f32x4v*)p2; u2 = *(const f32x4v*)(p2 + D_FF); a1 = *(const f32x4v*)(p2 + 2 * D_FF); u1 = *(const f32x4v*)(p2 + 3 * D_FF); }
  else if (sample) { const float* p2 = c.cache_ffn_conv + (size_t)(sg - BATCH * (SEQ / 8)) * 2 * (2 * D_FF) + col; a2 = *(const f32x4v*)p2; u2 = *(const f32x4v*)(p2 + D_FF); a1 = *(const f32x4v*)(p2 + 2 * D_FF); u1 = *(const f32x4v*)(p2 + 3 * D_FF); }
#pragma unroll
  for (int t = 0; t < 8; ++t) { const float* p = c.UP + (size_t)(m0 + t) * (2 * D_FF) + col; const f32x4v a0 = *(const f32x4v*)p, u0 = *(const f32x4v*)(p + D_FF);
    const f32x4v ya = ba + wa[0] * a2 + wa[1] * a1 + wa[2] * a0, yu = bu + wu[0] * u2 + wu[1] * u1 + wu[2] * u0;
    st_pk4(c.ACT + (size_t)(m0 + t) * D_FF + col, f32x4v{siluf_(ya.x) * yu.x, siluf_(ya.y) * yu.y, siluf_(ya.z) * yu.z, siluf_(ya.w) * yu.w});
    a2 = a1; a1 = a0; u2 = u1; u1 = u0; }
}
namespace pg8 {
#define PG8_LAS __attribute__((address_space(3)))
typedef unsigned short bf16_t;
typedef short bf16x8 __attribute__((ext_vector_type(8)));
typedef float f32x4 __attribute__((ext_vector_type(4)));
typedef unsigned u32x4 __attribute__((ext_vector_type(4)));
constexpr int BM = 256, BK = 64, HALF = 128, HTB = HALF * BK * 2  , STAGE_BYTES = 8 * HTB, NXCD = 8, WGM = 8;

__host__ __device__ __forceinline__ int lds_byte(int r, int c) { const int st = (r >> 4) * 2 + (c >> 5), rr = r & 15, cc = c & 31, ob = rr * 64 + cc * 2; return st * 1024 + (ob ^ (((ob >> 9) & 1) << 5)); }
__host__ __device__ __forceinline__ void stage_rc(int b, int& R, int& C) { const int st = b / 1024, sb = b % 1024, swz = sb ^ (((sb >> 9) & 1) << 5); R = (st >> 1) * 16 + swz / 64; C = (st & 1) * 32 + (swz % 64) / 2; }
__host__ __device__ __forceinline__ int perm32(int rho) { const int n = rho >> 4, i = rho & 15; return 8 * (i >> 2) + 4 * n + (i & 3); }

struct Unit { int pm, pn; };
struct Gemm { const bf16_t* A; const bf16_t* Bt; int M, N, K; };

struct StaticOrder {
    int nM, nN, nwg, G, c;
    __host__ __device__ void init(int M, int N, int G_, int c_) { nM = M / BM; nN = N / BM; nwg = nM * nN; G = G_; c = c_; }
    __host__ __device__ bool next(int i, Unit& u) const {
        const long L = (long)i * G + c; if (L >= nwg) return false;
        int wgid = (int)L; { const int q = nwg / NXCD, r = nwg % NXCD, xcd = wgid % NXCD, off = wgid / NXCD; wgid = (xcd < r ? xcd * (q + 1) : r * (q + 1) + (xcd - r) * q) + off; }
        const int nig = WGM * nN, gid = wgid / nig, fm = gid * WGM, gsz = (nM - fm) < WGM ? (nM - fm) : WGM;
        u.pm = fm + ((wgid % nig) % gsz); u.pn = (wgid % nig) / gsz; return true;
    }
    __device__ __forceinline__ void a_ready(const Unit&) const {}
    __device__ __forceinline__ void done(const Unit&) const {}
};

struct EpiF32 { static constexpr bool PERM = false, AFTER_DRAIN = false;
  float* C; int ldc; const float* resP; const float* resS; int mp;
  __device__ __forceinline__ void operator()(const f32x4 (&acc)[2][2][4][2], const Unit& u, int wr, int wc, int fr, int fq) const {
#pragma unroll
    for (int ai = 0; ai < 2; ++ai)
#pragma unroll
      for (int m = 0; m < 4; ++m) {
        const int row = u.pm * BM + ai * HALF + wr * 64 + m * 16 + fr;
        float* crow = C + (size_t)row * ldc;
        const float* rrow = resP ? (row < mp ? resP + (size_t)row * 1024 : resS + (size_t)(row - mp) * 1024) : nullptr;
#pragma unroll
        for (int bj = 0; bj < 2; ++bj)
#pragma unroll
          for (int n = 0; n < 2; ++n) {
            const int col = u.pn * BM + bj * HALF + wc * 32 + n * 16 + 4 * fq;
            f32x4 v = acc[ai][bj][m][n]; if (rrow) v += *(const f32x4*)(rrow + col);
            *(f32x4*)(crow + col) = v;
          }
      }
  } };
template <class Epi, class Sched, bool ALIGN_EPI = false, bool SP2 = false>
__device__ __forceinline__ void gemm_phase(PG8_LAS unsigned char* lds, const Gemm g, const Sched& S, const Epi& E) {
    const int tid = threadIdx.x, wid = __builtin_amdgcn_readfirstlane(tid >> 6), lane = tid & 63, wr = wid >> 2, wc = wid & 3, fr = lane & 15, fq = lane >> 4;
    const int K = g.K, nt = K / BK;
    unsigned voffA[2], voffB[2];
#pragma unroll
    for (int i = 0; i < 2; ++i) { int R, C; stage_rc(tid * 16 + i * 8192, R, C); const int Rb = Epi::PERM ? ((R & ~31) + perm32(R & 31)) : R;
        voffA[i] = (unsigned)(R * K + C) * 2u; voffB[i] = (unsigned)(Rb * K + C) * 2u; }
    const size_t kstep = (size_t)(BK * 2);
    const size_t hstep = (size_t)HALF * K * 2;
    const size_t tstep = 2 * hstep;
    const unsigned ldsw = (unsigned)wid * 1024u;
    const int aoff = lds_byte(wr * 64 + fr, fq * 8), boff = lds_byte(wc * 32 + fr, fq * 8);
#define PG8_SA(b, h) (((b) * 2 + (h)) * HTB)
#define PG8_SB(b, h) ((4 + (b) * 2 + (h)) * HTB)
#define PG8_STAGE(bufoff, gbase, voff) do { _Pragma("unroll") for (int _i = 0; _i < 2; ++_i) \
        __builtin_amdgcn_global_load_lds((const unsigned*)((const char*)(gbase) + (voff)[_i]), (PG8_LAS unsigned*)(lds + (bufoff) + ldsw + _i * 8192), 16, 0, 0); } while (0)
#define PG8_LDA(dst, b, h) do { _Pragma("unroll") for (int m = 0; m < 4; ++m) _Pragma("unroll") for (int k = 0; k < 2; ++k) dst[m][k] = *(const PG8_LAS bf16x8*)(lds + PG8_SA(b, h) + aoff + m * 2048 + k * 1024); } while (0)
#define PG8_LDB(dst, b, h) do { _Pragma("unroll") for (int n = 0; n < 2; ++n) _Pragma("unroll") for (int k = 0; k < 2; ++k) dst[n][k] = *(const PG8_LAS bf16x8*)(lds + PG8_SB(b, h) + boff + n * 2048 + k * 1024); } while (0)
#define PG8_MMA(ai, bj, At, Bt) do { __builtin_amdgcn_s_setprio(1); _Pragma("unroll") for (int m = 0; m < 4; ++m) _Pragma("unroll") for (int n = 0; n < 2; ++n) _Pragma("unroll") for (int k = 0; k < 2; ++k) \
        acc[ai][bj][m][n] = __builtin_amdgcn_mfma_f32_16x16x32_bf16(Bt[n][k], At[m][k], acc[ai][bj][m][n], 0, 0, 0); __builtin_amdgcn_s_setprio(0); } while (0)
#define PG8_WAIT_V(n) asm volatile("s_waitcnt vmcnt(" #n ")" ::: "memory")
#define PG8_WAIT_L(n) asm volatile("s_waitcnt lgkmcnt(" #n ")" ::: "memory")
#define PG8_BAR __builtin_amdgcn_s_barrier()
#define PG8_SCHED __builtin_amdgcn_sched_barrier(0)
    Unit cur, nxt; int ui = 0;
    if (!S.next(0, cur)) return;
    f32x4 acc[2][2][4][2];
#pragma unroll
    for (int a = 0; a < 2; ++a)
#pragma unroll
        for (int b = 0; b < 2; ++b)
#pragma unroll
            for (int m = 0; m < 4; ++m)
#pragma unroll
                for (int n = 0; n < 2; ++n) acc[a][b][m][n] = (f32x4){0.f, 0.f, 0.f, 0.f};
    bf16x8 At[4][2], B0[2][2], B1[2][2];
    const char* cA = (const char*)g.A + (size_t)cur.pm * tstep; const char* cB = (const char*)g.Bt + (size_t)cur.pn * tstep;
    S.a_ready(cur);
    if constexpr (SP2) {
        PG8_STAGE(PG8_SB(0, 0), cB, voffB); PG8_STAGE(PG8_SB(0, 1), cB + hstep, voffB); PG8_STAGE(PG8_SA(0, 0), cA, voffA); PG8_STAGE(PG8_SA(0, 1), cA + hstep, voffA);
        if (wr == 1) PG8_BAR;
        PG8_WAIT_V(2); PG8_BAR;
        PG8_STAGE(PG8_SB(1, 0), cB + kstep, voffB); PG8_STAGE(PG8_SA(1, 0), cA + kstep, voffA); PG8_STAGE(PG8_SB(1, 1), cB + hstep + kstep, voffB);
        PG8_WAIT_V(6); PG8_BAR;
    } else {
        PG8_STAGE(PG8_SB(0, 0), cB, voffB); PG8_STAGE(PG8_SA(0, 0), cA, voffA); PG8_STAGE(PG8_SB(0, 1), cB + hstep, voffB); PG8_STAGE(PG8_SA(0, 1), cA + hstep, voffA);
        if (wr == 1) PG8_BAR;
        PG8_WAIT_V(4); PG8_BAR;
        PG8_STAGE(PG8_SB(1, 0), cB + kstep, voffB); PG8_STAGE(PG8_SA(1, 0), cA + kstep, voffA); PG8_STAGE(PG8_SB(1, 1), cB + hstep + kstep, voffB);
        PG8_WAIT_V(6); PG8_BAR;
    }
    for (;;) {
        const bool has_next = S.next(ui + 1, nxt);
        const char* nA = has_next ? (const char*)g.A + (size_t)nxt.pm * tstep : cA; const char* nB = has_next ? (const char*)g.Bt + (size_t)nxt.pn * tstep : cB;
        for (int t = 0; t < nt; t += 2) {
            const bool last = (t == nt - 2);
            const char* a1 = cA + (size_t)(t + 1) * kstep;
            const char* a2 = last ? nA : cA + (size_t)(t + 2) * kstep; const char* b2 = last ? nB : cB + (size_t)(t + 2) * kstep;
            const char* a3 = a2 + kstep; const char* b3 = b2 + kstep;
            if (last && has_next) S.a_ready(nxt);
            if constexpr (SP2) {
            PG8_LDB(B0, 0, 0); PG8_LDB(B1, 0, 1); PG8_SCHED; PG8_LDA(At, 0, 0); PG8_STAGE(PG8_SA(1, 1), a1 + hstep, voffA);
            PG8_WAIT_V(8); PG8_WAIT_L(0); PG8_BAR; PG8_MMA(0, 0, At, B0); PG8_MMA(0, 1, At, B1); PG8_BAR; PG8_SCHED;
            PG8_LDA(At, 0, 1); PG8_STAGE(PG8_SB(0, 0), b2, voffB); PG8_STAGE(PG8_SB(0, 1), b2 + hstep, voffB); PG8_STAGE(PG8_SA(0, 0), a2, voffA);
            PG8_WAIT_V(8); PG8_WAIT_L(0); PG8_BAR; PG8_MMA(1, 0, At, B0); PG8_MMA(1, 1, At, B1); PG8_BAR; PG8_SCHED;
            PG8_LDB(B0, 1, 0); PG8_LDB(B1, 1, 1); PG8_SCHED; PG8_LDA(At, 1, 0); PG8_STAGE(PG8_SA(0, 1), a2 + hstep, voffA);
            PG8_WAIT_V(8); PG8_WAIT_L(0); PG8_BAR; PG8_MMA(0, 0, At, B0); PG8_MMA(0, 1, At, B1); PG8_BAR; PG8_SCHED;
            PG8_LDA(At, 1, 1); PG8_STAGE(PG8_SB(1, 0), b3, voffB); PG8_STAGE(PG8_SB(1, 1), b3 + hstep, voffB); PG8_STAGE(PG8_SA(1, 0), a3, voffA);
            PG8_WAIT_V(8); PG8_WAIT_L(0); PG8_BAR; PG8_MMA(1, 0, At, B0); PG8_MMA(1, 1, At, B1); PG8_BAR; PG8_SCHED;
            } else {
            PG8_LDB(B0, 0, 0); PG8_SCHED; PG8_LDA(At, 0, 0); PG8_STAGE(PG8_SA(1, 1), a1 + hstep, voffA);
            PG8_WAIT_L(8); PG8_BAR; PG8_WAIT_L(0); PG8_MMA(0, 0, At, B0); PG8_BAR; PG8_SCHED;
            PG8_LDB(B1, 0, 1); PG8_STAGE(PG8_SB(0, 0), b2, voffB);
            PG8_BAR; PG8_WAIT_L(0); PG8_MMA(0, 1, At, B1); PG8_BAR;
            PG8_LDA(At, 0, 1); PG8_STAGE(PG8_SA(0, 0), a2, voffA);
            PG8_BAR; PG8_WAIT_L(0); PG8_MMA(1, 0, At, B0); PG8_BAR; PG8_SCHED;
            PG8_STAGE(PG8_SB(0, 1), b2 + hstep, voffB);
            PG8_WAIT_V(6); PG8_BAR; PG8_MMA(1, 1, At, B1); PG8_BAR;
            PG8_LDB(B0, 1, 0); PG8_SCHED; PG8_LDA(At, 1, 0); PG8_STAGE(PG8_SA(0, 1), a2 + hstep, voffA);
            PG8_WAIT_L(8); PG8_BAR; PG8_WAIT_L(0); PG8_MMA(0, 0, At, B0); PG8_BAR; PG8_SCHED;
            PG8_LDB(B1, 1, 1); PG8_STAGE(PG8_SB(1, 0), b3, voffB);
            PG8_BAR; PG8_WAIT_L(0); PG8_MMA(0, 1, At, B1); PG8_BAR;
            PG8_LDA(At, 1, 1); PG8_STAGE(PG8_SA(1, 0), a3, voffA);
            PG8_BAR; PG8_WAIT_L(0); PG8_MMA(1, 0, At, B0); PG8_BAR; PG8_SCHED;
            PG8_STAGE(PG8_SB(1, 1), b3 + hstep, voffB);
            PG8_WAIT_V(6); PG8_BAR; PG8_MMA(1, 1, At, B1); PG8_BAR;
            }
        }
        if constexpr (ALIGN_EPI) { if (wr == 0) PG8_BAR; }
        if constexpr (!Epi::AFTER_DRAIN) { E(acc, cur, wr, wc, fr, fq); S.done(cur); }
        if (!has_next) break;
#pragma unroll
        for (int a = 0; a < 2; ++a)
#pragma unroll
            for (int b = 0; b < 2; ++b)
#pragma unroll
                for (int m = 0; m < 4; ++m)
#pragma unroll
                    for (int n = 0; n < 2; ++n) acc[a][b][m][n] = (f32x4){0.f, 0.f, 0.f, 0.f};
        cur = nxt; cA = nA; cB = nB; ++ui;
        if constexpr (ALIGN_EPI) { if (wr == 1) PG8_BAR; }
    }
    PG8_WAIT_V(0);
    if constexpr (!ALIGN_EPI) { if (wr == 0) PG8_BAR; }
    PG8_BAR;
    if constexpr (Epi::AFTER_DRAIN) { E.fused(acc, cur, wr, wc, fr, fq, lds, wid, lane); S.done(cur); }
#undef PG8_SA
#undef PG8_SB
#undef PG8_STAGE
#undef PG8_LDA
#undef PG8_LDB
#undef PG8_MMA
#undef PG8_WAIT_V
#undef PG8_WAIT_L
#undef PG8_BAR
#undef PG8_SCHED
}
}
#define GAS __attribute__((address_space(1)))
#define LAS __attribute__((address_space(3)))
typedef unsigned v4u __attribute__((ext_vector_type(4)));
#define LDS_WAIT() asm volatile("s_waitcnt lgkmcnt(0)" ::: "memory")
__device__ __forceinline__ unsigned pk2(float lo, float hi) { return f2bf_u(lo) | (f2bf_u(hi) << 16); }
constexpr int LDS_BYTES = 147456;
constexpr int NWAVES = 8;
__device__ __forceinline__ void p0_transpose_item(const float* W, int K, int N, bf16_t* WT, int row_off, LAS float* scr, int item, int lane) {
    const int nblk = N / 32, kb = item / nblk, nb = item % nblk, k0 = 64 * kb, n0 = 32 * nb;
#pragma unroll 8
    for (int i = 0; i < 32; ++i) { const int kk = 2 * i + (lane >> 5); scr[kk * 33 + (lane & 31)] = W[(size_t)(k0 + kk) * N + n0 + (lane & 31)]; }
    LDS_WAIT(); asm volatile("" ::: "memory");
    const int c = lane & 7;
#pragma unroll
    for (int j = 0; j < 4; ++j) { const int n = (lane >> 3) + 8 * j; const LAS float* s = scr + (8 * c) * 33 + n;
        v4u o; o.x = pk2(s[0 * 33], s[1 * 33]); o.y = pk2(s[2 * 33], s[3 * 33]); o.z = pk2(s[4 * 33], s[5 * 33]); o.w = pk2(s[6 * 33], s[7 * 33]);
        *(GAS v4u*)(WT + (size_t)(row_off + n0 + n) * K + k0 + 8 * c) = o; }
    LDS_WAIT(); asm volatile("" ::: "memory");
}
struct Args { Ctx c; bf16_t *WinT, *WkvT, *WoutT, *WxqT, *WxoT, *WupT, *WdownT; unsigned* ctr; int ph_lo, ph_hi; };
template <class F> __device__ __forceinline__ void run_stage(const F& f) {
  const long stride = (long)gridDim.x * 512;
  for (long i = (long)blockIdx.x * 512 + threadIdx.x; i < F::N; i += stride) f(i);
}
constexpr int N_PHASES = 18;
struct Args;
__device__ __forceinline__ const Args* phase_args() { unsigned long long p = (unsigned long long)__builtin_amdgcn_kernarg_segment_ptr(); asm volatile("" : "+s"(p)); return (const Args*)p; }
__global__ void __launch_bounds__(512, 2) mega(Args a0) {
  extern __shared__ __attribute__((aligned(16))) unsigned char lds_raw[];
  LAS unsigned char* lds = (LAS unsigned char*)lds_raw;
  cg::grid_group grid = cg::this_grid();
  const int ph_lo = a0.ph_lo, ph_hi = a0.ph_hi;
  const int tid = threadIdx.x, lane = tid & 63, wave = __builtin_amdgcn_readfirstlane(tid >> 6);
#define PH(k) if (ph_lo <= (k) && (k) < ph_hi) if (const Args* ap_ = phase_args()) if (const Args& a = *ap_; true) if (const Ctx& c = a.c; true)
#define WUNITS(n, expr) do { const int G8_ = (int)gridDim.x * NWAVES; for (int u = (int)blockIdx.x * NWAVES + wave; u < (n); u += G8_) { expr; } } while (0)
#define SYNC(k) do { if ((k) + 1 < ph_hi) grid.sync(); } while (0)
#define GEMM(A_, B_, M_, N_, K_, C_, LDC_, RP_, RS_) do { __syncthreads(); pg8::Gemm g{A_, B_, M_, N_, K_}; pg8::StaticOrder S; S.init(M_, N_, (int)gridDim.x, (int)blockIdx.x); \
      pg8::EpiF32 E{C_, LDC_, RP_, RS_, MP}; pg8::gemm_phase<pg8::EpiF32, pg8::StaticOrder, true, true>(lds, g, S, E); } while (0)
  PH(0) {
    LAS float* scr = (LAS float*)(lds + wave * 16384);
    const int gw = blockIdx.x * NWAVES + wave, NGW = gridDim.x * NWAVES;
    constexpr int I_IN = (D_MODEL / 64) * (IN_COLS / 32), I_SQ = (D_MODEL / 64) * (D_MODEL / 32), I_UP = (D_MODEL / 64) * (2 * D_FF / 32), I_DN = (D_FF / 64) * (D_MODEL / 32);
    constexpr int NIT = I_IN + 5 * I_SQ + I_UP + I_DN;
    for (int it = gw; it < NIT; it += NGW) { int r = it;
      if (r < I_IN) { p0_transpose_item(c.w_in, D_MODEL, IN_COLS, a.WinT, 0, scr, r, lane); continue; } r -= I_IN;
      if (r < I_SQ) { p0_transpose_item(c.w_xk, D_MODEL, D_MODEL, a.WkvT, 0, scr, r, lane); continue; } r -= I_SQ;
      if (r < I_SQ) { p0_transpose_item(c.w_xv, D_MODEL, D_MODEL, a.WkvT, D_MODEL, scr, r, lane); continue; } r -= I_SQ;
      if (r < I_SQ) { p0_transpose_item(c.w_out, D_MODEL, D_MODEL, a.WoutT, 0, scr, r, lane); continue; } r -= I_SQ;
      if (r < I_SQ) { p0_transpose_item(c.w_xq, D_MODEL, D_MODEL, a.WxqT, 0, scr, r, lane); continue; } r -= I_SQ;
      if (r < I_SQ) { p0_transpose_item(c.w_xo, D_MODEL, D_MODEL, a.WxoT, 0, scr, r, lane); continue; } r -= I_SQ;
      if (r < I_UP) { p0_transpose_item(c.w_up, D_MODEL, 2 * D_FF, a.WupT, 0, scr, r, lane); continue; } r -= I_UP;
      p0_transpose_item(c.w_down, D_FF, D_MODEL, a.WdownT, 0, scr, r, lane); }
    run_stage(StCmpWT{c}); run_stage(StCmpBias{c});
    if (blockIdx.x == 0 && tid < 8) a.ctr[64 * tid] = 0u;
    WUNITS(MTOT + MMEM, (u < MTOT ? rms_row_unit(x_row(c, u), c.attn_norm_w, c.XN + (size_t)u * D_MODEL) : rms_row_unit(c.mem_prompt + (size_t)(u - MTOT) * D_MODEL, c.mem_norm_w, c.MN + (size_t)(u - MTOT) * D_MODEL)));
    SYNC(0); }
  PH(1) { GEMM(c.XN, a.WinT, MTOT, LDP, D_MODEL, c.P, LDP, nullptr, nullptr); SYNC(1); }
  PH(2) { GEMM(c.MN, a.WkvT, MMEM, 2048, D_MODEL, c.MKV, 2048, nullptr, nullptr); SYNC(2); }
  PH(3) { WUNITS(MTOT, postproc_unit(c, u)); WUNITS(MTOT, gdn_conv_unit(c, u)); WUNITS(VT_UNITS, vt_unit(c, u));
    WUNITS(MMEM, memkv_unit(c, u)); WUNITS(DEC_BATCH * MEM_TOKENS, xk_pack_unit(c, u)); WUNITS(XVT_UNITS, xvt_unit(c, u)); run_stage(StGdnConvOut{c}); SYNC(3); }
  PH(4) {
    { const int G8 = (int)gridDim.x * NWAVES, local = (int)blockIdx.x * NWAVES + wave; float* wscr = (float*)(lds_raw + wave * 18432);
      for (int u = local; u < GDN_PREP_UNITS; u += G8) gdn_prep_unit(c, u, wscr); }
    WUNITS(CMP_UNITS_S, compress_unit<true>(c, u)); WUNITS(CMP_UNITS_P, compress_unit<false>(c, u));
    WUNITS(WKS_UNITS, winks_unit(c, u)); WUNITS(WVS_UNITS, winvs_unit(c, u)); run_stage(StWinOut4{c}); SYNC(4); }
  PH(5) { run_stage(StPackCmp2{c}); SYNC(5); }
  PH(6) {
    { const int local = (int)blockIdx.x * NWAVES + wave; if (local < GDN_SCAN_UNITS) gdn_scan_unit(c, local); }
    if (wave == 0 && blockIdx.x >= 128 && blockIdx.x < 128 + NSA_UNITS_S) nsa_unit<true>(c, (int)blockIdx.x - 128, (float*)lds_raw);
    const int xq = (int)blockIdx.x & 7; constexpr int PERQ = NSA_UNITS_P / 8;
    for (;;) { int k = 0; if (lane == 0) k = (int)atomicAdd(a.ctr + 64 * xq, 1u); k = __builtin_amdgcn_readfirstlane(k); if (k >= PERQ) break;
      const int tile = (SEQ / 8 - 1) - (k >> 1), bk = 2 * xq + (k & 1); nsa_unit<false>(c, bk * (SEQ / 8) + tile, nullptr); }
    SYNC(6); }
  PH(7) { WUNITS(MTOT, gdn_norm_unit(c, u)); SYNC(7); }
  PH(8) { GEMM(c.CAT, a.WoutT, MTOT, D_MODEL, D_MODEL, c.H1, D_MODEL, c.x_prompt, c.x_sample); SYNC(8); }
  PH(9) { WUNITS(MTOT, rms_row_unit(c.H1 + (size_t)u * D_MODEL, c.xattn_norm_w, c.XN + (size_t)u * D_MODEL)); SYNC(9); }
  PH(10) { GEMM(c.XN, a.WxqT, MTOT, D_MODEL, D_MODEL, c.Q2, D_MODEL, nullptr, nullptr); SYNC(10); }
  PH(11) { WUNITS(MTOT, xq_norm_unit(c, u)); SYNC(11); }
  PH(12) {
    const int G8 = (int)gridDim.x * NWAVES, local = (int)blockIdx.x * NWAVES + wave;
    for (int u = local; u < XA_UNITS_P; u += G8) xattn_unit<false>(c, u);
    for (int u = local; u < XA_UNITS_S; u += G8) xattn_unit<true>(c, u);
    SYNC(12); }
  PH(13) { GEMM(c.OX, a.WxoT, MTOT, D_MODEL, D_MODEL, c.H2, D_MODEL, c.H1, c.H1 + (size_t)MP * D_MODEL); SYNC(13); }
  PH(14) { WUNITS(MTOT, rms_row_unit(c.H2 + (size_t)u * D_MODEL, c.ffn_norm_w, c.XN + (size_t)u * D_MODEL)); SYNC(14); }
  PH(15) { GEMM(c.XN, a.WupT, MTOT, 2 * D_FF, D_MODEL, c.UP, 2 * D_FF, nullptr, nullptr); SYNC(15); }
  PH(16) { WUNITS(FFN_UNITS, ffn_act_unit(c, u)); run_stage(StFfnConvOut{c}); SYNC(16); }
#ifdef EXTRA_LO
  PH(20) { if (wave == 0 && blockIdx.x >= 128 && blockIdx.x < 128 + NSA_UNITS_S) nsa_unit<true>(c, (int)blockIdx.x - 128, (float*)lds_raw); }
  PH(21) { const int local = (int)blockIdx.x * NWAVES + wave; if (local < GDN_SCAN_UNITS) gdn_scan_unit(c, local); }
  PH(22) { const int G8 = (int)gridDim.x * NWAVES, local = (int)blockIdx.x * NWAVES + wave; float* wscr = (float*)(lds_raw + wave * 18432);
      for (int u = local; u < GDN_PREP_UNITS; u += G8) gdn_prep_unit(c, u, wscr); }
  PH(23) { WUNITS(CMP_UNITS_S, compress_unit<true>(c, u)); WUNITS(CMP_UNITS_P, compress_unit<false>(c, u)); }
  PH(24) { WUNITS(WKS_UNITS, winks_unit(c, u)); WUNITS(WVS_UNITS, winvs_unit(c, u)); run_stage(StWinOut4{c}); }
  PH(25) { WUNITS(MTOT, postproc_unit(c, u)); }
  PH(26) { WUNITS(MTOT, gdn_conv_unit(c, u)); }
  PH(27) { WUNITS(VT_UNITS, vt_unit(c, u)); }
  PH(28) { WUNITS(MMEM, memkv_unit(c, u)); WUNITS(DEC_BATCH * MEM_TOKENS, xk_pack_unit(c, u)); WUNITS(XVT_UNITS, xvt_unit(c, u)); run_stage(StGdnConvOut{c}); }
#endif
  PH(17) { GEMM(c.ACT, a.WdownT, MTOT, D_MODEL, D_FF, c.out + O_YP, D_MODEL, c.H2, c.H2 + (size_t)MP * D_MODEL); }
}
#ifndef MK_MULTI
#define MK_MULTI 0
#endif
extern "C" void kernel_launch(void* const* d_in, const int* in_sizes, int n_in, void* d_out, int out_size, void* d_ws, size_t ws_size, hipStream_t stream) {
  static int grid = 0;
  if (grid == 0) {
    int dev = 0, cus = 0, per_cu = 0;
    if (hipGetDevice(&dev) != hipSuccess || hipDeviceGetAttribute(&cus, hipDeviceAttributeMultiprocessorCount, dev) != hipSuccess) { fprintf(stderr, "kernel_launch: device query failed\n"); grid = -1; return; }
    if (hipFuncSetAttribute((const void*)mega, hipFuncAttributeMaxDynamicSharedMemorySize, LDS_BYTES) != hipSuccess) { fprintf(stderr, "kernel_launch: hipFuncSetAttribute failed\n"); grid = -1; return; }
    if (hipOccupancyMaxActiveBlocksPerMultiprocessor(&per_cu, (const void*)mega, 512, LDS_BYTES) != hipSuccess || per_cu < 1) { fprintf(stderr, "kernel_launch: occupancy query says %d blocks/CU\n", per_cu); (void)hipGetLastError(); }
    grid = cus;
    if (n_in != 34 || (size_t)out_size != O_END) fprintf(stderr, "kernel_launch: unexpected n_in %d / out_size %d (want 34 / %zu)\n", n_in, out_size, (size_t)O_END);
  }
  if (grid < 0) return;
  Args a{}; Ctx& c = a.c; int k = 0;
  c.x_prompt = (const float*)d_in[k++]; c.x_sample = (const float*)d_in[k++]; c.mem_prompt = (const float*)d_in[k++]; c.cache_nsa_kv = (const float*)d_in[k++]; c.cache_nsa_win = (const float*)d_in[k++];
  c.state_gdn = (const float*)d_in[k++]; c.cache_gdn_conv = (const float*)d_in[k++]; c.cache_ffn_conv = (const float*)d_in[k++]; c.cache_mem_kv = (const float*)d_in[k++]; c.page_table = (const int*)d_in[k++];
  c.attn_norm_w = (const float*)d_in[k++]; c.w_in = (const float*)d_in[k++]; c.nsa_q_norm_w = (const float*)d_in[k++]; c.nsa_k_norm_w = (const float*)d_in[k++]; c.cmp_pe = (const float*)d_in[k++]; c.cmp_w = (const float*)d_in[k++];
  c.gdn_conv_w = (const float*)d_in[k++]; c.gdn_a_log = (const float*)d_in[k++]; c.gdn_dt_bias = (const float*)d_in[k++]; c.gdn_norm_w = (const float*)d_in[k++]; c.w_out = (const float*)d_in[k++];
  c.mem_norm_w = (const float*)d_in[k++]; c.w_xk = (const float*)d_in[k++]; c.w_xv = (const float*)d_in[k++]; c.xk_norm_w = (const float*)d_in[k++]; c.xattn_norm_w = (const float*)d_in[k++]; c.w_xq = (const float*)d_in[k++];
  c.xq_norm_w = (const float*)d_in[k++]; c.w_xo = (const float*)d_in[k++]; c.ffn_norm_w = (const float*)d_in[k++]; c.w_up = (const float*)d_in[k++]; c.ffn_conv_w = (const float*)d_in[k++]; c.ffn_conv_b = (const float*)d_in[k++]; c.w_down = (const float*)d_in[k++];
  c.out = (float*)d_out;
  unsigned char* ws = (unsigned char*)d_ws; WsMap w{0};
  a.ctr = (unsigned*)(ws + w.take(4096));
  a.WinT = (bf16_t*)(ws + w.take((size_t)LDP * D_MODEL * 2)); a.WkvT = (bf16_t*)(ws + w.take((size_t)2048 * D_MODEL * 2));
  a.WoutT = (bf16_t*)(ws + w.take((size_t)D_MODEL * D_MODEL * 2)); a.WxqT = (bf16_t*)(ws + w.take((size_t)D_MODEL * D_MODEL * 2)); a.WxoT = (bf16_t*)(ws + w.take((size_t)D_MODEL * D_MODEL * 2));
  a.WupT = (bf16_t*)(ws + w.take((size_t)2 * D_FF * D_MODEL * 2)); a.WdownT = (bf16_t*)(ws + w.take((size_t)D_MODEL * D_FF * 2));
  const size_t need = ws_carve(c, ws, w.off);
  if (need > ws_size) { fprintf(stderr, "kernel_launch: workspace too small: need %zu, have %zu\n", need, ws_size); return; }
#if MK_MULTI
  for (int ph = 0; ph < N_PHASES; ++ph) { a.ph_lo = ph; a.ph_hi = ph + 1; void* args[] = {&a};
    hipError_t e = hipLaunchCooperativeKernel((const void*)mega, dim3(grid), dim3(512), args, LDS_BYTES, stream);
    if (e != hipSuccess) { fprintf(stderr, "kernel_launch: cooperative launch failed: %s\n", hipGetErrorString(e)); return; } }
#else
  a.ph_lo = 0; a.ph_hi = N_PHASES; void* args[] = {&a};
  hipError_t e = hipLaunchCooperativeKernel((const void*)mega, dim3(grid), dim3(512), args, LDS_BYTES, stream);
  if (e != hipSuccess) fprintf(stderr, "kernel_launch: cooperative launch failed: %s (grid %d)\n", hipGetErrorString(e), grid);
#ifdef EXTRA_LO
  a.ph_lo = EXTRA_LO; a.ph_hi = EXTRA_HI; (void)hipLaunchCooperativeKernel((const void*)mega, dim3(grid), dim3(512), args, LDS_BYTES, stream);
#endif
#endif
}
```

```cpp
#include <hip/hip_runtime.h>
#include <hip/hip_cooperative_groups.h>
#include <cstdio>
#include <cstdint>
namespace cg = cooperative_groups;
#define HD __host__ __device__ __forceinline__
#ifdef CFG_SMALL
constexpr int BATCH = 1, SEQ = 1024, DEC_BATCH = 2, PAST_LEN = 1024, MEM_TOKENS = 64, D_FF = 256;
#else
constexpr int BATCH = 8, SEQ = 2048, DEC_BATCH = 32, PAST_LEN = 8192, MEM_TOKENS = 256, D_FF = 2816;
#endif
constexpr int D_MODEL = 1024, DEC_SEQ = 8, PAGE_SIZE = 128;
constexpr int NSA_HEADS = 8, NSA_KVH = 2, NSA_HD = 64, NSA_G = 4;
constexpr int CMP_BLOCK = 32, CMP_STRIDE = 16, SEL_BLOCK = 64, SEL_TOPN = 8, WINDOW = 512;
constexpr int GDN_HEADS = 4, GDN_HD = 128, GDN_CONV = 4;
constexpr int XA_HEADS = 4, XA_HD = 256, FFN_CONV = 3;
constexpr float EPS = 1e-6f, NEGF = -1e30f, FORCED_BONUS = 1e4f;
constexpr int NSA_Q_W = 512, NSA_KV_W = 768, NSA_GATE_W = 24, GDN_W = 512;
constexpr int IN_COLS = 3360, LDP = 3584;
constexpr int OFF_Q = 0, OFF_KV = 512, OFF_GATE = 1280, OFF_QKV = 1304, OFF_Z = 2840, OFF_B = 3352, OFF_A = 3356;
constexpr int MP = BATCH * SEQ, MS = DEC_BATCH * DEC_SEQ, MTOT = MP + MS;
constexpr int MMEM = BATCH * MEM_TOKENS;
constexpr int NPAGES = PAST_LEN / PAGE_SIZE;
constexpr int NCP = SEQ / CMP_STRIDE - 1;
constexpr int NCS = PAST_LEN / CMP_STRIDE - 1;
constexpr int NCPS = 128, NCSS = 512;
constexpr int NSELP = SEQ / SEL_BLOCK;
constexpr int NSELS = PAST_LEN / SEL_BLOCK + 1;
constexpr int NSELMAX = 160;
constexpr int WINP = (WINDOW < SEQ ? WINDOW : SEQ);
constexpr int WBUF = (WINDOW < PAST_LEN ? WINDOW : PAST_LEN);
constexpr int WINS = (WINDOW < WBUF + DEC_SEQ ? WINDOW : WBUF + DEC_SEQ);
static_assert(NCP <= NCPS && NCS <= NCSS && NSELS <= NSELMAX && NSELP <= NSELMAX, "strides");
static_assert(WBUF == WINDOW && WINP == WINDOW && WINS == WINDOW, "window assumptions");

constexpr size_t O_YP = 0;
constexpr size_t O_YS = O_YP + (size_t)MP * D_MODEL;
constexpr size_t O_KVP = O_YS + (size_t)MS * D_MODEL;
constexpr size_t O_WINP = O_KVP + (size_t)MP * 512;
constexpr size_t O_STP = O_WINP + (size_t)BATCH * WINP * 256;
constexpr size_t O_GCP = O_STP + (size_t)BATCH * 4 * 128 * 128;
constexpr size_t O_FCP = O_GCP + (size_t)BATCH * 3 * 1536;
constexpr size_t O_MKVP = O_FCP + (size_t)BATCH * 2 * 2 * D_FF;
constexpr size_t O_KVS = O_MKVP + (size_t)MMEM * 2048;
constexpr size_t O_WINS = O_KVS + (size_t)MS * 512;
constexpr size_t O_STS = O_WINS + (size_t)DEC_BATCH * WINS * 256;
constexpr size_t O_GCS = O_STS + (size_t)DEC_BATCH * 4 * 128 * 128;
constexpr size_t O_FCS = O_GCS + (size_t)DEC_BATCH * 3 * 1536;
constexpr size_t O_END = O_FCS + (size_t)DEC_BATCH * 2 * 2 * D_FF;

typedef unsigned short bf16_t;
HD unsigned f2bf_u(float f) { unsigned u = __builtin_bit_cast(unsigned, f); return (u + 0x7fffu + ((u >> 16) & 1u)) >> 16; }
HD bf16_t f2bf(float f) { return (bf16_t)f2bf_u(f); }
HD float bf2f(bf16_t b) { return __builtin_bit_cast(float, (unsigned)b << 16); }
HD float sigmoidf_(float x) { return 1.f / (1.f + expf(-x)); }
HD float siluf_(float x) { return x / (1.f + expf(-x)); }
HD float softplusf_(float x) { return x > 20.f ? x : log1pf(expf(x)); }

struct Ctx {
  const float *x_prompt, *x_sample, *mem_prompt, *cache_nsa_kv, *cache_nsa_win, *state_gdn, *cache_gdn_conv, *cache_ffn_conv, *cache_mem_kv;
  const int* page_table;
  const float *attn_norm_w, *w_in, *nsa_q_norm_w, *nsa_k_norm_w, *cmp_pe, *cmp_w, *gdn_conv_w, *gdn_a_log, *gdn_dt_bias, *gdn_norm_w, *w_out,
      *mem_norm_w, *w_xk, *w_xv, *xk_norm_w, *xattn_norm_w, *w_xq, *xq_norm_w, *w_xo, *ffn_norm_w, *w_up, *ffn_conv_w, *ffn_conv_b, *w_down;
  float* out;
  bf16_t *XN, *MN, *CAT, *OX, *ACT;
  float *P, *MKV, *QC, *QR, *WR, *GATE, *GQ, *GK, *GV, *GB, *GG, *KCMP, *VCMP, *SCP, *SCS, *SCORE, *SS, *SW, *OG, *H1, *Q2, *SX, *H2, *UP;
  int* SIDX;
  bf16_t *QCb, *QRb, *KSb, *VSTb, *KWb, *VWTb, *KWsb, *VWTsb, *KCb, *VCTb, *KXb, *VXTb, *Q2b, *GWp, *GQKp, *GQDp, *GKDTp, *WcT;
  float *GS, *GSW, *GL, *PP, *CBIAS, *GKt, *GVt;
};

HD int row_b(int m) { return m < MP ? m / SEQ : (m - MP) / DEC_SEQ; }
HD int row_t(int m) { return m < MP ? m % SEQ : (m - MP) % DEC_SEQ; }
HD int row_pos(int m) { return m < MP ? m % SEQ : PAST_LEN + (m - MP) % DEC_SEQ; }
HD const float* x_row(const Ctx& c, int m) { return m < MP ? c.x_prompt + (size_t)m * D_MODEL : c.x_sample + (size_t)(m - MP) * D_MODEL; }
HD float* kvrow_out(const Ctx& c, int m) { return m < MP ? c.out + O_KVP + (size_t)m * 512 : c.out + O_KVS + (size_t)(m - MP) * 512; }

struct StRms0 { const Ctx& c; static constexpr long N = MTOT + MMEM;
  HD void operator()(long i) const {
    const float* src; const float* w; bf16_t* dst;
    if (i < MTOT) { src = x_row(c, (int)i); w = c.attn_norm_w; dst = c.XN + (size_t)i * D_MODEL; }
    else { const long mm = i - MTOT; src = c.mem_prompt + (size_t)mm * D_MODEL; w = c.mem_norm_w; dst = c.MN + (size_t)mm * D_MODEL; }
    float ss = 0.f; for (int d = 0; d < D_MODEL; ++d) ss += src[d] * src[d];
    const float r = 1.f / sqrtf(ss / D_MODEL + EPS);
    for (int d = 0; d < D_MODEL; ++d) dst[d] = f2bf(src[d] * r * w[d]);
  } };
struct StRmsRows { const float* src; const float* w; bf16_t* dst; static constexpr long N = MTOT;
  HD void operator()(long i) const {
    const float* s = src + (size_t)i * D_MODEL; bf16_t* o = dst + (size_t)i * D_MODEL;
    float ss = 0.f; for (int d = 0; d < D_MODEL; ++d) ss += s[d] * s[d];
    const float r = 1.f / sqrtf(ss / D_MODEL + EPS);
    for (int d = 0; d < D_MODEL; ++d) o[d] = f2bf(s[d] * r * w[d]);
  } };
HD void rope_pair(float x1, float x2, int i, int pos, float& o1, float& o2) {
  const float inv = powf(10000.f, -(float)i / 32.f); const float ang = (float)pos * inv;
  const float cs = cosf(ang), sn = sinf(ang); o1 = x1 * cs - x2 * sn; o2 = x1 * sn + x2 * cs;
}
struct StQ { const Ctx& c; static constexpr long N = (long)MTOT * NSA_HEADS;
  HD void operator()(long i) const {
    const int m = (int)(i / NSA_HEADS), h = (int)(i % NSA_HEADS); const float* p = c.P + (size_t)m * LDP + OFF_Q + h * 64;
    float ss = 0.f; for (int d = 0; d < 64; ++d) ss += p[d] * p[d];
    const float r = 1.f / sqrtf(ss / 64.f + EPS); const int pos = row_pos(m);
    float* qc = c.QC + (size_t)m * 512 + h * 64; float* qr = c.QR + (size_t)m * 512 + h * 64;
    for (int d = 0; d < 32; ++d) { const float a = p[d] * r * c.nsa_q_norm_w[d], b = p[d + 32] * r * c.nsa_q_norm_w[d + 32];
      qc[d] = a; qc[d + 32] = b; float o1, o2; rope_pair(a, b, d, pos, o1, o2); qr[d] = o1; qr[d + 32] = o2; }
  } };
struct StKV { const Ctx& c; static constexpr long N = (long)MTOT * 6;
  HD void operator()(long i) const {
    const int m = (int)(i / 6), br = (int)(i % 6) / 2, kvh = (int)(i % 2); const float* pk = c.P + (size_t)m * LDP + OFF_KV + ((br * 2 + 0) * 2 + kvh) * 64;
    const float* pv = c.P + (size_t)m * LDP + OFF_KV + ((br * 2 + 1) * 2 + kvh) * 64;
    float ss = 0.f; for (int d = 0; d < 64; ++d) ss += pk[d] * pk[d];
    const float r = 1.f / sqrtf(ss / 64.f + EPS); const int pos = row_pos(m); const float* w = c.nsa_k_norm_w + br * 64;
    float *ko, *vo;
    if (br < 2) { float* ro = kvrow_out(c, m); ko = ro + ((br * 2 + 0) * 2 + kvh) * 64; vo = ro + ((br * 2 + 1) * 2 + kvh) * 64; }
    else { float* wo = c.WR + (size_t)m * 256; ko = wo + (0 * 2 + kvh) * 64; vo = wo + (1 * 2 + kvh) * 64; }
    for (int d = 0; d < 32; ++d) { const float a = pk[d] * r * w[d], b = pk[d + 32] * r * w[d + 32];
      if (br == 0) { ko[d] = a; ko[d + 32] = b; } else { float o1, o2; rope_pair(a, b, d, pos, o1, o2); ko[d] = o1; ko[d + 32] = o2; } }
    for (int d = 0; d < 64; ++d) vo[d] = pv[d];
  } };
struct StWinOut { const Ctx& c; static constexpr long N = (long)(BATCH + DEC_BATCH) * WINDOW * 256;
  HD void operator()(long i) const {
    const int e = (int)(i % 256); const long r = i / 256; const int j = (int)(r % WINDOW), bb = (int)(r / WINDOW);
    if (bb < BATCH) c.out[O_WINP + ((size_t)bb * WINDOW + j) * 256 + e] = c.WR[((size_t)bb * SEQ + SEQ - WINDOW + j) * 256 + e];
    else { const int b = bb - BATCH; const int w = j + DEC_SEQ;
      const float v = w < WBUF ? c.cache_nsa_win[((size_t)b * WBUF + w) * 256 + e] : c.WR[((size_t)MP + b * DEC_SEQ + (w - WBUF)) * 256 + e];
      c.out[O_WINS + ((size_t)b * WINDOW + j) * 256 + e] = v; }
  } };
struct StGate { const Ctx& c; static constexpr long N = (long)MTOT * 24;
  HD void operator()(long i) const { const int m = (int)(i / 24), e = (int)(i % 24); c.GATE[(size_t)m * 24 + e] = sigmoidf_(c.P[(size_t)m * LDP + OFF_GATE + e]); } };
HD float gdn_pre(const Ctx& c, int m, int dt_back, int ch) {
  const int t = row_t(m) - dt_back;
  if (t >= 0) return c.P[(size_t)(m - dt_back) * LDP + OFF_QKV + ch];
  if (m < MP) return 0.f;
  const int b = (m - MP) / DEC_SEQ; return c.cache_gdn_conv[((size_t)b * 3 + (3 + t)) * 1536 + ch];
}
struct StGdnConv { const Ctx& c; static constexpr long N = (long)MTOT * 12;
  HD void operator()(long i) const {
    const int m = (int)(i / 12), part = (int)(i % 12), which = part / 4, h = part % 4; const int ch0 = which * 512 + h * 128;
    float* dst = (which == 0 ? c.GQ : which == 1 ? c.GK : c.GV) + (size_t)m * 512 + h * 128;
    float ss = 0.f;
    for (int d = 0; d < 128; ++d) { const int ch = ch0 + d; float y = 0.f;
      for (int k = 0; k < 4; ++k) y += c.gdn_conv_w[k * 1536 + ch] * gdn_pre(c, m, 3 - k, ch);
      y = siluf_(y); dst[d] = y; ss += y * y; }
    if (which < 2) { const float r = (1.f / sqrtf(ss + EPS)) * (which == 0 ? 0.08838834764831845f : 1.f); for (int d = 0; d < 128; ++d) dst[d] *= r; }
  } };
struct StGdnMisc { const Ctx& c; static constexpr long N = (long)MTOT * 4;
  HD void operator()(long i) const {
    const int m = (int)(i / 4), h = (int)(i % 4); const float* p = c.P + (size_t)m * LDP;
    c.GB[i] = sigmoidf_(p[OFF_B + h]); c.GG[i] = -expf(c.gdn_a_log[h]) * softplusf_(p[OFF_A + h] + c.gdn_dt_bias[h]);
  } };
struct StGdnConvOut { const Ctx& c; static constexpr long N = (long)(BATCH + DEC_BATCH) * 3 * 1536;
  HD void operator()(long i) const {
    const int ch = (int)(i % 1536); const int r = (int)((i / 1536) % 3), bb = (int)(i / (3 * 1536));
    if (bb < BATCH) c.out[O_GCP + i] = c.P[((size_t)bb * SEQ + SEQ - 3 + r) * LDP + OFF_QKV + ch];
    else { const int b = bb - BATCH; c.out[O_GCS + ((size_t)b * 3 + r) * 1536 + ch] = c.P[((size_t)MP + b * DEC_SEQ + DEC_SEQ - 3 + r) * LDP + OFF_QKV + ch]; }
  } };
HD const float* nsa_row(const Ctx& c, bool sample, int b, int pos, int r, int kvh) {
  if (!sample) return c.out + O_KVP + ((size_t)b * SEQ + pos) * 512 + (r * 2 + kvh) * 64;
  if (pos < PAST_LEN) { const int pg = c.page_table[b * NPAGES + pos / PAGE_SIZE]; return c.cache_nsa_kv + ((size_t)pg * PAGE_SIZE + pos % PAGE_SIZE) * 512 + (r * 2 + kvh) * 64; }
  return c.out + O_KVS + ((size_t)b * DEC_SEQ + (pos - PAST_LEN)) * 512 + (r * 2 + kvh) * 64;
}
constexpr long NCMP_ITEMS_P = (long)BATCH * NCP * 2 * 2 * 64, NCMP_ITEMS_S = (long)DEC_BATCH * NCS * 2 * 2 * 64;
struct StCompress { const Ctx& c; static constexpr long N = NCMP_ITEMS_P + NCMP_ITEMS_S;
  HD void operator()(long i) const {
    const bool sample = i >= NCMP_ITEMS_P; long r = sample ? i - NCMP_ITEMS_P : i; const int nc = sample ? NCS : NCP;
    const int e = (int)(r % 64); r /= 64; const int kv = (int)(r % 2); r /= 2; const int kvh = (int)(r % 2); r /= 2; const int cb = (int)(r % nc), b = (int)(r / nc);
    const float* W = c.cmp_w + (size_t)kv * 32 * 64 * 64; const float* pe = c.cmp_pe + (size_t)kv * 32 * 64;
    float acc = 0.f;
    for (int j = 0; j < 32; ++j) { const float* x = nsa_row(c, sample, b, 16 * cb + j, kv, kvh);
      for (int d = 0; d < 64; ++d) acc += (x[d] + pe[j * 64 + d]) * W[((size_t)j * 64 + d) * 64 + e]; }
    float* dst = (kv == 0 ? c.KCMP : c.VCMP) + (sample ? (size_t)BATCH * NCP * 128 : 0) + (((size_t)b * nc + cb) * 2 + kvh) * 64 + e;
    *dst = acc;
  } };
HD const float* cmp_ptr(const Ctx& c, const float* base, bool sample, int b, int cb, int kvh) {
  return base + (sample ? (size_t)BATCH * NCP * 128 : 0) + (((size_t)b * (sample ? NCS : NCP) + cb) * 2 + kvh) * 64; }
HD float* scmp_ptr(const Ctx& c, int m, int h) { return m < MP ? c.SCP + ((size_t)m * 8 + h) * NCPS : c.SCS + ((size_t)(m - MP) * 8 + h) * NCSS; }
constexpr long NSC_P = (long)MP * 8 * NCPS, NSC_S = (long)MS * 8 * NCSS;
struct StCmpScore { const Ctx& c; static constexpr long N = NSC_P + NSC_S;
  HD void operator()(long i) const {
    const bool sample = i >= NSC_P; const long r = sample ? i - NSC_P : i; const int st = sample ? NCSS : NCPS, nc = sample ? NCS : NCP;
    const int cb = (int)(r % st), h = (int)((r / st) % 8); const int m = (int)(r / st / 8) + (sample ? MP : 0);
    float* dst = scmp_ptr(c, m, h) + cb; const int pos = row_pos(m);
    if (cb >= nc || 16 * cb + 31 > pos) { *dst = -3e38f; return; }
    const float* q = c.QC + (size_t)m * 512 + h * 64; const float* k = cmp_ptr(c, c.KCMP, sample, row_b(m), cb, h / 4);
    float s = 0.f; for (int d = 0; d < 64; ++d) s += q[d] * k[d];
    *dst = s * 0.125f;
  } };
HD void softmax_inplace(float* s, int n) {
  float mx = -3e38f; for (int j = 0; j < n; ++j) mx = fmaxf(mx, s[j]);
  if (mx < -1e38f) { for (int j = 0; j < n; ++j) s[j] = 0.f; return; }
  float sum = 0.f; for (int j = 0; j < n; ++j) { const float v = s[j]; if (v > -1e38f) sum += expf(v - mx); }
  const float inv = 1.f / fmaxf(sum, 1e-30f);
  for (int j = 0; j < n; ++j) { const float v = s[j]; s[j] = v > -1e38f ? expf(v - mx) * inv : 0.f; }
}
struct StCmpSoftmax { const Ctx& c; static constexpr long N = (long)MTOT * 8;
  HD void operator()(long i) const { const int m = (int)(i / 8), h = (int)(i % 8); softmax_inplace(scmp_ptr(c, m, h), m < MP ? NCPS : NCSS); } };
struct StTopk { const Ctx& c; static constexpr long N = (long)MTOT * 2;
  HD void operator()(long i) const {
    const int m = (int)(i / 2), kvh = (int)(i % 2); const bool sample = m >= MP; const int nsel = sample ? NSELS : NSELP, nc = sample ? NCS : NCP;
    const int pos = row_pos(m), qblk = pos / SEL_BLOCK; float* sc = c.SCORE + (size_t)i * NSELMAX;
    for (int s = 0; s < nsel; ++s) {
      float imp = 0.f;
      for (int g = 0; g < 4; ++g) { const float* p = scmp_ptr(c, m, kvh * 4 + g);
        for (int cb = 4 * s - 1; cb <= 4 * s + 3; ++cb) if (cb >= 0 && cb < nc) imp += p[cb]; }
      const bool visible = s <= qblk, forced = (s == 0) || (s == qblk) || (s == qblk - 1);
      sc[s] = visible ? imp + (forced ? FORCED_BONUS : 0.f) : NEGF;
    }
    const int ntop = nsel < SEL_TOPN ? nsel : SEL_TOPN;
    for (int n = 0; n < SEL_TOPN; ++n) {
      int best = -1; float bv = -3e38f;
      if (n < ntop) { for (int s = 0; s < nsel; ++s) if (sc[s] > bv) { bv = sc[s]; best = s; } }
      if (best >= 0) sc[best] = -3.2e38f;
      c.SIDX[i * 8 + n] = (best >= 0 && bv > 0.5f * NEGF) ? best : -1;
    }
  } };
struct StSelScore { const Ctx& c; static constexpr long N = (long)MTOT * 8 * 512;
  HD void operator()(long i) const {
    const int j = (int)(i % 64), n = (int)((i / 64) % 8), h = (int)((i / 512) % 8), m = (int)(i / 4096); const bool sample = m >= MP;
    const int blk = c.SIDX[((size_t)m * 2 + h / 4) * 8 + n]; const int pos = row_pos(m), key = blk * 64 + j;
    if (blk < 0 || key > pos) { c.SS[i] = -3e38f; return; }
    const float* q = c.QR + (size_t)m * 512 + h * 64; const float* k = nsa_row(c, sample, row_b(m), key, 2, h / 4);
    float s = 0.f; for (int d = 0; d < 64; ++d) s += q[d] * k[d];
    c.SS[i] = s * 0.125f;
  } };
HD const float* win_row(const Ctx& c, int m, int j, int which, int kvh) {
  const int pos = row_pos(m), kp = pos - (WINDOW - 1) + j; if (kp < 0) return nullptr;
  if (m < MP) return c.WR + ((size_t)(m / SEQ) * SEQ + kp) * 256 + (which * 2 + kvh) * 64;
  const int b = (m - MP) / DEC_SEQ;
  if (kp < PAST_LEN) return c.cache_nsa_win + ((size_t)b * WBUF + (kp - (PAST_LEN - WBUF))) * 256 + (which * 2 + kvh) * 64;
  return c.WR + ((size_t)MP + b * DEC_SEQ + (kp - PAST_LEN)) * 256 + (which * 2 + kvh) * 64;
}
struct StWinScore { const Ctx& c; static constexpr long N = (long)MTOT * 8 * 512;
  HD void operator()(long i) const {
    const int j = (int)(i % 512), h = (int)((i / 512) % 8), m = (int)(i / 4096);
    const float* k = win_row(c, m, j, 0, h / 4); if (!k) { c.SW[i] = -3e38f; return; }
    const float* q = c.QR + (size_t)m * 512 + h * 64; float s = 0.f; for (int d = 0; d < 64; ++d) s += q[d] * k[d];
    c.SW[i] = s * 0.125f;
  } };
struct StSoftmax512 { float* buf; static constexpr long N = (long)MTOT * 8;
  HD void operator()(long i) const { softmax_inplace(buf + (size_t)i * 512, 512); } };
struct StNsaOut { const Ctx& c; static constexpr long N = (long)MTOT * 512;
  HD void operator()(long i) const {
    const int d = (int)(i % 64), h = (int)((i / 64) % 8), m = (int)(i / 512), kvh = h / 4; const bool sample = m >= MP; const int b = row_b(m);
    const float* pc = scmp_ptr(c, m, h); const int nc = sample ? NCS : NCP;
    float oc = 0.f; for (int cb = 0; cb < nc; ++cb) { const float p = pc[cb]; if (p != 0.f) oc += p * cmp_ptr(c, c.VCMP, sample, b, cb, kvh)[d]; }
    const float* ps = c.SS + ((size_t)m * 8 + h) * 512; float os = 0.f;
    for (int n = 0; n < 8; ++n) { const int blk = c.SIDX[((size_t)m * 2 + kvh) * 8 + n]; if (blk < 0) continue;
      for (int j = 0; j < 64; ++j) { const float p = ps[n * 64 + j]; if (p != 0.f) os += p * nsa_row(c, sample, b, blk * 64 + j, 3, kvh)[d]; } }
    const float* pw = c.SW + ((size_t)m * 8 + h) * 512; float ow = 0.f;
    for (int j = 0; j < 512; ++j) { const float p = pw[j]; if (p != 0.f) ow += p * win_row(c, m, j, 1, kvh)[d]; }
    const float* g = c.GATE + (size_t)m * 24 + h * 3;
    c.CAT[(size_t)m * D_MODEL + h * 64 + d] = f2bf(oc * g[0] + os * g[1] + ow * g[2]);
  } };
#if defined(__HIP_DEVICE_COMPILE__)
#define GDN_FENCE() asm volatile("" ::: "memory")
#else
#define GDN_FENCE() do {} while (0)
#endif
struct StGdnScan { const Ctx& c; static constexpr long N = (long)(BATCH + DEC_BATCH) * 4 * 128;
  HD void operator()(long i) const {
    const int dv = (int)(i % 128), h = (int)((i / 128) % 4), bb = (int)(i / 512); const bool sample = bb >= BATCH; const int b = sample ? bb - BATCH : bb;
    const int T = sample ? DEC_SEQ : SEQ; const int m0 = sample ? MP + b * DEC_SEQ : b * SEQ;
    float S[128];
#pragma unroll
    for (int k = 0; k < 128; ++k) S[k] = sample ? c.state_gdn[(((size_t)b * 4 + h) * 128 + k) * 128 + dv] : 0.f;
    for (int t = 0; t < T; ++t) { const int m = m0 + t;
      const float* kk = c.GK + (size_t)m * 512 + h * 128; const float* qq = c.GQ + (size_t)m * 512 + h * 128;
      const float v = c.GV[(size_t)m * 512 + h * 128 + dv], beta = c.GB[(size_t)m * 4 + h], a = expf(c.GG[(size_t)m * 4 + h]);
      float ks = 0.f;
#pragma unroll
      for (int k0 = 0; k0 < 128; k0 += 16) {
#pragma unroll
        for (int k = 0; k < 16; ++k) ks += kk[k0 + k] * S[k0 + k];
        GDN_FENCE(); }
      const float coef = beta * (v - a * ks); float o = 0.f;
#pragma unroll
      for (int k0 = 0; k0 < 128; k0 += 16) {
#pragma unroll
        for (int k = 0; k < 16; ++k) { S[k0 + k] = a * S[k0 + k] + kk[k0 + k] * coef; o += qq[k0 + k] * S[k0 + k]; }
        GDN_FENCE(); }
      c.OG[(size_t)m * 512 + h * 128 + dv] = o; }
    float* so = c.out + (sample ? O_STS : O_STP) + (((size_t)b * 4 + h) * 128) * 128 + dv;
#pragma unroll
    for (int k = 0; k < 128; ++k) so[(size_t)k * 128] = S[k];
  } };
struct StGdnNorm { const Ctx& c; static constexpr long N = (long)MTOT * 4;
  HD void operator()(long i) const {
    const int m = (int)(i / 4), h = (int)(i % 4); const float* o = c.OG + (size_t)m * 512 + h * 128; const float* z = c.P + (size_t)m * LDP + OFF_Z + h * 128;
    float ss = 0.f; for (int d = 0; d < 128; ++d) ss += o[d] * o[d];
    const float r = 1.f / sqrtf(ss / 128.f + EPS);
    for (int d = 0; d < 128; ++d) c.CAT[(size_t)m * D_MODEL + 512 + h * 128 + d] = f2bf(o[d] * r * c.gdn_norm_w[d] * siluf_(z[d]));
  } };
struct StMemKV { const Ctx& c; static constexpr long N = (long)MMEM * 4;
  HD void operator()(long i) const {
    const int mm = (int)(i / 4), h = (int)(i % 4); const float* k = c.MKV + (size_t)mm * 2048 + h * 256; const float* v = c.MKV + (size_t)mm * 2048 + 1024 + h * 256;
    float ss = 0.f; for (int d = 0; d < 256; ++d) ss += k[d] * k[d];
    const float r = 1.f / sqrtf(ss / 256.f + EPS); float* o = c.out + O_MKVP + (size_t)mm * 2048;
    for (int d = 0; d < 256; ++d) { o[h * 256 + d] = k[d] * r * c.xk_norm_w[d]; o[1024 + h * 256 + d] = v[d]; }
  } };
struct StXqNorm { const Ctx& c; static constexpr long N = (long)MTOT * 4;
  HD void operator()(long i) const {
    float* q = c.Q2 + (size_t)(i / 4) * D_MODEL + (i % 4) * 256; float ss = 0.f; for (int d = 0; d < 256; ++d) ss += q[d] * q[d];
    const float r = 1.f / sqrtf(ss / 256.f + EPS); for (int d = 0; d < 256; ++d) q[d] = q[d] * r * c.xq_norm_w[d];
  } };
HD const float* memkv_row(const Ctx& c, int m, int j, int which, int h) {
  if (m < MP) return c.out + O_MKVP + ((size_t)(m / SEQ) * MEM_TOKENS + j) * 2048 + which * 1024 + h * 256;
  return c.cache_mem_kv + ((size_t)((m - MP) / DEC_SEQ) * MEM_TOKENS + j) * 2048 + which * 1024 + h * 256;
}
struct StXScore { const Ctx& c; static constexpr long N = (long)MTOT * 4 * MEM_TOKENS;
  HD void operator()(long i) const {
    const int j = (int)(i % MEM_TOKENS), h = (int)((i / MEM_TOKENS) % 4), m = (int)(i / MEM_TOKENS / 4);
    const float* q = c.Q2 + (size_t)m * D_MODEL + h * 256; const float* k = memkv_row(c, m, j, 0, h);
    float s = 0.f; for (int d = 0; d < 256; ++d) s += q[d] * k[d];
    c.SX[i] = s * 0.0625f;
  } };
struct StXSoftmax { const Ctx& c; static constexpr long N = (long)MTOT * 4;
  HD void operator()(long i) const { softmax_inplace(c.SX + (size_t)i * MEM_TOKENS, MEM_TOKENS); } };
struct StXOut { const Ctx& c; static constexpr long N = (long)MTOT * D_MODEL;
  HD void operator()(long i) const {
    const int d = (int)(i % 256), h = (int)((i / 256) % 4), m = (int)(i / D_MODEL); const float* p = c.SX + ((size_t)m * 4 + h) * MEM_TOKENS;
    float o = 0.f; for (int j = 0; j < MEM_TOKENS; ++j) o += p[j] * memkv_row(c, m, j, 1, h)[d];
    c.OX[i] = f2bf(o);
  } };
HD float up_at(const Ctx& c, int m, int back, int col) {
  const int t = row_t(m) - back; if (t >= 0) return c.UP[(size_t)(m - back) * (2 * D_FF) + col];
  if (m < MP) return 0.f;
  return c.cache_ffn_conv[((size_t)((m - MP) / DEC_SEQ) * 2 + (2 + t)) * (2 * D_FF) + col];
}
struct StFfnAct { const Ctx& c; static constexpr long N = (long)MTOT * D_FF;
  HD void operator()(long i) const {
    const int col = (int)(i % D_FF), m = (int)(i / D_FF); float a = c.ffn_conv_b[col], u = c.ffn_conv_b[D_FF + col];
    for (int k = 0; k < 3; ++k) { a += c.ffn_conv_w[k * 2 * D_FF + col] * up_at(c, m, 2 - k, col); u += c.ffn_conv_w[k * 2 * D_FF + D_FF + col] * up_at(c, m, 2 - k, D_FF + col); }
    c.ACT[i] = f2bf(siluf_(a) * u);
  } };
struct StFfnConvOut { const Ctx& c; static constexpr long N = (long)(BATCH + DEC_BATCH) * 2 * 2 * D_FF;
  HD void operator()(long i) const {
    const int col = (int)(i % (2 * D_FF)), r = (int)((i / (2 * D_FF)) % 2), bb = (int)(i / (4 * D_FF));
    if (bb < BATCH) c.out[O_FCP + i] = c.UP[((size_t)bb * SEQ + SEQ - 2 + r) * (2 * D_FF) + col];
    else { const int b = bb - BATCH; c.out[O_FCS + ((size_t)b * 2 + r) * (2 * D_FF) + col] = c.UP[((size_t)MP + b * DEC_SEQ + DEC_SEQ - 2 + r) * (2 * D_FF) + col]; }
  } };

struct WsMap { size_t off; HD size_t take(size_t bytes) { const size_t o = off; off += (bytes + 255) & ~(size_t)255; return o; } };
inline size_t ws_carve(Ctx& c, unsigned char* ws, size_t base) {
  WsMap w{base};
  c.XN = (bf16_t*)(ws + w.take((size_t)MTOT * D_MODEL * 2)); c.MN = (bf16_t*)(ws + w.take((size_t)MMEM * D_MODEL * 2));
  c.CAT = (bf16_t*)(ws + w.take((size_t)MTOT * D_MODEL * 2)); c.OX = (bf16_t*)(ws + w.take((size_t)MTOT * D_MODEL * 2));
  c.ACT = (bf16_t*)(ws + w.take((size_t)MTOT * D_FF * 2));
  c.P = (float*)(ws + w.take((size_t)MTOT * LDP * 4)); c.MKV = (float*)(ws + w.take((size_t)MMEM * 2048 * 4));
  c.QC = (float*)(ws + w.take((size_t)MTOT * 512 * 4)); c.QR = (float*)(ws + w.take((size_t)MTOT * 512 * 4));
  c.WR = (float*)(ws + w.take((size_t)MTOT * 256 * 4)); c.GATE = (float*)(ws + w.take((size_t)MTOT * 24 * 4));
  c.GQ = (float*)(ws + w.take((size_t)MTOT * 512 * 4)); c.GK = (float*)(ws + w.take((size_t)MTOT * 512 * 4)); c.GV = (float*)(ws + w.take((size_t)MTOT * 512 * 4));
  c.GB = (float*)(ws + w.take((size_t)MTOT * 4 * 4)); c.GG = (float*)(ws + w.take((size_t)MTOT * 4 * 4));
  const size_t ncmp = ((size_t)BATCH * NCP + (size_t)DEC_BATCH * NCS) * 128 * 4;
  c.KCMP = (float*)(ws + w.take(ncmp)); c.VCMP = (float*)(ws + w.take(ncmp));
  c.SCP = (float*)(ws + w.take((size_t)MP * 8 * NCPS * 4)); c.SCS = (float*)(ws + w.take((size_t)MS * 8 * NCSS * 4));
  c.SCORE = (float*)(ws + w.take((size_t)MTOT * 2 * NSELMAX * 4)); c.SIDX = (int*)(ws + w.take((size_t)MTOT * 2 * 8 * 4));
  c.OG = (float*)(ws + w.take(((size_t)BATCH * 4 * (SEQ / 64) + (size_t)DEC_BATCH * 4) * 64 * 128 * 4 > (size_t)MTOT * 512 * 4 ? ((size_t)BATCH * 4 * (SEQ / 64) + (size_t)DEC_BATCH * 4) * 64 * 128 * 4 : (size_t)MTOT * 512 * 4)); c.H1 = (float*)(ws + w.take((size_t)MTOT * D_MODEL * 4));
  c.Q2 = (float*)(ws + w.take((size_t)MTOT * D_MODEL * 4)); c.SX = (float*)(ws + w.take((size_t)MTOT * 4 * MEM_TOKENS * 4));
  c.H2 = (float*)(ws + w.take((size_t)MTOT * D_MODEL * 4));
  c.QCb = (bf16_t*)(ws + w.take((size_t)MTOT * 512 * 2)); c.QRb = (bf16_t*)(ws + w.take((size_t)MTOT * 512 * 2));
  c.KSb = (bf16_t*)(ws + w.take((size_t)BATCH * 2 * SEQ * 64 * 2)); c.VSTb = (bf16_t*)(ws + w.take((size_t)BATCH * 2 * SEQ * 64 * 2));
  c.KWb = (bf16_t*)(ws + w.take((size_t)BATCH * 2 * SEQ * 64 * 2)); c.VWTb = (bf16_t*)(ws + w.take((size_t)BATCH * 2 * SEQ * 64 * 2));
  c.KWsb = (bf16_t*)(ws + w.take((size_t)DEC_BATCH * 2 * 544 * 64 * 2)); c.VWTsb = (bf16_t*)(ws + w.take((size_t)DEC_BATCH * 2 * 544 * 64 * 2));
  { const size_t nb = ((size_t)BATCH * 2 * 128 + (size_t)DEC_BATCH * 2 * 512) * 64 * 2; c.KCb = (bf16_t*)(ws + w.take(nb)); c.VCTb = (bf16_t*)(ws + w.take(nb)); }
  { const size_t nb = (size_t)(BATCH + DEC_BATCH) * 4 * MEM_TOKENS * 256 * 2; c.KXb = (bf16_t*)(ws + w.take(nb)); c.VXTb = (bf16_t*)(ws + w.take(nb)); c.Q2b = (bf16_t*)(ws + w.take((size_t)MTOT * D_MODEL * 2)); }
  { constexpr size_t nchunk = (size_t)BATCH * 4 * (SEQ / 64) + (size_t)DEC_BATCH * 4;
    c.GS = (float*)(ws + w.take(nchunk * 64 * 128 * 4)); c.GSW = (float*)(ws + w.take(nchunk * 64 * 128 * 4)); c.GKt = (float*)(ws + w.take(nchunk * 64 * 128 * 4)); c.GVt = (float*)(ws + w.take(nchunk * 64 * 128 * 4)); c.GWp = (bf16_t*)(ws + w.take(nchunk * 64 * 128 * 2)); c.GQKp = (bf16_t*)(ws + w.take(nchunk * 64 * 64 * 2));
    c.GQDp = (bf16_t*)(ws + w.take(nchunk * 64 * 128 * 2)); c.GKDTp = (bf16_t*)(ws + w.take(nchunk * 128 * 64 * 2)); c.GL = (float*)(ws + w.take(nchunk * 4)); }
  c.WcT = (bf16_t*)(ws + w.take((size_t)2 * 2 * 64 * 1024 * 2)); c.CBIAS = (float*)(ws + w.take(128 * 4));
  c.PP = (float*)(ws + w.take(((size_t)2 * BATCH * 2 * (SEQ / 16) + (size_t)2 * DEC_BATCH * 2 * (PAST_LEN / 16)) * 128 * 4));
  const size_t ssb = (size_t)MTOT * 8 * 512 * 4, upb = (size_t)MTOT * 2 * D_FF * 4; const size_t big = w.take(2 * ssb > upb ? 2 * ssb : upb);
  c.SS = (float*)(ws + big); c.SW = (float*)(ws + big + ssb); c.UP = (float*)(ws + big);
  return w.off;
}
typedef short bf16x8 __attribute__((ext_vector_type(8)));
typedef float f32x16 __attribute__((ext_vector_type(16)));
typedef float f32x4v __attribute__((ext_vector_type(4)));
typedef unsigned u32x4v __attribute__((ext_vector_type(4)));
typedef unsigned u32x2v __attribute__((ext_vector_type(2)));
#ifdef HOST_TEST
#include <ucontext.h>
struct EmuSlot { short a[8]; short b[8]; float c[16]; unsigned u; };
struct EmuWave {
  ucontext_t main_ctx; ucontext_t ctx[64]; char* stacks; int cur; int ndone; bool done[64]; int gen[64];
  EmuSlot slot[2][64]; void (*fn)(void*, int); void* arg;
};
static thread_local EmuWave* tl_emu = nullptr;
static void emu_trampoline(int lane) { EmuWave* e = tl_emu; e->fn(e->arg, lane); e->done[lane] = true; e->ndone++; swapcontext(&e->ctx[lane], &e->main_ctx); }
static void emu_run_wave(void (*fn)(void*, int), void* arg) {
  static thread_local EmuWave* e = nullptr; constexpr size_t STK = 256 * 1024;
  if (!e) { e = new EmuWave; e->stacks = (char*)malloc(64 * STK); }
  tl_emu = e; e->fn = fn; e->arg = arg; e->ndone = 0;
  for (int l = 0; l < 64; ++l) { e->done[l] = false; e->gen[l] = 0; getcontext(&e->ctx[l]); e->ctx[l].uc_stack.ss_sp = e->stacks + l * STK; e->ctx[l].uc_stack.ss_size = STK; e->ctx[l].uc_link = nullptr;
    makecontext(&e->ctx[l], (void (*)())emu_trampoline, 1, l); }
  while (e->ndone < 64) for (int l = 0; l < 64; ++l) if (!e->done[l]) { e->cur = l; swapcontext(&e->main_ctx, &e->ctx[l]); }
}
static inline EmuSlot* emu_my_slot() { EmuWave* e = tl_emu; return &e->slot[e->gen[e->cur] & 1][e->cur]; }
static inline EmuSlot* emu_exchange() { EmuWave* e = tl_emu; const int l = e->cur; swapcontext(&e->ctx[l], &e->main_ctx); e = tl_emu; EmuSlot* s = e->slot[e->gen[l] & 1]; e->gen[l]++; return s; }
static inline int wv_lane() { return tl_emu->cur; }
static inline int wv_lane_opaque() { return tl_emu->cur; }
static inline float bfbits2f(short s) { return __builtin_bit_cast(float, (unsigned)(unsigned short)s << 16); }
static inline f32x16 wv_mfma32(bf16x8 a, bf16x8 b, f32x16 c) {
  EmuSlot* m = emu_my_slot(); for (int j = 0; j < 8; ++j) { m->a[j] = a[j]; m->b[j] = b[j]; }
  EmuSlot* s = emu_exchange(); const int l = wv_lane(), col = l & 31, hi = l >> 5; f32x16 d;
  for (int r = 0; r < 16; ++r) { const int row = (r & 3) + 8 * (r >> 2) + 4 * hi; float acc = c[r];
    for (int k = 0; k < 16; ++k) acc += bfbits2f(s[row + 32 * (k >> 3)].a[k & 7]) * bfbits2f(s[col + 32 * (k >> 3)].b[k & 7]);
    d[r] = acc; }
  return d;
}
static inline unsigned wv_shfl_xor_u(unsigned v, int mask) { emu_my_slot()->u = v; EmuSlot* s = emu_exchange(); return s[wv_lane() ^ mask].u; }
static inline unsigned wv_shfl_u(unsigned v, int src) { emu_my_slot()->u = v; EmuSlot* s = emu_exchange(); return s[src & 63].u; }
static inline unsigned long long wv_ballot(bool p) { emu_my_slot()->u = p ? 1u : 0u; EmuSlot* s = emu_exchange(); unsigned long long r = 0; for (int l = 0; l < 64; ++l) if (s[l].u) r |= 1ull << l; return r; }
static inline float wv_exp2(float x) { return exp2f(x); }
static inline float wv_rcp(float x) { return 1.f / x; }
static inline unsigned wv_pk_bf16(float lo, float hi) { return f2bf_u(lo) | (f2bf_u(hi) << 16); }
#define WV_DEV inline
#define WV_SCHED_BARRIER() do {} while (0)
static inline void wv_fence() { emu_my_slot()->u = 0; (void)emu_exchange(); }
#else
#define WV_DEV __device__ __forceinline__
#define WV_SCHED_BARRIER() __builtin_amdgcn_sched_barrier(0)
WV_DEV int wv_lane() { return (int)(threadIdx.x & 63); }
WV_DEV int wv_lane_opaque() { int l = (int)(threadIdx.x & 63); asm volatile("" : "+v"(l)); return l; }
WV_DEV void wv_fence() { asm volatile("s_waitcnt vmcnt(0) lgkmcnt(0)" ::: "memory"); }
WV_DEV f32x16 wv_mfma32(bf16x8 a, bf16x8 b, f32x16 c) { return __builtin_amdgcn_mfma_f32_32x32x16_bf16(a, b, c, 0, 0, 0); }
WV_DEV unsigned wv_shfl_xor_u(unsigned v, int mask) { return (unsigned)__shfl_xor((int)v, mask); }
WV_DEV unsigned wv_shfl_u(unsigned v, int src) { return (unsigned)__shfl((int)v, src); }
WV_DEV unsigned long long wv_ballot(bool p) { return __ballot(p); }
WV_DEV float wv_exp2(float x) { return __builtin_amdgcn_exp2f(x); }
WV_DEV float wv_rcp(float x) { return __builtin_amdgcn_rcpf(x); }
typedef float wv_f32x2 __attribute__((ext_vector_type(2))); typedef __bf16 wv_bf16x2 __attribute__((ext_vector_type(2)));
WV_DEV unsigned wv_pk_bf16(float lo, float hi) { wv_f32x2 v = {lo, hi}; wv_bf16x2 b = __builtin_convertvector(v, wv_bf16x2); return __builtin_bit_cast(unsigned, b); }
#endif
WV_DEV float wv_shfl_xor_f(float v, int mask) { return __builtin_bit_cast(float, wv_shfl_xor_u(__builtin_bit_cast(unsigned, v), mask)); }
WV_DEV bf16x8 wv_pack8(float a0, float a1, float a2, float a3, float a4, float a5, float a6, float a7) {
  u32x4v w; w.x = wv_pk_bf16(a0, a1); w.y = wv_pk_bf16(a2, a3); w.z = wv_pk_bf16(a4, a5); w.w = wv_pk_bf16(a6, a7); return __builtin_bit_cast(bf16x8, w); }
WV_DEV bf16x8 wv_ld8(const bf16_t* p) { return *(const bf16x8*)p; }
WV_DEV bf16x8 wv_ld8_f32(const float* p) { const f32x4v a = *(const f32x4v*)p, b = *(const f32x4v*)(p + 4); return wv_pack8(a.x, a.y, a.z, a.w, b.x, b.y, b.z, b.w); }
constexpr int WKS = 544;
HD int vperm16(int k) { const int w = k & 15; return (k & ~15) | ((((w >> 2) & 1) << 3) + ((w >> 3) << 2) + (w & 3)); }
HD size_t frag_idx(int r, int k, int K) { return ((size_t)(r >> 5) * (K >> 4) + (k >> 4)) * 512 + (size_t)(((((k >> 3) & 1) << 5) + (r & 31)) << 3) + (k & 7); }
HD size_t kc_off(bool sample, int b, int kvh) { return sample ? (size_t)BATCH * 2 * 128 * 64 + ((size_t)b * 2 + kvh) * 512 * 64 : ((size_t)b * 2 + kvh) * 128 * 64; }
struct StPackQ { const Ctx& c; static constexpr long N = (long)MTOT * 512;
  HD void operator()(long i) const { c.QCb[i] = f2bf(c.QC[i]); c.QRb[i] = f2bf(c.QR[i]); } };
struct StPackKV { const Ctx& c; static constexpr long N = (long)BATCH * 2 * SEQ * 64;
  HD void operator()(long i) const {
    const int d = (int)(i % 64), t = (int)((i / 64) % SEQ), kvh = (int)((i / 64 / SEQ) % 2), b = (int)(i / 64 / SEQ / 2);
    const float* row = c.out + O_KVP + ((size_t)b * SEQ + t) * 512; const float* wr = c.WR + ((size_t)b * SEQ + t) * 256;
    const size_t bk = (size_t)b * 2 + kvh;
    c.KSb[bk * SEQ * 64 + frag_idx(t, d, 64)] = f2bf(row[(2 * 2 + kvh) * 64 + d]); c.VSTb[bk * 64 * SEQ + frag_idx(d, vperm16(t), SEQ)] = f2bf(row[(3 * 2 + kvh) * 64 + d]);
    c.KWb[bk * SEQ * 64 + frag_idx(t, d, 64)] = f2bf(wr[(0 * 2 + kvh) * 64 + d]); c.VWTb[bk * 64 * SEQ + frag_idx(d, vperm16(t), SEQ)] = f2bf(wr[(1 * 2 + kvh) * 64 + d]);
  } };
struct StPackWinS { const Ctx& c; static constexpr long N = (long)DEC_BATCH * 2 * WKS * 64;
  HD void operator()(long i) const {
    const int d = (int)(i % 64), w = (int)((i / 64) % WKS), kvh = (int)((i / 64 / WKS) % 2), b = (int)(i / 64 / WKS / 2);
    float k = 0.f, v = 0.f;
    if (w < WBUF) { const float* r = c.cache_nsa_win + ((size_t)b * WBUF + w) * 256; k = r[(0 * 2 + kvh) * 64 + d]; v = r[(1 * 2 + kvh) * 64 + d]; }
    else if (w < WBUF + DEC_SEQ) { const float* r = c.WR + ((size_t)MP + b * DEC_SEQ + (w - WBUF)) * 256; k = r[(0 * 2 + kvh) * 64 + d]; v = r[(1 * 2 + kvh) * 64 + d]; }
    const size_t bk = (size_t)b * 2 + kvh;
    c.KWsb[bk * WKS * 64 + frag_idx(w, d, 64)] = f2bf(k); c.VWTsb[bk * 64 * WKS + frag_idx(d, vperm16(w), WKS)] = f2bf(v);
  } };
constexpr long NPC_P = (long)BATCH * 2 * 128 * 64, NPC_S = (long)DEC_BATCH * 2 * 512 * 64;
struct StPackCmp { const Ctx& c; static constexpr long N = NPC_P + NPC_S;
  HD void operator()(long i) const {
    const bool sample = i >= NPC_P; long r = sample ? i - NPC_P : i; const int cpad = sample ? 512 : 128, nc = sample ? NCS : NCP;
    const int d = (int)(r % 64); r /= 64; const int cb = (int)(r % cpad); r /= cpad; const int kvh = (int)(r % 2), b = (int)(r / 2);
    float k = 0.f, v = 0.f; if (cb < nc) { k = cmp_ptr(c, c.KCMP, sample, b, cb, kvh)[d]; v = cmp_ptr(c, c.VCMP, sample, b, cb, kvh)[d]; }
    const size_t o = kc_off(sample, b, kvh);
    c.KCb[o + frag_idx(cb, d, 64)] = f2bf(k); c.VCTb[o + frag_idx(d, vperm16(cb), cpad)] = f2bf(v);
  } };

HD int crow16(int r, int hi) { return (r & 3) + 8 * (r >> 2) + 4 * hi; }
struct SoftSt { float m, l; f32x16 o[2]; };
constexpr float NSA_SCL = 0.125f * 1.4426950408889634f;
WV_DEV void soft_step(SoftSt& st, const f32x16& S, unsigned vm, bf16x8 v00, bf16x8 v01, bf16x8 v10, bf16x8 v11) {
  float sc[16]; float mx = -3e38f;
#pragma unroll
  for (int r = 0; r < 16; ++r) { sc[r] = ((vm >> r) & 1u) ? S[r] * NSA_SCL : -3e38f; mx = fmaxf(mx, sc[r]); }
  mx = fmaxf(mx, wv_shfl_xor_f(mx, 32));
  const float mn = fmaxf(st.m, mx), alpha = wv_exp2(st.m - mn); st.m = mn;
  float p[16]; float sum = 0.f;
#pragma unroll
  for (int r = 0; r < 16; ++r) { p[r] = ((vm >> r) & 1u) ? wv_exp2(sc[r] - mn) : 0.f; sum += p[r]; }
  st.l = st.l * alpha + sum; st.o[0] = st.o[0] * alpha; st.o[1] = st.o[1] * alpha;
  const bf16x8 p0 = wv_pack8(p[0], p[1], p[2], p[3], p[4], p[5], p[6], p[7]), p1 = wv_pack8(p[8], p[9], p[10], p[11], p[12], p[13], p[14], p[15]);
  st.o[0] = wv_mfma32(v00, p0, st.o[0]); st.o[0] = wv_mfma32(v01, p1, st.o[0]);
  st.o[1] = wv_mfma32(v10, p0, st.o[1]); st.o[1] = wv_mfma32(v11, p1, st.o[1]);
}
WV_DEV void soft_finish(SoftSt& st, float gate, f32x16 (&ot)[2]) {
  const float l = st.l + wv_shfl_xor_f(st.l, 32); const float f = l > 0.f ? gate * wv_rcp(l) : 0.f;
  ot[0] = ot[0] + st.o[0] * f; ot[1] = ot[1] + st.o[1] * f;
}
WV_DEV f32x16 qk_tile(const bf16_t* ktile  , const bf16x8 (&q)[4]) {
  f32x16 S = {};
#pragma unroll
  for (int ks = 0; ks < 4; ++ks) S = wv_mfma32(wv_ld8(ktile + ks * 512), q[ks], S);
  return S;
}
WV_DEV void cmp_tile2(const bf16_t* kcb, const bf16_t* vcb, int cpad, int tile, int r32, int hi, int ncv, float mc, float invc, const bf16x8 (&qc)[4], f32x16 (&oc)[2],
                      bool need_imp, float& prevLp, float (&v4)[4]) {
  const f32x16 S = qk_tile(kcb + (size_t)tile * 2048 + (hi * 32 + r32) * 8, qc);
  float p[16];
#pragma unroll
  for (int r = 0; r < 16; ++r) p[r] = (tile * 32 + crow16(r, hi) < ncv) ? wv_exp2(S[r] * NSA_SCL - mc) * invc : 0.f;
  if (need_imp) {
#pragma unroll
    for (int u = 0; u < 4; ++u) {
      const float lp = wv_shfl_xor_f(p[4 * u + 3], 32); float v = (p[4 * u] + p[4 * u + 1]) + (p[4 * u + 2] + p[4 * u + 3]) + (hi ? lp : prevLp); prevLp = lp;
      v += wv_shfl_xor_f(v, 1); v += wv_shfl_xor_f(v, 2); v4[u] = v; }
  }
  const bf16x8 p0 = wv_pack8(p[0], p[1], p[2], p[3], p[4], p[5], p[6], p[7]), p1 = wv_pack8(p[8], p[9], p[10], p[11], p[12], p[13], p[14], p[15]);
  const bf16_t* vb = vcb + (size_t)(tile * 2) * 512 + (hi * 32 + r32) * 8; const size_t dbs = (size_t)(cpad >> 4) * 512;
  oc[0] = wv_mfma32(wv_ld8(vb), p0, oc[0]); oc[0] = wv_mfma32(wv_ld8(vb + 512), p1, oc[0]);
  oc[1] = wv_mfma32(wv_ld8(vb + dbs), p0, oc[1]); oc[1] = wv_mfma32(wv_ld8(vb + dbs + 512), p1, oc[1]);
}
HD const float* sample_row(const Ctx& c, int b, int kp) {
  if (kp < PAST_LEN) { const int pg = c.page_table[b * NPAGES + kp / PAGE_SIZE]; return c.cache_nsa_kv + ((size_t)pg * PAGE_SIZE + kp % PAGE_SIZE) * 512; }
  int j = kp - PAST_LEN; if (j > DEC_SEQ - 1) j = DEC_SEQ - 1; return c.out + O_KVS + ((size_t)b * DEC_SEQ + j) * 512;
}
template <bool SAMPLE> WV_DEV void nsa_unit(const Ctx& c, int unit, float* wscr  ) {
  constexpr int NC = SAMPLE ? NCS : NCP, CPAD = SAMPLE ? 512 : 128, NCT = CPAD / 32, NI = NCT * 4;
  const int lane = wv_lane(), r32 = lane & 31, hi = lane >> 5, tt = r32 >> 2, g = r32 & 3;
  int b, kvh, t0;
  if (SAMPLE) { b = unit >> 1; kvh = unit & 1; t0 = 0; } else { const int tile = unit % (SEQ / 8), bk = unit / (SEQ / 8); t0 = tile * 8; kvh = bk & 1; b = bk >> 1; }
  const int m = (SAMPLE ? MP + b * DEC_SEQ : b * SEQ + t0) + tt, pos = (SAMPLE ? PAST_LEN : t0) + tt, h = kvh * 4 + g;
  const int pos_last = (SAMPLE ? PAST_LEN : t0) + 7;
  bf16x8 qc[4], qr[4];
#pragma unroll
  for (int ks = 0; ks < 4; ++ks) { qc[ks] = wv_ld8(c.QCb + (size_t)m * 512 + h * 64 + 16 * ks + 8 * hi); qr[ks] = wv_ld8(c.QRb + (size_t)m * 512 + h * 64 + 16 * ks + 8 * hi); }
  const float* gate = c.GATE + (size_t)m * 24 + h * 3;
  f32x16 ot[2]; ot[0] = f32x16{}; ot[1] = f32x16{};
  const bf16_t* kcb = c.KCb + kc_off(SAMPLE, b, kvh); const bf16_t* vcb = c.VCTb + kc_off(SAMPLE, b, kvh);
  const int ncv = pos >= 31 ? ((pos - 31) / 16 + 1 < NC ? (pos - 31) / 16 + 1 : NC) : 0;
  const int ncv_last = pos_last >= 31 ? ((pos_last - 31) / 16 + 1 < NC ? (pos_last - 31) / 16 + 1 : NC) : 0;
  const int ntc = (ncv_last + 31) / 32;
  float mc = -3e38f, lc = 0.f;
  for (int tile = 0; tile < ntc; ++tile) {
    const f32x16 S = qk_tile(kcb + (size_t)tile * 2048 + lane * 8, qc);
    float sc[16]; float mx = -3e38f;
#pragma unroll
    for (int r = 0; r < 16; ++r) { const bool v = tile * 32 + crow16(r, hi) < ncv; sc[r] = v ? S[r] * NSA_SCL : -3e38f; mx = fmaxf(mx, sc[r]); }
    mx = fmaxf(mx, wv_shfl_xor_f(mx, 32));
    const float mn = fmaxf(mc, mx); float sum = 0.f;
#pragma unroll
    for (int r = 0; r < 16; ++r) sum += (tile * 32 + crow16(r, hi) < ncv) ? wv_exp2(sc[r] - mn) : 0.f;
    lc = lc * wv_exp2(mc - mn) + sum; mc = mn;
  }
  lc = lc + wv_shfl_xor_f(lc, 32);
  const float invc = lc > 0.f ? wv_rcp(lc) : 0.f;
  const int qblk = pos >> 6;
  const bool need_imp = SAMPLE || qblk > 7;
  unsigned long long sel0 = 0ull, sel1 = 0ull;
  float prevLp = 0.f; f32x16 oc[2]; oc[0] = f32x16{}; oc[1] = f32x16{};
  if constexpr (!SAMPLE) {
    float imp[NI];
#pragma unroll
    for (int i = 0; i < NI; ++i) imp[i] = -1.f;
#pragma unroll
    for (int tile = 0; tile < NCT; ++tile) {
      if (tile < ntc) { float v4[4] = {0.f, 0.f, 0.f, 0.f};
        cmp_tile2(kcb, vcb, CPAD, tile, r32, hi, ncv, mc, invc, qc, oc, need_imp, prevLp, v4);
#pragma unroll
        for (int u = 0; u < 4; ++u) { const int s = 2 * (tile * 4 + u) + hi; imp[tile * 4 + u] = (need_imp && s >= 1 && s <= qblk - 2) ? v4[u] : -1.f; } }
    }
    if (!need_imp) sel0 = (2ull << qblk) - 1ull;
    else {
      for (int round = 0; round < 5; ++round) {
        float bv = -1.f; int bs = 1 << 20;
#pragma unroll
        for (int i = 0; i < NI; ++i) if (imp[i] > bv) { bv = imp[i]; bs = 2 * i + hi; }
        const float pv = wv_shfl_xor_f(bv, 32); const int ps = (int)wv_shfl_xor_u((unsigned)bs, 32);
        const int ws = (pv > bv || (pv == bv && ps < bs)) ? ps : bs;
        sel0 |= 1ull << ws;
#pragma unroll
        for (int i = 0; i < NI; ++i) if (2 * i + hi == ws) imp[i] = -1.f;
      }
      sel0 |= 1ull | (1ull << qblk) | (1ull << (qblk - 1));
    }
  } else {
    for (int tile = 0; tile < ntc; ++tile) { float v4[4] = {0.f, 0.f, 0.f, 0.f};
      cmp_tile2(kcb, vcb, CPAD, tile, r32, hi, ncv, mc, invc, qc, oc, true, prevLp, v4);
      if (g == 0) {
#pragma unroll
        for (int u = 0; u < 4; ++u) wscr[tt * 128 + 2 * (tile * 4 + u) + hi] = v4[u]; }
    }
    wv_fence();
    const int sl = (g * 2 + hi) * 16; int w0 = -1, w1 = -1, w2 = -1, w3 = -1;
    for (int round = 0; round < 5; ++round) {
      float bv = -1.f; int bs = 1 << 20;
      for (int j = 0; j < 16; ++j) { const int s = sl + j; const float v = wscr[tt * 128 + s];
        const bool cand = s >= 1 && s <= qblk - 2 && s != w0 && s != w1 && s != w2 && s != w3;
        if (cand && v > bv) { bv = v; bs = s; } }
#pragma unroll
      for (int sh = 0; sh < 3; ++sh) { const int msk = sh == 0 ? 1 : sh == 1 ? 2 : 32;
        const float pv = wv_shfl_xor_f(bv, msk); const int ps = (int)wv_shfl_xor_u((unsigned)bs, msk);
        if (pv > bv || (pv == bv && ps < bs)) { bv = pv; bs = ps; } }
      if (bs < 64) sel0 |= 1ull << bs; else if (bs < 128) sel1 |= 1ull << (bs - 64);
      w3 = w2; w2 = w1; w1 = w0; w0 = bs;
    }
    sel0 |= 1ull;
    if (qblk < 64) sel0 |= 1ull << qblk; else if (qblk < 128) sel1 |= 1ull << (qblk - 64);
    if (qblk - 1 < 64) sel0 |= 1ull << (qblk - 1); else if (qblk - 1 < 128) sel1 |= 1ull << (qblk - 1 - 64);
  }
  { const float g0 = gate[0]; ot[0] = oc[0] * g0; ot[1] = oc[1] * g0; }
  unsigned long long un0 = sel0, un1 = sel1;
#pragma unroll
  for (int sh = 4; sh <= 16; sh <<= 1) {
    un0 |= (unsigned long long)wv_shfl_xor_u((unsigned)un0, sh) | ((unsigned long long)wv_shfl_xor_u((unsigned)(un0 >> 32), sh) << 32);
    if (SAMPLE) un1 |= (unsigned long long)wv_shfl_xor_u((unsigned)un1, sh) | ((unsigned long long)wv_shfl_xor_u((unsigned)(un1 >> 32), sh) << 32);
  }
  { SoftSt st; st.m = -3e38f; st.l = 0.f; st.o[0] = f32x16{}; st.o[1] = f32x16{};
    const int nblk = SAMPLE ? NSELS : qblk + 1;
    for (int s = 0; s < nblk; ++s) {
      const bool in_union = SAMPLE ? (s == NSELS - 1 || (s < 64 ? (un0 >> s) & 1ull : (un1 >> (s - 64)) & 1ull)) : ((un0 >> s) & 1ull);
      if (!in_union) continue;
      const bool mine = SAMPLE ? (s == NSELS - 1 || (s < 64 ? (sel0 >> s) & 1ull : (sel1 >> (s - 64)) & 1ull)) : ((sel0 >> s) & 1ull);
      for (int half = 0; half < 2; ++half) {
        const int kb = s * 64 + half * 32; if (kb > pos_last) break;
        unsigned vm = 0u;
#pragma unroll
        for (int r = 0; r < 16; ++r) if (mine && kb + crow16(r, hi) <= pos) vm |= 1u << r;
        if (!SAMPLE) {
          const size_t bk = (size_t)b * 2 + kvh;
          const f32x16 S = qk_tile(c.KSb + bk * SEQ * 64 + (size_t)(kb >> 5) * 2048 + lane * 8, qr);
          const bf16_t* vb = c.VSTb + bk * 64 * SEQ + (size_t)(kb >> 4) * 512 + lane * 8;
          soft_step(st, S, vm, wv_ld8(vb), wv_ld8(vb + 512), wv_ld8(vb + (size_t)(SEQ >> 4) * 512), wv_ld8(vb + (size_t)(SEQ >> 4) * 512 + 512));
        } else {
          const float* blk; int rmax;
          if (s < NSELS - 1) { const int pg = c.page_table[b * NPAGES + (s >> 1)]; blk = c.cache_nsa_kv + ((size_t)pg * PAGE_SIZE + (s & 1) * 64) * 512; rmax = 63; }
          else { blk = c.out + O_KVS + (size_t)b * DEC_SEQ * 512; rmax = DEC_SEQ - 1; }
          const int kr = half * 32 + r32; const float* krow = blk + (size_t)(kr < rmax ? kr : rmax) * 512 + (2 * 2 + kvh) * 64 + 8 * hi;
          f32x16 S = {};
#pragma unroll
          for (int ks = 0; ks < 4; ++ks) S = wv_mfma32(wv_ld8_f32(krow + 16 * ks), qr[ks], S);
          bf16x8 vf[2][2];
#pragma unroll
          for (int ks = 0; ks < 2; ++ks) { float v0[8], v1[8];
#pragma unroll
            for (int j = 0; j < 8; ++j) { const int vr = half * 32 + 16 * ks + 8 * (j >> 2) + 4 * hi + (j & 3); const float* vp = blk + (size_t)(vr < rmax ? vr : rmax) * 512 + (3 * 2 + kvh) * 64; v0[j] = vp[r32]; v1[j] = vp[32 + r32]; }
            vf[0][ks] = wv_pack8(v0[0], v0[1], v0[2], v0[3], v0[4], v0[5], v0[6], v0[7]); vf[1][ks] = wv_pack8(v1[0], v1[1], v1[2], v1[3], v1[4], v1[5], v1[6], v1[7]); }
          soft_step(st, S, vm, vf[0][0], vf[0][1], vf[1][0], vf[1][1]);
        }
      }
    }
    soft_finish(st, gate[1], ot); }
  { SoftSt st; st.m = -3e38f; st.l = 0.f; st.o[0] = f32x16{}; st.o[1] = f32x16{};
    if (!SAMPLE) {
      const size_t bk = (size_t)b * 2 + kvh; const int lo = t0 - (WINDOW - 1) > 0 ? t0 - (WINDOW - 1) : 0;
      for (int kb = lo & ~31; kb <= pos_last; kb += 32) {
        unsigned vm = 0u;
#pragma unroll
        for (int r = 0; r < 16; ++r) { const int key = kb + crow16(r, hi); if (key <= pos && key > pos - WINDOW) vm |= 1u << r; }
        const f32x16 S = qk_tile(c.KWb + bk * SEQ * 64 + (size_t)(kb >> 5) * 2048 + lane * 8, qr);
        const bf16_t* vb = c.VWTb + bk * 64 * SEQ + (size_t)(kb >> 4) * 512 + lane * 8;
        soft_step(st, S, vm, wv_ld8(vb), wv_ld8(vb + 512), wv_ld8(vb + (size_t)(SEQ >> 4) * 512), wv_ld8(vb + (size_t)(SEQ >> 4) * 512 + 512));
      }
    } else {
      const size_t bk = (size_t)b * 2 + kvh;
      for (int kb = 0; kb < WKS; kb += 32) {
        unsigned vm = 0u;
#pragma unroll
        for (int r = 0; r < 16; ++r) { const int i = kb + crow16(r, hi); if (i >= tt + 1 && i <= WBUF + tt) vm |= 1u << r; }
        const f32x16 S = qk_tile(c.KWsb + bk * WKS * 64 + (size_t)(kb >> 5) * 2048 + lane * 8, qr);
        const bf16_t* vb = c.VWTsb + bk * 64 * WKS + (size_t)(kb >> 4) * 512 + lane * 8;
        soft_step(st, S, vm, wv_ld8(vb), wv_ld8(vb + 512), wv_ld8(vb + (size_t)(WKS >> 4) * 512), wv_ld8(vb + (size_t)(WKS >> 4) * 512 + 512));
      }
    }
    soft_finish(st, gate[2], ot); }
  bf16_t* orow = c.CAT + (size_t)m * D_MODEL + h * 64 + 4 * hi;
#pragma unroll
  for (int db = 0; db < 2; ++db)
#pragma unroll
    for (int u = 0; u < 4; ++u) { u32x2v w; w.x = wv_pk_bf16(ot[db][4 * u], ot[db][4 * u + 1]); w.y = wv_pk_bf16(ot[db][4 * u + 2], ot[db][4 * u + 3]); *(u32x2v*)(orow + db * 32 + 8 * u) = w; }
}
constexpr int NSA_UNITS_P = BATCH * 2 * (SEQ / 8), NSA_UNITS_S = DEC_BATCH * 2;
constexpr int XNT = MEM_TOKENS / 32;
HD int bb_row0(int bb) { return bb < BATCH ? bb * SEQ : MP + (bb - BATCH) * DEC_SEQ; }
struct StPackX { const Ctx& c; static constexpr long N = (long)(BATCH + DEC_BATCH) * 4 * MEM_TOKENS * 256;
  HD void operator()(long i) const {
    const int d = (int)(i % 256), j = (int)((i / 256) % MEM_TOKENS), h = (int)((i / 256 / MEM_TOKENS) % 4), bb = (int)(i / 256 / MEM_TOKENS / 4);
    const int m = bb_row0(bb); const size_t bh = (size_t)bb * 4 + h;
    c.KXb[bh * MEM_TOKENS * 256 + frag_idx(j, d, 256)] = f2bf(memkv_row(c, m, j, 0, h)[d]); c.VXTb[bh * 256 * MEM_TOKENS + frag_idx(d, vperm16(j), MEM_TOKENS)] = f2bf(memkv_row(c, m, j, 1, h)[d]);
  } };
struct StXqNormB { const Ctx& c; static constexpr long N = (long)MTOT * 4;
  HD void operator()(long i) const {
    const float* q = c.Q2 + (size_t)(i / 4) * D_MODEL + (i % 4) * 256; bf16_t* o = c.Q2b + (size_t)(i / 4) * D_MODEL + (i % 4) * 256;
    float ss = 0.f; for (int d = 0; d < 256; ++d) ss += q[d] * q[d];
    const float r = 1.f / sqrtf(ss / 256.f + EPS); for (int d = 0; d < 256; ++d) o[d] = f2bf(q[d] * r * c.xq_norm_w[d]);
  } };
constexpr int XA_UNITS_P = BATCH * 4 * (SEQ / 32), XA_UNITS_S = DEC_BATCH * 4;
template <bool SAMPLE> WV_DEV void xattn_unit(const Ctx& c, int unit) {
  const int lane = wv_lane(), r32 = lane & 31, hi = lane >> 5;
  int h, bb, m; bool valid = true;
  if (!SAMPLE) { const int tile = unit % (SEQ / 32), bh = unit / (SEQ / 32); h = bh & 3; bb = bh >> 2; m = bb * SEQ + tile * 32 + r32; }
  else { h = unit & 3; const int b = unit >> 2; bb = BATCH + b; m = MP + b * DEC_SEQ + (r32 & (DEC_SEQ - 1)); valid = r32 < DEC_SEQ; }
  const bf16_t* qrow = c.Q2b + (size_t)m * D_MODEL + h * 256 + 8 * hi;
  const bf16_t* kb = c.KXb + ((size_t)bb * 4 + h) * MEM_TOKENS * 256 + lane * 8;
  const bf16_t* vb = c.VXTb + ((size_t)bb * 4 + h) * 256 * MEM_TOKENS + lane * 8;
  f32x16 S[XNT];
#pragma unroll
  for (int t = 0; t < XNT; ++t) S[t] = f32x16{};
#pragma unroll 2
  for (int ks = 0; ks < 16; ++ks) { const bf16x8 qf = wv_ld8(qrow + 16 * ks);
#pragma unroll
    for (int t = 0; t < XNT; ++t) S[t] = wv_mfma32(wv_ld8(kb + (size_t)(t * 16 + ks) * 512), qf, S[t]); }
  constexpr float SC = 0.0625f * 1.4426950408889634f;
  float mx = -3e38f;
#pragma unroll
  for (int t = 0; t < XNT; ++t)
#pragma unroll
    for (int r = 0; r < 16; ++r) mx = fmaxf(mx, S[t][r]);
  mx = fmaxf(mx, wv_shfl_xor_f(mx, 32));
  float sum = 0.f; bf16x8 pf[XNT][2];
#pragma unroll
  for (int t = 0; t < XNT; ++t) { float p[16];
#pragma unroll
    for (int r = 0; r < 16; ++r) { p[r] = wv_exp2((S[t][r] - mx) * SC); sum += p[r]; }
    pf[t][0] = wv_pack8(p[0], p[1], p[2], p[3], p[4], p[5], p[6], p[7]); pf[t][1] = wv_pack8(p[8], p[9], p[10], p[11], p[12], p[13], p[14], p[15]); }
  sum += wv_shfl_xor_f(sum, 32);
  const float inv = wv_rcp(sum);
  bf16_t* orow = c.OX + (size_t)m * D_MODEL + h * 256 + 4 * hi;
  for (int db = 0; db < 8; ++db) { f32x16 o = {};
#pragma unroll
    for (int t = 0; t < XNT; ++t) { o = wv_mfma32(wv_ld8(vb + (size_t)(db * (MEM_TOKENS / 16) + 2 * t) * 512), pf[t][0], o); o = wv_mfma32(wv_ld8(vb + (size_t)(db * (MEM_TOKENS / 16) + 2 * t + 1) * 512), pf[t][1], o); }
    if (valid) {
#pragma unroll
      for (int u = 0; u < 4; ++u) { u32x2v w; w.x = wv_pk_bf16(o[4 * u] * inv, o[4 * u + 1] * inv); w.y = wv_pk_bf16(o[4 * u + 2] * inv, o[4 * u + 3] * inv); *(u32x2v*)(orow + db * 32 + 8 * u) = w; } }
  }
}
constexpr int NCH = SEQ / 64;
constexpr int NCHUNK_P = BATCH * 4 * NCH, NCHUNK = NCHUNK_P + DEC_BATCH * 4;
constexpr int GDN_PREP_UNITS = NCHUNK * 4, GDN_SCAN_UNITS = (BATCH + DEC_BATCH) * 4 * 4;
constexpr int GDN_WSCR_FLOATS = 64 * 64 + 128;
HD void chunk_decode(int ch, int& b, int& h, int& m0, int& nvalid) {
  if (ch < NCHUNK_P) { const int n = ch % NCH, bh = ch / NCH; h = bh & 3; b = bh >> 2; m0 = b * SEQ + n * 64; nvalid = 64; }
  else { const int r = ch - NCHUNK_P; h = r & 3; b = r >> 2; m0 = MP + b * DEC_SEQ; nvalid = DEC_SEQ; }
}
HD size_t acc_idx(int ch, int i, int col) { const int il = i & 31; return ((((size_t)ch * 4 + (col >> 5)) * 2 + (i >> 5)) * 64 + ((il >> 2) & 1) * 32 + (col & 31)) * 16 + (il & 3) + 4 * (il >> 3); }
WV_DEV bf16x8 ldrow8(const float* buf, int m0, int i, int nvalid, int off) {
  return wv_ld8_f32(buf + (size_t)(m0 + (i < nvalid ? i : nvalid - 1)) * 512 + off);
}
WV_DEV void gdn_prep_unit(const Ctx& c, int unit, float* wscr) {
  const int lane = wv_lane(), r32 = lane & 31, hi = lane >> 5, ch = unit >> 2, quarter = unit & 3;
  int b, h, m0, nvalid; chunk_decode(ch, b, h, m0, nvalid);
  float* At = wscr; float* gcs = wscr + 4096; float* bts = wscr + 4160;
  const float gi = lane < nvalid ? c.GG[(size_t)(m0 + lane) * 4 + h] : 0.f, bi = lane < nvalid ? c.GB[(size_t)(m0 + lane) * 4 + h] : 0.f;
  float gc = gi;
#pragma unroll
  for (int off = 1; off < 64; off <<= 1) { const float t = __builtin_bit_cast(float, wv_shfl_u(__builtin_bit_cast(unsigned, gc), lane - off)); if (lane >= off) gc += t; }
  gcs[lane] = gc; bts[lane] = bi;
  const float g_last = __builtin_bit_cast(float, wv_shfl_u(__builtin_bit_cast(unsigned, gc), 63));
  wv_fence();
#pragma unroll 1
  for (int bp = 0; bp < 3; ++bp) { const int ib = bp == 0 ? 0 : 1, jb = bp == 2 ? 1 : 0;
    f32x16 S = {};
#pragma unroll 2
    for (int ks = 0; ks < 8; ++ks) S = wv_mfma32(ldrow8(c.GK, m0, ib * 32 + r32, nvalid, h * 128 + 16 * ks + 8 * hi), ldrow8(c.GK, m0, jb * 32 + r32, nvalid, h * 128 + 16 * ks + 8 * hi), S);
    const int j = jb * 32 + r32; const float gcj = gcs[j];
#pragma unroll
    for (int r = 0; r < 16; ++r) { const int i = ib * 32 + crow16(r, hi); At[j * 64 + i] = (j < i) ? bts[i] * S[r] * expf(gcs[i] - gcj) : 0.f; }
  }
#pragma unroll
  for (int r = 0; r < 16; ++r) At[(32 + r32) * 64 + crow16(r, hi)] = 0.f;
  wv_fence();
  { const int col = quarter * 64 + lane; const bool isu = col < 128; const int dcol = isu ? col : col - 128; const float* src = isu ? c.GV : c.GK;
    const int slot = vperm16(dcol);
#pragma unroll 1
    for (int rb = 0; rb < 4; ++rb) {
      float acc[16];
#pragma unroll
      for (int i = 0; i < 16; ++i) { const int row = rb * 16 + i; const float x = row < nvalid ? src[(size_t)(m0 + row) * 512 + h * 128 + dcol] : 0.f; acc[i] = x * bts[row] * (isu ? 1.f : expf(gcs[row])); }
      for (int j = 0; j < rb * 16; ++j) { const float sj = isu ? c.GS[acc_idx(ch, j, dcol)] : c.GSW[((size_t)ch * 64 + j) * 128 + dcol]; const float* at = At + j * 64 + rb * 16;
#pragma unroll
        for (int i = 0; i < 16; ++i) acc[i] -= at[i] * sj; }
#pragma unroll
      for (int j = 0; j < 16; ++j) { const float sj = acc[j]; const float* at = At + (rb * 16 + j) * 64 + rb * 16;
#pragma unroll
        for (int i = 0; i < 16; ++i) if (i > j) acc[i] -= at[i] * sj; }
#pragma unroll
      for (int i = 0; i < 16; ++i) { if (isu) c.GS[acc_idx(ch, rb * 16 + i, dcol)] = acc[i]; else { c.GSW[((size_t)ch * 64 + rb * 16 + i) * 128 + dcol] = acc[i]; c.GWp[(size_t)ch * 8192 + frag_idx(rb * 16 + i, slot, 128)] = f2bf(-acc[i]); } }
      wv_fence();
    }
  }
  if (quarter == 0) {
#pragma unroll 1
    for (int bp = 0; bp < 3; ++bp) { const int ib = bp == 0 ? 0 : 1, jb = bp == 2 ? 1 : 0;
      f32x16 S = {};
#pragma unroll 2
      for (int ks = 0; ks < 8; ++ks) S = wv_mfma32(ldrow8(c.GQ, m0, ib * 32 + r32, nvalid, h * 128 + 16 * ks + 8 * hi), ldrow8(c.GK, m0, jb * 32 + r32, nvalid, h * 128 + 16 * ks + 8 * hi), S);
      const int j = jb * 32 + r32; const float gcj = gcs[j]; const int slot = vperm16(j);
#pragma unroll
      for (int r = 0; r < 16; ++r) { const int i = ib * 32 + crow16(r, hi); c.GQKp[(size_t)ch * 4096 + frag_idx(i, slot, 64)] = f2bf((j <= i) ? S[r] * expf(gcs[i] - gcj) : 0.f); }
    }
  } else if (quarter == 1) {
    const float e = expf(gc); const float* q = c.GQ + (size_t)(m0 + lane) * 512 + h * 128;
#pragma unroll
    for (int g16 = 0; g16 < 8; ++g16)
#pragma unroll
      for (int h2 = 0; h2 < 2; ++h2) { f32x4v lo = {0.f, 0.f, 0.f, 0.f}, hv = {0.f, 0.f, 0.f, 0.f};
        if (lane < nvalid) { lo = *(const f32x4v*)(q + g16 * 16 + 4 * h2); hv = *(const f32x4v*)(q + g16 * 16 + 8 + 4 * h2); }
        *(bf16x8*)(c.GQDp + (size_t)ch * 8192 + frag_idx(lane, g16 * 16 + h2 * 8, 128)) = wv_pack8(lo.x * e, lo.y * e, lo.z * e, lo.w * e, hv.x * e, hv.y * e, hv.z * e, hv.w * e); }
  } else if (quarter == 2) {
#pragma unroll 1
    for (int pass = 0; pass < 2; ++pass) { const int dk = lane + 64 * pass; const float* kcol = c.GK + (size_t)m0 * 512 + h * 128 + 64 * pass;
#pragma unroll 1
      for (int g8 = 0; g8 < 8; ++g8) { const int g16 = g8 >> 1, h2 = g8 & 1; float v[8];
#pragma unroll
        for (int j = 0; j < 8; ++j) { const int i = g16 * 16 + 8 * (j >> 2) + 4 * h2 + (j & 3); v[j] = (kcol + (i < nvalid ? i : nvalid - 1) * 512)[(unsigned)lane] * expf(g_last - gcs[i]); }
        *(bf16x8*)(c.GKDTp + (size_t)ch * 8192 + frag_idx(dk, g16 * 16 + h2 * 8, 64)) = wv_pack8(v[0], v[1], v[2], v[3], v[4], v[5], v[6], v[7]); } }
  } else { if (lane == 0) c.GL[ch] = g_last; }
  wv_fence();
}
WV_DEV void tri_solve32(float (&acc)[32], const float* At, int base) {
#pragma unroll
  for (int j = 0; j < 31; ++j) { const float xj = acc[j]; const float* at = At + (base + j) * 64 + base;
#pragma unroll
    for (int i = 0; i < 32; ++i) if (i > j) acc[i] -= at[i] * xj;
    GDN_FENCE(); }
}
constexpr int GDN_PREP2_UNITS = NCHUNK;
WV_DEV void gdn_prep2_unit(const Ctx& c, int ch, float* wscr) {
  const int lane = wv_lane_opaque(), r32 = lane & 31, hi = lane >> 5;
  int b, h, m0, nvalid; chunk_decode(ch, b, h, m0, nvalid);
  float* At = wscr; float* gcs = wscr + 4096; float* bts = wscr + 4160;
#pragma unroll 1
  for (int tq = 0; tq < 4; ++tq) { const float* srow = (tq < 2 ? c.GK : c.GV) + (size_t)m0 * 512 + h * 128 + (tq & 1) * 64; float* dcol_ = (tq < 2 ? c.GKt : c.GVt) + ((size_t)ch * 128 + (tq & 1) * 64 + lane) * 64;
#pragma unroll 1
    for (int i0 = 0; i0 < 64; i0 += 16) { float v[16];
#pragma unroll
      for (int i = 0; i < 16; ++i) { const int ir = (i0 + i) < nvalid ? i0 + i : nvalid - 1; v[i] = (srow + ir * 512)[(unsigned)lane]; }
#pragma unroll
      for (int i4 = 0; i4 < 4; ++i4) *(f32x4v*)(dcol_ + i0 + 4 * i4) = f32x4v{v[4 * i4], v[4 * i4 + 1], v[4 * i4 + 2], v[4 * i4 + 3]}; } }
  const float gi = lane < nvalid ? c.GG[(size_t)(m0 + lane) * 4 + h] : 0.f, bi = lane < nvalid ? c.GB[(size_t)(m0 + lane) * 4 + h] : 0.f;
  float gc = gi;
#pragma unroll
  for (int off = 1; off < 64; off <<= 1) { const float t = __builtin_bit_cast(float, wv_shfl_u(__builtin_bit_cast(unsigned, gc), lane - off)); if (lane >= off) gc += t; }
  gcs[lane] = gc; bts[lane] = bi;
  const float g_last = __builtin_bit_cast(float, wv_shfl_u(__builtin_bit_cast(unsigned, gc), 63));
  if (lane == 0) c.GL[ch] = g_last;
  wv_fence();
#pragma unroll 1
  for (int bp = 0; bp < 3; ++bp) { const int ib = bp == 0 ? 0 : 1, jb = bp == 2 ? 1 : 0;
    f32x16 Sk = {}, Sq = {};
#pragma unroll 2
    for (int ks = 0; ks < 8; ++ks) { const bf16x8 kj = ldrow8(c.GK, m0, jb * 32 + r32, nvalid, h * 128 + 16 * ks + 8 * hi);
      Sk = wv_mfma32(ldrow8(c.GK, m0, ib * 32 + r32, nvalid, h * 128 + 16 * ks + 8 * hi), kj, Sk); Sq = wv_mfma32(ldrow8(c.GQ, m0, ib * 32 + r32, nvalid, h * 128 + 16 * ks + 8 * hi), kj, Sq); }
    const int j = jb * 32 + r32; const float gcj = gcs[j]; const int slot = vperm16(j);
#pragma unroll
    for (int r = 0; r < 16; ++r) { const int i = ib * 32 + crow16(r, hi); const float dec = expf(gcs[i] - gcj);
      At[j * 64 + i] = (j < i) ? bts[i] * Sk[r] * dec : 0.f; c.GQKp[(size_t)ch * 4096 + frag_idx(i, slot, 64)] = f2bf((j <= i) ? Sq[r] * dec : 0.f); }
  }
  { const float e = expf(gc); const float* q = c.GQ + (size_t)(m0 + (lane < nvalid ? lane : nvalid - 1)) * 512 + h * 128;
#pragma unroll 2
    for (int g8 = 0; g8 < 16; ++g8) { const int g16 = g8 >> 1, h2 = g8 & 1; f32x4v lo = {0.f, 0.f, 0.f, 0.f}, hv = {0.f, 0.f, 0.f, 0.f};
      lo = *(const f32x4v*)(q + g16 * 16 + 4 * h2); hv = *(const f32x4v*)(q + g16 * 16 + 8 + 4 * h2);
      *(bf16x8*)(c.GQDp + (size_t)ch * 8192 + frag_idx(lane, g16 * 16 + h2 * 8, 128)) = wv_pack8(lo.x * e, lo.y * e, lo.z * e, lo.w * e, hv.x * e, hv.y * e, hv.z * e, hv.w * e); } }
#pragma unroll 1
  for (int pass = 0; pass < 2; ++pass) { const int dk = lane + 64 * pass; const float* kc = c.GKt + ((size_t)ch * 128 + dk) * 64;
#pragma unroll 2
    for (int g8 = 0; g8 < 8; ++g8) { const int g16 = g8 >> 1, h2 = g8 & 1; const f32x4v lo = *(const f32x4v*)(kc + g16 * 16 + 4 * h2), hv = *(const f32x4v*)(kc + g16 * 16 + 8 + 4 * h2);
      const int i0 = g16 * 16 + 4 * h2;
      *(bf16x8*)(c.GKDTp + (size_t)ch * 8192 + frag_idx(dk, g16 * 16 + h2 * 8, 64)) = wv_pack8(lo.x * expf(g_last - gcs[i0]), lo.y * expf(g_last - gcs[i0 + 1]), lo.z * expf(g_last - gcs[i0 + 2]), lo.w * expf(g_last - gcs[i0 + 3]),
                                                                                                hv.x * expf(g_last - gcs[i0 + 8]), hv.y * expf(g_last - gcs[i0 + 9]), hv.z * expf(g_last - gcs[i0 + 10]), hv.w * expf(g_last - gcs[i0 + 11])); } }
  wv_fence();
  bf16x8 a10[2];
#pragma unroll
  for (int s = 0; s < 2; ++s) { float t[8];
#pragma unroll
    for (int jj = 0; jj < 8; ++jj) t[jj] = At[(16 * s + 8 * hi + jj) * 64 + 32 + r32];
    a10[s] = wv_pack8(t[0], t[1], t[2], t[3], t[4], t[5], t[6], t[7]); }
#pragma unroll 1
  for (int cg = 0; cg < 8; ++cg) { const bool isu = cg < 4; const int dcol = (cg & 3) * 32 + r32; const float* colp = (isu ? c.GVt : c.GKt) + ((size_t)ch * 128 + dcol) * 64;
    float x0[32], x1[32];
#pragma unroll
    for (int i4 = 0; i4 < 8; ++i4) { const f32x4v t = *(const f32x4v*)(colp + 4 * i4); x0[4 * i4] = t.x; x0[4 * i4 + 1] = t.y; x0[4 * i4 + 2] = t.z; x0[4 * i4 + 3] = t.w; }
#pragma unroll
    for (int i = 0; i < 32; ++i) x0[i] = x0[i] * bts[i] * (isu ? 1.f : expf(gcs[i]));
    tri_solve32(x0, At, 0);
    GDN_FENCE();
    f32x16 D = {};
#pragma unroll
    for (int s = 0; s < 2; ++s) { const bf16x8 bfr = hi ? wv_pack8(x0[16 * s + 8], x0[16 * s + 9], x0[16 * s + 10], x0[16 * s + 11], x0[16 * s + 12], x0[16 * s + 13], x0[16 * s + 14], x0[16 * s + 15])
                                                        : wv_pack8(x0[16 * s], x0[16 * s + 1], x0[16 * s + 2], x0[16 * s + 3], x0[16 * s + 4], x0[16 * s + 5], x0[16 * s + 6], x0[16 * s + 7]);
      D = wv_mfma32(a10[s], bfr, D); }
#pragma unroll
    for (int i4 = 0; i4 < 8; ++i4) { const f32x4v t = *(const f32x4v*)(colp + 32 + 4 * i4); x1[4 * i4] = t.x; x1[4 * i4 + 1] = t.y; x1[4 * i4 + 2] = t.z; x1[4 * i4 + 3] = t.w; }
#pragma unroll
    for (int i = 0; i < 32; ++i) x1[i] = x1[i] * bts[32 + i] * (isu ? 1.f : expf(gcs[32 + i]));
#pragma unroll
    for (int r = 0; r < 16; ++r) { const float oth = wv_shfl_xor_f(D[r], 32);
      const int rme = (r & 3) + 8 * (r >> 2); x1[rme + 4] -= hi ? D[r] : oth; x1[rme] -= hi ? oth : D[r]; }
    GDN_FENCE();
    tri_solve32(x1, At, 32);
    if (isu) { float* gu = c.GS + (((size_t)ch * 4 + (cg & 3)) * 2) * 1024 + lane * 16;
#pragma unroll
      for (int r4 = 0; r4 < 4; ++r4) { const int rb_ = 8 * r4;
        *(f32x4v*)(gu + 4 * r4) = hi ? f32x4v{x0[rb_ + 4], x0[rb_ + 5], x0[rb_ + 6], x0[rb_ + 7]} : f32x4v{x0[rb_], x0[rb_ + 1], x0[rb_ + 2], x0[rb_ + 3]};
        *(f32x4v*)(gu + 1024 + 4 * r4) = hi ? f32x4v{x1[rb_ + 4], x1[rb_ + 5], x1[rb_ + 6], x1[rb_ + 7]} : f32x4v{x1[rb_], x1[rb_ + 1], x1[rb_ + 2], x1[rb_ + 3]}; }
    } else { const int slot = vperm16(dcol); bf16_t* wq = c.GWp + (size_t)ch * 8192;
      const unsigned lpart = (unsigned)frag_idx(4 * hi, slot, 128);
#pragma unroll
      for (int r = 0; r < 16; ++r) { const int row = (r & 3) + 8 * (r >> 2); const float a0 = hi ? x0[row + 4] : x0[row], a1 = hi ? x1[row + 4] : x1[row];
        wq[lpart + (unsigned)(row * 8)] = f2bf(-a0); wq[lpart + (unsigned)(row * 8 + 8 * 512)] = f2bf(-a1); }
    }
  }
  wv_fence();
}
WV_DEV float warm_lines(const void* base, int nlines, size_t pitch, int lane) { float acc = 0.f; for (int k = lane; k < nlines; k += 64) acc += *(const float*)((const char*)base + (size_t)k * pitch); return acc; }
WV_DEV void gdn_scan_unit(const Ctx& c, int unit) {
  const int lane = wv_lane(), r32 = lane & 31, hi = lane >> 5, bbh = unit >> 2, dv0 = (unit & 3) * 32;
  const bool sample = bbh >= BATCH * 4; const int idx = sample ? bbh - BATCH * 4 : bbh, b = idx >> 2, h = idx & 3;
  const int nch = sample ? 1 : NCH, chunk0 = sample ? NCHUNK_P + idx : idx * NCH, nvalid = sample ? DEC_SEQ : 64;
  f32x16 S[4]; const unsigned lst = (unsigned)(hi * 4 * 128 + r32);
#pragma unroll
  for (int kb = 0; kb < 4; ++kb)
#pragma unroll
    for (int r = 0; r < 16; ++r) S[kb][r] = sample ? (c.state_gdn + (((size_t)b * 4 + h) * 128 + kb * 32 + crow16(r, 0)) * 128 + dv0)[lst] : 0.f;
  f32x16 vn[2]; bf16x8 fa[16]; const unsigned l8 = (unsigned)lane * 8u, l16 = (unsigned)lane * 16u;
#define GDN_LOAD_B1(CH) do { const size_t ch_ = (size_t)(CH); \
    _Pragma("unroll") for (int cb = 0; cb < 2; ++cb) { \
      { const float* gu_ = c.GS + ((ch_ * 4 + (dv0 >> 5)) * 2 + cb) * 1024; _Pragma("unroll") for (int r4 = 0; r4 < 4; ++r4) { const f32x4v t_ = *(const f32x4v*)(gu_ + l16 + 4 * r4); vn[cb][4 * r4] = t_.x; vn[cb][4 * r4 + 1] = t_.y; vn[cb][4 * r4 + 2] = t_.z; vn[cb][4 * r4 + 3] = t_.w; } } \
      _Pragma("unroll") for (int q = 0; q < 8; ++q) fa[cb * 8 + q] = wv_ld8(c.GWp + ch_ * 8192 + (cb * 8 + q) * 512 + l8); } } while (0)
  GDN_LOAD_B1(chunk0);
  for (int n = 0; n < nch; ++n) { const int ch = chunk0 + n;
#define GDN_SF(KB, SS) wv_pack8(S[KB][8 * (SS)], S[KB][8 * (SS) + 1], S[KB][8 * (SS) + 2], S[KB][8 * (SS) + 3], S[KB][8 * (SS) + 4], S[KB][8 * (SS) + 5], S[KB][8 * (SS) + 6], S[KB][8 * (SS) + 7])
#pragma unroll
    for (int kb = 0; kb < 4; ++kb) { const bf16x8 s0 = GDN_SF(kb, 0), s1 = GDN_SF(kb, 1);
#pragma unroll
      for (int cb = 0; cb < 2; ++cb) { vn[cb] = wv_mfma32(fa[cb * 8 + kb * 2], s0, vn[cb]); vn[cb] = wv_mfma32(fa[cb * 8 + kb * 2 + 1], s1, vn[cb]); } }
    WV_SCHED_BARRIER();
#pragma unroll
    for (int cb = 0; cb < 2; ++cb)
#pragma unroll
      for (int q = 0; q < 8; ++q) fa[cb * 8 + q] = wv_ld8(c.GQDp + (size_t)ch * 8192 + (cb * 8 + q) * 512 + l8);
    WV_SCHED_BARRIER();
    f32x16 o[2]; o[0] = f32x16{}; o[1] = f32x16{};
#pragma unroll
    for (int kb = 0; kb < 4; ++kb) { const bf16x8 s0 = GDN_SF(kb, 0), s1 = GDN_SF(kb, 1);
#pragma unroll
      for (int cb = 0; cb < 2; ++cb) { o[cb] = wv_mfma32(fa[cb * 8 + kb * 2], s0, o[cb]); o[cb] = wv_mfma32(fa[cb * 8 + kb * 2 + 1], s1, o[cb]); } }
    WV_SCHED_BARRIER();
#undef GDN_SF
    bf16x8 vf[2][2];
#pragma unroll
    for (int kc = 0; kc < 2; ++kc)
#pragma unroll
      for (int s = 0; s < 2; ++s) vf[kc][s] = wv_pack8(vn[kc][8 * s], vn[kc][8 * s + 1], vn[kc][8 * s + 2], vn[kc][8 * s + 3], vn[kc][8 * s + 4], vn[kc][8 * s + 5], vn[kc][8 * s + 6], vn[kc][8 * s + 7]);
    WV_SCHED_BARRIER();
    bf16x8 fq[6];
#pragma unroll
    for (int bp = 0; bp < 3; ++bp) { const int cb = bp == 0 ? 0 : 1, kc = bp == 2 ? 1 : 0; const bf16_t* arow = c.GQKp + (size_t)ch * 4096 + (cb * 4 + kc * 2) * 512; fq[2 * bp] = wv_ld8(arow + l8); fq[2 * bp + 1] = wv_ld8(arow + 512 + l8); }
#pragma unroll
    for (int kb = 0; kb < 4; ++kb)
#pragma unroll
      for (int q = 0; q < 4; ++q) fa[kb * 4 + q] = wv_ld8(c.GKDTp + (size_t)ch * 8192 + (kb * 4 + q) * 512 + l8);
    const float e = expf(c.GL[ch]);
    WV_SCHED_BARRIER();
#pragma unroll
    for (int bp = 0; bp < 3; ++bp) { const int cb = bp == 0 ? 0 : 1, kc = bp == 2 ? 1 : 0; o[cb] = wv_mfma32(fq[2 * bp], vf[kc][0], o[cb]); o[cb] = wv_mfma32(fq[2 * bp + 1], vf[kc][1], o[cb]); }
#pragma unroll
    for (int cb = 0; cb < 2; ++cb) { float* ou = c.OG + (((size_t)ch * 4 + (dv0 >> 5)) * 2 + cb) * 1024;
#pragma unroll
      for (int r4 = 0; r4 < 4; ++r4) *(f32x4v*)(ou + l16 + 4 * r4) = f32x4v{o[cb][4 * r4], o[cb][4 * r4 + 1], o[cb][4 * r4 + 2], o[cb][4 * r4 + 3]}; }
    WV_SCHED_BARRIER();
#pragma unroll
    for (int kb = 0; kb < 4; ++kb) { S[kb] = S[kb] * e;
#pragma unroll
      for (int q = 0; q < 4; ++q) S[kb] = wv_mfma32(fa[kb * 4 + q], vf[q >> 1][q & 1], S[kb]); }
    WV_SCHED_BARRIER();
    if (n + 1 < nch) GDN_LOAD_B1(ch + 1);
  }
#undef GDN_LOAD_B1
  float* so = c.out + (sample ? O_STS : O_STP) + ((size_t)b * 4 + h) * 128 * 128;
#pragma unroll
  for (int kb = 0; kb < 4; ++kb)
#pragma unroll
    for (int r = 0; r < 16; ++r) (so + (size_t)(kb * 32 + crow16(r, 0)) * 128 + dv0)[lst] = S[kb][r];
}
WV_DEV float wv_allsum(float v) {
#pragma unroll
  for (int o = 1; o < 64; o <<= 1) v += wv_shfl_xor_f(v, o);
  return v;
}
WV_DEV void st_pk4(bf16_t* p, f32x4v v) { u32x2v w; w.x = wv_pk_bf16(v.x, v.y); w.y = wv_pk_bf16(v.z, v.w); *(u32x2v*)p = w; }
WV_DEV void rms_row_unit(const float* src, const float* w, bf16_t* dst) {
  const int lane = wv_lane(); f32x4v v[4]; float ss = 0.f;
#pragma unroll
  for (int j = 0; j < 4; ++j) { v[j] = *(const f32x4v*)(src + lane * 4 + 256 * j); ss += (v[j].x * v[j].x + v[j].y * v[j].y) + (v[j].z * v[j].z + v[j].w * v[j].w); }
  ss = wv_allsum(ss); const float r = 1.f / sqrtf(ss / D_MODEL + EPS);
#pragma unroll
  for (int j = 0; j < 4; ++j) { const f32x4v ww = *(const f32x4v*)(w + lane * 4 + 256 * j); st_pk4(dst + lane * 4 + 256 * j, v[j] * ww * r); }
}
WV_DEV void xq_norm_unit(const Ctx& c, int m) {
  const int lane = wv_lane(); const float* q = c.Q2 + (size_t)m * D_MODEL + lane * 16; f32x4v v[4]; float ss = 0.f;
#pragma unroll
  for (int j = 0; j < 4; ++j) { v[j] = *(const f32x4v*)(q + 4 * j); ss += (v[j].x * v[j].x + v[j].y * v[j].y) + (v[j].z * v[j].z + v[j].w * v[j].w); }
  ss += wv_shfl_xor_f(ss, 1); ss += wv_shfl_xor_f(ss, 2); ss += wv_shfl_xor_f(ss, 4); ss += wv_shfl_xor_f(ss, 8);
  const float r = 1.f / sqrtf(ss / 256.f + EPS); const float* w = c.xq_norm_w + (lane & 15) * 16;
#pragma unroll
  for (int j = 0; j < 4; ++j) { const f32x4v ww = *(const f32x4v*)(w + 4 * j); st_pk4(c.Q2b + (size_t)m * D_MODEL + lane * 16 + 4 * j, v[j] * ww * r); }
}
WV_DEV void gdn_norm_unit(const Ctx& c, int m) {
  const int lane = wv_lane(); const float* z = c.P + (size_t)m * LDP + OFF_Z + lane * 8; const int hh = lane >> 4, dv = (lane & 15) * 8;
  int ch, i; if (m < MP) { const int bq = m / SEQ, t = m % SEQ; ch = (bq * 4 + hh) * (SEQ / 64) + t / 64; i = t % 64; } else { ch = BATCH * 4 * (SEQ / 64) + ((m - MP) / DEC_SEQ) * 4 + hh; i = (m - MP) % DEC_SEQ; }
  const float* og = c.OG + acc_idx(ch, i, dv);
  const f32x4v a = {og[0], og[16], og[32], og[48]}, b = {og[64], og[80], og[96], og[112]}; float ss = (a.x * a.x + a.y * a.y) + (a.z * a.z + a.w * a.w) + (b.x * b.x + b.y * b.y) + (b.z * b.z + b.w * b.w);
  ss += wv_shfl_xor_f(ss, 1); ss += wv_shfl_xor_f(ss, 2); ss += wv_shfl_xor_f(ss, 4); ss += wv_shfl_xor_f(ss, 8);
  const float r = 1.f / sqrtf(ss / 128.f + EPS); const float* w = c.gdn_norm_w + (lane & 15) * 8;
  const f32x4v za = *(const f32x4v*)z, zb = *(const f32x4v*)(z + 4), wa = *(const f32x4v*)w, wb = *(const f32x4v*)(w + 4);
  *(bf16x8*)(c.CAT + (size_t)m * D_MODEL + 512 + lane * 8) = wv_pack8(a.x * r * wa.x * siluf_(za.x), a.y * r * wa.y * siluf_(za.y), a.z * r * wa.z * siluf_(za.z), a.w * r * wa.w * siluf_(za.w),
                                                                          b.x * r * wb.x * siluf_(zb.x), b.y * r * wb.y * siluf_(zb.y), b.z * r * wb.z * siluf_(zb.z), b.w * r * wb.w * siluf_(zb.w));
}
WV_DEV void postproc_unit(const Ctx& c, int m) {
  const int lane = wv_lane(), j = lane & 7; const float* p = c.P + (size_t)m * LDP; const int pos = row_pos(m);
  float cs[8], sn[8];
#pragma unroll
  for (int i = 0; i < 8; ++i) { const float inv = powf(10000.f, -(float)((8 * j + i) & 31) / 32.f), ang = (float)pos * inv; cs[i] = cosf(ang); sn[i] = sinf(ang); }
  const bool lowhalf = j < 4;
  { const int h = lane >> 3; const f32x4v a = *(const f32x4v*)(p + h * 64 + j * 8), b = *(const f32x4v*)(p + h * 64 + j * 8 + 4);
    float x[8] = {a.x, a.y, a.z, a.w, b.x, b.y, b.z, b.w}; float ss = 0.f;
#pragma unroll
    for (int i = 0; i < 8; ++i) ss += x[i] * x[i];
    ss += wv_shfl_xor_f(ss, 1); ss += wv_shfl_xor_f(ss, 2); ss += wv_shfl_xor_f(ss, 4);
    const float r = 1.f / sqrtf(ss / 64.f + EPS); float o[8];
#pragma unroll
    for (int i = 0; i < 8; ++i) x[i] = x[i] * r * c.nsa_q_norm_w[j * 8 + i];
#pragma unroll
    for (int i = 0; i < 8; ++i) { const float pa = wv_shfl_xor_f(x[i], 4); o[i] = lowhalf ? x[i] * cs[i] - pa * sn[i] : pa * sn[i] + x[i] * cs[i]; }
    *(bf16x8*)(c.QCb + (size_t)m * 512 + h * 64 + j * 8) = wv_pack8(x[0], x[1], x[2], x[3], x[4], x[5], x[6], x[7]);
    *(bf16x8*)(c.QRb + (size_t)m * 512 + h * 64 + j * 8) = wv_pack8(o[0], o[1], o[2], o[3], o[4], o[5], o[6], o[7]); }
#pragma unroll
  for (int pass = 0; pass < 2; ++pass) {
    const int s = pass * 8 + (lane >> 3); const bool act = s < 12; const int sc = act ? s : 11, kv = (sc >> 1) & 1, br = sc >> 2, kvh = sc & 1;
    const f32x4v a = *(const f32x4v*)(p + OFF_KV + sc * 64 + j * 8), b = *(const f32x4v*)(p + OFF_KV + sc * 64 + j * 8 + 4);
    float x[8] = {a.x, a.y, a.z, a.w, b.x, b.y, b.z, b.w}; float ss = 0.f;
#pragma unroll
    for (int i = 0; i < 8; ++i) ss += x[i] * x[i];
    ss += wv_shfl_xor_f(ss, 1); ss += wv_shfl_xor_f(ss, 2); ss += wv_shfl_xor_f(ss, 4);
    const float r = 1.f / sqrtf(ss / 64.f + EPS);
    if (kv == 0) {
#pragma unroll
      for (int i = 0; i < 8; ++i) x[i] = x[i] * r * c.nsa_k_norm_w[br * 64 + j * 8 + i]; }
    float o[8];
#pragma unroll
    for (int i = 0; i < 8; ++i) { const float pa = wv_shfl_xor_f(x[i], 4); o[i] = (kv == 0 && br >= 1) ? (lowhalf ? x[i] * cs[i] - pa * sn[i] : pa * sn[i] + x[i] * cs[i]) : x[i]; }
    if (act) {
      float* dst = sc < 8 ? kvrow_out(c, m) + sc * 64 + j * 8 : c.WR + (size_t)m * 256 + (sc - 8) * 64 + j * 8;
      *(f32x4v*)dst = f32x4v{o[0], o[1], o[2], o[3]}; *(f32x4v*)(dst + 4) = f32x4v{o[4], o[5], o[6], o[7]};
      if (kv == 0 && br >= 1 && m < MP) { bf16_t* kb = (br == 1 ? c.KSb : c.KWb) + ((size_t)(m / SEQ) * 2 + kvh) * SEQ * 64 + frag_idx(m % SEQ, j * 8, 64);
        *(bf16x8*)kb = wv_pack8(o[0], o[1], o[2], o[3], o[4], o[5], o[6], o[7]); }
    }
  }
  if (lane < 24) c.GATE[(size_t)m * 24 + lane] = sigmoidf_(p[OFF_GATE + lane]);
  if (lane < 4) { c.GB[(size_t)m * 4 + lane] = sigmoidf_(p[OFF_B + lane]); c.GG[(size_t)m * 4 + lane] = -expf(c.gdn_a_log[lane]) * softplusf_(p[OFF_A + lane] + c.gdn_dt_bias[lane]); }
}
WV_DEV void gdn_conv_unit(const Ctx& c, int m) {
  const int lane = wv_lane(); const int t = row_t(m);
#pragma unroll
  for (int seg = 0; seg < 3; ++seg) { const int ch = seg * 512 + lane * 8; float y[8] = {0.f, 0.f, 0.f, 0.f, 0.f, 0.f, 0.f, 0.f};
#pragma unroll
    for (int k = 0; k < 4; ++k) { const int back = 3 - k; const float* src;
      if (t - back >= 0) src = c.P + (size_t)(m - back) * LDP + OFF_QKV + ch;
      else if (m >= MP) src = c.cache_gdn_conv + ((size_t)((m - MP) / DEC_SEQ) * 3 + (3 + t - back)) * 1536 + ch;
      else src = nullptr;
      if (src) { const f32x4v a = *(const f32x4v*)src, b = *(const f32x4v*)(src + 4), wa = *(const f32x4v*)(c.gdn_conv_w + k * 1536 + ch), wb = *(const f32x4v*)(c.gdn_conv_w + k * 1536 + ch + 4);
        y[0] += wa.x * a.x; y[1] += wa.y * a.y; y[2] += wa.z * a.z; y[3] += wa.w * a.w; y[4] += wb.x * b.x; y[5] += wb.y * b.y; y[6] += wb.z * b.z; y[7] += wb.w * b.w; } }
    float ss = 0.f;
#pragma unroll
    for (int i = 0; i < 8; ++i) { y[i] = siluf_(y[i]); ss += y[i] * y[i]; }
    ss += wv_shfl_xor_f(ss, 1); ss += wv_shfl_xor_f(ss, 2); ss += wv_shfl_xor_f(ss, 4); ss += wv_shfl_xor_f(ss, 8);
    const float r = seg == 2 ? 1.f : (1.f / sqrtf(ss + EPS)) * (seg == 0 ? 0.08838834764831845f : 1.f);
    float* dst = (seg == 0 ? c.GQ : seg == 1 ? c.GK : c.GV) + (size_t)m * 512 + lane * 8;
    *(f32x4v*)dst = f32x4v{y[0] * r, y[1] * r, y[2] * r, y[3] * r}; *(f32x4v*)(dst + 4) = f32x4v{y[4] * r, y[5] * r, y[6] * r, y[7] * r};
  }
}
constexpr int VT_UNITS = 2 * BATCH * 2 * (SEQ / 16);
WV_DEV void vt_unit(const Ctx& c, int unit) {
  const int lane = wv_lane(); const int g16 = unit % (SEQ / 16); int r = unit / (SEQ / 16); const int kvh = r & 1; r >>= 1; const int b = r % BATCH, img = r / BATCH;
  const int col = OFF_KV + (((img + 1) * 2 + 1) * 2 + kvh) * 64 + lane; const float* src = c.P + ((size_t)b * SEQ + g16 * 16) * LDP + col; float v[16];
#pragma unroll
  for (int i = 0; i < 16; ++i) v[i] = src[(size_t)i * LDP];
  bf16_t* dst = (img == 0 ? c.VSTb : c.VWTb) + ((size_t)b * 2 + kvh) * 64 * SEQ;
  *(bf16x8*)(dst + frag_idx(lane, g16 * 16, SEQ)) = wv_pack8(v[0], v[1], v[2], v[3], v[8], v[9], v[10], v[11]); *(bf16x8*)(dst + frag_idx(lane, g16 * 16 + 8, SEQ)) = wv_pack8(v[4], v[5], v[6], v[7], v[12], v[13], v[14], v[15]);
}
constexpr int NCHK_P = SEQ / 16, NCHK_S = PAST_LEN / 16;
constexpr int CMP_UNITS_P = 2 * BATCH * 2 * (NCHK_P / 32), CMP_UNITS_S = 2 * DEC_BATCH * 2 * (NCHK_S / 32);
HD size_t pp_off(bool sample, int kv, int bk  , int n) {
  return sample ? ((size_t)2 * BATCH * 2 * NCHK_P + ((size_t)(kv * DEC_BATCH * 2 + bk)) * NCHK_S + n) * 128 : (((size_t)(kv * BATCH * 2 + bk)) * NCHK_P + n) * 128; }
struct StCmpWT { const Ctx& c; static constexpr long N = 2 * 2 * 64 * 1024;
  HD void operator()(long i) const { const int k = (int)(i % 1024), e = (int)((i / 1024) % 64), half = (int)((i / 65536) % 2), kv = (int)(i / 131072);
    c.WcT[(size_t)kv * 131072 + frag_idx(half * 64 + e, k, 1024)] = f2bf(c.cmp_w[(((size_t)kv * 32 + half * 16 + k / 64) * 64 + k % 64) * 64 + e]); } };
struct StCmpBias { const Ctx& c; static constexpr long N = 128;
  HD void operator()(long i) const { const int e = (int)(i % 64), kv = (int)(i / 64); float s = 0.f;
    for (int jd = 0; jd < 2048; ++jd) s += c.cmp_pe[(size_t)kv * 2048 + jd] * c.cmp_w[((size_t)kv * 2048 + jd) * 64 + e];
    c.CBIAS[i] = s; } };
template <bool SAMPLE> WV_DEV void compress_unit(const Ctx& c, int unit) {
  constexpr int NG = (SAMPLE ? NCHK_S : NCHK_P) / 32, NB = SAMPLE ? DEC_BATCH : BATCH;
  const int lane = wv_lane(), r32 = lane & 31, hi = lane >> 5;
  const int grp = unit % NG; int r = unit / NG; const int kvh = r & 1; r >>= 1; const int b = r % NB, kv = r / NB;
  const int n = grp * 32 + r32;
  const float* arow;
  if (!SAMPLE) arow = c.out + O_KVP + ((size_t)b * SEQ + 16 * n) * 512 + (kv * 2 + kvh) * 64 + 8 * hi;
  else { const int pos = 16 * n, pg = c.page_table[b * NPAGES + pos / PAGE_SIZE]; arow = c.cache_nsa_kv + ((size_t)pg * PAGE_SIZE + pos % PAGE_SIZE) * 512 + (kv * 2 + kvh) * 64 + 8 * hi; }
  const bf16_t* wt = c.WcT + (size_t)kv * 2 * 64 * 1024 + lane * 8;
  f32x16 acc[4];
#pragma unroll
  for (int t = 0; t < 4; ++t) acc[t] = f32x16{};
#pragma unroll 2
  for (int ks = 0; ks < 64; ++ks) {
    const bf16x8 af = wv_ld8_f32(arow + (size_t)(ks >> 2) * 512 + (ks & 3) * 16);
#pragma unroll
    for (int t = 0; t < 4; ++t) acc[t] = wv_mfma32(af, wv_ld8(wt + (size_t)(t * 64 + ks) * 512), acc[t]);
  }
  float* pp = c.PP + pp_off(SAMPLE, kv, b * 2 + kvh, grp * 32);
#pragma unroll
  for (int t = 0; t < 4; ++t)
#pragma unroll
    for (int rr = 0; rr < 16; ++rr) pp[(size_t)crow16(rr, hi) * 128 + t * 32 + r32] = acc[t][rr];
}
struct StPackCmp2 { const Ctx& c; static constexpr long N = NPC_P + NPC_S;
  HD void operator()(long i) const {
    const bool sample = i >= NPC_P; long r = sample ? i - NPC_P : i; const int cpad = sample ? 512 : 128, nc = sample ? NCS : NCP;
    const int d = (int)(r % 64); r /= 64; const int cb = (int)(r % cpad); r /= cpad; const int kvh = (int)(r % 2), b = (int)(r / 2);
    float k = 0.f, v = 0.f;
    if (cb < nc) { k = c.PP[pp_off(sample, 0, b * 2 + kvh, cb) + d] + c.PP[pp_off(sample, 0, b * 2 + kvh, cb + 1) + 64 + d] + c.CBIAS[d];
                   v = c.PP[pp_off(sample, 1, b * 2 + kvh, cb) + d] + c.PP[pp_off(sample, 1, b * 2 + kvh, cb + 1) + 64 + d] + c.CBIAS[64 + d]; }
    const size_t o = kc_off(sample, b, kvh);
    c.KCb[o + frag_idx(cb, d, 64)] = f2bf(k); c.VCTb[o + frag_idx(d, vperm16(cb), cpad)] = f2bf(v);
  } };
WV_DEV void memkv_unit(const Ctx& c, int mm) {
  const int lane = wv_lane(), h = lane >> 4, dd = (lane & 15) * 16; const float* k = c.MKV + (size_t)mm * 2048 + lane * 16; const float* v = k + 1024;
  f32x4v kv[4], vv[4]; float ss = 0.f;
#pragma unroll
  for (int j = 0; j < 4; ++j) { kv[j] = *(const f32x4v*)(k + 4 * j); vv[j] = *(const f32x4v*)(v + 4 * j); ss += (kv[j].x * kv[j].x + kv[j].y * kv[j].y) + (kv[j].z * kv[j].z + kv[j].w * kv[j].w); }
  ss += wv_shfl_xor_f(ss, 1); ss += wv_shfl_xor_f(ss, 2); ss += wv_shfl_xor_f(ss, 4); ss += wv_shfl_xor_f(ss, 8);
  const float r = 1.f / sqrtf(ss / 256.f + EPS); float* o = c.out + O_MKVP + (size_t)mm * 2048 + lane * 16;
#pragma unroll
  for (int j = 0; j < 4; ++j) { kv[j] = kv[j] * *(const f32x4v*)(c.xk_norm_w + dd + 4 * j) * r; *(f32x4v*)(o + 4 * j) = kv[j]; *(f32x4v*)(o + 1024 + 4 * j) = vv[j]; }
  const int bb = mm / MEM_TOKENS, jj = mm % MEM_TOKENS; bf16_t* kb = c.KXb + ((size_t)bb * 4 + h) * MEM_TOKENS * 256;
  *(bf16x8*)(kb + frag_idx(jj, dd, 256)) = wv_pack8(kv[0].x, kv[0].y, kv[0].z, kv[0].w, kv[1].x, kv[1].y, kv[1].z, kv[1].w); *(bf16x8*)(kb + frag_idx(jj, dd + 8, 256)) = wv_pack8(kv[2].x, kv[2].y, kv[2].z, kv[2].w, kv[3].x, kv[3].y, kv[3].z, kv[3].w);
}
WV_DEV void xk_pack_unit(const Ctx& c, int row  ) {
  const int lane = wv_lane(), h = lane >> 4, dd = (lane & 15) * 16; const float* k = c.cache_mem_kv + (size_t)row * 2048 + lane * 16;
  const f32x4v a = *(const f32x4v*)k, b = *(const f32x4v*)(k + 4), e = *(const f32x4v*)(k + 8), f = *(const f32x4v*)(k + 12);
  const int bb = BATCH + row / MEM_TOKENS, jj = row % MEM_TOKENS; bf16_t* kb = c.KXb + ((size_t)bb * 4 + h) * MEM_TOKENS * 256;
  *(bf16x8*)(kb + frag_idx(jj, dd, 256)) = wv_pack8(a.x, a.y, a.z, a.w, b.x, b.y, b.z, b.w); *(bf16x8*)(kb + frag_idx(jj, dd + 8, 256)) = wv_pack8(e.x, e.y, e.z, e.w, f.x, f.y, f.z, f.w);
}
constexpr int XVT_UNITS = (BATCH + DEC_BATCH) * 4 * (MEM_TOKENS / 16) * 4;
WV_DEV void xvt_unit(const Ctx& c, int unit) {
  const int lane = wv_lane(); const int dblk = unit & 3; int r = unit >> 2; const int g16 = r % (MEM_TOKENS / 16); r /= (MEM_TOKENS / 16); const int h = r & 3, bb = r >> 2;
  const int d = dblk * 64 + lane;
  const float* src = (bb < BATCH ? c.MKV + ((size_t)bb * MEM_TOKENS + g16 * 16) * 2048 : c.cache_mem_kv + ((size_t)(bb - BATCH) * MEM_TOKENS + g16 * 16) * 2048) + 1024 + h * 256 + d; float v[16];
#pragma unroll
  for (int i = 0; i < 16; ++i) v[i] = src[(size_t)i * 2048];
  bf16_t* dst = c.VXTb + ((size_t)bb * 4 + h) * 256 * MEM_TOKENS;
  *(bf16x8*)(dst + frag_idx(d, g16 * 16, MEM_TOKENS)) = wv_pack8(v[0], v[1], v[2], v[3], v[8], v[9], v[10], v[11]); *(bf16x8*)(dst + frag_idx(d, g16 * 16 + 8, MEM_TOKENS)) = wv_pack8(v[4], v[5], v[6], v[7], v[12], v[13], v[14], v[15]);
}
HD const float* wall_row(const Ctx& c, int b, int w) {
  if (w < WBUF) return c.cache_nsa_win + ((size_t)b * WBUF + w) * 256;
  if (w < WBUF + DEC_SEQ) return c.WR + ((size_t)MP + b * DEC_SEQ + (w - WBUF)) * 256;
  return nullptr;
}
constexpr int WKS_UNITS = DEC_BATCH * 2 * (WKS / 8), WVS_UNITS = DEC_BATCH * 2 * (WKS / 16);
WV_DEV void winks_unit(const Ctx& c, int unit) {
  const int lane = wv_lane(); const int g8 = unit % (WKS / 8); int r = unit / (WKS / 8); const int kvh = r & 1, b = r >> 1; const int w = g8 * 8 + (lane >> 3), j = lane & 7;
  const float* src = wall_row(c, b, w); f32x4v a = {0.f, 0.f, 0.f, 0.f}, e = {0.f, 0.f, 0.f, 0.f};
  if (src) { a = *(const f32x4v*)(src + (0 * 2 + kvh) * 64 + j * 8); e = *(const f32x4v*)(src + (0 * 2 + kvh) * 64 + j * 8 + 4); }
  *(bf16x8*)(c.KWsb + ((size_t)b * 2 + kvh) * WKS * 64 + frag_idx(w, j * 8, 64)) = wv_pack8(a.x, a.y, a.z, a.w, e.x, e.y, e.z, e.w);
}
WV_DEV void winvs_unit(const Ctx& c, int unit) {
  const int lane = wv_lane(); const int g16 = unit % (WKS / 16); int r = unit / (WKS / 16); const int kvh = r & 1, b = r >> 1; float v[16];
#pragma unroll
  for (int i = 0; i < 16; ++i) { const float* src = wall_row(c, b, g16 * 16 + i); v[i] = src ? src[(1 * 2 + kvh) * 64 + lane] : 0.f; }
  bf16_t* dst = c.VWTsb + ((size_t)b * 2 + kvh) * 64 * WKS;
  *(bf16x8*)(dst + frag_idx(lane, g16 * 16, WKS)) = wv_pack8(v[0], v[1], v[2], v[3], v[8], v[9], v[10], v[11]); *(bf16x8*)(dst + frag_idx(lane, g16 * 16 + 8, WKS)) = wv_pack8(v[4], v[5], v[6], v[7], v[12], v[13], v[14], v[15]);
}
struct StWinOut4 { const Ctx& c; static constexpr long N = (long)(BATCH + DEC_BATCH) * WINDOW * 64;
  HD void operator()(long i) const {
    const int e = (int)(i % 64) * 4; const long r = i / 64; const int j = (int)(r % WINDOW), bb = (int)(r / WINDOW);
    if (bb < BATCH) *(f32x4v*)(c.out + O_WINP + ((size_t)bb * WINDOW + j) * 256 + e) = *(const f32x4v*)(c.WR + ((size_t)bb * SEQ + SEQ - WINDOW + j) * 256 + e);
    else { const int b = bb - BATCH; *(f32x4v*)(c.out + O_WINS + ((size_t)b * WINDOW + j) * 256 + e) = *(const f32x4v*)(wall_row(c, b, j + DEC_SEQ) + e); }
  } };
constexpr int FFN_CB = D_FF / 256, FFN_UNITS = (BATCH * (SEQ / 8) + DEC_BATCH) * FFN_CB;
WV_DEV void ffn_act_unit(const Ctx& c, int unit) {
  const int lane = wv_lane(); const int cb = unit % FFN_CB, sg = unit / FFN_CB; const int col = cb * 256 + lane * 4;
  const bool sample = sg >= BATCH * (SEQ / 8); const int m0 = sample ? MP + (sg - BATCH * (SEQ / 8)) * DEC_SEQ : sg * 8; const int t0 = sample ? 0 : (sg % (SEQ / 8)) * 8;
  f32x4v wa[3], wu[3];
#pragma unroll
  for (int k = 0; k < 3; ++k) { wa[k] = *(const f32x4v*)(c.ffn_conv_w + (size_t)k * 2 * D_FF + col); wu[k] = *(const f32x4v*)(c.ffn_conv_w + (size_t)k * 2 * D_FF + D_FF + col); }
  const f32x4v ba = *(const f32x4v*)(c.ffn_conv_b + col), bu = *(const f32x4v*)(c.ffn_conv_b + D_FF + col);
  f32x4v a2 = {0.f, 0.f, 0.f, 0.f}, a1 = a2, u2 = a2, u1 = a2;
  if (t0 >= 2) { const float* p2 = c.UP + (size_t)(m0 - 2) * (2 * D_FF) + col; a2 = *(const f32x4v*)p2; u2 = *(const f32x4v*)(p2 + D_FF); a1 = *(const f32x4v*)(p2 + 2 * D_FF); u1 = *(const f32x4v*)(p2 + 3 * D_FF); }
  else if (sample) { const float* p2 = c.cache_ffn_conv + (size_t)(sg - BATCH * (SEQ / 8)) * 2 * (2 * D_FF) + col; a2 = *(const f32x4v*)p2; u2 = *(const f32x4v*)(p2 + D_FF); a1 = *(const f32x4v*)(p2 + 2 * D_FF); u1 = *(const f32x4v*)(p2 + 3 * D_FF); }
#pragma unroll
  for (int t = 0; t < 8; ++t) { const float* p = c.UP + (size_t)(m0 + t) * (2 * D_FF) + col; const f32x4v a0 = *(const f32x4v*)p, u0 = *(const f32x4v*)(p + D_FF);
    const f32x4v ya = ba + wa[0] * a2 + wa[1] * a1 + wa[2] * a0, yu = bu + wu[0] * u2 + wu[1] * u1 + wu[2] * u0;
    st_pk4(c.ACT + (size_t)(m0 + t) * D_FF + col, f32x4v{siluf_(ya.x) * yu.x, siluf_(ya.y) * yu.y, siluf_(ya.z) * yu.z, siluf_(ya.w) * yu.w});
    a2 = a1; a1 = a0; u2 = u1; u1 = u0; }
}
namespace pg8 {
#define PG8_LAS __attribute__((address_space(3)))
typedef unsigned short bf16_t;
typedef short bf16x8 __attribute__((ext_vector_type(8)));
typedef float f32x4 __attribute__((ext_vector_type(4)));
typedef unsigned u32x4 __attribute__((ext_vector_type(4)));
constexpr int BM = 256, BK = 64, HALF = 128, HTB = HALF * BK * 2  , STAGE_BYTES = 8 * HTB, NXCD = 8, WGM = 8;

__host__ __device__ __forceinline__ int lds_byte(int r, int c) { const int st = (r >> 4) * 2 + (c >> 5), rr = r & 15, cc = c & 31, ob = rr * 64 + cc * 2; return st * 1024 + (ob ^ (((ob >> 9) & 1) << 5)); }
__host__ __device__ __forceinline__ void stage_rc(int b, int& R, int& C) { const int st = b / 1024, sb = b % 1024, swz = sb ^ (((sb >> 9) & 1) << 5); R = (st >> 1) * 16 + swz / 64; C = (st & 1) * 32 + (swz % 64) / 2; }
__host__ __device__ __forceinline__ int perm32(int rho) { const int n = rho >> 4, i = rho & 15; return 8 * (i >> 2) + 4 * n + (i & 3); }

struct Unit { int pm, pn; };
struct Gemm { const bf16_t* A; const bf16_t* Bt; int M, N, K; };

struct StaticOrder {
    int nM, nN, nwg, G, c;
    __host__ __device__ void init(int M, int N, int G_, int c_) { nM = M / BM; nN = N / BM; nwg = nM * nN; G = G_; c = c_; }
    __host__ __device__ bool next(int i, Unit& u) const {
        const long L = (long)i * G + c; if (L >= nwg) return false;
        int wgid = (int)L; { const int q = nwg / NXCD, r = nwg % NXCD, xcd = wgid % NXCD, off = wgid / NXCD; wgid = (xcd < r ? xcd * (q + 1) : r * (q + 1) + (xcd - r) * q) + off; }
        const int nig = WGM * nN, gid = wgid / nig, fm = gid * WGM, gsz = (nM - fm) < WGM ? (nM - fm) : WGM;
        u.pm = fm + ((wgid % nig) % gsz); u.pn = (wgid % nig) / gsz; return true;
    }
    __device__ __forceinline__ void a_ready(const Unit&) const {}
    __device__ __forceinline__ void done(const Unit&) const {}
};

struct EpiF32 { static constexpr bool PERM = false, AFTER_DRAIN = false;
  float* C; int ldc; const float* resP; const float* resS; int mp;
  __device__ __forceinline__ void operator()(const f32x4 (&acc)[2][2][4][2], const Unit& u, int wr, int wc, int fr, int fq) const {
#pragma unroll
    for (int ai = 0; ai < 2; ++ai)
#pragma unroll
      for (int m = 0; m < 4; ++m) {
        const int row = u.pm * BM + ai * HALF + wr * 64 + m * 16 + fr;
        float* crow = C + (size_t)row * ldc;
        const float* rrow = resP ? (row < mp ? resP + (size_t)row * 1024 : resS + (size_t)(row - mp) * 1024) : nullptr;
#pragma unroll
        for (int bj = 0; bj < 2; ++bj)
#pragma unroll
          for (int n = 0; n < 2; ++n) {
            const int col = u.pn * BM + bj * HALF + wc * 32 + n * 16 + 4 * fq;
            f32x4 v = acc[ai][bj][m][n]; if (rrow) v += *(const f32x4*)(rrow + col);
            *(f32x4*)(crow + col) = v;
          }
      }
  } };
template <class Epi, class Sched, bool ALIGN_EPI = false, bool SP2 = false>
__device__ __forceinline__ void gemm_phase(PG8_LAS unsigned char* lds, const Gemm g, const Sched& S, const Epi& E) {
    const int tid = threadIdx.x, wid = __builtin_amdgcn_readfirstlane(tid >> 6), lane = tid & 63, wr = wid >> 2, wc = wid & 3, fr = lane & 15, fq = lane >> 4;
    const int K = g.K, nt = K / BK;
    unsigned voffA[2], voffB[2];
#pragma unroll
    for (int i = 0; i < 2; ++i) { int R, C; stage_rc(tid * 16 + i * 8192, R, C); const int Rb = Epi::PERM ? ((R & ~31) + perm32(R & 31)) : R;
        voffA[i] = (unsigned)(R * K + C) * 2u; voffB[i] = (unsigned)(Rb * K + C) * 2u; }
    const size_t kstep = (size_t)(BK * 2);
    const size_t hstep = (size_t)HALF * K * 2;
    const size_t tstep = 2 * hstep;
    const unsigned ldsw = (unsigned)wid * 1024u;
    const int aoff = lds_byte(wr * 64 + fr, fq * 8), boff = lds_byte(wc * 32 + fr, fq * 8);
#define PG8_SA(b, h) (((b) * 2 + (h)) * HTB)
#define PG8_SB(b, h) ((4 + (b) * 2 + (h)) * HTB)
#define PG8_STAGE(bufoff, gbase, voff) do { _Pragma("unroll") for (int _i = 0; _i < 2; ++_i) \
        __builtin_amdgcn_global_load_lds((const unsigned*)((const char*)(gbase) + (voff)[_i]), (PG8_LAS unsigned*)(lds + (bufoff) + ldsw + _i * 8192), 16, 0, 0); } while (0)
#define PG8_LDA(dst, b, h) do { _Pragma("unroll") for (int m = 0; m < 4; ++m) _Pragma("unroll") for (int k = 0; k < 2; ++k) dst[m][k] = *(const PG8_LAS bf16x8*)(lds + PG8_SA(b, h) + aoff + m * 2048 + k * 1024); } while (0)
#define PG8_LDB(dst, b, h) do { _Pragma("unroll") for (int n = 0; n < 2; ++n) _Pragma("unroll") for (int k = 0; k < 2; ++k) dst[n][k] = *(const PG8_LAS bf16x8*)(lds + PG8_SB(b, h) + boff + n * 2048 + k * 1024); } while (0)
#define PG8_MMA(ai, bj, At, Bt) do { __builtin_amdgcn_s_setprio(1); _Pragma("unroll") for (int m = 0; m < 4; ++m) _Pragma("unroll") for (int n = 0; n < 2; ++n) _Pragma("unroll") for (int k = 0; k < 2; ++k) \
        acc[ai][bj][m][n] = __builtin_amdgcn_mfma_f32_16x16x32_bf16(Bt[n][k], At[m][k], acc[ai][bj][m][n], 0, 0, 0); __builtin_amdgcn_s_setprio(0); } while (0)
#define PG8_WAIT_V(n) asm volatile("s_waitcnt vmcnt(" #n ")" ::: "memory")
#define PG8_WAIT_L(n) asm volatile("s_waitcnt lgkmcnt(" #n ")" ::: "memory")
#define PG8_BAR __builtin_amdgcn_s_barrier()
#define PG8_SCHED __builtin_amdgcn_sched_barrier(0)
    Unit cur, nxt; int ui = 0;
    if (!S.next(0, cur)) return;
    f32x4 acc[2][2][4][2];
#pragma unroll
    for (int a = 0; a < 2; ++a)
#pragma unroll
        for (int b = 0; b < 2; ++b)
#pragma unroll
            for (int m = 0; m < 4; ++m)
#pragma unroll
                for (int n = 0; n < 2; ++n) acc[a][b][m][n] = (f32x4){0.f, 0.f, 0.f, 0.f};
    bf16x8 At[4][2], B0[2][2], B1[2][2];
    const char* cA = (const char*)g.A + (size_t)cur.pm * tstep; const char* cB = (const char*)g.Bt + (size_t)cur.pn * tstep;
    S.a_ready(cur);
    if constexpr (SP2) {
        PG8_STAGE(PG8_SB(0, 0), cB, voffB); PG8_STAGE(PG8_SB(0, 1), cB + hstep, voffB); PG8_STAGE(PG8_SA(0, 0), cA, voffA); PG8_STAGE(PG8_SA(0, 1), cA + hstep, voffA);
        if (wr == 1) PG8_BAR;
        PG8_WAIT_V(2); PG8_BAR;
        PG8_STAGE(PG8_SB(1, 0), cB + kstep, voffB); PG8_STAGE(PG8_SA(1, 0), cA + kstep, voffA); PG8_STAGE(PG8_SB(1, 1), cB + hstep + kstep, voffB);
        PG8_WAIT_V(6); PG8_BAR;
    } else {
        PG8_STAGE(PG8_SB(0, 0), cB, voffB); PG8_STAGE(PG8_SA(0, 0), cA, voffA); PG8_STAGE(PG8_SB(0, 1), cB + hstep, voffB); PG8_STAGE(PG8_SA(0, 1), cA + hstep, voffA);
        if (wr == 1) PG8_BAR;
        PG8_WAIT_V(4); PG8_BAR;
        PG8_STAGE(PG8_SB(1, 0), cB + kstep, voffB); PG8_STAGE(PG8_SA(1, 0), cA + kstep, voffA); PG8_STAGE(PG8_SB(1, 1), cB + hstep + kstep, voffB);
        PG8_WAIT_V(6); PG8_BAR;
    }
    for (;;) {
        const bool has_next = S.next(ui + 1, nxt);
        const char* nA = has_next ? (const char*)g.A + (size_t)nxt.pm * tstep : cA; const char* nB = has_next ? (const char*)g.Bt + (size_t)nxt.pn * tstep : cB;
        for (int t = 0; t < nt; t += 2) {
            const bool last = (t == nt - 2);
            const char* a1 = cA + (size_t)(t + 1) * kstep;
            const char* a2 = last ? nA : cA + (size_t)(t + 2) * kstep; const char* b2 = last ? nB : cB + (size_t)(t + 2) * kstep;
            const char* a3 = a2 + kstep; const char* b3 = b2 + kstep;
            if (last && has_next) S.a_ready(nxt);
            if constexpr (SP2) {
            PG8_LDB(B0, 0, 0); PG8_LDB(B1, 0, 1); PG8_SCHED; PG8_LDA(At, 0, 0); PG8_STAGE(PG8_SA(1, 1), a1 + hstep, voffA);
            PG8_WAIT_V(8); PG8_WAIT_L(0); PG8_BAR; PG8_MMA(0, 0, At, B0); PG8_MMA(0, 1, At, B1); PG8_BAR; PG8_SCHED;
            PG8_LDA(At, 0, 1); PG8_STAGE(PG8_SB(0, 0), b2, voffB); PG8_STAGE(PG8_SB(0, 1), b2 + hstep, voffB); PG8_STAGE(PG8_SA(0, 0), a2, voffA);
            PG8_WAIT_V(8); PG8_WAIT_L(0); PG8_BAR; PG8_MMA(1, 0, At, B0); PG8_MMA(1, 1, At, B1); PG8_BAR; PG8_SCHED;
            PG8_LDB(B0, 1, 0); PG8_LDB(B1, 1, 1); PG8_SCHED; PG8_LDA(At, 1, 0); PG8_STAGE(PG8_SA(0, 1), a2 + hstep, voffA);
            PG8_WAIT_V(8); PG8_WAIT_L(0); PG8_BAR; PG8_MMA(0, 0, At, B0); PG8_MMA(0, 1, At, B1); PG8_BAR; PG8_SCHED;
            PG8_LDA(At, 1, 1); PG8_STAGE(PG8_SB(1, 0), b3, voffB); PG8_STAGE(PG8_SB(1, 1), b3 + hstep, voffB); PG8_STAGE(PG8_SA(1, 0), a3, voffA);
            PG8_WAIT_V(8); PG8_WAIT_L(0); PG8_BAR; PG8_MMA(1, 0, At, B0); PG8_MMA(1, 1, At, B1); PG8_BAR; PG8_SCHED;
            } else {
            PG8_LDB(B0, 0, 0); PG8_SCHED; PG8_LDA(At, 0, 0); PG8_STAGE(PG8_SA(1, 1), a1 + hstep, voffA);
            PG8_WAIT_L(8); PG8_BAR; PG8_WAIT_L(0); PG8_MMA(0, 0, At, B0); PG8_BAR; PG8_SCHED;
            PG8_LDB(B1, 0, 1); PG8_STAGE(PG8_SB(0, 0), b2, voffB);
            PG8_BAR; PG8_WAIT_L(0); PG8_MMA(0, 1, At, B1); PG8_BAR;
            PG8_LDA(At, 0, 1); PG8_STAGE(PG8_SA(0, 0), a2, voffA);
            PG8_BAR; PG8_WAIT_L(0); PG8_MMA(1, 0, At, B0); PG8_BAR; PG8_SCHED;
            PG8_STAGE(PG8_SB(0, 1), b2 + hstep, voffB);
            PG8_WAIT_V(6); PG8_BAR; PG8_MMA(1, 1, At, B1); PG8_BAR;
            PG8_LDB(B0, 1, 0); PG8_SCHED; PG8_LDA(At, 1, 0); PG8_STAGE(PG8_SA(0, 1), a2 + hstep, voffA);
            PG8_WAIT_L(8); PG8_BAR; PG8_WAIT_L(0); PG8_MMA(0, 0, At, B0); PG8_BAR; PG8_SCHED;
            PG8_LDB(B1, 1, 1); PG8_STAGE(PG8_SB(1, 0), b3, voffB);
            PG8_BAR; PG8_WAIT_L(0); PG8_MMA(0, 1, At, B1); PG8_BAR;
            PG8_LDA(At, 1, 1); PG8_STAGE(PG8_SA(1, 0), a3, voffA);
            PG8_BAR; PG8_WAIT_L(0); PG8_MMA(1, 0, At, B0); PG8_BAR; PG8_SCHED;
            PG8_STAGE(PG8_SB(1, 1), b3 + hstep, voffB);
            PG8_WAIT_V(6); PG8_BAR; PG8_MMA(1, 1, At, B1); PG8_BAR;
            }
        }
        if constexpr (ALIGN_EPI) { if (wr == 0) PG8_BAR; }
        if constexpr (!Epi::AFTER_DRAIN) { E(acc, cur, wr, wc, fr, fq); S.done(cur); }
        if (!has_next) break;
#pragma unroll
        for (int a = 0; a < 2; ++a)
#pragma unroll
            for (int b = 0; b < 2; ++b)
#pragma unroll
                for (int m = 0; m < 4; ++m)
#pragma unroll
                    for (int n = 0; n < 2; ++n) acc[a][b][m][n] = (f32x4){0.f, 0.f, 0.f, 0.f};
        cur = nxt; cA = nA; cB = nB; ++ui;
        if constexpr (ALIGN_EPI) { if (wr == 1) PG8_BAR; }
    }
    PG8_WAIT_V(0);
    if constexpr (!ALIGN_EPI) { if (wr == 0) PG8_BAR; }
    PG8_BAR;
    if constexpr (Epi::AFTER_DRAIN) { E.fused(acc, cur, wr, wc, fr, fq, lds, wid, lane); S.done(cur); }
#undef PG8_SA
#undef PG8_SB
#undef PG8_STAGE
#undef PG8_LDA
#undef PG8_LDB
#undef PG8_MMA
#undef PG8_WAIT_V
#undef PG8_WAIT_L
#undef PG8_BAR
#undef PG8_SCHED
}
}
#define GAS __attribute__((address_space(1)))
#define LAS __attribute__((address_space(3)))
typedef unsigned v4u __attribute__((ext_vector_type(4)));
#define LDS_WAIT() asm volatile("s_waitcnt lgkmcnt(0)" ::: "memory")
__device__ __forceinline__ unsigned pk2(float lo, float hi) { return f2bf_u(lo) | (f2bf_u(hi) << 16); }
constexpr int LDS_BYTES = 147456;
constexpr int NWAVES = 8;
__device__ __forceinline__ void p0_transpose_item(const float* W, int K, int N, bf16_t* WT, int row_off, LAS float* scr, int item, int lane) {
    const int nblk = N / 32, kb = item / nblk, nb = item % nblk, k0 = 64 * kb, n0 = 32 * nb;
#pragma unroll 8
    for (int i = 0; i < 32; ++i) { const int kk = 2 * i + (lane >> 5); scr[kk * 33 + (lane & 31)] = W[(size_t)(k0 + kk) * N + n0 + (lane & 31)]; }
    LDS_WAIT(); asm volatile("" ::: "memory");
    const int c = lane & 7;
#pragma unroll
    for (int j = 0; j < 4; ++j) { const int n = (lane >> 3) + 8 * j; const LAS float* s = scr + (8 * c) * 33 + n;
        v4u o; o.x = pk2(s[0 * 33], s[1 * 33]); o.y = pk2(s[2 * 33], s[3 * 33]); o.z = pk2(s[4 * 33], s[5 * 33]); o.w = pk2(s[6 * 33], s[7 * 33]);
        *(GAS v4u*)(WT + (size_t)(row_off + n0 + n) * K + k0 + 8 * c) = o; }
    LDS_WAIT(); asm volatile("" ::: "memory");
}
struct Args { Ctx c; bf16_t *WinT, *WkvT, *WoutT, *WxqT, *WxoT, *WupT, *WdownT; unsigned* ctr; int ph_lo, ph_hi; };
template <class F> __device__ __forceinline__ void run_stage(const F& f) {
  const long stride = (long)gridDim.x * 512;
  for (long i = (long)blockIdx.x * 512 + threadIdx.x; i < F::N; i += stride) f(i);
}
constexpr int N_PHASES = 18;
struct Args;
__device__ __forceinline__ const Args* phase_args() { unsigned long long p = (unsigned long long)__builtin_amdgcn_kernarg_segment_ptr(); asm volatile("" : "+s"(p)); return (const Args*)p; }
__global__ void __launch_bounds__(512, 2) mega(Args a0) {
  extern __shared__ __attribute__((aligned(16))) unsigned char lds_raw[];
  LAS unsigned char* lds = (LAS unsigned char*)lds_raw;
  cg::grid_group grid = cg::this_grid();
  const int ph_lo = a0.ph_lo, ph_hi = a0.ph_hi;
  const int tid = threadIdx.x, lane = tid & 63, wave = __builtin_amdgcn_readfirstlane(tid >> 6);
#define PH(k) if (ph_lo <= (k) && (k) < ph_hi) if (const Args* ap_ = phase_args()) if (const Args& a = *ap_; true) if (const Ctx& c = a.c; true)
#define WUNITS(n, expr) do { const int G8_ = (int)gridDim.x * NWAVES; for (int u = (int)blockIdx.x * NWAVES + wave; u < (n); u += G8_) { expr; } } while (0)
#define SYNC(k) do { if ((k) + 1 < ph_hi) grid.sync(); } while (0)
#define GEMM(A_, B_, M_, N_, K_, C_, LDC_, RP_, RS_) do { __syncthreads(); pg8::Gemm g{A_, B_, M_, N_, K_}; pg8::StaticOrder S; S.init(M_, N_, (int)gridDim.x, (int)blockIdx.x); \
      pg8::EpiF32 E{C_, LDC_, RP_, RS_, MP}; pg8::gemm_phase<pg8::EpiF32, pg8::StaticOrder, true, true>(lds, g, S, E); } while (0)
  PH(0) {
    LAS float* scr = (LAS float*)(lds + wave * 16384);
    const int gw = blockIdx.x * NWAVES + wave, NGW = gridDim.x * NWAVES;
    constexpr int I_IN = (D_MODEL / 64) * (IN_COLS / 32), I_SQ = (D_MODEL / 64) * (D_MODEL / 32), I_UP = (D_MODEL / 64) * (2 * D_FF / 32), I_DN = (D_FF / 64) * (D_MODEL / 32);
    constexpr int NIT = I_IN + 5 * I_SQ + I_UP + I_DN;
    for (int it = gw; it < NIT; it += NGW) { int r = it;
      if (r < I_IN) { p0_transpose_item(c.w_in, D_MODEL, IN_COLS, a.WinT, 0, scr, r, lane); continue; } r -= I_IN;
      if (r < I_SQ) { p0_transpose_item(c.w_xk, D_MODEL, D_MODEL, a.WkvT, 0, scr, r, lane); continue; } r -= I_SQ;
      if (r < I_SQ) { p0_transpose_item(c.w_xv, D_MODEL, D_MODEL, a.WkvT, D_MODEL, scr, r, lane); continue; } r -= I_SQ;
      if (r < I_SQ) { p0_transpose_item(c.w_out, D_MODEL, D_MODEL, a.WoutT, 0, scr, r, lane); continue; } r -= I_SQ;
      if (r < I_SQ) { p0_transpose_item(c.w_xq, D_MODEL, D_MODEL, a.WxqT, 0, scr, r, lane); continue; } r -= I_SQ;
      if (r < I_SQ) { p0_transpose_item(c.w_xo, D_MODEL, D_MODEL, a.WxoT, 0, scr, r, lane); continue; } r -= I_SQ;
      if (r < I_UP) { p0_transpose_item(c.w_up, D_MODEL, 2 * D_FF, a.WupT, 0, scr, r, lane); continue; } r -= I_UP;
      p0_transpose_item(c.w_down, D_FF, D_MODEL, a.WdownT, 0, scr, r, lane); }
    run_stage(StCmpWT{c}); run_stage(StCmpBias{c});
    if (blockIdx.x == 0 && tid < 8) a.ctr[64 * tid] = 0u;
    WUNITS(MTOT + MMEM, (u < MTOT ? rms_row_unit(x_row(c, u), c.attn_norm_w, c.XN + (size_t)u * D_MODEL) : rms_row_unit(c.mem_prompt + (size_t)(u - MTOT) * D_MODEL, c.mem_norm_w, c.MN + (size_t)(u - MTOT) * D_MODEL)));
    SYNC(0); }
  PH(1) { GEMM(c.XN, a.WinT, MTOT, LDP, D_MODEL, c.P, LDP, nullptr, nullptr); SYNC(1); }
  PH(2) { GEMM(c.MN, a.WkvT, MMEM, 2048, D_MODEL, c.MKV, 2048, nullptr, nullptr); SYNC(2); }
  PH(3) { WUNITS(MTOT, postproc_unit(c, u)); WUNITS(MTOT, gdn_conv_unit(c, u)); WUNITS(VT_UNITS, vt_unit(c, u));
    WUNITS(MMEM, memkv_unit(c, u)); WUNITS(DEC_BATCH * MEM_TOKENS, xk_pack_unit(c, u)); WUNITS(XVT_UNITS, xvt_unit(c, u)); run_stage(StGdnConvOut{c}); SYNC(3); }
  PH(4) {
    { const int G8 = (int)gridDim.x * NWAVES, local = (int)blockIdx.x * NWAVES + wave; float* wscr = (float*)(lds_raw + (tid >> 6) * 18432);
      for (int u = local; u < GDN_PREP2_UNITS; u += G8) gdn_prep2_unit(c, u, wscr); }
    WUNITS(CMP_UNITS_S, compress_unit<true>(c, u)); WUNITS(CMP_UNITS_P, compress_unit<false>(c, u));
    WUNITS(WKS_UNITS, winks_unit(c, u)); WUNITS(WVS_UNITS, winvs_unit(c, u)); run_stage(StWinOut4{c}); SYNC(4); }
  PH(5) { run_stage(StPackCmp2{c}); SYNC(5); }
  PH(6) {
    if (wave == 0) { if (blockIdx.x < BATCH * 16) gdn_scan_unit(c, (int)blockIdx.x); }
    else if (wave <= 2) { const int u = BATCH * 16 + (int)blockIdx.x * 2 + (wave - 1); if (u < GDN_SCAN_UNITS) gdn_scan_unit(c, u); }
    else if (wave == 3) { if ((blockIdx.x & 3) == 0 && (int)(blockIdx.x >> 2) < NSA_UNITS_S) nsa_unit<true>(c, (int)(blockIdx.x >> 2), (float*)(lds_raw + 3 * 18432)); }
    const int xq = (int)blockIdx.x & 7; constexpr int PERQ = NSA_UNITS_P / 8;
    for (;;) { int k = 0; if (lane == 0) k = (int)atomicAdd(a.ctr + 64 * xq, 1u); k = __builtin_amdgcn_readfirstlane(k); if (k >= PERQ) break;
      const int tile = (SEQ / 8 - 1) - (k >> 1), bk = 2 * xq + (k & 1); nsa_unit<false>(c, bk * (SEQ / 8) + tile, nullptr); }
    SYNC(6); }
  PH(7) { WUNITS(MTOT, gdn_norm_unit(c, u)); SYNC(7); }
  PH(8) { GEMM(c.CAT, a.WoutT, MTOT, D_MODEL, D_MODEL, c.H1, D_MODEL, c.x_prompt, c.x_sample); SYNC(8); }
  PH(9) { WUNITS(MTOT, rms_row_unit(c.H1 + (size_t)u * D_MODEL, c.xattn_norm_w, c.XN + (size_t)u * D_MODEL)); SYNC(9); }
  PH(10) { GEMM(c.XN, a.WxqT, MTOT, D_MODEL, D_MODEL, c.Q2, D_MODEL, nullptr, nullptr); SYNC(10); }
  PH(11) { WUNITS(MTOT, xq_norm_unit(c, u)); SYNC(11); }
  PH(12) {
    const int G8 = (int)gridDim.x * NWAVES, local = (int)blockIdx.x * NWAVES + wave;
    for (int u = local; u < XA_UNITS_P; u += G8) xattn_unit<false>(c, u);
    for (int u = local; u < XA_UNITS_S; u += G8) xattn_unit<true>(c, u);
    SYNC(12); }
  PH(13) { GEMM(c.OX, a.WxoT, MTOT, D_MODEL, D_MODEL, c.H2, D_MODEL, c.H1, c.H1 + (size_t)MP * D_MODEL); SYNC(13); }
  PH(14) { WUNITS(MTOT, rms_row_unit(c.H2 + (size_t)u * D_MODEL, c.ffn_norm_w, c.XN + (size_t)u * D_MODEL)); SYNC(14); }
  PH(15) { GEMM(c.XN, a.WupT, MTOT, 2 * D_FF, D_MODEL, c.UP, 2 * D_FF, nullptr, nullptr); SYNC(15); }
  PH(16) { WUNITS(FFN_UNITS, ffn_act_unit(c, u)); run_stage(StFfnConvOut{c}); SYNC(16); }
#ifdef EXTRA_LO
  PH(20) { if (wave == 0 && blockIdx.x >= 128 && blockIdx.x < 128 + NSA_UNITS_S) nsa_unit<true>(c, (int)blockIdx.x - 128, (float*)lds_raw); }
  PH(21) { const int local = (int)blockIdx.x * NWAVES + wave; if (local < GDN_SCAN_UNITS) gdn_scan_unit(c, local); }
  PH(22) { const int G8 = (int)gridDim.x * NWAVES, local = (int)blockIdx.x * NWAVES + wave; float* wscr = (float*)(lds_raw + (tid >> 6) * 18432);
      for (int u = local; u < GDN_PREP2_UNITS; u += G8) gdn_prep2_unit(c, u, wscr); }
  PH(23) { WUNITS(CMP_UNITS_S, compress_unit<true>(c, u)); WUNITS(CMP_UNITS_P, compress_unit<false>(c, u)); }
  PH(24) { WUNITS(WKS_UNITS, winks_unit(c, u)); WUNITS(WVS_UNITS, winvs_unit(c, u)); run_stage(StWinOut4{c}); }
  PH(25) { WUNITS(MTOT, postproc_unit(c, u)); }
  PH(26) { WUNITS(MTOT, gdn_conv_unit(c, u)); }
  PH(27) { WUNITS(VT_UNITS, vt_unit(c, u)); }
  PH(28) { WUNITS(MMEM, memkv_unit(c, u)); WUNITS(DEC_BATCH * MEM_TOKENS, xk_pack_unit(c, u)); WUNITS(XVT_UNITS, xvt_unit(c, u)); run_stage(StGdnConvOut{c}); }
  PH(29) { if (blockIdx.x == 0 && tid < 8) a.ctr[64 * tid] = 0u; SYNC(29); }
  PH(30) { const int xq = (int)blockIdx.x & 7; constexpr int PERQ = NSA_UNITS_P / 8;
    for (;;) { int k = 0; if (lane == 0) k = (int)atomicAdd(a.ctr + 64 * xq, 1u); k = __builtin_amdgcn_readfirstlane(k); if (k >= PERQ) break;
      const int tile = (SEQ / 8 - 1) - (k >> 1), bk = 2 * xq + (k & 1); nsa_unit<false>(c, bk * (SEQ / 8) + tile, nullptr); } }
#endif
  PH(17) { GEMM(c.ACT, a.WdownT, MTOT, D_MODEL, D_FF, c.out + O_YP, D_MODEL, c.H2, c.H2 + (size_t)MP * D_MODEL); }
}
#ifndef MK_MULTI
#define MK_MULTI 0
#endif
extern "C" void kernel_launch(void* const* d_in, const int* in_sizes, int n_in, void* d_out, int out_size, void* d_ws, size_t ws_size, hipStream_t stream) {
  static int grid = 0;
  if (grid == 0) {
    int dev = 0, cus = 0, per_cu = 0;
    if (hipGetDevice(&dev) != hipSuccess || hipDeviceGetAttribute(&cus, hipDeviceAttributeMultiprocessorCount, dev) != hipSuccess) { fprintf(stderr, "kernel_launch: device query failed\n"); grid = -1; return; }
    if (hipFuncSetAttribute((const void*)mega, hipFuncAttributeMaxDynamicSharedMemorySize, LDS_BYTES) != hipSuccess) { fprintf(stderr, "kernel_launch: hipFuncSetAttribute failed\n"); grid = -1; return; }
    if (hipOccupancyMaxActiveBlocksPerMultiprocessor(&per_cu, (const void*)mega, 512, LDS_BYTES) != hipSuccess || per_cu < 1) { fprintf(stderr, "kernel_launch: occupancy query says %d blocks/CU\n", per_cu); (void)hipGetLastError(); }
    grid = cus;
    if (n_in != 34 || (size_t)out_size != O_END) fprintf(stderr, "kernel_launch: unexpected n_in %d / out_size %d (want 34 / %zu)\n", n_in, out_size, (size_t)O_END);
  }
  if (grid < 0) return;
  Args a{}; Ctx& c = a.c; int k = 0;
  c.x_prompt = (const float*)d_in[k++]; c.x_sample = (const float*)d_in[k++]; c.mem_prompt = (const float*)d_in[k++]; c.cache_nsa_kv = (const float*)d_in[k++]; c.cache_nsa_win = (const float*)d_in[k++];
  c.state_gdn = (const float*)d_in[k++]; c.cache_gdn_conv = (const float*)d_in[k++]; c.cache_ffn_conv = (const float*)d_in[k++]; c.cache_mem_kv = (const float*)d_in[k++]; c.page_table = (const int*)d_in[k++];
  c.attn_norm_w = (const float*)d_in[k++]; c.w_in = (const float*)d_in[k++]; c.nsa_q_norm_w = (const float*)d_in[k++]; c.nsa_k_norm_w = (const float*)d_in[k++]; c.cmp_pe = (const float*)d_in[k++]; c.cmp_w = (const float*)d_in[k++];
  c.gdn_conv_w = (const float*)d_in[k++]; c.gdn_a_log = (const float*)d_in[k++]; c.gdn_dt_bias = (const float*)d_in[k++]; c.gdn_norm_w = (const float*)d_in[k++]; c.w_out = (const float*)d_in[k++];
  c.mem_norm_w = (const float*)d_in[k++]; c.w_xk = (const float*)d_in[k++]; c.w_xv = (const float*)d_in[k++]; c.xk_norm_w = (const float*)d_in[k++]; c.xattn_norm_w = (const float*)d_in[k++]; c.w_xq = (const float*)d_in[k++];
  c.xq_norm_w = (const float*)d_in[k++]; c.w_xo = (const float*)d_in[k++]; c.ffn_norm_w = (const float*)d_in[k++]; c.w_up = (const float*)d_in[k++]; c.ffn_conv_w = (const float*)d_in[k++]; c.ffn_conv_b = (const float*)d_in[k++]; c.w_down = (const float*)d_in[k++];
  c.out = (float*)d_out;
  unsigned char* ws = (unsigned char*)d_ws; WsMap w{0};
  a.ctr = (unsigned*)(ws + w.take(4096));
  a.WinT = (bf16_t*)(ws + w.take((size_t)LDP * D_MODEL * 2)); a.WkvT = (bf16_t*)(ws + w.take((size_t)2048 * D_MODEL * 2));
  a.WoutT = (bf16_t*)(ws + w.take((size_t)D_MODEL * D_MODEL * 2)); a.WxqT = (bf16_t*)(ws + w.take((size_t)D_MODEL * D_MODEL * 2)); a.WxoT = (bf16_t*)(ws + w.take((size_t)D_MODEL * D_MODEL * 2));
  a.WupT = (bf16_t*)(ws + w.take((size_t)2 * D_FF * D_MODEL * 2)); a.WdownT = (bf16_t*)(ws + w.take((size_t)D_MODEL * D_FF * 2));
  const size_t need = ws_carve(c, ws, w.off);
  if (need > ws_size) { fprintf(stderr, "kernel_launch: workspace too small: need %zu, have %zu\n", need, ws_size); return; }
#if MK_MULTI
  for (int ph = 0; ph < N_PHASES; ++ph) { a.ph_lo = ph; a.ph_hi = ph + 1; void* args[] = {&a};
    hipError_t e = hipLaunchCooperativeKernel((const void*)mega, dim3(grid), dim3(512), args, LDS_BYTES, stream);
    if (e != hipSuccess) { fprintf(stderr, "kernel_launch: cooperative launch failed: %s\n", hipGetErrorString(e)); return; } }
#else
  a.ph_lo = 0; a.ph_hi = N_PHASES; void* args[] = {&a};
  hipError_t e = hipLaunchCooperativeKernel((const void*)mega, dim3(grid), dim3(512), args, LDS_BYTES, stream);
  if (e != hipSuccess) fprintf(stderr, "kernel_launch: cooperative launch failed: %s (grid %d)\n", hipGetErrorString(e), grid);
#ifdef EXTRA_LO
  a.ph_lo = EXTRA_LO; a.ph_hi = EXTRA_HI; (void)hipLaunchCooperativeKernel((const void*)mega, dim3(grid), dim3(512), args, LDS_BYTES, stream);
#endif
#endif
}
```

```cpp
#include <hip/hip_runtime.h>
#include <hip/hip_cooperative_groups.h>
#include <cstdio>
#include <cstdint>
namespace cg = cooperative_groups;
#define HD __host__ __device__ __forceinline__
#ifdef CFG_SMALL
constexpr int BATCH = 1, SEQ = 1024, DEC_BATCH = 2, PAST_LEN = 1024, MEM_TOKENS = 64, D_FF = 256;
#else
constexpr int BATCH = 8, SEQ = 2048, DEC_BATCH = 32, PAST_LEN = 8192, MEM_TOKENS = 256, D_FF = 2816;
#endif
constexpr int D_MODEL = 1024, DEC_SEQ = 8, PAGE_SIZE = 128;
constexpr int NSA_HEADS = 8, NSA_KVH = 2, NSA_HD = 64, NSA_G = 4;
constexpr int CMP_BLOCK = 32, CMP_STRIDE = 16, SEL_BLOCK = 64, SEL_TOPN = 8, WINDOW = 512;
constexpr int GDN_HEADS = 4, GDN_HD = 128, GDN_CONV = 4;
constexpr int XA_HEADS = 4, XA_HD = 256, FFN_CONV = 3;
constexpr float EPS = 1e-6f, NEGF = -1e30f, FORCED_BONUS = 1e4f;
constexpr int NSA_Q_W = 512, NSA_KV_W = 768, NSA_GATE_W = 24, GDN_W = 512;
constexpr int IN_COLS = 3360, LDP = 3584;
constexpr int OFF_Q = 0, OFF_KV = 512, OFF_GATE = 1280, OFF_QKV = 1304, OFF_Z = 2840, OFF_B = 3352, OFF_A = 3356;
constexpr int MP = BATCH * SEQ, MS = DEC_BATCH * DEC_SEQ, MTOT = MP + MS;
constexpr int MMEM = BATCH * MEM_TOKENS;
constexpr int NPAGES = PAST_LEN / PAGE_SIZE;
constexpr int NCP = SEQ / CMP_STRIDE - 1;
constexpr int NCS = PAST_LEN / CMP_STRIDE - 1;
constexpr int NCPS = 128, NCSS = 512;
constexpr int NSELP = SEQ / SEL_BLOCK;
constexpr int NSELS = PAST_LEN / SEL_BLOCK + 1;
constexpr int NSELMAX = 160;
constexpr int WINP = (WINDOW < SEQ ? WINDOW : SEQ);
constexpr int WBUF = (WINDOW < PAST_LEN ? WINDOW : PAST_LEN);
constexpr int WINS = (WINDOW < WBUF + DEC_SEQ ? WINDOW : WBUF + DEC_SEQ);
static_assert(NCP <= NCPS && NCS <= NCSS && NSELS <= NSELMAX && NSELP <= NSELMAX, "strides");
static_assert(WBUF == WINDOW && WINP == WINDOW && WINS == WINDOW, "window assumptions");

constexpr size_t O_YP = 0;
constexpr size_t O_YS = O_YP + (size_t)MP * D_MODEL;
constexpr size_t O_KVP = O_YS + (size_t)MS * D_MODEL;
constexpr size_t O_WINP = O_KVP + (size_t)MP * 512;
constexpr size_t O_STP = O_WINP + (size_t)BATCH * WINP * 256;
constexpr size_t O_GCP = O_STP + (size_t)BATCH * 4 * 128 * 128;
constexpr size_t O_FCP = O_GCP + (size_t)BATCH * 3 * 1536;
constexpr size_t O_MKVP = O_FCP + (size_t)BATCH * 2 * 2 * D_FF;
constexpr size_t O_KVS = O_MKVP + (size_t)MMEM * 2048;
constexpr size_t O_WINS = O_KVS + (size_t)MS * 512;
constexpr size_t O_STS = O_WINS + (size_t)DEC_BATCH * WINS * 256;
constexpr size_t O_GCS = O_STS + (size_t)DEC_BATCH * 4 * 128 * 128;
constexpr size_t O_FCS = O_GCS + (size_t)DEC_BATCH * 3 * 1536;
constexpr size_t O_END = O_FCS + (size_t)DEC_BATCH * 2 * 2 * D_FF;

typedef unsigned short bf16_t;
HD unsigned f2bf_u(float f) { unsigned u = __builtin_bit_cast(unsigned, f); return (u + 0x7fffu + ((u >> 16) & 1u)) >> 16; }
HD bf16_t f2bf(float f) { return (bf16_t)f2bf_u(f); }
HD float bf2f(bf16_t b) { return __builtin_bit_cast(float, (unsigned)b << 16); }
HD float sigmoidf_(float x) { return 1.f / (1.f + expf(-x)); }
HD float siluf_(float x) { return x / (1.f + expf(-x)); }
HD float softplusf_(float x) { return x > 20.f ? x : log1pf(expf(x)); }

struct Ctx {
  const float *x_prompt, *x_sample, *mem_prompt, *cache_nsa_kv, *cache_nsa_win, *state_gdn, *cache_gdn_conv, *cache_ffn_conv, *cache_mem_kv;
  const int* page_table;
  const float *attn_norm_w, *w_in, *nsa_q_norm_w, *nsa_k_norm_w, *cmp_pe, *cmp_w, *gdn_conv_w, *gdn_a_log, *gdn_dt_bias, *gdn_norm_w, *w_out,
      *mem_norm_w, *w_xk, *w_xv, *xk_norm_w, *xattn_norm_w, *w_xq, *xq_norm_w, *w_xo, *ffn_norm_w, *w_up, *ffn_conv_w, *ffn_conv_b, *w_down;
  float* out;
  bf16_t *XN, *MN, *CAT, *OX, *ACT;
  float *P, *MKV, *QC, *QR, *WR, *GATE, *GQ, *GK, *GV, *GB, *GG, *KCMP, *VCMP, *SCP, *SCS, *SCORE, *SS, *SW, *OG, *H1, *Q2, *SX, *H2, *UP;
  int* SIDX;
  bf16_t *Pb, *UPb, *QCb, *QRb, *KSb, *VSTb, *KWb, *VWTb, *KWsb, *VWTsb, *KCb, *VCTb, *KXb, *VXTb, *Q2b, *GWp, *GQKp, *GQDp, *GKDTp, *WcT;
  float *GS, *GSW, *GL, *PP, *CBIAS, *GKt, *GVt, *ROPE, *NPART;
};

HD int row_b(int m) { return m < MP ? m / SEQ : (m - MP) / DEC_SEQ; }
HD int row_t(int m) { return m < MP ? m % SEQ : (m - MP) % DEC_SEQ; }
HD int row_pos(int m) { return m < MP ? m % SEQ : PAST_LEN + (m - MP) % DEC_SEQ; }
HD const float* x_row(const Ctx& c, int m) { return m < MP ? c.x_prompt + (size_t)m * D_MODEL : c.x_sample + (size_t)(m - MP) * D_MODEL; }
HD float* kvrow_out(const Ctx& c, int m) { return m < MP ? c.out + O_KVP + (size_t)m * 512 : c.out + O_KVS + (size_t)(m - MP) * 512; }

struct StRms0 { const Ctx& c; static constexpr long N = MTOT + MMEM;
  HD void operator()(long i) const {
    const float* src; const float* w; bf16_t* dst;
    if (i < MTOT) { src = x_row(c, (int)i); w = c.attn_norm_w; dst = c.XN + (size_t)i * D_MODEL; }
    else { const long mm = i - MTOT; src = c.mem_prompt + (size_t)mm * D_MODEL; w = c.mem_norm_w; dst = c.MN + (size_t)mm * D_MODEL; }
    float ss = 0.f; for (int d = 0; d < D_MODEL; ++d) ss += src[d] * src[d];
    const float r = 1.f / sqrtf(ss / D_MODEL + EPS);
    for (int d = 0; d < D_MODEL; ++d) dst[d] = f2bf(src[d] * r * w[d]);
  } };
struct StRmsRows { const float* src; const float* w; bf16_t* dst; static constexpr long N = MTOT;
  HD void operator()(long i) const {
    const float* s = src + (size_t)i * D_MODEL; bf16_t* o = dst + (size_t)i * D_MODEL;
    float ss = 0.f; for (int d = 0; d < D_MODEL; ++d) ss += s[d] * s[d];
    const float r = 1.f / sqrtf(ss / D_MODEL + EPS);
    for (int d = 0; d < D_MODEL; ++d) o[d] = f2bf(s[d] * r * w[d]);
  } };
HD void rope_pair(float x1, float x2, int i, int pos, float& o1, float& o2) {
  const float inv = powf(10000.f, -(float)i / 32.f); const float ang = (float)pos * inv;
  const float cs = cosf(ang), sn = sinf(ang); o1 = x1 * cs - x2 * sn; o2 = x1 * sn + x2 * cs;
}
struct StQ { const Ctx& c; static constexpr long N = (long)MTOT * NSA_HEADS;
  HD void operator()(long i) const {
    const int m = (int)(i / NSA_HEADS), h = (int)(i % NSA_HEADS); const float* p = c.P + (size_t)m * LDP + OFF_Q + h * 64;
    float ss = 0.f; for (int d = 0; d < 64; ++d) ss += p[d] * p[d];
    const float r = 1.f / sqrtf(ss / 64.f + EPS); const int pos = row_pos(m);
    float* qc = c.QC + (size_t)m * 512 + h * 64; float* qr = c.QR + (size_t)m * 512 + h * 64;
    for (int d = 0; d < 32; ++d) { const float a = p[d] * r * c.nsa_q_norm_w[d], b = p[d + 32] * r * c.nsa_q_norm_w[d + 32];
      qc[d] = a; qc[d + 32] = b; float o1, o2; rope_pair(a, b, d, pos, o1, o2); qr[d] = o1; qr[d + 32] = o2; }
  } };
struct StKV { const Ctx& c; static constexpr long N = (long)MTOT * 6;
  HD void operator()(long i) const {
    const int m = (int)(i / 6), br = (int)(i % 6) / 2, kvh = (int)(i % 2); const float* pk = c.P + (size_t)m * LDP + OFF_KV + ((br * 2 + 0) * 2 + kvh) * 64;
    const float* pv = c.P + (size_t)m * LDP + OFF_KV + ((br * 2 + 1) * 2 + kvh) * 64;
    float ss = 0.f; for (int d = 0; d < 64; ++d) ss += pk[d] * pk[d];
    const float r = 1.f / sqrtf(ss / 64.f + EPS); const int pos = row_pos(m); const float* w = c.nsa_k_norm_w + br * 64;
    float *ko, *vo;
    if (br < 2) { float* ro = kvrow_out(c, m); ko = ro + ((br * 2 + 0) * 2 + kvh) * 64; vo = ro + ((br * 2 + 1) * 2 + kvh) * 64; }
    else { float* wo = c.WR + (size_t)m * 256; ko = wo + (0 * 2 + kvh) * 64; vo = wo + (1 * 2 + kvh) * 64; }
    for (int d = 0; d < 32; ++d) { const float a = pk[d] * r * w[d], b = pk[d + 32] * r * w[d + 32];
      if (br == 0) { ko[d] = a; ko[d + 32] = b; } else { float o1, o2; rope_pair(a, b, d, pos, o1, o2); ko[d] = o1; ko[d + 32] = o2; } }
    for (int d = 0; d < 64; ++d) vo[d] = pv[d];
  } };
struct StWinOut { const Ctx& c; static constexpr long N = (long)(BATCH + DEC_BATCH) * WINDOW * 256;
  HD void operator()(long i) const {
    const int e = (int)(i % 256); const long r = i / 256; const int j = (int)(r % WINDOW), bb = (int)(r / WINDOW);
    if (bb < BATCH) c.out[O_WINP + ((size_t)bb * WINDOW + j) * 256 + e] = c.WR[((size_t)bb * SEQ + SEQ - WINDOW + j) * 256 + e];
    else { const int b = bb - BATCH; const int w = j + DEC_SEQ;
      const float v = w < WBUF ? c.cache_nsa_win[((size_t)b * WBUF + w) * 256 + e] : c.WR[((size_t)MP + b * DEC_SEQ + (w - WBUF)) * 256 + e];
      c.out[O_WINS + ((size_t)b * WINDOW + j) * 256 + e] = v; }
  } };
struct StGate { const Ctx& c; static constexpr long N = (long)MTOT * 24;
  HD void operator()(long i) const { const int m = (int)(i / 24), e = (int)(i % 24); c.GATE[(size_t)m * 24 + e] = sigmoidf_(c.P[(size_t)m * LDP + OFF_GATE + e]); } };
HD float gdn_pre(const Ctx& c, int m, int dt_back, int ch) {
  const int t = row_t(m) - dt_back;
  if (t >= 0) return c.P[(size_t)(m - dt_back) * LDP + OFF_QKV + ch];
  if (m < MP) return 0.f;
  const int b = (m - MP) / DEC_SEQ; return c.cache_gdn_conv[((size_t)b * 3 + (3 + t)) * 1536 + ch];
}
struct StGdnConv { const Ctx& c; static constexpr long N = (long)MTOT * 12;
  HD void operator()(long i) const {
    const int m = (int)(i / 12), part = (int)(i % 12), which = part / 4, h = part % 4; const int ch0 = which * 512 + h * 128;
    float* dst = (which == 0 ? c.GQ : which == 1 ? c.GK : c.GV) + (size_t)m * 512 + h * 128;
    float ss = 0.f;
    for (int d = 0; d < 128; ++d) { const int ch = ch0 + d; float y = 0.f;
      for (int k = 0; k < 4; ++k) y += c.gdn_conv_w[k * 1536 + ch] * gdn_pre(c, m, 3 - k, ch);
      y = siluf_(y); dst[d] = y; ss += y * y; }
    if (which < 2) { const float r = (1.f / sqrtf(ss + EPS)) * (which == 0 ? 0.08838834764831845f : 1.f); for (int d = 0; d < 128; ++d) dst[d] *= r; }
  } };
struct StGdnMisc { const Ctx& c; static constexpr long N = (long)MTOT * 4;
  HD void operator()(long i) const {
    const int m = (int)(i / 4), h = (int)(i % 4); const float* p = c.P + (size_t)m * LDP;
    c.GB[i] = sigmoidf_(p[OFF_B + h]); c.GG[i] = -expf(c.gdn_a_log[h]) * softplusf_(p[OFF_A + h] + c.gdn_dt_bias[h]);
  } };
struct StGdnConvOut { const Ctx& c; static constexpr long N = (long)(BATCH + DEC_BATCH) * 3 * 1536;
  HD void operator()(long i) const {
    const int ch = (int)(i % 1536); const int r = (int)((i / 1536) % 3), bb = (int)(i / (3 * 1536));
    if (bb < BATCH) c.out[O_GCP + i] = c.P[((size_t)bb * SEQ + SEQ - 3 + r) * LDP + OFF_QKV + ch];
    else { const int b = bb - BATCH; c.out[O_GCS + ((size_t)b * 3 + r) * 1536 + ch] = c.P[((size_t)MP + b * DEC_SEQ + DEC_SEQ - 3 + r) * LDP + OFF_QKV + ch]; }
  } };
HD const float* nsa_row(const Ctx& c, bool sample, int b, int pos, int r, int kvh) {
  if (!sample) return c.out + O_KVP + ((size_t)b * SEQ + pos) * 512 + (r * 2 + kvh) * 64;
  if (pos < PAST_LEN) { const int pg = c.page_table[b * NPAGES + pos / PAGE_SIZE]; return c.cache_nsa_kv + ((size_t)pg * PAGE_SIZE + pos % PAGE_SIZE) * 512 + (r * 2 + kvh) * 64; }
  return c.out + O_KVS + ((size_t)b * DEC_SEQ + (pos - PAST_LEN)) * 512 + (r * 2 + kvh) * 64;
}
constexpr long NCMP_ITEMS_P = (long)BATCH * NCP * 2 * 2 * 64, NCMP_ITEMS_S = (long)DEC_BATCH * NCS * 2 * 2 * 64;
struct StCompress { const Ctx& c; static constexpr long N = NCMP_ITEMS_P + NCMP_ITEMS_S;
  HD void operator()(long i) const {
    const bool sample = i >= NCMP_ITEMS_P; long r = sample ? i - NCMP_ITEMS_P : i; const int nc = sample ? NCS : NCP;
    const int e = (int)(r % 64); r /= 64; const int kv = (int)(r % 2); r /= 2; const int kvh = (int)(r % 2); r /= 2; const int cb = (int)(r % nc), b = (int)(r / nc);
    const float* W = c.cmp_w + (size_t)kv * 32 * 64 * 64; const float* pe = c.cmp_pe + (size_t)kv * 32 * 64;
    float acc = 0.f;
    for (int j = 0; j < 32; ++j) { const float* x = nsa_row(c, sample, b, 16 * cb + j, kv, kvh);
      for (int d = 0; d < 64; ++d) acc += (x[d] + pe[j * 64 + d]) * W[((size_t)j * 64 + d) * 64 + e]; }
    float* dst = (kv == 0 ? c.KCMP : c.VCMP) + (sample ? (size_t)BATCH * NCP * 128 : 0) + (((size_t)b * nc + cb) * 2 + kvh) * 64 + e;
    *dst = acc;
  } };
HD const float* cmp_ptr(const Ctx& c, const float* base, bool sample, int b, int cb, int kvh) {
  return base + (sample ? (size_t)BATCH * NCP * 128 : 0) + (((size_t)b * (sample ? NCS : NCP) + cb) * 2 + kvh) * 64; }
HD float* scmp_ptr(const Ctx& c, int m, int h) { return m < MP ? c.SCP + ((size_t)m * 8 + h) * NCPS : c.SCS + ((size_t)(m - MP) * 8 + h) * NCSS; }
constexpr long NSC_P = (long)MP * 8 * NCPS, NSC_S = (long)MS * 8 * NCSS;
struct StCmpScore { const Ctx& c; static constexpr long N = NSC_P + NSC_S;
  HD void operator()(long i) const {
    const bool sample = i >= NSC_P; const long r = sample ? i - NSC_P : i; const int st = sample ? NCSS : NCPS, nc = sample ? NCS : NCP;
    const int cb = (int)(r % st), h = (int)((r / st) % 8); const int m = (int)(r / st / 8) + (sample ? MP : 0);
    float* dst = scmp_ptr(c, m, h) + cb; const int pos = row_pos(m);
    if (cb >= nc || 16 * cb + 31 > pos) { *dst = -3e38f; return; }
    const float* q = c.QC + (size_t)m * 512 + h * 64; const float* k = cmp_ptr(c, c.KCMP, sample, row_b(m), cb, h / 4);
    float s = 0.f; for (int d = 0; d < 64; ++d) s += q[d] * k[d];
    *dst = s * 0.125f;
  } };
HD void softmax_inplace(float* s, int n) {
  float mx = -3e38f; for (int j = 0; j < n; ++j) mx = fmaxf(mx, s[j]);
  if (mx < -1e38f) { for (int j = 0; j < n; ++j) s[j] = 0.f; return; }
  float sum = 0.f; for (int j = 0; j < n; ++j) { const float v = s[j]; if (v > -1e38f) sum += expf(v - mx); }
  const float inv = 1.f / fmaxf(sum, 1e-30f);
  for (int j = 0; j < n; ++j) { const float v = s[j]; s[j] = v > -1e38f ? expf(v - mx) * inv : 0.f; }
}
struct StCmpSoftmax { const Ctx& c; static constexpr long N = (long)MTOT * 8;
  HD void operator()(long i) const { const int m = (int)(i / 8), h = (int)(i % 8); softmax_inplace(scmp_ptr(c, m, h), m < MP ? NCPS : NCSS); } };
struct StTopk { const Ctx& c; static constexpr long N = (long)MTOT * 2;
  HD void operator()(long i) const {
    const int m = (int)(i / 2), kvh = (int)(i % 2); const bool sample = m >= MP; const int nsel = sample ? NSELS : NSELP, nc = sample ? NCS : NCP;
    const int pos = row_pos(m), qblk = pos / SEL_BLOCK; float* sc = c.SCORE + (size_t)i * NSELMAX;
    for (int s = 0; s < nsel; ++s) {
      float imp = 0.f;
      for (int g = 0; g < 4; ++g) { const float* p = scmp_ptr(c, m, kvh * 4 + g);
        for (int cb = 4 * s - 1; cb <= 4 * s + 3; ++cb) if (cb >= 0 && cb < nc) imp += p[cb]; }
      const bool visible = s <= qblk, forced = (s == 0) || (s == qblk) || (s == qblk - 1);
      sc[s] = visible ? imp + (forced ? FORCED_BONUS : 0.f) : NEGF;
    }
    const int ntop = nsel < SEL_TOPN ? nsel : SEL_TOPN;
    for (int n = 0; n < SEL_TOPN; ++n) {
      int best = -1; float bv = -3e38f;
      if (n < ntop) { for (int s = 0; s < nsel; ++s) if (sc[s] > bv) { bv = sc[s]; best = s; } }
      if (best >= 0) sc[best] = -3.2e38f;
      c.SIDX[i * 8 + n] = (best >= 0 && bv > 0.5f * NEGF) ? best : -1;
    }
  } };
struct StSelScore { const Ctx& c; static constexpr long N = (long)MTOT * 8 * 512;
  HD void operator()(long i) const {
    const int j = (int)(i % 64), n = (int)((i / 64) % 8), h = (int)((i / 512) % 8), m = (int)(i / 4096); const bool sample = m >= MP;
    const int blk = c.SIDX[((size_t)m * 2 + h / 4) * 8 + n]; const int pos = row_pos(m), key = blk * 64 + j;
    if (blk < 0 || key > pos) { c.SS[i] = -3e38f; return; }
    const float* q = c.QR + (size_t)m * 512 + h * 64; const float* k = nsa_row(c, sample, row_b(m), key, 2, h / 4);
    float s = 0.f; for (int d = 0; d < 64; ++d) s += q[d] * k[d];
    c.SS[i] = s * 0.125f;
  } };
HD const float* win_row(const Ctx& c, int m, int j, int which, int kvh) {
  const int pos = row_pos(m), kp = pos - (WINDOW - 1) + j; if (kp < 0) return nullptr;
  if (m < MP) return c.WR + ((size_t)(m / SEQ) * SEQ + kp) * 256 + (which * 2 + kvh) * 64;
  const int b = (m - MP) / DEC_SEQ;
  if (kp < PAST_LEN) return c.cache_nsa_win + ((size_t)b * WBUF + (kp - (PAST_LEN - WBUF))) * 256 + (which * 2 + kvh) * 64;
  return c.WR + ((size_t)MP + b * DEC_SEQ + (kp - PAST_LEN)) * 256 + (which * 2 + kvh) * 64;
}
struct StWinScore { const Ctx& c; static constexpr long N = (long)MTOT * 8 * 512;
  HD void operator()(long i) const {
    const int j = (int)(i % 512), h = (int)((i / 512) % 8), m = (int)(i / 4096);
    const float* k = win_row(c, m, j, 0, h / 4); if (!k) { c.SW[i] = -3e38f; return; }
    const float* q = c.QR + (size_t)m * 512 + h * 64; float s = 0.f; for (int d = 0; d < 64; ++d) s += q[d] * k[d];
    c.SW[i] = s * 0.125f;
  } };
struct StSoftmax512 { float* buf; static constexpr long N = (long)MTOT * 8;
  HD void operator()(long i) const { softmax_inplace(buf + (size_t)i * 512, 512); } };
struct StNsaOut { const Ctx& c; static constexpr long N = (long)MTOT * 512;
  HD void operator()(long i) const {
    const int d = (int)(i % 64), h = (int)((i / 64) % 8), m = (int)(i / 512), kvh = h / 4; const bool sample = m >= MP; const int b = row_b(m);
    const float* pc = scmp_ptr(c, m, h); const int nc = sample ? NCS : NCP;
    float oc = 0.f; for (int cb = 0; cb < nc; ++cb) { const float p = pc[cb]; if (p != 0.f) oc += p * cmp_ptr(c, c.VCMP, sample, b, cb, kvh)[d]; }
    const float* ps = c.SS + ((size_t)m * 8 + h) * 512; float os = 0.f;
    for (int n = 0; n < 8; ++n) { const int blk = c.SIDX[((size_t)m * 2 + kvh) * 8 + n]; if (blk < 0) continue;
      for (int j = 0; j < 64; ++j) { const float p = ps[n * 64 + j]; if (p != 0.f) os += p * nsa_row(c, sample, b, blk * 64 + j, 3, kvh)[d]; } }
    const float* pw = c.SW + ((size_t)m * 8 + h) * 512; float ow = 0.f;
    for (int j = 0; j < 512; ++j) { const float p = pw[j]; if (p != 0.f) ow += p * win_row(c, m, j, 1, kvh)[d]; }
    const float* g = c.GATE + (size_t)m * 24 + h * 3;
    c.CAT[(size_t)m * D_MODEL + h * 64 + d] = f2bf(oc * g[0] + os * g[1] + ow * g[2]);
  } };
#if defined(__HIP_DEVICE_COMPILE__)
#define GDN_FENCE() asm volatile("" ::: "memory")
#else
#define GDN_FENCE() do {} while (0)
#endif
struct StGdnScan { const Ctx& c; static constexpr long N = (long)(BATCH + DEC_BATCH) * 4 * 128;
  HD void operator()(long i) const {
    const int dv = (int)(i % 128), h = (int)((i / 128) % 4), bb = (int)(i / 512); const bool sample = bb >= BATCH; const int b = sample ? bb - BATCH : bb;
    const int T = sample ? DEC_SEQ : SEQ; const int m0 = sample ? MP + b * DEC_SEQ : b * SEQ;
    float S[128];
#pragma unroll
    for (int k = 0; k < 128; ++k) S[k] = sample ? c.state_gdn[(((size_t)b * 4 + h) * 128 + k) * 128 + dv] : 0.f;
    for (int t = 0; t < T; ++t) { const int m = m0 + t;
      const float* kk = c.GK + (size_t)m * 512 + h * 128; const float* qq = c.GQ + (size_t)m * 512 + h * 128;
      const float v = c.GV[(size_t)m * 512 + h * 128 + dv], beta = c.GB[(size_t)m * 4 + h], a = expf(c.GG[(size_t)m * 4 + h]);
      float ks = 0.f;
#pragma unroll
      for (int k0 = 0; k0 < 128; k0 += 16) {
#pragma unroll
        for (int k = 0; k < 16; ++k) ks += kk[k0 + k] * S[k0 + k];
        GDN_FENCE(); }
      const float coef = beta * (v - a * ks); float o = 0.f;
#pragma unroll
      for (int k0 = 0; k0 < 128; k0 += 16) {
#pragma unroll
        for (int k = 0; k < 16; ++k) { S[k0 + k] = a * S[k0 + k] + kk[k0 + k] * coef; o += qq[k0 + k] * S[k0 + k]; }
        GDN_FENCE(); }
      c.OG[(size_t)m * 512 + h * 128 + dv] = o; }
    float* so = c.out + (sample ? O_STS : O_STP) + (((size_t)b * 4 + h) * 128) * 128 + dv;
#pragma unroll
    for (int k = 0; k < 128; ++k) so[(size_t)k * 128] = S[k];
  } };
struct StGdnNorm { const Ctx& c; static constexpr long N = (long)MTOT * 4;
  HD void operator()(long i) const {
    const int m = (int)(i / 4), h = (int)(i % 4); const float* o = c.OG + (size_t)m * 512 + h * 128; const float* z = c.P + (size_t)m * LDP + OFF_Z + h * 128;
    float ss = 0.f; for (int d = 0; d < 128; ++d) ss += o[d] * o[d];
    const float r = 1.f / sqrtf(ss / 128.f + EPS);
    for (int d = 0; d < 128; ++d) c.CAT[(size_t)m * D_MODEL + 512 + h * 128 + d] = f2bf(o[d] * r * c.gdn_norm_w[d] * siluf_(z[d]));
  } };
struct StMemKV { const Ctx& c; static constexpr long N = (long)MMEM * 4;
  HD void operator()(long i) const {
    const int mm = (int)(i / 4), h = (int)(i % 4); const float* k = c.MKV + (size_t)mm * 2048 + h * 256; const float* v = c.MKV + (size_t)mm * 2048 + 1024 + h * 256;
    float ss = 0.f; for (int d = 0; d < 256; ++d) ss += k[d] * k[d];
    const float r = 1.f / sqrtf(ss / 256.f + EPS); float* o = c.out + O_MKVP + (size_t)mm * 2048;
    for (int d = 0; d < 256; ++d) { o[h * 256 + d] = k[d] * r * c.xk_norm_w[d]; o[1024 + h * 256 + d] = v[d]; }
  } };
struct StXqNorm { const Ctx& c; static constexpr long N = (long)MTOT * 4;
  HD void operator()(long i) const {
    float* q = c.Q2 + (size_t)(i / 4) * D_MODEL + (i % 4) * 256; float ss = 0.f; for (int d = 0; d < 256; ++d) ss += q[d] * q[d];
    const float r = 1.f / sqrtf(ss / 256.f + EPS); for (int d = 0; d < 256; ++d) q[d] = q[d] * r * c.xq_norm_w[d];
  } };
HD const float* memkv_row(const Ctx& c, int m, int j, int which, int h) {
  if (m < MP) return c.out + O_MKVP + ((size_t)(m / SEQ) * MEM_TOKENS + j) * 2048 + which * 1024 + h * 256;
  return c.cache_mem_kv + ((size_t)((m - MP) / DEC_SEQ) * MEM_TOKENS + j) * 2048 + which * 1024 + h * 256;
}
struct StXScore { const Ctx& c; static constexpr long N = (long)MTOT * 4 * MEM_TOKENS;
  HD void operator()(long i) const {
    const int j = (int)(i % MEM_TOKENS), h = (int)((i / MEM_TOKENS) % 4), m = (int)(i / MEM_TOKENS / 4);
    const float* q = c.Q2 + (size_t)m * D_MODEL + h * 256; const float* k = memkv_row(c, m, j, 0, h);
    float s = 0.f; for (int d = 0; d < 256; ++d) s += q[d] * k[d];
    c.SX[i] = s * 0.0625f;
  } };
struct StXSoftmax { const Ctx& c; static constexpr long N = (long)MTOT * 4;
  HD void operator()(long i) const { softmax_inplace(c.SX + (size_t)i * MEM_TOKENS, MEM_TOKENS); } };
struct StXOut { const Ctx& c; static constexpr long N = (long)MTOT * D_MODEL;
  HD void operator()(long i) const {
    const int d = (int)(i % 256), h = (int)((i / 256) % 4), m = (int)(i / D_MODEL); const float* p = c.SX + ((size_t)m * 4 + h) * MEM_TOKENS;
    float o = 0.f; for (int j = 0; j < MEM_TOKENS; ++j) o += p[j] * memkv_row(c, m, j, 1, h)[d];
    c.OX[i] = f2bf(o);
  } };
HD float up_at(const Ctx& c, int m, int back, int col) {
  const int t = row_t(m) - back; if (t >= 0) return c.UP[(size_t)(m - back) * (2 * D_FF) + col];
  if (m < MP) return 0.f;
  return c.cache_ffn_conv[((size_t)((m - MP) / DEC_SEQ) * 2 + (2 + t)) * (2 * D_FF) + col];
}
struct StFfnAct { const Ctx& c; static constexpr long N = (long)MTOT * D_FF;
  HD void operator()(long i) const {
    const int col = (int)(i % D_FF), m = (int)(i / D_FF); float a = c.ffn_conv_b[col], u = c.ffn_conv_b[D_FF + col];
    for (int k = 0; k < 3; ++k) { a += c.ffn_conv_w[k * 2 * D_FF + col] * up_at(c, m, 2 - k, col); u += c.ffn_conv_w[k * 2 * D_FF + D_FF + col] * up_at(c, m, 2 - k, D_FF + col); }
    c.ACT[i] = f2bf(siluf_(a) * u);
  } };
struct StFfnConvOut { const Ctx& c; static constexpr long N = (long)(BATCH + DEC_BATCH) * 2 * 2 * D_FF;
  HD void operator()(long i) const {
    const int col = (int)(i % (2 * D_FF)), r = (int)((i / (2 * D_FF)) % 2), bb = (int)(i / (4 * D_FF));
    if (bb < BATCH) c.out[O_FCP + i] = c.UP[((size_t)bb * SEQ + SEQ - 2 + r) * (2 * D_FF) + col];
    else { const int b = bb - BATCH; c.out[O_FCS + ((size_t)b * 2 + r) * (2 * D_FF) + col] = c.UP[((size_t)MP + b * DEC_SEQ + DEC_SEQ - 2 + r) * (2 * D_FF) + col]; }
  } };

struct WsMap { size_t off; HD size_t take(size_t bytes) { const size_t o = off; off += (bytes + 255) & ~(size_t)255; return o; } };
inline size_t ws_carve(Ctx& c, unsigned char* ws, size_t base) {
  WsMap w{base};
  c.XN = (bf16_t*)(ws + w.take((size_t)MTOT * D_MODEL * 2)); c.MN = (bf16_t*)(ws + w.take((size_t)MMEM * D_MODEL * 2));
  c.CAT = (bf16_t*)(ws + w.take((size_t)MTOT * D_MODEL * 2)); c.OX = (bf16_t*)(ws + w.take((size_t)MTOT * D_MODEL * 2));
  c.ACT = (bf16_t*)(ws + w.take((size_t)MTOT * D_FF * 2));
  c.P = (float*)(ws + w.take((size_t)MTOT * LDP * 4)); c.Pb = (bf16_t*)c.P;   c.MKV = (float*)(ws + w.take((size_t)MMEM * 2048 * 4));
  c.QC = (float*)(ws + w.take((size_t)MTOT * 512 * 4)); c.QR = (float*)(ws + w.take((size_t)MTOT * 512 * 4));
  c.WR = (float*)(ws + w.take((size_t)MTOT * 256 * 4)); c.GATE = (float*)(ws + w.take((size_t)MTOT * 24 * 4));
  c.GQ = (float*)(ws + w.take((size_t)MTOT * 512 * 4)); c.GK = (float*)(ws + w.take((size_t)MTOT * 512 * 4)); c.GV = (float*)(ws + w.take((size_t)MTOT * 512 * 4));
  c.GB = (float*)(ws + w.take((size_t)MTOT * 4 * 4)); c.GG = (float*)(ws + w.take((size_t)MTOT * 4 * 4));
  const size_t ncmp = ((size_t)BATCH * NCP + (size_t)DEC_BATCH * NCS) * 128 * 4;
  c.KCMP = (float*)(ws + w.take(ncmp)); c.VCMP = (float*)(ws + w.take(ncmp));
  c.SCP = (float*)(ws + w.take((size_t)MP * 8 * NCPS * 4)); c.SCS = (float*)(ws + w.take((size_t)MS * 8 * NCSS * 4));
  c.SCORE = (float*)(ws + w.take((size_t)MTOT * 2 * NSELMAX * 4)); c.SIDX = (int*)(ws + w.take((size_t)MTOT * 2 * 8 * 4));
  c.OG = (float*)(ws + w.take(((size_t)BATCH * 4 * (SEQ / 64) + (size_t)DEC_BATCH * 4) * 64 * 128 * 4 > (size_t)MTOT * 512 * 4 ? ((size_t)BATCH * 4 * (SEQ / 64) + (size_t)DEC_BATCH * 4) * 64 * 128 * 4 : (size_t)MTOT * 512 * 4)); c.H1 = (float*)(ws + w.take((size_t)MTOT * D_MODEL * 4));
  c.Q2 = (float*)(ws + w.take((size_t)MTOT * D_MODEL * 4)); c.SX = (float*)(ws + w.take((size_t)MTOT * 4 * MEM_TOKENS * 4));
  c.H2 = (float*)(ws + w.take((size_t)MTOT * D_MODEL * 4));
  c.QCb = (bf16_t*)(ws + w.take((size_t)MTOT * 512 * 2)); c.QRb = (bf16_t*)(ws + w.take((size_t)MTOT * 512 * 2));
  c.KSb = (bf16_t*)(ws + w.take((size_t)BATCH * 2 * SEQ * 64 * 2)); c.VSTb = (bf16_t*)(ws + w.take((size_t)BATCH * 2 * SEQ * 64 * 2));
  c.KWb = (bf16_t*)(ws + w.take((size_t)BATCH * 2 * SEQ * 64 * 2)); c.VWTb = (bf16_t*)(ws + w.take((size_t)BATCH * 2 * SEQ * 64 * 2));
  c.KWsb = (bf16_t*)(ws + w.take((size_t)DEC_BATCH * 2 * 544 * 64 * 2)); c.VWTsb = (bf16_t*)(ws + w.take((size_t)DEC_BATCH * 2 * 544 * 64 * 2));
  { const size_t nb = ((size_t)BATCH * 2 * 128 + (size_t)DEC_BATCH * 2 * 512) * 64 * 2; c.KCb = (bf16_t*)(ws + w.take(nb)); c.VCTb = (bf16_t*)(ws + w.take(nb)); }
  { const size_t nb = (size_t)(BATCH + DEC_BATCH) * 4 * MEM_TOKENS * 256 * 2; c.KXb = (bf16_t*)(ws + w.take(nb)); c.VXTb = (bf16_t*)(ws + w.take(nb)); c.Q2b = (bf16_t*)(ws + w.take((size_t)MTOT * D_MODEL * 2)); }
  { constexpr size_t nchunk = (size_t)BATCH * 4 * (SEQ / 64) + (size_t)DEC_BATCH * 4;
    c.GS = (float*)(ws + w.take(nchunk * 64 * 128 * 4)); c.GSW = (float*)(ws + w.take(nchunk * 64 * 128 * 4)); c.GKt = (float*)(ws + w.take(nchunk * 64 * 128 * 4)); c.GVt = (float*)(ws + w.take(nchunk * 64 * 128 * 4)); c.GWp = (bf16_t*)(ws + w.take(nchunk * 64 * 128 * 2)); c.GQKp = (bf16_t*)(ws + w.take(nchunk * 64 * 64 * 2));
    c.GQDp = (bf16_t*)(ws + w.take(nchunk * 64 * 128 * 2)); c.GKDTp = (bf16_t*)(ws + w.take(nchunk * 128 * 64 * 2)); c.GL = (float*)(ws + w.take(nchunk * 4)); }
  c.ROPE = (float*)(ws + w.take((size_t)(SEQ + DEC_SEQ) * 64 * 4)); c.NPART = (float*)(ws + w.take((size_t)DEC_BATCH * 2 * 4 * 3 * 64 * 34 * 4));
  c.WcT = (bf16_t*)(ws + w.take((size_t)2 * 2 * 64 * 1024 * 2)); c.CBIAS = (float*)(ws + w.take(128 * 4));
  c.PP = (float*)(ws + w.take(((size_t)2 * BATCH * 2 * (SEQ / 16) + (size_t)2 * DEC_BATCH * 2 * (PAST_LEN / 16)) * 128 * 4));
  const size_t ssb = (size_t)MTOT * 8 * 512 * 4, upb = (size_t)MTOT * 2 * D_FF * 4; const size_t big = w.take(2 * ssb > upb ? 2 * ssb : upb);
  c.SS = (float*)(ws + big); c.SW = (float*)(ws + big + ssb); c.UP = (float*)(ws + big); c.UPb = (bf16_t*)(ws + big);
  return w.off;
}
typedef short bf16x8 __attribute__((ext_vector_type(8)));
typedef float f32x16 __attribute__((ext_vector_type(16)));
typedef float f32x4v __attribute__((ext_vector_type(4)));
typedef unsigned u32x4v __attribute__((ext_vector_type(4)));
typedef unsigned u32x2v __attribute__((ext_vector_type(2)));
#ifdef HOST_TEST
#include <ucontext.h>
struct EmuSlot { short a[8]; short b[8]; float c[16]; unsigned u; };
struct EmuWave {
  ucontext_t main_ctx; ucontext_t ctx[64]; char* stacks; int cur; int ndone; bool done[64]; int gen[64];
  EmuSlot slot[2][64]; void (*fn)(void*, int); void* arg;
};
static thread_local EmuWave* tl_emu = nullptr;
static void emu_trampoline(int lane) { EmuWave* e = tl_emu; e->fn(e->arg, lane); e->done[lane] = true; e->ndone++; swapcontext(&e->ctx[lane], &e->main_ctx); }
static void emu_run_wave(void (*fn)(void*, int), void* arg) {
  static thread_local EmuWave* e = nullptr; constexpr size_t STK = 256 * 1024;
  if (!e) { e = new EmuWave; e->stacks = (char*)malloc(64 * STK); }
  tl_emu = e; e->fn = fn; e->arg = arg; e->ndone = 0;
  for (int l = 0; l < 64; ++l) { e->done[l] = false; e->gen[l] = 0; getcontext(&e->ctx[l]); e->ctx[l].uc_stack.ss_sp = e->stacks + l * STK; e->ctx[l].uc_stack.ss_size = STK; e->ctx[l].uc_link = nullptr;
    makecontext(&e->ctx[l], (void (*)())emu_trampoline, 1, l); }
  while (e->ndone < 64) for (int l = 0; l < 64; ++l) if (!e->done[l]) { e->cur = l; swapcontext(&e->main_ctx, &e->ctx[l]); }
}
static inline EmuSlot* emu_my_slot() { EmuWave* e = tl_emu; return &e->slot[e->gen[e->cur] & 1][e->cur]; }
static inline EmuSlot* emu_exchange() { EmuWave* e = tl_emu; const int l = e->cur; swapcontext(&e->ctx[l], &e->main_ctx); e = tl_emu; EmuSlot* s = e->slot[e->gen[l] & 1]; e->gen[l]++; return s; }
static inline int wv_lane() { return tl_emu->cur; }
static inline int wv_lane_opaque() { return tl_emu->cur; }
static inline float bfbits2f(short s) { return __builtin_bit_cast(float, (unsigned)(unsigned short)s << 16); }
static inline f32x16 wv_mfma32(bf16x8 a, bf16x8 b, f32x16 c) {
  EmuSlot* m = emu_my_slot(); for (int j = 0; j < 8; ++j) { m->a[j] = a[j]; m->b[j] = b[j]; }
  EmuSlot* s = emu_exchange(); const int l = wv_lane(), col = l & 31, hi = l >> 5; f32x16 d;
  for (int r = 0; r < 16; ++r) { const int row = (r & 3) + 8 * (r >> 2) + 4 * hi; float acc = c[r];
    for (int k = 0; k < 16; ++k) acc += bfbits2f(s[row + 32 * (k >> 3)].a[k & 7]) * bfbits2f(s[col + 32 * (k >> 3)].b[k & 7]);
    d[r] = acc; }
  return d;
}
static inline unsigned wv_shfl_xor_u(unsigned v, int mask) { emu_my_slot()->u = v; EmuSlot* s = emu_exchange(); return s[wv_lane() ^ mask].u; }
static inline unsigned wv_shfl_u(unsigned v, int src) { emu_my_slot()->u = v; EmuSlot* s = emu_exchange(); return s[src & 63].u; }
static inline unsigned long long wv_ballot(bool p) { emu_my_slot()->u = p ? 1u : 0u; EmuSlot* s = emu_exchange(); unsigned long long r = 0; for (int l = 0; l < 64; ++l) if (s[l].u) r |= 1ull << l; return r; }
static inline float wv_exp2(float x) { return exp2f(x); }
static inline float wv_rcp(float x) { return 1.f / x; }
static inline unsigned wv_pk_bf16(float lo, float hi) { return f2bf_u(lo) | (f2bf_u(hi) << 16); }
#define WV_DEV inline
#define WV_SCHED_BARRIER() do {} while (0)
static inline void wv_fence() { emu_my_slot()->u = 0; (void)emu_exchange(); }
#else
#define WV_DEV __device__ __forceinline__
#define WV_SCHED_BARRIER() __builtin_amdgcn_sched_barrier(0)
WV_DEV int wv_lane() { return (int)(threadIdx.x & 63); }
WV_DEV int wv_lane_opaque() { int l = (int)(threadIdx.x & 63); asm volatile("" : "+v"(l)); return l; }
WV_DEV void wv_fence() { asm volatile("s_waitcnt vmcnt(0) lgkmcnt(0)" ::: "memory"); }
WV_DEV f32x16 wv_mfma32(bf16x8 a, bf16x8 b, f32x16 c) { return __builtin_amdgcn_mfma_f32_32x32x16_bf16(a, b, c, 0, 0, 0); }
WV_DEV unsigned wv_shfl_xor_u(unsigned v, int mask) { return (unsigned)__shfl_xor((int)v, mask); }
WV_DEV unsigned wv_shfl_u(unsigned v, int src) { return (unsigned)__shfl((int)v, src); }
WV_DEV unsigned long long wv_ballot(bool p) { return __ballot(p); }
WV_DEV float wv_exp2(float x) { return __builtin_amdgcn_exp2f(x); }
WV_DEV float wv_rcp(float x) { return __builtin_amdgcn_rcpf(x); }
typedef float wv_f32x2 __attribute__((ext_vector_type(2))); typedef __bf16 wv_bf16x2 __attribute__((ext_vector_type(2)));
WV_DEV unsigned wv_pk_bf16(float lo, float hi) { wv_f32x2 v = {lo, hi}; wv_bf16x2 b = __builtin_convertvector(v, wv_bf16x2); return __builtin_bit_cast(unsigned, b); }
#endif
#ifdef HOST_TEST
constexpr bool PBF = false;
#else
constexpr bool PBF = true;
#endif
WV_DEV float bfu2f(unsigned short b) { return __builtin_bit_cast(float, (unsigned)b << 16); }
WV_DEV float wv_shfl_xor_f(float v, int mask) { return __builtin_bit_cast(float, wv_shfl_xor_u(__builtin_bit_cast(unsigned, v), mask)); }
WV_DEV bf16x8 wv_pack8(float a0, float a1, float a2, float a3, float a4, float a5, float a6, float a7) {
  u32x4v w; w.x = wv_pk_bf16(a0, a1); w.y = wv_pk_bf16(a2, a3); w.z = wv_pk_bf16(a4, a5); w.w = wv_pk_bf16(a6, a7); return __builtin_bit_cast(bf16x8, w); }
WV_DEV bf16x8 wv_ld8(const bf16_t* p) { return *(const bf16x8*)p; }
WV_DEV bf16x8 wv_ld8_f32(const float* p) { const f32x4v a = *(const f32x4v*)p, b = *(const f32x4v*)(p + 4); return wv_pack8(a.x, a.y, a.z, a.w, b.x, b.y, b.z, b.w); }
constexpr int WKS = 544;
HD int vperm16(int k) { const int w = k & 15; return (k & ~15) | ((((w >> 2) & 1) << 3) + ((w >> 3) << 2) + (w & 3)); }
HD size_t frag_idx(int r, int k, int K) { return ((size_t)(r >> 5) * (K >> 4) + (k >> 4)) * 512 + (size_t)(((((k >> 3) & 1) << 5) + (r & 31)) << 3) + (k & 7); }
HD size_t kc_off(bool sample, int b, int kvh) { return sample ? (size_t)BATCH * 2 * 128 * 64 + ((size_t)b * 2 + kvh) * 512 * 64 : ((size_t)b * 2 + kvh) * 128 * 64; }
struct StPackQ { const Ctx& c; static constexpr long N = (long)MTOT * 512;
  HD void operator()(long i) const { c.QCb[i] = f2bf(c.QC[i]); c.QRb[i] = f2bf(c.QR[i]); } };
struct StPackKV { const Ctx& c; static constexpr long N = (long)BATCH * 2 * SEQ * 64;
  HD void operator()(long i) const {
    const int d = (int)(i % 64), t = (int)((i / 64) % SEQ), kvh = (int)((i / 64 / SEQ) % 2), b = (int)(i / 64 / SEQ / 2);
    const float* row = c.out + O_KVP + ((size_t)b * SEQ + t) * 512; const float* wr = c.WR + ((size_t)b * SEQ + t) * 256;
    const size_t bk = (size_t)b * 2 + kvh;
    c.KSb[bk * SEQ * 64 + frag_idx(t, d, 64)] = f2bf(row[(2 * 2 + kvh) * 64 + d]); c.VSTb[bk * 64 * SEQ + frag_idx(d, vperm16(t), SEQ)] = f2bf(row[(3 * 2 + kvh) * 64 + d]);
    c.KWb[bk * SEQ * 64 + frag_idx(t, d, 64)] = f2bf(wr[(0 * 2 + kvh) * 64 + d]); c.VWTb[bk * 64 * SEQ + frag_idx(d, vperm16(t), SEQ)] = f2bf(wr[(1 * 2 + kvh) * 64 + d]);
  } };
struct StPackWinS { const Ctx& c; static constexpr long N = (long)DEC_BATCH * 2 * WKS * 64;
  HD void operator()(long i) const {
    const int d = (int)(i % 64), w = (int)((i / 64) % WKS), kvh = (int)((i / 64 / WKS) % 2), b = (int)(i / 64 / WKS / 2);
    float k = 0.f, v = 0.f;
    if (w < WBUF) { const float* r = c.cache_nsa_win + ((size_t)b * WBUF + w) * 256; k = r[(0 * 2 + kvh) * 64 + d]; v = r[(1 * 2 + kvh) * 64 + d]; }
    else if (w < WBUF + DEC_SEQ) { const float* r = c.WR + ((size_t)MP + b * DEC_SEQ + (w - WBUF)) * 256; k = r[(0 * 2 + kvh) * 64 + d]; v = r[(1 * 2 + kvh) * 64 + d]; }
    const size_t bk = (size_t)b * 2 + kvh;
    c.KWsb[bk * WKS * 64 + frag_idx(w, d, 64)] = f2bf(k); c.VWTsb[bk * 64 * WKS + frag_idx(d, vperm16(w), WKS)] = f2bf(v);
  } };
constexpr long NPC_P = (long)BATCH * 2 * 128 * 64, NPC_S = (long)DEC_BATCH * 2 * 512 * 64;
struct StPackCmp { const Ctx& c; static constexpr long N = NPC_P + NPC_S;
  HD void operator()(long i) const {
    const bool sample = i >= NPC_P; long r = sample ? i - NPC_P : i; const int cpad = sample ? 512 : 128, nc = sample ? NCS : NCP;
    const int d = (int)(r % 64); r /= 64; const int cb = (int)(r % cpad); r /= cpad; const int kvh = (int)(r % 2), b = (int)(r / 2);
    float k = 0.f, v = 0.f; if (cb < nc) { k = cmp_ptr(c, c.KCMP, sample, b, cb, kvh)[d]; v = cmp_ptr(c, c.VCMP, sample, b, cb, kvh)[d]; }
    const size_t o = kc_off(sample, b, kvh);
    c.KCb[o + frag_idx(cb, d, 64)] = f2bf(k); c.VCTb[o + frag_idx(d, vperm16(cb), cpad)] = f2bf(v);
  } };

HD int crow16(int r, int hi) { return (r & 3) + 8 * (r >> 2) + 4 * hi; }
struct SoftSt { float m, l; f32x16 o[2]; };
constexpr float NSA_SCL = 0.125f * 1.4426950408889634f;
WV_DEV void soft_step(SoftSt& st, const f32x16& S, unsigned vm, bf16x8 v00, bf16x8 v01, bf16x8 v10, bf16x8 v11) {
  float sc[16]; float mx = -3e38f;
#pragma unroll
  for (int r = 0; r < 16; ++r) { sc[r] = ((vm >> r) & 1u) ? S[r] * NSA_SCL : -3e38f; mx = fmaxf(mx, sc[r]); }
  mx = fmaxf(mx, wv_shfl_xor_f(mx, 32));
  const float mn = fmaxf(st.m, mx), alpha = wv_exp2(st.m - mn); st.m = mn;
  float p[16]; float sum = 0.f;
#pragma unroll
  for (int r = 0; r < 16; ++r) { p[r] = ((vm >> r) & 1u) ? wv_exp2(sc[r] - mn) : 0.f; sum += p[r]; }
  st.l = st.l * alpha + sum; st.o[0] = st.o[0] * alpha; st.o[1] = st.o[1] * alpha;
  const bf16x8 p0 = wv_pack8(p[0], p[1], p[2], p[3], p[4], p[5], p[6], p[7]), p1 = wv_pack8(p[8], p[9], p[10], p[11], p[12], p[13], p[14], p[15]);
  st.o[0] = wv_mfma32(v00, p0, st.o[0]); st.o[0] = wv_mfma32(v01, p1, st.o[0]);
  st.o[1] = wv_mfma32(v10, p0, st.o[1]); st.o[1] = wv_mfma32(v11, p1, st.o[1]);
}
WV_DEV void soft_finish(SoftSt& st, float gate, f32x16 (&ot)[2]) {
  const float l = st.l + wv_shfl_xor_f(st.l, 32); const float f = l > 0.f ? gate * wv_rcp(l) : 0.f;
  ot[0] = ot[0] + st.o[0] * f; ot[1] = ot[1] + st.o[1] * f;
}
WV_DEV f32x16 qk_tile(const bf16_t* ktile  , const bf16x8 (&q)[4]) {
  f32x16 S = {};
#pragma unroll
  for (int ks = 0; ks < 4; ++ks) S = wv_mfma32(wv_ld8(ktile + ks * 512), q[ks], S);
  return S;
}
WV_DEV void cmp_tile2(const bf16_t* kcb, const bf16_t* vcb, int cpad, int tile, int r32, int hi, int ncv, float mc, float invc, const bf16x8 (&qc)[4], f32x16 (&oc)[2],
                      bool need_imp, float& prevLp, float (&v4)[4]) {
  const f32x16 S = qk_tile(kcb + (size_t)tile * 2048 + (hi * 32 + r32) * 8, qc);
  float p[16];
#pragma unroll
  for (int r = 0; r < 16; ++r) p[r] = (tile * 32 + crow16(r, hi) < ncv) ? wv_exp2(S[r] * NSA_SCL - mc) * invc : 0.f;
  if (need_imp) {
#pragma unroll
    for (int u = 0; u < 4; ++u) {
      const float lp = wv_shfl_xor_f(p[4 * u + 3], 32); float v = (p[4 * u] + p[4 * u + 1]) + (p[4 * u + 2] + p[4 * u + 3]) + (hi ? lp : prevLp); prevLp = lp;
      v += wv_shfl_xor_f(v, 1); v += wv_shfl_xor_f(v, 2); v4[u] = v; }
  }
  const bf16x8 p0 = wv_pack8(p[0], p[1], p[2], p[3], p[4], p[5], p[6], p[7]), p1 = wv_pack8(p[8], p[9], p[10], p[11], p[12], p[13], p[14], p[15]);
  const bf16_t* vb = vcb + (size_t)(tile * 2) * 512 + (hi * 32 + r32) * 8; const size_t dbs = (size_t)(cpad >> 4) * 512;
  oc[0] = wv_mfma32(wv_ld8(vb), p0, oc[0]); oc[0] = wv_mfma32(wv_ld8(vb + 512), p1, oc[0]);
  oc[1] = wv_mfma32(wv_ld8(vb + dbs), p0, oc[1]); oc[1] = wv_mfma32(wv_ld8(vb + dbs + 512), p1, oc[1]);
}
HD const float* sample_row(const Ctx& c, int b, int kp) {
  if (kp < PAST_LEN) { const int pg = c.page_table[b * NPAGES + kp / PAGE_SIZE]; return c.cache_nsa_kv + ((size_t)pg * PAGE_SIZE + kp % PAGE_SIZE) * 512; }
  int j = kp - PAST_LEN; if (j > DEC_SEQ - 1) j = DEC_SEQ - 1; return c.out + O_KVS + ((size_t)b * DEC_SEQ + j) * 512;
}
constexpr int NSA_SUB = 4, NSA_PART = 34;
template <bool SAMPLE> WV_DEV void nsa_unit(const Ctx& c, int unit, float* wscr  ) {
  constexpr int NC = SAMPLE ? NCS : NCP, CPAD = SAMPLE ? 512 : 128, NCT = CPAD / 32, NI = NCT * 4;
  const int lane = wv_lane(), r32 = lane & 31, hi = lane >> 5, tt = r32 >> 2, g = r32 & 3;
  int b, kvh, t0;
  int sub = 0;
  if (SAMPLE) { sub = unit % NSA_SUB; unit /= NSA_SUB; b = unit >> 1; kvh = unit & 1; t0 = 0; } else { const int tile = unit % (SEQ / 8), bk = unit / (SEQ / 8); t0 = tile * 8; kvh = bk & 1; b = bk >> 1; }
  const int m = (SAMPLE ? MP + b * DEC_SEQ : b * SEQ + t0) + tt, pos = (SAMPLE ? PAST_LEN : t0) + tt, h = kvh * 4 + g;
  const int pos_last = (SAMPLE ? PAST_LEN : t0) + 7;
  bf16x8 qc[4], qr[4];
#pragma unroll
  for (int ks = 0; ks < 4; ++ks) { qc[ks] = wv_ld8(c.QCb + (size_t)m * 512 + h * 64 + 16 * ks + 8 * hi); qr[ks] = wv_ld8(c.QRb + (size_t)m * 512 + h * 64 + 16 * ks + 8 * hi); }
  const float* gate = c.GATE + (size_t)m * 24 + h * 3;
  f32x16 ot[2]; ot[0] = f32x16{}; ot[1] = f32x16{};
  const bf16_t* kcb = c.KCb + kc_off(SAMPLE, b, kvh); const bf16_t* vcb = c.VCTb + kc_off(SAMPLE, b, kvh);
  const int ncv = pos >= 31 ? ((pos - 31) / 16 + 1 < NC ? (pos - 31) / 16 + 1 : NC) : 0;
  const int ncv_last = pos_last >= 31 ? ((pos_last - 31) / 16 + 1 < NC ? (pos_last - 31) / 16 + 1 : NC) : 0;
  const int ntc = (ncv_last + 31) / 32;
  float mc = -3e38f, lc = 0.f;
  for (int tile = 0; tile < ntc; ++tile) {
    const f32x16 S = qk_tile(kcb + (size_t)tile * 2048 + lane * 8, qc);
    float sc[16]; float mx = -3e38f;
#pragma unroll
    for (int r = 0; r < 16; ++r) { const bool v = tile * 32 + crow16(r, hi) < ncv; sc[r] = v ? S[r] * NSA_SCL : -3e38f; mx = fmaxf(mx, sc[r]); }
    mx = fmaxf(mx, wv_shfl_xor_f(mx, 32));
    const float mn = fmaxf(mc, mx); float sum = 0.f;
#pragma unroll
    for (int r = 0; r < 16; ++r) sum += (tile * 32 + crow16(r, hi) < ncv) ? wv_exp2(sc[r] - mn) : 0.f;
    lc = lc * wv_exp2(mc - mn) + sum; mc = mn;
  }
  lc = lc + wv_shfl_xor_f(lc, 32);
  const float invc = lc > 0.f ? wv_rcp(lc) : 0.f;
  const int qblk = pos >> 6;
  const bool need_imp = SAMPLE || qblk > 7;
  unsigned long long sel0 = 0ull, sel1 = 0ull;
  float prevLp = 0.f; f32x16 oc[2]; oc[0] = f32x16{}; oc[1] = f32x16{};
  if constexpr (!SAMPLE) {
    float imp[NI];
#pragma unroll
    for (int i = 0; i < NI; ++i) imp[i] = -1.f;
#pragma unroll
    for (int tile = 0; tile < NCT; ++tile) {
      if (tile < ntc) { float v4[4] = {0.f, 0.f, 0.f, 0.f};
        cmp_tile2(kcb, vcb, CPAD, tile, r32, hi, ncv, mc, invc, qc, oc, need_imp, prevLp, v4);
#pragma unroll
        for (int u = 0; u < 4; ++u) { const int s = 2 * (tile * 4 + u) + hi; imp[tile * 4 + u] = (need_imp && s >= 1 && s <= qblk - 2) ? v4[u] : -1.f; } }
    }
    if (!need_imp) sel0 = (2ull << qblk) - 1ull;
    else {
      for (int round = 0; round < 5; ++round) {
        float bv = -1.f; int bs = 1 << 20;
#pragma unroll
        for (int i = 0; i < NI; ++i) if (imp[i] > bv) { bv = imp[i]; bs = 2 * i + hi; }
        const float pv = wv_shfl_xor_f(bv, 32); const int ps = (int)wv_shfl_xor_u((unsigned)bs, 32);
        const int ws = (pv > bv || (pv == bv && ps < bs)) ? ps : bs;
        sel0 |= 1ull << ws;
#pragma unroll
        for (int i = 0; i < NI; ++i) if (2 * i + hi == ws) imp[i] = -1.f;
      }
      sel0 |= 1ull | (1ull << qblk) | (1ull << (qblk - 1));
    }
  } else {
    for (int tile = 0; tile < ntc; ++tile) { float v4[4] = {0.f, 0.f, 0.f, 0.f};
      cmp_tile2(kcb, vcb, CPAD, tile, r32, hi, ncv, mc, invc, qc, oc, true, prevLp, v4);
      if (g == 0) {
#pragma unroll
        for (int u = 0; u < 4; ++u) wscr[tt * 128 + 2 * (tile * 4 + u) + hi] = v4[u]; }
    }
    wv_fence();
    const int sl = (g * 2 + hi) * 16; int w0 = -1, w1 = -1, w2 = -1, w3 = -1;
    for (int round = 0; round < 5; ++round) {
      float bv = -1.f; int bs = 1 << 20;
      for (int j = 0; j < 16; ++j) { const int s = sl + j; const float v = wscr[tt * 128 + s];
        const bool cand = s >= 1 && s <= qblk - 2 && s != w0 && s != w1 && s != w2 && s != w3;
        if (cand && v > bv) { bv = v; bs = s; } }
#pragma unroll
      for (int sh = 0; sh < 3; ++sh) { const int msk = sh == 0 ? 1 : sh == 1 ? 2 : 32;
        const float pv = wv_shfl_xor_f(bv, msk); const int ps = (int)wv_shfl_xor_u((unsigned)bs, msk);
        if (pv > bv || (pv == bv && ps < bs)) { bv = pv; bs = ps; } }
      if (bs < 64) sel0 |= 1ull << bs; else if (bs < 128) sel1 |= 1ull << (bs - 64);
      w3 = w2; w2 = w1; w1 = w0; w0 = bs;
    }
    sel0 |= 1ull;
    if (qblk < 64) sel0 |= 1ull << qblk; else if (qblk < 128) sel1 |= 1ull << (qblk - 64);
    if (qblk - 1 < 64) sel0 |= 1ull << (qblk - 1); else if (qblk - 1 < 128) sel1 |= 1ull << (qblk - 1 - 64);
  }
  { const float g0 = gate[0]; ot[0] = oc[0] * g0; ot[1] = oc[1] * g0; }
  unsigned long long un0 = sel0, un1 = sel1;
#pragma unroll
  for (int sh = 4; sh <= 16; sh <<= 1) {
    un0 |= (unsigned long long)wv_shfl_xor_u((unsigned)un0, sh) | ((unsigned long long)wv_shfl_xor_u((unsigned)(un0 >> 32), sh) << 32);
    if (SAMPLE) un1 |= (unsigned long long)wv_shfl_xor_u((unsigned)un1, sh) | ((unsigned long long)wv_shfl_xor_u((unsigned)(un1 >> 32), sh) << 32);
  }
  if constexpr (!SAMPLE) {
    SoftSt st; st.m = -3e38f; st.l = 0.f; st.o[0] = f32x16{}; st.o[1] = f32x16{};
    const size_t bk = (size_t)b * 2 + kvh; const bf16_t* kbase = c.KSb + bk * SEQ * 64 + lane * 8; const bf16_t* vbase = c.VSTb + bk * 64 * SEQ + lane * 8;
    unsigned long long um = un0; int s = __builtin_ctzll(um), half = 0, kb = s * 64;
    bf16x8 kf[4], vf[4];
#define NSA_ISSUE(KB) do { const bf16_t* kp_ = kbase + (size_t)((KB) >> 5) * 2048; const bf16_t* vp_ = vbase + (size_t)((KB) >> 4) * 512; \
      kf[0] = wv_ld8(kp_); kf[1] = wv_ld8(kp_ + 512); kf[2] = wv_ld8(kp_ + 1024); kf[3] = wv_ld8(kp_ + 1536); \
      vf[0] = wv_ld8(vp_); vf[1] = wv_ld8(vp_ + 512); vf[2] = wv_ld8(vp_ + (size_t)(SEQ >> 4) * 512); vf[3] = wv_ld8(vp_ + (size_t)(SEQ >> 4) * 512 + 512); } while (0)
    NSA_ISSUE(kb);
    for (;;) {
      int ns = s, nhalf = half; bool has_next;
      if (half == 0 && s * 64 + 32 <= pos_last) { nhalf = 1; has_next = true; } else { um &= um - 1ull; has_next = um != 0ull; if (has_next) { ns = __builtin_ctzll(um); nhalf = 0; } }
      const int nkb = ns * 64 + nhalf * 32;
      const bf16x8 ck0 = kf[0], ck1 = kf[1], ck2 = kf[2], ck3 = kf[3], cv0 = vf[0], cv1 = vf[1], cv2 = vf[2], cv3 = vf[3];
      if (has_next) NSA_ISSUE(nkb);
      const bool mine = (sel0 >> s) & 1ull; unsigned vm = 0u;
#pragma unroll
      for (int r = 0; r < 16; ++r) if (mine && kb + crow16(r, hi) <= pos) vm |= 1u << r;
      f32x16 S = {}; S = wv_mfma32(ck0, qr[0], S); S = wv_mfma32(ck1, qr[1], S); S = wv_mfma32(ck2, qr[2], S); S = wv_mfma32(ck3, qr[3], S);
      soft_step(st, S, vm, cv0, cv1, cv2, cv3);
      if (!has_next) break;
      s = ns; half = nhalf; kb = nkb;
    }
    soft_finish(st, gate[1], ot);
    SoftSt sw; sw.m = -3e38f; sw.l = 0.f; sw.o[0] = f32x16{}; sw.o[1] = f32x16{};
    kbase = c.KWb + bk * SEQ * 64 + lane * 8; vbase = c.VWTb + bk * 64 * SEQ + lane * 8;
    const int lo = t0 - (WINDOW - 1) > 0 ? t0 - (WINDOW - 1) : 0; kb = lo & ~31;
    NSA_ISSUE(kb);
    for (;;) {
      const int nkb = kb + 32; const bool has_next = nkb <= pos_last;
      const bf16x8 ck0 = kf[0], ck1 = kf[1], ck2 = kf[2], ck3 = kf[3], cv0 = vf[0], cv1 = vf[1], cv2 = vf[2], cv3 = vf[3];
      if (has_next) NSA_ISSUE(nkb);
      unsigned vm = 0u;
#pragma unroll
      for (int r = 0; r < 16; ++r) { const int key = kb + crow16(r, hi); if (key <= pos && key > pos - WINDOW) vm |= 1u << r; }
      f32x16 S = {}; S = wv_mfma32(ck0, qr[0], S); S = wv_mfma32(ck1, qr[1], S); S = wv_mfma32(ck2, qr[2], S); S = wv_mfma32(ck3, qr[3], S);
      soft_step(sw, S, vm, cv0, cv1, cv2, cv3);
      if (!has_next) break;
      kb = nkb;
    }
    soft_finish(sw, gate[2], ot);
#undef NSA_ISSUE
  } else
  { SoftSt st; st.m = -3e38f; st.l = 0.f; st.o[0] = f32x16{}; st.o[1] = f32x16{};
    const int nblk = SAMPLE ? NSELS : qblk + 1; int dealt = 0;
    for (int s = 0; s < nblk; ++s) {
      const bool in_union = SAMPLE ? (s == NSELS - 1 || (s < 64 ? (un0 >> s) & 1ull : (un1 >> (s - 64)) & 1ull)) : ((un0 >> s) & 1ull);
      if (!in_union) continue;
      if (SAMPLE) { const bool take = (dealt % NSA_SUB) == sub; ++dealt; if (!take) continue; }
      const bool mine = SAMPLE ? (s == NSELS - 1 || (s < 64 ? (sel0 >> s) & 1ull : (sel1 >> (s - 64)) & 1ull)) : ((sel0 >> s) & 1ull);
      for (int half = 0; half < 2; ++half) {
        const int kb = s * 64 + half * 32; if (kb > pos_last) break;
        unsigned vm = 0u;
#pragma unroll
        for (int r = 0; r < 16; ++r) if (mine && kb + crow16(r, hi) <= pos) vm |= 1u << r;
        if (!SAMPLE) {
          const size_t bk = (size_t)b * 2 + kvh;
          const f32x16 S = qk_tile(c.KSb + bk * SEQ * 64 + (size_t)(kb >> 5) * 2048 + lane * 8, qr);
          const bf16_t* vb = c.VSTb + bk * 64 * SEQ + (size_t)(kb >> 4) * 512 + lane * 8;
          soft_step(st, S, vm, wv_ld8(vb), wv_ld8(vb + 512), wv_ld8(vb + (size_t)(SEQ >> 4) * 512), wv_ld8(vb + (size_t)(SEQ >> 4) * 512 + 512));
        } else {
          const float* blk; int rmax;
          if (s < NSELS - 1) { const int pg = c.page_table[b * NPAGES + (s >> 1)]; blk = c.cache_nsa_kv + ((size_t)pg * PAGE_SIZE + (s & 1) * 64) * 512; rmax = 63; }
          else { blk = c.out + O_KVS + (size_t)b * DEC_SEQ * 512; rmax = DEC_SEQ - 1; }
          const int kr = half * 32 + r32; const float* krow = blk + (size_t)(kr < rmax ? kr : rmax) * 512 + (2 * 2 + kvh) * 64 + 8 * hi;
          f32x16 S = {};
#pragma unroll
          for (int ks = 0; ks < 4; ++ks) S = wv_mfma32(wv_ld8_f32(krow + 16 * ks), qr[ks], S);
          bf16x8 vf[2][2];
#pragma unroll
          for (int ks = 0; ks < 2; ++ks) { float v0[8], v1[8];
#pragma unroll
            for (int j = 0; j < 8; ++j) { const int vr = half * 32 + 16 * ks + 8 * (j >> 2) + 4 * hi + (j & 3); const float* vp = blk + (size_t)(vr < rmax ? vr : rmax) * 512 + (3 * 2 + kvh) * 64; v0[j] = vp[r32]; v1[j] = vp[32 + r32]; }
            vf[0][ks] = wv_pack8(v0[0], v0[1], v0[2], v0[3], v0[4], v0[5], v0[6], v0[7]); vf[1][ks] = wv_pack8(v1[0], v1[1], v1[2], v1[3], v1[4], v1[5], v1[6], v1[7]); }
          soft_step(st, S, vm, vf[0][0], vf[0][1], vf[1][0], vf[1][1]);
        }
      }
    }
    if (!SAMPLE) soft_finish(st, gate[1], ot);
    else { float* pr = c.NPART + (((size_t)unit * NSA_SUB + sub) * 3 + 0) * 64 * NSA_PART + lane * NSA_PART; pr[0] = st.m; pr[1] = st.l;
#pragma unroll
      for (int r = 0; r < 16; ++r) { pr[2 + r] = st.o[0][r]; pr[18 + r] = st.o[1][r]; } } }
  if constexpr (SAMPLE)
  { SoftSt st; st.m = -3e38f; st.l = 0.f; st.o[0] = f32x16{}; st.o[1] = f32x16{};
    if (!SAMPLE) {
      const size_t bk = (size_t)b * 2 + kvh; const int lo = t0 - (WINDOW - 1) > 0 ? t0 - (WINDOW - 1) : 0;
      for (int kb = lo & ~31; kb <= pos_last; kb += 32) {
        unsigned vm = 0u;
#pragma unroll
        for (int r = 0; r < 16; ++r) { const int key = kb + crow16(r, hi); if (key <= pos && key > pos - WINDOW) vm |= 1u << r; }
        const f32x16 S = qk_tile(c.KWb + bk * SEQ * 64 + (size_t)(kb >> 5) * 2048 + lane * 8, qr);
        const bf16_t* vb = c.VWTb + bk * 64 * SEQ + (size_t)(kb >> 4) * 512 + lane * 8;
        soft_step(st, S, vm, wv_ld8(vb), wv_ld8(vb + 512), wv_ld8(vb + (size_t)(SEQ >> 4) * 512), wv_ld8(vb + (size_t)(SEQ >> 4) * 512 + 512));
      }
    } else {
      const size_t bk = (size_t)b * 2 + kvh;
      for (int kb = 0; kb < WKS; kb += 32) {
        if (((kb >> 5) % NSA_SUB) != sub) continue;
        unsigned vm = 0u;
#pragma unroll
        for (int r = 0; r < 16; ++r) { const int i = kb + crow16(r, hi); if (i >= tt + 1 && i <= WBUF + tt) vm |= 1u << r; }
        const f32x16 S = qk_tile(c.KWsb + bk * WKS * 64 + (size_t)(kb >> 5) * 2048 + lane * 8, qr);
        const bf16_t* vb = c.VWTsb + bk * 64 * WKS + (size_t)(kb >> 4) * 512 + lane * 8;
        soft_step(st, S, vm, wv_ld8(vb), wv_ld8(vb + 512), wv_ld8(vb + (size_t)(WKS >> 4) * 512), wv_ld8(vb + (size_t)(WKS >> 4) * 512 + 512));
      }
    }
    if (!SAMPLE) soft_finish(st, gate[2], ot);
    else { float* pr = c.NPART + (((size_t)unit * NSA_SUB + sub) * 3 + 1) * 64 * NSA_PART + lane * NSA_PART; pr[0] = st.m; pr[1] = st.l;
#pragma unroll
      for (int r = 0; r < 16; ++r) { pr[2 + r] = st.o[0][r]; pr[18 + r] = st.o[1][r]; } } }
  if (SAMPLE) {
    float* pr = c.NPART + (((size_t)unit * NSA_SUB + sub) * 3 + 2) * 64 * NSA_PART + lane * NSA_PART;
#pragma unroll
    for (int r = 0; r < 16; ++r) { pr[2 + r] = sub == 0 ? ot[0][r] : 0.f; pr[18 + r] = sub == 0 ? ot[1][r] : 0.f; }
    return; }
  bf16_t* orow = c.CAT + (size_t)m * D_MODEL + h * 64 + 4 * hi;
#pragma unroll
  for (int db = 0; db < 2; ++db)
#pragma unroll
    for (int u = 0; u < 4; ++u) { u32x2v w; w.x = wv_pk_bf16(ot[db][4 * u], ot[db][4 * u + 1]); w.y = wv_pk_bf16(ot[db][4 * u + 2], ot[db][4 * u + 3]); *(u32x2v*)(orow + db * 32 + 8 * u) = w; }
}
constexpr int NSA_UNITS_P = BATCH * 2 * (SEQ / 8), NSA_UNITS_S = DEC_BATCH * 2 * NSA_SUB, NSA_COMB_UNITS = DEC_BATCH * 2;
WV_DEV void nsa_combine_unit(const Ctx& c, int unit) {
  const int lane = wv_lane(), r32 = lane & 31, hi = lane >> 5, tt = r32 >> 2, g = r32 & 3; const int b = unit >> 1, kvh = unit & 1, h = kvh * 4 + g, m = MP + b * DEC_SEQ + tt;
  const float* gate = c.GATE + (size_t)m * 24 + h * 3; float ot[32];
  { const float* pr = c.NPART + (((size_t)unit * NSA_SUB + 0) * 3 + 2) * 64 * NSA_PART + lane * NSA_PART;
#pragma unroll
    for (int r = 0; r < 32; ++r) ot[r] = pr[2 + r]; }
#pragma unroll 1
  for (int br = 0; br < 2; ++br) { float M = -3e38f;
#pragma unroll
    for (int s = 0; s < NSA_SUB; ++s) M = fmaxf(M, c.NPART[(((size_t)unit * NSA_SUB + s) * 3 + br) * 64 * NSA_PART + lane * NSA_PART]);
    float l = 0.f, o[32];
#pragma unroll
    for (int r = 0; r < 32; ++r) o[r] = 0.f;
#pragma unroll
    for (int s = 0; s < NSA_SUB; ++s) { const float* pr = c.NPART + (((size_t)unit * NSA_SUB + s) * 3 + br) * 64 * NSA_PART + lane * NSA_PART; const float f = wv_exp2(pr[0] - M); l += f * pr[1];
#pragma unroll
      for (int r = 0; r < 32; ++r) o[r] += f * pr[2 + r]; }
    l += wv_shfl_xor_f(l, 32); const float f = l > 0.f ? gate[1 + br] * wv_rcp(l) : 0.f;
#pragma unroll
    for (int r = 0; r < 32; ++r) ot[r] += o[r] * f; }
  bf16_t* orow = c.CAT + (size_t)m * D_MODEL + h * 64 + 4 * hi;
#pragma unroll
  for (int db = 0; db < 2; ++db)
#pragma unroll
    for (int u = 0; u < 4; ++u) { u32x2v w; w.x = wv_pk_bf16(ot[db * 16 + 4 * u], ot[db * 16 + 4 * u + 1]); w.y = wv_pk_bf16(ot[db * 16 + 4 * u + 2], ot[db * 16 + 4 * u + 3]); *(u32x2v*)(orow + db * 32 + 8 * u) = w; }
}
constexpr int XNT = MEM_TOKENS / 32;
HD int bb_row0(int bb) { return bb < BATCH ? bb * SEQ : MP + (bb - BATCH) * DEC_SEQ; }
struct StPackX { const Ctx& c; static constexpr long N = (long)(BATCH + DEC_BATCH) * 4 * MEM_TOKENS * 256;
  HD void operator()(long i) const {
    const int d = (int)(i % 256), j = (int)((i / 256) % MEM_TOKENS), h = (int)((i / 256 / MEM_TOKENS) % 4), bb = (int)(i / 256 / MEM_TOKENS / 4);
    const int m = bb_row0(bb); const size_t bh = (size_t)bb * 4 + h;
    c.KXb[bh * MEM_TOKENS * 256 + frag_idx(j, d, 256)] = f2bf(memkv_row(c, m, j, 0, h)[d] * c.xq_norm_w[d]); c.VXTb[bh * 256 * MEM_TOKENS + frag_idx(d, vperm16(j), MEM_TOKENS)] = f2bf(memkv_row(c, m, j, 1, h)[d]);
  } };
struct StXqNormB { const Ctx& c; static constexpr long N = (long)MTOT * 4;
  HD void operator()(long i) const {
    const float* q = c.Q2 + (size_t)(i / 4) * D_MODEL + (i % 4) * 256; bf16_t* o = c.Q2b + (size_t)(i / 4) * D_MODEL + (i % 4) * 256;
    float ss = 0.f; for (int d = 0; d < 256; ++d) ss += q[d] * q[d];
    const float r = 1.f / sqrtf(ss / 256.f + EPS); for (int d = 0; d < 256; ++d) o[d] = f2bf(q[d] * r * c.xq_norm_w[d]);
  } };
struct StXqRawB { const Ctx& c; static constexpr long N = (long)MTOT * D_MODEL;
  HD void operator()(long i) const { c.Q2b[i] = f2bf(c.Q2[i]); } };
constexpr int XA_UNITS_P = BATCH * 4 * (SEQ / 32), XA_UNITS_S = DEC_BATCH * 4;
template <bool SAMPLE> WV_DEV void xattn_unit(const Ctx& c, int unit) {
  const int lane = wv_lane(), r32 = lane & 31, hi = lane >> 5;
  int h, bb, m; bool valid = true;
  if (!SAMPLE) { const int tile = unit % (SEQ / 32), bh = unit / (SEQ / 32); h = bh & 3; bb = bh >> 2; m = bb * SEQ + tile * 32 + r32; }
  else { h = unit & 3; const int b = unit >> 2; bb = BATCH + b; m = MP + b * DEC_SEQ + (r32 & (DEC_SEQ - 1)); valid = r32 < DEC_SEQ; }
  const bf16_t* qrow = c.Q2b + (size_t)m * D_MODEL + h * 256 + 8 * hi;
  const bf16_t* kb = c.KXb + ((size_t)bb * 4 + h) * MEM_TOKENS * 256 + lane * 8;
  const bf16_t* vb = c.VXTb + ((size_t)bb * 4 + h) * 256 * MEM_TOKENS + lane * 8;
  f32x16 S[XNT];
#pragma unroll
  for (int t = 0; t < XNT; ++t) S[t] = f32x16{};
  float qss = 0.f;
  { bf16x8 kf[2][XNT], qf[2];
    qf[0] = wv_ld8(qrow);
#pragma unroll
    for (int t = 0; t < XNT; ++t) kf[0][t] = wv_ld8(kb + (size_t)(t * 16) * 512);
#pragma unroll
    for (int ks = 0; ks < 16; ++ks) { const int cur = ks & 1, nxt = cur ^ 1;
      if (ks + 1 < 16) { qf[nxt] = wv_ld8(qrow + 16 * (ks + 1));
#pragma unroll
        for (int t = 0; t < XNT; ++t) kf[nxt][t] = wv_ld8(kb + (size_t)(t * 16 + ks + 1) * 512); }
#pragma unroll
      for (int t = 0; t < XNT; ++t) S[t] = wv_mfma32(kf[cur][t], qf[cur], S[t]);
#pragma unroll
      for (int e = 0; e < 8; ++e) { const float qv = bfu2f((unsigned short)qf[cur][e]); qss += qv * qv; }
      WV_SCHED_BARRIER(); } }
  qss += wv_shfl_xor_f(qss, 32); const float qr_ = 1.f / sqrtf(qss / 256.f + EPS);
  const float SC = 0.0625f * 1.4426950408889634f * qr_;
  float mx = -3e38f;
#pragma unroll
  for (int t = 0; t < XNT; ++t)
#pragma unroll
    for (int r = 0; r < 16; ++r) mx = fmaxf(mx, S[t][r]);
  mx = fmaxf(mx, wv_shfl_xor_f(mx, 32));
  float sum = 0.f; bf16x8 pf[XNT][2];
#pragma unroll
  for (int t = 0; t < XNT; ++t) { float p[16];
#pragma unroll
    for (int r = 0; r < 16; ++r) { p[r] = wv_exp2((S[t][r] - mx) * SC); sum += p[r]; }
    pf[t][0] = wv_pack8(p[0], p[1], p[2], p[3], p[4], p[5], p[6], p[7]); pf[t][1] = wv_pack8(p[8], p[9], p[10], p[11], p[12], p[13], p[14], p[15]); }
  sum += wv_shfl_xor_f(sum, 32);
  const float inv = wv_rcp(sum);
  bf16_t* orow = c.OX + (size_t)m * D_MODEL + h * 256 + 4 * hi;
  bf16x8 vf[2][2 * XNT];
#pragma unroll
  for (int q = 0; q < 2 * XNT; ++q) vf[0][q] = wv_ld8(vb + (size_t)q * 512);
#pragma unroll
  for (int db = 0; db < 8; ++db) { f32x16 o = {}; const int cur = db & 1, nxt = cur ^ 1;
    if (db + 1 < 8) {
#pragma unroll
      for (int q = 0; q < 2 * XNT; ++q) vf[nxt][q] = wv_ld8(vb + (size_t)((db + 1) * (MEM_TOKENS / 16) + q) * 512); }
#pragma unroll
    for (int t = 0; t < XNT; ++t) { o = wv_mfma32(vf[cur][2 * t], pf[t][0], o); o = wv_mfma32(vf[cur][2 * t + 1], pf[t][1], o); }
    WV_SCHED_BARRIER();
    if (valid) {
#pragma unroll
      for (int u = 0; u < 4; ++u) { u32x2v w; w.x = wv_pk_bf16(o[4 * u] * inv, o[4 * u + 1] * inv); w.y = wv_pk_bf16(o[4 * u + 2] * inv, o[4 * u + 3] * inv); *(u32x2v*)(orow + db * 32 + 8 * u) = w; } }
  }
}
constexpr int NCH = SEQ / 64;
constexpr int NCHUNK_P = BATCH * 4 * NCH, NCHUNK = NCHUNK_P + DEC_BATCH * 4;
constexpr int GDN_PREP_UNITS = NCHUNK * 4, GDN_SCAN_UNITS = (BATCH + DEC_BATCH) * 4 * 4;
constexpr int GDN_WSCR_FLOATS = 64 * 64 + 128;
HD void chunk_decode(int ch, int& b, int& h, int& m0, int& nvalid) {
  if (ch < NCHUNK_P) { const int n = ch % NCH, bh = ch / NCH; h = bh & 3; b = bh >> 2; m0 = b * SEQ + n * 64; nvalid = 64; }
  else { const int r = ch - NCHUNK_P; h = r & 3; b = r >> 2; m0 = MP + b * DEC_SEQ; nvalid = DEC_SEQ; }
}
HD size_t acc_idx(int ch, int i, int col) { const int il = i & 31; return ((((size_t)ch * 4 + (col >> 5)) * 2 + (i >> 5)) * 64 + ((il >> 2) & 1) * 32 + (col & 31)) * 16 + (il & 3) + 4 * (il >> 3); }
WV_DEV bf16x8 ldrow8(const float* buf, int m0, int i, int nvalid, int off) {
  return wv_ld8_f32(buf + (size_t)(m0 + (i < nvalid ? i : nvalid - 1)) * 512 + off);
}
WV_DEV void gdn_prep_unit(const Ctx& c, int unit, float* wscr) {
  const int lane = wv_lane(), r32 = lane & 31, hi = lane >> 5, ch = unit >> 2, quarter = unit & 3;
  int b, h, m0, nvalid; chunk_decode(ch, b, h, m0, nvalid);
  float* At = wscr; float* gcs = wscr + 4096; float* bts = wscr + 4160;
  const float gi = lane < nvalid ? c.GG[(size_t)(m0 + lane) * 4 + h] : 0.f, bi = lane < nvalid ? c.GB[(size_t)(m0 + lane) * 4 + h] : 0.f;
  float gc = gi;
#pragma unroll
  for (int off = 1; off < 64; off <<= 1) { const float t = __builtin_bit_cast(float, wv_shfl_u(__builtin_bit_cast(unsigned, gc), lane - off)); if (lane >= off) gc += t; }
  gcs[lane] = gc; bts[lane] = bi;
  const float g_last = __builtin_bit_cast(float, wv_shfl_u(__builtin_bit_cast(unsigned, gc), 63));
  wv_fence();
#pragma unroll 1
  for (int bp = 0; bp < 3; ++bp) { const int ib = bp == 0 ? 0 : 1, jb = bp == 2 ? 1 : 0;
    f32x16 S = {};
#pragma unroll 2
    for (int ks = 0; ks < 8; ++ks) S = wv_mfma32(ldrow8(c.GK, m0, ib * 32 + r32, nvalid, h * 128 + 16 * ks + 8 * hi), ldrow8(c.GK, m0, jb * 32 + r32, nvalid, h * 128 + 16 * ks + 8 * hi), S);
    const int j = jb * 32 + r32; const float gcj = gcs[j];
#pragma unroll
    for (int r = 0; r < 16; ++r) { const int i = ib * 32 + crow16(r, hi); At[j * 64 + i] = (j < i) ? bts[i] * S[r] * expf(gcs[i] - gcj) : 0.f; }
  }
#pragma unroll
  for (int r = 0; r < 16; ++r) At[(32 + r32) * 64 + crow16(r, hi)] = 0.f;
  wv_fence();
  { const int col = quarter * 64 + lane; const bool isu = col < 128; const int dcol = isu ? col : col - 128; const float* src = isu ? c.GV : c.GK;
    const int slot = vperm16(dcol);
#pragma unroll 1
    for (int rb = 0; rb < 4; ++rb) {
      float acc[16];
#pragma unroll
      for (int i = 0; i < 16; ++i) { const int row = rb * 16 + i; const float x = row < nvalid ? src[(size_t)(m0 + row) * 512 + h * 128 + dcol] : 0.f; acc[i] = x * bts[row] * (isu ? 1.f : expf(gcs[row])); }
      for (int j = 0; j < rb * 16; ++j) { const float sj = isu ? c.GS[acc_idx(ch, j, dcol)] : c.GSW[((size_t)ch * 64 + j) * 128 + dcol]; const float* at = At + j * 64 + rb * 16;
#pragma unroll
        for (int i = 0; i < 16; ++i) acc[i] -= at[i] * sj; }
#pragma unroll
      for (int j = 0; j < 16; ++j) { const float sj = acc[j]; const float* at = At + (rb * 16 + j) * 64 + rb * 16;
#pragma unroll
        for (int i = 0; i < 16; ++i) if (i > j) acc[i] -= at[i] * sj; }
#pragma unroll
      for (int i = 0; i < 16; ++i) { if (isu) c.GS[acc_idx(ch, rb * 16 + i, dcol)] = acc[i]; else { c.GSW[((size_t)ch * 64 + rb * 16 + i) * 128 + dcol] = acc[i]; c.GWp[(size_t)ch * 8192 + frag_idx(rb * 16 + i, slot, 128)] = f2bf(-acc[i]); } }
      wv_fence();
    }
  }
  if (quarter == 0) {
#pragma unroll 1
    for (int bp = 0; bp < 3; ++bp) { const int ib = bp == 0 ? 0 : 1, jb = bp == 2 ? 1 : 0;
      f32x16 S = {};
#pragma unroll 2
      for (int ks = 0; ks < 8; ++ks) S = wv_mfma32(ldrow8(c.GQ, m0, ib * 32 + r32, nvalid, h * 128 + 16 * ks + 8 * hi), ldrow8(c.GK, m0, jb * 32 + r32, nvalid, h * 128 + 16 * ks + 8 * hi), S);
      const int j = jb * 32 + r32; const float gcj = gcs[j]; const int slot = vperm16(j);
#pragma unroll
      for (int r = 0; r < 16; ++r) { const int i = ib * 32 + crow16(r, hi); c.GQKp[(size_t)ch * 4096 + frag_idx(i, slot, 64)] = f2bf((j <= i) ? S[r] * expf(gcs[i] - gcj) : 0.f); }
    }
  } else if (quarter == 1) {
    const float e = expf(gc); const float* q = c.GQ + (size_t)(m0 + lane) * 512 + h * 128;
#pragma unroll
    for (int g16 = 0; g16 < 8; ++g16)
#pragma unroll
      for (int h2 = 0; h2 < 2; ++h2) { f32x4v lo = {0.f, 0.f, 0.f, 0.f}, hv = {0.f, 0.f, 0.f, 0.f};
        if (lane < nvalid) { lo = *(const f32x4v*)(q + g16 * 16 + 4 * h2); hv = *(const f32x4v*)(q + g16 * 16 + 8 + 4 * h2); }
        *(bf16x8*)(c.GQDp + (size_t)ch * 8192 + frag_idx(lane, g16 * 16 + h2 * 8, 128)) = wv_pack8(lo.x * e, lo.y * e, lo.z * e, lo.w * e, hv.x * e, hv.y * e, hv.z * e, hv.w * e); }
  } else if (quarter == 2) {
#pragma unroll 1
    for (int pass = 0; pass < 2; ++pass) { const int dk = lane + 64 * pass; const float* kcol = c.GK + (size_t)m0 * 512 + h * 128 + 64 * pass;
#pragma unroll 1
      for (int g8 = 0; g8 < 8; ++g8) { const int g16 = g8 >> 1, h2 = g8 & 1; float v[8];
#pragma unroll
        for (int j = 0; j < 8; ++j) { const int i = g16 * 16 + 8 * (j >> 2) + 4 * h2 + (j & 3); v[j] = (kcol + (i < nvalid ? i : nvalid - 1) * 512)[(unsigned)lane] * expf(g_last - gcs[i]); }
        *(bf16x8*)(c.GKDTp + (size_t)ch * 8192 + frag_idx(dk, g16 * 16 + h2 * 8, 64)) = wv_pack8(v[0], v[1], v[2], v[3], v[4], v[5], v[6], v[7]); } }
  } else { if (lane == 0) c.GL[ch] = g_last; }
  wv_fence();
}
WV_DEV void tri_solve32(float (&acc)[32], const float* At, int base) {
#pragma unroll
  for (int j = 0; j < 31; ++j) { const float xj = acc[j]; const f32x4v* at = (const f32x4v*)(At + (base + j) * 64 + base);
#pragma unroll
    for (int i4 = (j + 1) / 4; i4 < 8; ++i4) { const f32x4v a = at[i4];
      if (4 * i4 + 0 > j) acc[4 * i4 + 0] -= a.x * xj; if (4 * i4 + 1 > j) acc[4 * i4 + 1] -= a.y * xj; if (4 * i4 + 2 > j) acc[4 * i4 + 2] -= a.z * xj; if (4 * i4 + 3 > j) acc[4 * i4 + 3] -= a.w * xj; }
    if ((j & 3) == 3) GDN_FENCE(); }
}
constexpr int GDN_PREP2_UNITS = NCHUNK * 4;
WV_DEV void gdn_prep2_unit(const Ctx& c, int unit, float* wscr) {
  const int ch = unit >> 2, quarter = unit & 3;
  const int lane = wv_lane_opaque(), r32 = lane & 31, hi = lane >> 5;
  int b, h, m0, nvalid; chunk_decode(ch, b, h, m0, nvalid);
  float* At = wscr; float* gcs = wscr + 4096; float* bts = wscr + 4160;
  { const int tq = quarter < 2 ? 2 + quarter : quarter - 2;
    const float* srow = (tq < 2 ? c.GK : c.GV) + (size_t)m0 * 512 + h * 128 + (tq & 1) * 64; float* dcol_ = (tq < 2 ? c.GKt : c.GVt) + ((size_t)ch * 128 + (tq & 1) * 64 + lane) * 64;
#pragma unroll 1
    for (int i0 = 0; i0 < 64; i0 += 16) { float v[16];
#pragma unroll
      for (int i = 0; i < 16; ++i) { const int ir = (i0 + i) < nvalid ? i0 + i : nvalid - 1; v[i] = (srow + ir * 512)[(unsigned)lane]; }
#pragma unroll
      for (int i4 = 0; i4 < 4; ++i4) *(f32x4v*)(dcol_ + i0 + 4 * i4) = f32x4v{v[4 * i4], v[4 * i4 + 1], v[4 * i4 + 2], v[4 * i4 + 3]}; } }
  const float gi = lane < nvalid ? c.GG[(size_t)(m0 + lane) * 4 + h] : 0.f, bi = lane < nvalid ? c.GB[(size_t)(m0 + lane) * 4 + h] : 0.f;
  float gc = gi;
#pragma unroll
  for (int off = 1; off < 64; off <<= 1) { const float t = __builtin_bit_cast(float, wv_shfl_u(__builtin_bit_cast(unsigned, gc), lane - off)); if (lane >= off) gc += t; }
  gcs[lane] = gc; bts[lane] = bi;
  const float g_last = __builtin_bit_cast(float, wv_shfl_u(__builtin_bit_cast(unsigned, gc), 63));
  if (lane == 0 && quarter == 3) c.GL[ch] = g_last;
  wv_fence();
#pragma unroll 1
  for (int bp = 0; bp < 3; ++bp) { const int ib = bp == 0 ? 0 : 1, jb = bp == 2 ? 1 : 0;
    f32x16 Sk = {}, Sq = {};
#pragma unroll 2
    for (int ks = 0; ks < 8; ++ks) { const bf16x8 kj = ldrow8(c.GK, m0, jb * 32 + r32, nvalid, h * 128 + 16 * ks + 8 * hi);
      Sk = wv_mfma32(ldrow8(c.GK, m0, ib * 32 + r32, nvalid, h * 128 + 16 * ks + 8 * hi), kj, Sk); if (quarter == 0) Sq = wv_mfma32(ldrow8(c.GQ, m0, ib * 32 + r32, nvalid, h * 128 + 16 * ks + 8 * hi), kj, Sq); }
    const int j = jb * 32 + r32; const float gcj = gcs[j]; const int slot = vperm16(j);
#pragma unroll
    for (int r = 0; r < 16; ++r) { const int i = ib * 32 + crow16(r, hi); const float dec = expf(gcs[i] - gcj);
      At[j * 64 + i] = (j < i) ? bts[i] * Sk[r] * dec : 0.f; if (quarter == 0) c.GQKp[(size_t)ch * 4096 + frag_idx(i, slot, 64)] = f2bf((j <= i) ? Sq[r] * dec : 0.f); }
  }
  if (quarter == 1) { const float e = expf(gc); const float* q = c.GQ + (size_t)(m0 + (lane < nvalid ? lane : nvalid - 1)) * 512 + h * 128;
#pragma unroll 2
    for (int g8 = 0; g8 < 16; ++g8) { const int g16 = g8 >> 1, h2 = g8 & 1; f32x4v lo = {0.f, 0.f, 0.f, 0.f}, hv = {0.f, 0.f, 0.f, 0.f};
      lo = *(const f32x4v*)(q + g16 * 16 + 4 * h2); hv = *(const f32x4v*)(q + g16 * 16 + 8 + 4 * h2);
      *(bf16x8*)(c.GQDp + (size_t)ch * 8192 + frag_idx(lane, g16 * 16 + h2 * 8, 128)) = wv_pack8(lo.x * e, lo.y * e, lo.z * e, lo.w * e, hv.x * e, hv.y * e, hv.z * e, hv.w * e); } }
  if (quarter >= 2) { const int pass = quarter - 2; const int dk = lane + 64 * pass; const float* kc = c.GKt + ((size_t)ch * 128 + dk) * 64;
#pragma unroll 2
    for (int g8 = 0; g8 < 8; ++g8) { const int g16 = g8 >> 1, h2 = g8 & 1; const f32x4v lo = *(const f32x4v*)(kc + g16 * 16 + 4 * h2), hv = *(const f32x4v*)(kc + g16 * 16 + 8 + 4 * h2);
      const int i0 = g16 * 16 + 4 * h2;
      *(bf16x8*)(c.GKDTp + (size_t)ch * 8192 + frag_idx(dk, g16 * 16 + h2 * 8, 64)) = wv_pack8(lo.x * expf(g_last - gcs[i0]), lo.y * expf(g_last - gcs[i0 + 1]), lo.z * expf(g_last - gcs[i0 + 2]), lo.w * expf(g_last - gcs[i0 + 3]),
                                                                                                hv.x * expf(g_last - gcs[i0 + 8]), hv.y * expf(g_last - gcs[i0 + 9]), hv.z * expf(g_last - gcs[i0 + 10]), hv.w * expf(g_last - gcs[i0 + 11])); } }
  wv_fence();
  bf16x8 a10[2];
#pragma unroll
  for (int s = 0; s < 2; ++s) { float t[8];
#pragma unroll
    for (int jj = 0; jj < 8; ++jj) t[jj] = At[(16 * s + 8 * hi + jj) * 64 + 32 + r32];
    a10[s] = wv_pack8(t[0], t[1], t[2], t[3], t[4], t[5], t[6], t[7]); }
#pragma unroll 1
  for (int cg = 2 * quarter; cg < 2 * quarter + 2; ++cg) { const bool isu = cg < 4; const int dcol = (cg & 3) * 32 + r32; const float* colp = (isu ? c.GVt : c.GKt) + ((size_t)ch * 128 + dcol) * 64;
    float x0[32], x1[32];
#pragma unroll
    for (int i4 = 0; i4 < 8; ++i4) { const f32x4v t = *(const f32x4v*)(colp + 4 * i4); x0[4 * i4] = t.x; x0[4 * i4 + 1] = t.y; x0[4 * i4 + 2] = t.z; x0[4 * i4 + 3] = t.w; }
#pragma unroll
    for (int i = 0; i < 32; ++i) x0[i] = x0[i] * bts[i] * (isu ? 1.f : expf(gcs[i]));
    tri_solve32(x0, At, 0);
    GDN_FENCE();
    f32x16 D = {};
#pragma unroll
    for (int s = 0; s < 2; ++s) { const bf16x8 bfr = hi ? wv_pack8(x0[16 * s + 8], x0[16 * s + 9], x0[16 * s + 10], x0[16 * s + 11], x0[16 * s + 12], x0[16 * s + 13], x0[16 * s + 14], x0[16 * s + 15])
                                                        : wv_pack8(x0[16 * s], x0[16 * s + 1], x0[16 * s + 2], x0[16 * s + 3], x0[16 * s + 4], x0[16 * s + 5], x0[16 * s + 6], x0[16 * s + 7]);
      D = wv_mfma32(a10[s], bfr, D); }
#pragma unroll
    for (int i4 = 0; i4 < 8; ++i4) { const f32x4v t = *(const f32x4v*)(colp + 32 + 4 * i4); x1[4 * i4] = t.x; x1[4 * i4 + 1] = t.y; x1[4 * i4 + 2] = t.z; x1[4 * i4 + 3] = t.w; }
#pragma unroll
    for (int i = 0; i < 32; ++i) x1[i] = x1[i] * bts[32 + i] * (isu ? 1.f : expf(gcs[32 + i]));
#pragma unroll
    for (int r = 0; r < 16; ++r) { const float oth = wv_shfl_xor_f(D[r], 32);
      const int rme = (r & 3) + 8 * (r >> 2); x1[rme + 4] -= hi ? D[r] : oth; x1[rme] -= hi ? oth : D[r]; }
    GDN_FENCE();
    tri_solve32(x1, At, 32);
    if (isu) { float* gu = c.GS + (((size_t)ch * 4 + (cg & 3)) * 2) * 1024 + lane * 16;
#pragma unroll
      for (int r4 = 0; r4 < 4; ++r4) { const int rb_ = 8 * r4;
        *(f32x4v*)(gu + 4 * r4) = hi ? f32x4v{x0[rb_ + 4], x0[rb_ + 5], x0[rb_ + 6], x0[rb_ + 7]} : f32x4v{x0[rb_], x0[rb_ + 1], x0[rb_ + 2], x0[rb_ + 3]};
        *(f32x4v*)(gu + 1024 + 4 * r4) = hi ? f32x4v{x1[rb_ + 4], x1[rb_ + 5], x1[rb_ + 6], x1[rb_ + 7]} : f32x4v{x1[rb_], x1[rb_ + 1], x1[rb_ + 2], x1[rb_ + 3]}; }
    } else { const int slot = vperm16(dcol); bf16_t* wq = c.GWp + (size_t)ch * 8192;
      const unsigned lpart = (unsigned)frag_idx(4 * hi, slot, 128);
#pragma unroll
      for (int r = 0; r < 16; ++r) { const int row = (r & 3) + 8 * (r >> 2); const float a0 = hi ? x0[row + 4] : x0[row], a1 = hi ? x1[row + 4] : x1[row];
        wq[lpart + (unsigned)(row * 8)] = f2bf(-a0); wq[lpart + (unsigned)(row * 8 + 8 * 512)] = f2bf(-a1); }
    }
  }
  wv_fence();
}
WV_DEV float warm_lines(const void* base, int nlines, size_t pitch, int lane) { float acc = 0.f; for (int k = lane; k < nlines; k += 64) acc += *(const float*)((const char*)base + (size_t)k * pitch); return acc; }
WV_DEV void gdn_scan_unit(const Ctx& c, int unit) {
  const int lane = wv_lane(), r32 = lane & 31, hi = lane >> 5, bbh = unit >> 2, dv0 = (unit & 3) * 32;
  const bool sample = bbh >= BATCH * 4; const int idx = sample ? bbh - BATCH * 4 : bbh, b = idx >> 2, h = idx & 3;
  const int nch = sample ? 1 : NCH, chunk0 = sample ? NCHUNK_P + idx : idx * NCH, nvalid = sample ? DEC_SEQ : 64;
  f32x16 S[4]; const unsigned lst = (unsigned)(hi * 4 * 128 + r32);
#pragma unroll
  for (int kb = 0; kb < 4; ++kb)
#pragma unroll
    for (int r = 0; r < 16; ++r) S[kb][r] = sample ? (c.state_gdn + (((size_t)b * 4 + h) * 128 + kb * 32 + crow16(r, 0)) * 128 + dv0)[lst] : 0.f;
  f32x16 vn[2]; bf16x8 fa[16]; const unsigned l8 = (unsigned)lane * 8u, l16 = (unsigned)lane * 16u;
#define GDN_LOAD_B1(CH) do { const size_t ch_ = (size_t)(CH); \
    _Pragma("unroll") for (int cb = 0; cb < 2; ++cb) { \
      { const float* gu_ = c.GS + ((ch_ * 4 + (dv0 >> 5)) * 2 + cb) * 1024; _Pragma("unroll") for (int r4 = 0; r4 < 4; ++r4) { const f32x4v t_ = *(const f32x4v*)(gu_ + l16 + 4 * r4); vn[cb][4 * r4] = t_.x; vn[cb][4 * r4 + 1] = t_.y; vn[cb][4 * r4 + 2] = t_.z; vn[cb][4 * r4 + 3] = t_.w; } } \
      _Pragma("unroll") for (int q = 0; q < 8; ++q) fa[cb * 8 + q] = wv_ld8(c.GWp + ch_ * 8192 + (cb * 8 + q) * 512 + l8); } } while (0)
  GDN_LOAD_B1(chunk0);
  for (int n = 0; n < nch; ++n) { const int ch = chunk0 + n;
#define GDN_SF(KB, SS) wv_pack8(S[KB][8 * (SS)], S[KB][8 * (SS) + 1], S[KB][8 * (SS) + 2], S[KB][8 * (SS) + 3], S[KB][8 * (SS) + 4], S[KB][8 * (SS) + 5], S[KB][8 * (SS) + 6], S[KB][8 * (SS) + 7])
#pragma unroll
    for (int kb = 0; kb < 4; ++kb) { const bf16x8 s0 = GDN_SF(kb, 0), s1 = GDN_SF(kb, 1);
#pragma unroll
      for (int cb = 0; cb < 2; ++cb) { vn[cb] = wv_mfma32(fa[cb * 8 + kb * 2], s0, vn[cb]); vn[cb] = wv_mfma32(fa[cb * 8 + kb * 2 + 1], s1, vn[cb]); } }
    WV_SCHED_BARRIER();
#pragma unroll
    for (int cb = 0; cb < 2; ++cb)
#pragma unroll
      for (int q = 0; q < 8; ++q) fa[cb * 8 + q] = wv_ld8(c.GQDp + (size_t)ch * 8192 + (cb * 8 + q) * 512 + l8);
    WV_SCHED_BARRIER();
    f32x16 o[2]; o[0] = f32x16{}; o[1] = f32x16{};
#pragma unroll
    for (int kb = 0; kb < 4; ++kb) { const bf16x8 s0 = GDN_SF(kb, 0), s1 = GDN_SF(kb, 1);
#pragma unroll
      for (int cb = 0; cb < 2; ++cb) { o[cb] = wv_mfma32(fa[cb * 8 + kb * 2], s0, o[cb]); o[cb] = wv_mfma32(fa[cb * 8 + kb * 2 + 1], s1, o[cb]); } }
    WV_SCHED_BARRIER();
#undef GDN_SF
    bf16x8 vf[2][2];
#pragma unroll
    for (int kc = 0; kc < 2; ++kc)
#pragma unroll
      for (int s = 0; s < 2; ++s) vf[kc][s] = wv_pack8(vn[kc][8 * s], vn[kc][8 * s + 1], vn[kc][8 * s + 2], vn[kc][8 * s + 3], vn[kc][8 * s + 4], vn[kc][8 * s + 5], vn[kc][8 * s + 6], vn[kc][8 * s + 7]);
    WV_SCHED_BARRIER();
    bf16x8 fq[6];
#pragma unroll
    for (int bp = 0; bp < 3; ++bp) { const int cb = bp == 0 ? 0 : 1, kc = bp == 2 ? 1 : 0; const bf16_t* arow = c.GQKp + (size_t)ch * 4096 + (cb * 4 + kc * 2) * 512; fq[2 * bp] = wv_ld8(arow + l8); fq[2 * bp + 1] = wv_ld8(arow + 512 + l8); }
#pragma unroll
    for (int kb = 0; kb < 4; ++kb)
#pragma unroll
      for (int q = 0; q < 4; ++q) fa[kb * 4 + q] = wv_ld8(c.GKDTp + (size_t)ch * 8192 + (kb * 4 + q) * 512 + l8);
    const float e = expf(c.GL[ch]);
    WV_SCHED_BARRIER();
#pragma unroll
    for (int bp = 0; bp < 3; ++bp) { const int cb = bp == 0 ? 0 : 1, kc = bp == 2 ? 1 : 0; o[cb] = wv_mfma32(fq[2 * bp], vf[kc][0], o[cb]); o[cb] = wv_mfma32(fq[2 * bp + 1], vf[kc][1], o[cb]); }
#pragma unroll
    for (int cb = 0; cb < 2; ++cb) { float* ou = c.OG + (((size_t)ch * 4 + (dv0 >> 5)) * 2 + cb) * 1024;
#pragma unroll
      for (int r4 = 0; r4 < 4; ++r4) *(f32x4v*)(ou + l16 + 4 * r4) = f32x4v{o[cb][4 * r4], o[cb][4 * r4 + 1], o[cb][4 * r4 + 2], o[cb][4 * r4 + 3]}; }
    WV_SCHED_BARRIER();
#pragma unroll
    for (int kb = 0; kb < 4; ++kb) { S[kb] = S[kb] * e;
#pragma unroll
      for (int q = 0; q < 4; ++q) S[kb] = wv_mfma32(fa[kb * 4 + q], vf[q >> 1][q & 1], S[kb]); }
    WV_SCHED_BARRIER();
    if (n + 1 < nch) GDN_LOAD_B1(ch + 1);
  }
#undef GDN_LOAD_B1
  float* so = c.out + (sample ? O_STS : O_STP) + ((size_t)b * 4 + h) * 128 * 128;
#pragma unroll
  for (int kb = 0; kb < 4; ++kb)
#pragma unroll
    for (int r = 0; r < 16; ++r) (so + (size_t)(kb * 32 + crow16(r, 0)) * 128 + dv0)[lst] = S[kb][r];
}
WV_DEV float wv_allsum(float v) {
#pragma unroll
  for (int o = 1; o < 64; o <<= 1) v += wv_shfl_xor_f(v, o);
  return v;
}
WV_DEV void st_pk4(bf16_t* p, f32x4v v) { u32x2v w; w.x = wv_pk_bf16(v.x, v.y); w.y = wv_pk_bf16(v.z, v.w); *(u32x2v*)p = w; }
WV_DEV void ldP8(const Ctx& c, size_t row, int col, float (&x)[8]) {
  if (PBF) { const u32x4v w = *(const u32x4v*)(c.Pb + row * LDP + col);
    x[0] = __builtin_bit_cast(float, w.x << 16); x[1] = __builtin_bit_cast(float, w.x & 0xffff0000u); x[2] = __builtin_bit_cast(float, w.y << 16); x[3] = __builtin_bit_cast(float, w.y & 0xffff0000u);
    x[4] = __builtin_bit_cast(float, w.z << 16); x[5] = __builtin_bit_cast(float, w.z & 0xffff0000u); x[6] = __builtin_bit_cast(float, w.w << 16); x[7] = __builtin_bit_cast(float, w.w & 0xffff0000u); }
  else { const f32x4v a = *(const f32x4v*)(c.P + row * LDP + col), b = *(const f32x4v*)(c.P + row * LDP + col + 4); x[0] = a.x; x[1] = a.y; x[2] = a.z; x[3] = a.w; x[4] = b.x; x[5] = b.y; x[6] = b.z; x[7] = b.w; }
}
WV_DEV float ldP1(const Ctx& c, size_t row, int col) { return PBF ? bfu2f(c.Pb[row * LDP + col]) : c.P[row * LDP + col]; }
WV_DEV void rms_row_unit(const float* src, const float* w, bf16_t* dst) {
  const int lane = wv_lane(); f32x4v v[4]; float ss = 0.f;
#pragma unroll
  for (int j = 0; j < 4; ++j) { v[j] = *(const f32x4v*)(src + lane * 4 + 256 * j); ss += (v[j].x * v[j].x + v[j].y * v[j].y) + (v[j].z * v[j].z + v[j].w * v[j].w); }
  ss = wv_allsum(ss); const float r = 1.f / sqrtf(ss / D_MODEL + EPS);
#pragma unroll
  for (int j = 0; j < 4; ++j) { const f32x4v ww = *(const f32x4v*)(w + lane * 4 + 256 * j); st_pk4(dst + lane * 4 + 256 * j, v[j] * ww * r); }
}
WV_DEV void xq_norm_unit(const Ctx& c, int m) {
  const int lane = wv_lane(); const float* q = c.Q2 + (size_t)m * D_MODEL + lane * 16; f32x4v v[4]; float ss = 0.f;
#pragma unroll
  for (int j = 0; j < 4; ++j) { v[j] = *(const f32x4v*)(q + 4 * j); ss += (v[j].x * v[j].x + v[j].y * v[j].y) + (v[j].z * v[j].z + v[j].w * v[j].w); }
  ss += wv_shfl_xor_f(ss, 1); ss += wv_shfl_xor_f(ss, 2); ss += wv_shfl_xor_f(ss, 4); ss += wv_shfl_xor_f(ss, 8);
  const float r = 1.f / sqrtf(ss / 256.f + EPS); const float* w = c.xq_norm_w + (lane & 15) * 16;
#pragma unroll
  for (int j = 0; j < 4; ++j) { const f32x4v ww = *(const f32x4v*)(w + 4 * j); st_pk4(c.Q2b + (size_t)m * D_MODEL + lane * 16 + 4 * j, v[j] * ww * r); }
}
WV_DEV void gdn_norm_unit(const Ctx& c, int m) {
  const int lane = wv_lane(); float z[8]; ldP8(c, (size_t)m, OFF_Z + lane * 8, z); const int hh = lane >> 4, dv = (lane & 15) * 8;
  int ch, i; if (m < MP) { const int bq = m / SEQ, t = m % SEQ; ch = (bq * 4 + hh) * (SEQ / 64) + t / 64; i = t % 64; } else { ch = BATCH * 4 * (SEQ / 64) + ((m - MP) / DEC_SEQ) * 4 + hh; i = (m - MP) % DEC_SEQ; }
  const float* og = c.OG + acc_idx(ch, i, dv);
  const f32x4v a = {og[0], og[16], og[32], og[48]}, b = {og[64], og[80], og[96], og[112]}; float ss = (a.x * a.x + a.y * a.y) + (a.z * a.z + a.w * a.w) + (b.x * b.x + b.y * b.y) + (b.z * b.z + b.w * b.w);
  ss += wv_shfl_xor_f(ss, 1); ss += wv_shfl_xor_f(ss, 2); ss += wv_shfl_xor_f(ss, 4); ss += wv_shfl_xor_f(ss, 8);
  const float r = 1.f / sqrtf(ss / 128.f + EPS); const float* w = c.gdn_norm_w + (lane & 15) * 8;
  const f32x4v za = {z[0], z[1], z[2], z[3]}, zb = {z[4], z[5], z[6], z[7]}, wa = *(const f32x4v*)w, wb = *(const f32x4v*)(w + 4);
  *(bf16x8*)(c.CAT + (size_t)m * D_MODEL + 512 + lane * 8) = wv_pack8(a.x * r * wa.x * siluf_(za.x), a.y * r * wa.y * siluf_(za.y), a.z * r * wa.z * siluf_(za.z), a.w * r * wa.w * siluf_(za.w),
                                                                          b.x * r * wb.x * siluf_(zb.x), b.y * r * wb.y * siluf_(zb.y), b.z * r * wb.z * siluf_(zb.z), b.w * r * wb.w * siluf_(zb.w));
}
struct StRope { const Ctx& c; static constexpr long N = (long)(SEQ + DEC_SEQ) * 32;
  HD void operator()(long i) const { const int d = (int)(i % 32), r = (int)(i / 32); const int pos = r < SEQ ? r : PAST_LEN + (r - SEQ);
    const float inv = powf(10000.f, -(float)d / 32.f), ang = (float)pos * inv; c.ROPE[(size_t)r * 64 + d] = cosf(ang); c.ROPE[(size_t)r * 64 + 32 + d] = sinf(ang); } };
WV_DEV void postproc_unit(const Ctx& c, int m) {
  const int lane = wv_lane(), j = lane & 7; const int pos = row_pos(m);
  float cs[8], sn[8];
  { const float* rt = c.ROPE + (size_t)(m < MP ? pos : SEQ + (pos - PAST_LEN)) * 64 + (j & 3) * 8; const f32x4v c0 = *(const f32x4v*)rt, c1 = *(const f32x4v*)(rt + 4), s0 = *(const f32x4v*)(rt + 32), s1 = *(const f32x4v*)(rt + 36);
    cs[0] = c0.x; cs[1] = c0.y; cs[2] = c0.z; cs[3] = c0.w; cs[4] = c1.x; cs[5] = c1.y; cs[6] = c1.z; cs[7] = c1.w; sn[0] = s0.x; sn[1] = s0.y; sn[2] = s0.z; sn[3] = s0.w; sn[4] = s1.x; sn[5] = s1.y; sn[6] = s1.z; sn[7] = s1.w; }
  const bool lowhalf = j < 4;
  { const int h = lane >> 3; float x[8]; ldP8(c, (size_t)m, h * 64 + j * 8, x); float ss = 0.f;
#pragma unroll
    for (int i = 0; i < 8; ++i) ss += x[i] * x[i];
    ss += wv_shfl_xor_f(ss, 1); ss += wv_shfl_xor_f(ss, 2); ss += wv_shfl_xor_f(ss, 4);
    const float r = 1.f / sqrtf(ss / 64.f + EPS); float o[8];
#pragma unroll
    for (int i = 0; i < 8; ++i) x[i] = x[i] * r * c.nsa_q_norm_w[j * 8 + i];
#pragma unroll
    for (int i = 0; i < 8; ++i) { const float pa = wv_shfl_xor_f(x[i], 4); o[i] = lowhalf ? x[i] * cs[i] - pa * sn[i] : pa * sn[i] + x[i] * cs[i]; }
    *(bf16x8*)(c.QCb + (size_t)m * 512 + h * 64 + j * 8) = wv_pack8(x[0], x[1], x[2], x[3], x[4], x[5], x[6], x[7]);
    *(bf16x8*)(c.QRb + (size_t)m * 512 + h * 64 + j * 8) = wv_pack8(o[0], o[1], o[2], o[3], o[4], o[5], o[6], o[7]); }
#pragma unroll
  for (int pass = 0; pass < 2; ++pass) {
    const int s = pass * 8 + (lane >> 3); const bool act = s < 12; const int sc = act ? s : 11, kv = (sc >> 1) & 1, br = sc >> 2, kvh = sc & 1;
    float x[8]; ldP8(c, (size_t)m, OFF_KV + sc * 64 + j * 8, x); float ss = 0.f;
#pragma unroll
    for (int i = 0; i < 8; ++i) ss += x[i] * x[i];
    ss += wv_shfl_xor_f(ss, 1); ss += wv_shfl_xor_f(ss, 2); ss += wv_shfl_xor_f(ss, 4);
    const float r = 1.f / sqrtf(ss / 64.f + EPS);
    if (kv == 0) {
#pragma unroll
      for (int i = 0; i < 8; ++i) x[i] = x[i] * r * c.nsa_k_norm_w[br * 64 + j * 8 + i]; }
    float o[8];
#pragma unroll
    for (int i = 0; i < 8; ++i) { const float pa = wv_shfl_xor_f(x[i], 4); o[i] = (kv == 0 && br >= 1) ? (lowhalf ? x[i] * cs[i] - pa * sn[i] : pa * sn[i] + x[i] * cs[i]) : x[i]; }
    if (act) {
      float* dst = sc < 8 ? kvrow_out(c, m) + sc * 64 + j * 8 : c.WR + (size_t)m * 256 + (sc - 8) * 64 + j * 8;
      *(f32x4v*)dst = f32x4v{o[0], o[1], o[2], o[3]}; *(f32x4v*)(dst + 4) = f32x4v{o[4], o[5], o[6], o[7]};
      if (kv == 0 && br >= 1 && m < MP) { bf16_t* kb = (br == 1 ? c.KSb : c.KWb) + ((size_t)(m / SEQ) * 2 + kvh) * SEQ * 64 + frag_idx(m % SEQ, j * 8, 64);
        *(bf16x8*)kb = wv_pack8(o[0], o[1], o[2], o[3], o[4], o[5], o[6], o[7]); }
    }
  }
  if (lane < 24) c.GATE[(size_t)m * 24 + lane] = sigmoidf_(ldP1(c, (size_t)m, OFF_GATE + lane));
  if (lane < 4) { c.GB[(size_t)m * 4 + lane] = sigmoidf_(ldP1(c, (size_t)m, OFF_B + lane)); c.GG[(size_t)m * 4 + lane] = -expf(c.gdn_a_log[lane]) * softplusf_(ldP1(c, (size_t)m, OFF_A + lane) + c.gdn_dt_bias[lane]); }
}
WV_DEV void gdn_conv_unit(const Ctx& c, int m) {
  const int lane = wv_lane(); const int t = row_t(m);
#pragma unroll
  for (int seg = 0; seg < 3; ++seg) { const int ch = seg * 512 + lane * 8; float y[8] = {0.f, 0.f, 0.f, 0.f, 0.f, 0.f, 0.f, 0.f};
#pragma unroll
    for (int k = 0; k < 4; ++k) { const int back = 3 - k; float xin[8]; bool have = true;
      if (t - back >= 0) ldP8(c, (size_t)(m - back), OFF_QKV + ch, xin);
      else if (m >= MP) { const float* src = c.cache_gdn_conv + ((size_t)((m - MP) / DEC_SEQ) * 3 + (3 + t - back)) * 1536 + ch; const f32x4v a = *(const f32x4v*)src, b = *(const f32x4v*)(src + 4); xin[0] = a.x; xin[1] = a.y; xin[2] = a.z; xin[3] = a.w; xin[4] = b.x; xin[5] = b.y; xin[6] = b.z; xin[7] = b.w; }
      else have = false;
      if (have) { const f32x4v wa = *(const f32x4v*)(c.gdn_conv_w + k * 1536 + ch), wb = *(const f32x4v*)(c.gdn_conv_w + k * 1536 + ch + 4);
        y[0] += wa.x * xin[0]; y[1] += wa.y * xin[1]; y[2] += wa.z * xin[2]; y[3] += wa.w * xin[3]; y[4] += wb.x * xin[4]; y[5] += wb.y * xin[5]; y[6] += wb.z * xin[6]; y[7] += wb.w * xin[7]; } }
    float ss = 0.f;
#pragma unroll
    for (int i = 0; i < 8; ++i) { y[i] = siluf_(y[i]); ss += y[i] * y[i]; }
    ss += wv_shfl_xor_f(ss, 1); ss += wv_shfl_xor_f(ss, 2); ss += wv_shfl_xor_f(ss, 4); ss += wv_shfl_xor_f(ss, 8);
    const float r = seg == 2 ? 1.f : (1.f / sqrtf(ss + EPS)) * (seg == 0 ? 0.08838834764831845f : 1.f);
    float* dst = (seg == 0 ? c.GQ : seg == 1 ? c.GK : c.GV) + (size_t)m * 512 + lane * 8;
    *(f32x4v*)dst = f32x4v{y[0] * r, y[1] * r, y[2] * r, y[3] * r}; *(f32x4v*)(dst + 4) = f32x4v{y[4] * r, y[5] * r, y[6] * r, y[7] * r};
  }
}
constexpr int VT_UNITS = 2 * BATCH * 2 * (SEQ / 16);
WV_DEV void vt_unit(const Ctx& c, int unit) {
  const int lane = wv_lane(); const int g16 = unit % (SEQ / 16); int r = unit / (SEQ / 16); const int kvh = r & 1; r >>= 1; const int b = r % BATCH, img = r / BATCH;
  const int col = OFF_KV + (((img + 1) * 2 + 1) * 2 + kvh) * 64 + lane; float v[16];
#pragma unroll
  for (int i = 0; i < 16; ++i) v[i] = ldP1(c, (size_t)b * SEQ + g16 * 16 + i, col);
  bf16_t* dst = (img == 0 ? c.VSTb : c.VWTb) + ((size_t)b * 2 + kvh) * 64 * SEQ;
  *(bf16x8*)(dst + frag_idx(lane, g16 * 16, SEQ)) = wv_pack8(v[0], v[1], v[2], v[3], v[8], v[9], v[10], v[11]); *(bf16x8*)(dst + frag_idx(lane, g16 * 16 + 8, SEQ)) = wv_pack8(v[4], v[5], v[6], v[7], v[12], v[13], v[14], v[15]);
}
constexpr int NCHK_P = SEQ / 16, NCHK_S = PAST_LEN / 16;
constexpr int CMP_UNITS_P = 2 * 2 * BATCH * 2 * (NCHK_P / 32), CMP_UNITS_S = 2 * 2 * DEC_BATCH * 2 * (NCHK_S / 32);
HD size_t pp_off(bool sample, int kv, int bk  , int n) {
  return sample ? ((size_t)2 * BATCH * 2 * NCHK_P + ((size_t)(kv * DEC_BATCH * 2 + bk)) * NCHK_S + n) * 128 : (((size_t)(kv * BATCH * 2 + bk)) * NCHK_P + n) * 128; }
struct StCmpWT { const Ctx& c; static constexpr long N = 2 * 2 * 64 * 1024;
  HD void operator()(long i) const { const int k = (int)(i % 1024), e = (int)((i / 1024) % 64), half = (int)((i / 65536) % 2), kv = (int)(i / 131072);
    c.WcT[(size_t)kv * 131072 + frag_idx(half * 64 + e, k, 1024)] = f2bf(c.cmp_w[(((size_t)kv * 32 + half * 16 + k / 64) * 64 + k % 64) * 64 + e]); } };
struct StCmpBias { const Ctx& c; static constexpr long N = 128;
  HD void operator()(long i) const { const int e = (int)(i % 64), kv = (int)(i / 64); float s = 0.f;
    for (int jd = 0; jd < 2048; ++jd) s += c.cmp_pe[(size_t)kv * 2048 + jd] * c.cmp_w[((size_t)kv * 2048 + jd) * 64 + e];
    c.CBIAS[i] = s; } };
WV_DEV void cmp_bias_unit(const Ctx& c, int unit) {
  const int lane = wv_lane(), e = unit & 63, kv = unit >> 6; float s = 0.f;
#pragma unroll 4
  for (int k = 0; k < 32; ++k) { const int jd = lane + 64 * k; s += c.cmp_pe[(size_t)kv * 2048 + jd] * c.cmp_w[((size_t)kv * 2048 + jd) * 64 + e]; }
  s = wv_allsum(s); if (lane == 0) c.CBIAS[unit] = s;
}
template <bool SAMPLE> WV_DEV void compress_unit(const Ctx& c, int unit) {
  constexpr int NG = (SAMPLE ? NCHK_S : NCHK_P) / 32, NB = SAMPLE ? DEC_BATCH : BATCH;
  const int lane = wv_lane(), r32 = lane & 31, hi = lane >> 5;
  const int t0 = (unit & 1) * 2; unit >>= 1;
  const int grp = unit % NG; int r = unit / NG; const int kvh = r & 1; r >>= 1; const int b = r % NB, kv = r / NB;
  const int n = grp * 32 + r32;
  const float* arow;
  if (!SAMPLE) arow = c.out + O_KVP + ((size_t)b * SEQ + 16 * n) * 512 + (kv * 2 + kvh) * 64 + 8 * hi;
  else { const int pos = 16 * n, pg = c.page_table[b * NPAGES + pos / PAGE_SIZE]; arow = c.cache_nsa_kv + ((size_t)pg * PAGE_SIZE + pos % PAGE_SIZE) * 512 + (kv * 2 + kvh) * 64 + 8 * hi; }
  const bf16_t* wt = c.WcT + (size_t)kv * 2 * 64 * 1024 + lane * 8;
  f32x16 acc[2];
#pragma unroll
  for (int t = 0; t < 2; ++t) acc[t] = f32x16{};
#pragma unroll 4
  for (int ks = 0; ks < 64; ++ks) {
    const bf16x8 af = wv_ld8_f32(arow + (size_t)(ks >> 2) * 512 + (ks & 3) * 16);
#pragma unroll
    for (int t = 0; t < 2; ++t) acc[t] = wv_mfma32(af, wv_ld8(wt + (size_t)((t0 + t) * 64 + ks) * 512), acc[t]);
  }
  float* pp = c.PP + pp_off(SAMPLE, kv, b * 2 + kvh, grp * 32);
#pragma unroll
  for (int t = 0; t < 2; ++t)
#pragma unroll
    for (int rr = 0; rr < 16; ++rr) pp[(size_t)crow16(rr, hi) * 128 + (t0 + t) * 32 + r32] = acc[t][rr];
}
struct StPackCmp2 { const Ctx& c; static constexpr long N = NPC_P + NPC_S;
  HD void operator()(long i) const {
    const bool sample = i >= NPC_P; long r = sample ? i - NPC_P : i; const int cpad = sample ? 512 : 128, nc = sample ? NCS : NCP;
    const int d = (int)(r % 64); r /= 64; const int cb = (int)(r % cpad); r /= cpad; const int kvh = (int)(r % 2), b = (int)(r / 2);
    float k = 0.f, v = 0.f;
    if (cb < nc) { k = c.PP[pp_off(sample, 0, b * 2 + kvh, cb) + d] + c.PP[pp_off(sample, 0, b * 2 + kvh, cb + 1) + 64 + d] + c.CBIAS[d];
                   v = c.PP[pp_off(sample, 1, b * 2 + kvh, cb) + d] + c.PP[pp_off(sample, 1, b * 2 + kvh, cb + 1) + 64 + d] + c.CBIAS[64 + d]; }
    const size_t o = kc_off(sample, b, kvh);
    c.KCb[o + frag_idx(cb, d, 64)] = f2bf(k); c.VCTb[o + frag_idx(d, vperm16(cb), cpad)] = f2bf(v);
  } };
WV_DEV void memkv_unit(const Ctx& c, int mm) {
  const int lane = wv_lane(), h = lane >> 4, dd = (lane & 15) * 16; const float* k = c.MKV + (size_t)mm * 2048 + lane * 16; const float* v = k + 1024;
  f32x4v kv[4], vv[4]; float ss = 0.f;
#pragma unroll
  for (int j = 0; j < 4; ++j) { kv[j] = *(const f32x4v*)(k + 4 * j); vv[j] = *(const f32x4v*)(v + 4 * j); ss += (kv[j].x * kv[j].x + kv[j].y * kv[j].y) + (kv[j].z * kv[j].z + kv[j].w * kv[j].w); }
  ss += wv_shfl_xor_f(ss, 1); ss += wv_shfl_xor_f(ss, 2); ss += wv_shfl_xor_f(ss, 4); ss += wv_shfl_xor_f(ss, 8);
  const float r = 1.f / sqrtf(ss / 256.f + EPS); float* o = c.out + O_MKVP + (size_t)mm * 2048 + lane * 16;
#pragma unroll
  for (int j = 0; j < 4; ++j) { kv[j] = kv[j] * *(const f32x4v*)(c.xk_norm_w + dd + 4 * j) * r; *(f32x4v*)(o + 4 * j) = kv[j]; *(f32x4v*)(o + 1024 + 4 * j) = vv[j]; }
  const int bb = mm / MEM_TOKENS, jj = mm % MEM_TOKENS; bf16_t* kb = c.KXb + ((size_t)bb * 4 + h) * MEM_TOKENS * 256;
#pragma unroll
  for (int j = 0; j < 4; ++j) kv[j] = kv[j] * *(const f32x4v*)(c.xq_norm_w + dd + 4 * j);
  *(bf16x8*)(kb + frag_idx(jj, dd, 256)) = wv_pack8(kv[0].x, kv[0].y, kv[0].z, kv[0].w, kv[1].x, kv[1].y, kv[1].z, kv[1].w); *(bf16x8*)(kb + frag_idx(jj, dd + 8, 256)) = wv_pack8(kv[2].x, kv[2].y, kv[2].z, kv[2].w, kv[3].x, kv[3].y, kv[3].z, kv[3].w);
}
WV_DEV void xk_pack_unit(const Ctx& c, int row  ) {
  const int lane = wv_lane(), h = lane >> 4, dd = (lane & 15) * 16; const float* k = c.cache_mem_kv + (size_t)row * 2048 + lane * 16;
  const float* wq = c.xq_norm_w + dd; const f32x4v a = *(const f32x4v*)k * *(const f32x4v*)wq, b = *(const f32x4v*)(k + 4) * *(const f32x4v*)(wq + 4), e = *(const f32x4v*)(k + 8) * *(const f32x4v*)(wq + 8), f = *(const f32x4v*)(k + 12) * *(const f32x4v*)(wq + 12);
  const int bb = BATCH + row / MEM_TOKENS, jj = row % MEM_TOKENS; bf16_t* kb = c.KXb + ((size_t)bb * 4 + h) * MEM_TOKENS * 256;
  *(bf16x8*)(kb + frag_idx(jj, dd, 256)) = wv_pack8(a.x, a.y, a.z, a.w, b.x, b.y, b.z, b.w); *(bf16x8*)(kb + frag_idx(jj, dd + 8, 256)) = wv_pack8(e.x, e.y, e.z, e.w, f.x, f.y, f.z, f.w);
}
constexpr int XVT_UNITS = (BATCH + DEC_BATCH) * 4 * (MEM_TOKENS / 16) * 4;
WV_DEV void xvt_unit(const Ctx& c, int unit) {
  const int lane = wv_lane(); const int dblk = unit & 3; int r = unit >> 2; const int g16 = r % (MEM_TOKENS / 16); r /= (MEM_TOKENS / 16); const int h = r & 3, bb = r >> 2;
  const int d = dblk * 64 + lane;
  const float* src = (bb < BATCH ? c.MKV + ((size_t)bb * MEM_TOKENS + g16 * 16) * 2048 : c.cache_mem_kv + ((size_t)(bb - BATCH) * MEM_TOKENS + g16 * 16) * 2048) + 1024 + h * 256 + d; float v[16];
#pragma unroll
  for (int i = 0; i < 16; ++i) v[i] = src[(size_t)i * 2048];
  bf16_t* dst = c.VXTb + ((size_t)bb * 4 + h) * 256 * MEM_TOKENS;
  *(bf16x8*)(dst + frag_idx(d, g16 * 16, MEM_TOKENS)) = wv_pack8(v[0], v[1], v[2], v[3], v[8], v[9], v[10], v[11]); *(bf16x8*)(dst + frag_idx(d, g16 * 16 + 8, MEM_TOKENS)) = wv_pack8(v[4], v[5], v[6], v[7], v[12], v[13], v[14], v[15]);
}
HD const float* wall_row(const Ctx& c, int b, int w) {
  if (w < WBUF) return c.cache_nsa_win + ((size_t)b * WBUF + w) * 256;
  if (w < WBUF + DEC_SEQ) return c.WR + ((size_t)MP + b * DEC_SEQ + (w - WBUF)) * 256;
  return nullptr;
}
constexpr int WKS_UNITS = DEC_BATCH * 2 * (WKS / 8), WVS_UNITS = DEC_BATCH * 2 * (WKS / 16);
WV_DEV void winks_unit(const Ctx& c, int unit) {
  const int lane = wv_lane(); const int g8 = unit % (WKS / 8); int r = unit / (WKS / 8); const int kvh = r & 1, b = r >> 1; const int w = g8 * 8 + (lane >> 3), j = lane & 7;
  const float* src = wall_row(c, b, w); f32x4v a = {0.f, 0.f, 0.f, 0.f}, e = {0.f, 0.f, 0.f, 0.f};
  if (src) { a = *(const f32x4v*)(src + (0 * 2 + kvh) * 64 + j * 8); e = *(const f32x4v*)(src + (0 * 2 + kvh) * 64 + j * 8 + 4); }
  *(bf16x8*)(c.KWsb + ((size_t)b * 2 + kvh) * WKS * 64 + frag_idx(w, j * 8, 64)) = wv_pack8(a.x, a.y, a.z, a.w, e.x, e.y, e.z, e.w);
}
WV_DEV void winvs_unit(const Ctx& c, int unit) {
  const int lane = wv_lane(); const int g16 = unit % (WKS / 16); int r = unit / (WKS / 16); const int kvh = r & 1, b = r >> 1; float v[16];
#pragma unroll
  for (int i = 0; i < 16; ++i) { const float* src = wall_row(c, b, g16 * 16 + i); v[i] = src ? src[(1 * 2 + kvh) * 64 + lane] : 0.f; }
  bf16_t* dst = c.VWTsb + ((size_t)b * 2 + kvh) * 64 * WKS;
  *(bf16x8*)(dst + frag_idx(lane, g16 * 16, WKS)) = wv_pack8(v[0], v[1], v[2], v[3], v[8], v[9], v[10], v[11]); *(bf16x8*)(dst + frag_idx(lane, g16 * 16 + 8, WKS)) = wv_pack8(v[4], v[5], v[6], v[7], v[12], v[13], v[14], v[15]);
}
struct StWinOut4 { const Ctx& c; static constexpr long N = (long)(BATCH + DEC_BATCH) * WINDOW * 64;
  HD void operator()(long i) const {
    const int e = (int)(i % 64) * 4; const long r = i / 64; const int j = (int)(r % WINDOW), bb = (int)(r / WINDOW);
    if (bb < BATCH) *(f32x4v*)(c.out + O_WINP + ((size_t)bb * WINDOW + j) * 256 + e) = *(const f32x4v*)(c.WR + ((size_t)bb * SEQ + SEQ - WINDOW + j) * 256 + e);
    else { const int b = bb - BATCH; *(f32x4v*)(c.out + O_WINS + ((size_t)b * WINDOW + j) * 256 + e) = *(const f32x4v*)(wall_row(c, b, j + DEC_SEQ) + e); }
  } };
constexpr int FFN_CB = D_FF / 256, FFN_UNITS = (BATCH * (SEQ / 8) + DEC_BATCH) * FFN_CB;
WV_DEV f32x4v ld4bf(const bf16_t* p) { const u32x2v w = *(const u32x2v*)p; return f32x4v{__builtin_bit_cast(float, w.x << 16), __builtin_bit_cast(float, w.x & 0xffff0000u), __builtin_bit_cast(float, w.y << 16), __builtin_bit_cast(float, w.y & 0xffff0000u)}; }
template <bool UPBF> WV_DEV void ffn_act_unit_t(const Ctx& c, int unit) {
  const int lane = wv_lane(); const int cb = unit % FFN_CB, sg = unit / FFN_CB; const int col = cb * 256 + lane * 4;
  const bool sample = sg >= BATCH * (SEQ / 8); const int m0 = sample ? MP + (sg - BATCH * (SEQ / 8)) * DEC_SEQ : sg * 8; const int t0 = sample ? 0 : (sg % (SEQ / 8)) * 8;
  f32x4v wa[3], wu[3];
#pragma unroll
  for (int k = 0; k < 3; ++k) { wa[k] = *(const f32x4v*)(c.ffn_conv_w + (size_t)k * 2 * D_FF + col); wu[k] = *(const f32x4v*)(c.ffn_conv_w + (size_t)k * 2 * D_FF + D_FF + col); }
  const f32x4v ba = *(const f32x4v*)(c.ffn_conv_b + col), bu = *(const f32x4v*)(c.ffn_conv_b + D_FF + col);
  auto ldup = [&](int m, int cc) -> f32x4v { if (UPBF) return ld4bf(c.UPb + (size_t)m * (2 * D_FF) + cc); return *(const f32x4v*)(c.UP + (size_t)m * (2 * D_FF) + cc); };
  f32x4v a2 = {0.f, 0.f, 0.f, 0.f}, a1 = a2, u2 = a2, u1 = a2;
  if (t0 >= 2) { a2 = ldup(m0 - 2, col); u2 = ldup(m0 - 2, D_FF + col); a1 = ldup(m0 - 1, col); u1 = ldup(m0 - 1, D_FF + col); }
  else if (sample) { const float* p2 = c.cache_ffn_conv + (size_t)(sg - BATCH * (SEQ / 8)) * 2 * (2 * D_FF) + col; a2 = *(const f32x4v*)p2; u2 = *(const f32x4v*)(p2 + D_FF); a1 = *(const f32x4v*)(p2 + 2 * D_FF); u1 = *(const f32x4v*)(p2 + 3 * D_FF); }
#pragma unroll
  for (int t = 0; t < 8; ++t) { const f32x4v a0 = ldup(m0 + t, col), u0 = ldup(m0 + t, D_FF + col);
    const f32x4v ya = ba + wa[0] * a2 + wa[1] * a1 + wa[2] * a0, yu = bu + wu[0] * u2 + wu[1] * u1 + wu[2] * u0;
    st_pk4(c.ACT + (size_t)(m0 + t) * D_FF + col, f32x4v{siluf_(ya.x) * yu.x, siluf_(ya.y) * yu.y, siluf_(ya.z) * yu.z, siluf_(ya.w) * yu.w});
    a2 = a1; a1 = a0; u2 = u1; u1 = u0; }
}
constexpr int FFN_CB8 = (D_FF + 511) / 512, FFN_UNITS8 = (BATCH * (SEQ / 8) + DEC_BATCH) * FFN_CB8;
WV_DEV void ld8bf(const bf16_t* p, float (&x)[8]) { const u32x4v w = *(const u32x4v*)p;
  x[0] = __builtin_bit_cast(float, w.x << 16); x[1] = __builtin_bit_cast(float, w.x & 0xffff0000u); x[2] = __builtin_bit_cast(float, w.y << 16); x[3] = __builtin_bit_cast(float, w.y & 0xffff0000u);
  x[4] = __builtin_bit_cast(float, w.z << 16); x[5] = __builtin_bit_cast(float, w.z & 0xffff0000u); x[6] = __builtin_bit_cast(float, w.w << 16); x[7] = __builtin_bit_cast(float, w.w & 0xffff0000u); }
WV_DEV void ffn_act8_unit(const Ctx& c, int unit) {
  const int lane = wv_lane(); const int cb = unit % FFN_CB8, sg = unit / FFN_CB8; const int col = cb * 512 + lane * 8; if (col >= D_FF) return;
  const bool sample = sg >= BATCH * (SEQ / 8); const int m0 = sample ? MP + (sg - BATCH * (SEQ / 8)) * DEC_SEQ : sg * 8; const int t0 = sample ? 0 : (sg % (SEQ / 8)) * 8;
  float wa[3][8], wu[3][8], ba[8], bu[8];
#pragma unroll
  for (int k = 0; k < 3; ++k)
#pragma unroll
    for (int i4 = 0; i4 < 2; ++i4) { const f32x4v x = *(const f32x4v*)(c.ffn_conv_w + (size_t)k * 2 * D_FF + col + 4 * i4), y = *(const f32x4v*)(c.ffn_conv_w + (size_t)k * 2 * D_FF + D_FF + col + 4 * i4);
      wa[k][4 * i4] = x.x; wa[k][4 * i4 + 1] = x.y; wa[k][4 * i4 + 2] = x.z; wa[k][4 * i4 + 3] = x.w; wu[k][4 * i4] = y.x; wu[k][4 * i4 + 1] = y.y; wu[k][4 * i4 + 2] = y.z; wu[k][4 * i4 + 3] = y.w; }
#pragma unroll
  for (int i4 = 0; i4 < 2; ++i4) { const f32x4v x = *(const f32x4v*)(c.ffn_conv_b + col + 4 * i4), y = *(const f32x4v*)(c.ffn_conv_b + D_FF + col + 4 * i4);
    ba[4 * i4] = x.x; ba[4 * i4 + 1] = x.y; ba[4 * i4 + 2] = x.z; ba[4 * i4 + 3] = x.w; bu[4 * i4] = y.x; bu[4 * i4 + 1] = y.y; bu[4 * i4 + 2] = y.z; bu[4 * i4 + 3] = y.w; }
  float a2[8], a1[8], u2[8], u1[8];
#pragma unroll
  for (int i = 0; i < 8; ++i) { a2[i] = 0.f; a1[i] = 0.f; u2[i] = 0.f; u1[i] = 0.f; }
  if (t0 >= 2) { ld8bf(c.UPb + (size_t)(m0 - 2) * (2 * D_FF) + col, a2); ld8bf(c.UPb + (size_t)(m0 - 2) * (2 * D_FF) + D_FF + col, u2); ld8bf(c.UPb + (size_t)(m0 - 1) * (2 * D_FF) + col, a1); ld8bf(c.UPb + (size_t)(m0 - 1) * (2 * D_FF) + D_FF + col, u1); }
  else if (sample) { const float* p2 = c.cache_ffn_conv + (size_t)(sg - BATCH * (SEQ / 8)) * 2 * (2 * D_FF) + col;
#pragma unroll
    for (int i = 0; i < 8; ++i) { a2[i] = p2[i]; u2[i] = p2[D_FF + i]; a1[i] = p2[2 * D_FF + i]; u1[i] = p2[3 * D_FF + i]; } }
#pragma unroll
  for (int t = 0; t < 8; ++t) { float a0[8], u0[8], o[8]; ld8bf(c.UPb + (size_t)(m0 + t) * (2 * D_FF) + col, a0); ld8bf(c.UPb + (size_t)(m0 + t) * (2 * D_FF) + D_FF + col, u0);
#pragma unroll
    for (int i = 0; i < 8; ++i) { const float ya = ba[i] + wa[0][i] * a2[i] + wa[1][i] * a1[i] + wa[2][i] * a0[i], yu = bu[i] + wu[0][i] * u2[i] + wu[1][i] * u1[i] + wu[2][i] * u0[i]; o[i] = siluf_(ya) * yu; a2[i] = a1[i]; a1[i] = a0[i]; u2[i] = u1[i]; u1[i] = u0[i]; }
    *(bf16x8*)(c.ACT + (size_t)(m0 + t) * D_FF + col) = wv_pack8(o[0], o[1], o[2], o[3], o[4], o[5], o[6], o[7]); }
}
WV_DEV void ffn_act_unit(const Ctx& c, int unit) { ffn_act_unit_t<false>(c, unit); }
namespace pg8 {
#define PG8_LAS __attribute__((address_space(3)))
typedef unsigned short bf16_t;
typedef short bf16x8 __attribute__((ext_vector_type(8)));
typedef float f32x4 __attribute__((ext_vector_type(4)));
typedef unsigned u32x4 __attribute__((ext_vector_type(4)));
constexpr int BM = 256, BK = 64, HALF = 128, HTB = HALF * BK * 2  , STAGE_BYTES = 8 * HTB, NXCD = 8, WGM = 8;

__host__ __device__ __forceinline__ int lds_byte(int r, int c) { const int st = (r >> 4) * 2 + (c >> 5), rr = r & 15, cc = c & 31, ob = rr * 64 + cc * 2; return st * 1024 + (ob ^ (((ob >> 9) & 1) << 5)); }
__host__ __device__ __forceinline__ void stage_rc(int b, int& R, int& C) { const int st = b / 1024, sb = b % 1024, swz = sb ^ (((sb >> 9) & 1) << 5); R = (st >> 1) * 16 + swz / 64; C = (st & 1) * 32 + (swz % 64) / 2; }
__host__ __device__ __forceinline__ int perm32(int rho) { const int n = rho >> 4, i = rho & 15; return 8 * (i >> 2) + 4 * n + (i & 3); }

struct Unit { int pm, pn; };
struct Gemm { const bf16_t* A; const bf16_t* Bt; int M, N, K; };

struct StaticOrder {
    int nM, nN, nwg, G, c;
    __host__ __device__ void init(int M, int N, int G_, int c_) { nM = M / BM; nN = N / BM; nwg = nM * nN; G = G_; c = c_; }
    __host__ __device__ bool next(int i, Unit& u) const {
        const long L = (long)i * G + c; if (L >= nwg) return false;
        int wgid = (int)L; { const int q = nwg / NXCD, r = nwg % NXCD, xcd = wgid % NXCD, off = wgid / NXCD; wgid = (xcd < r ? xcd * (q + 1) : r * (q + 1) + (xcd - r) * q) + off; }
        const int nig = WGM * nN, gid = wgid / nig, fm = gid * WGM, gsz = (nM - fm) < WGM ? (nM - fm) : WGM;
        u.pm = fm + ((wgid % nig) % gsz); u.pn = (wgid % nig) / gsz; return true;
    }
    __device__ __forceinline__ void a_ready(const Unit&) const {}
    __device__ __forceinline__ void done(const Unit&) const {}
};

typedef unsigned u32x2 __attribute__((ext_vector_type(2)));
__device__ __forceinline__ unsigned cvt_pk_bf16_(float lo, float hi) { typedef float f2_ __attribute__((ext_vector_type(2))); typedef __bf16 b2_ __attribute__((ext_vector_type(2))); f2_ v = {lo, hi}; b2_ b = __builtin_convertvector(v, b2_); return __builtin_bit_cast(unsigned, b); }
struct EpiF32 { static constexpr bool PERM = false, AFTER_DRAIN = false;
  float* C; int ldc; const float* resP; const float* resS; int mp;
  __device__ __forceinline__ void operator()(const f32x4 (&acc)[2][2][4][2], const Unit& u, int wr, int wc, int fr, int fq) const {
#pragma unroll
    for (int ai = 0; ai < 2; ++ai)
#pragma unroll
      for (int m = 0; m < 4; ++m) {
        const int row = u.pm * BM + ai * HALF + wr * 64 + m * 16 + fr;
        float* crow = C + (size_t)row * ldc;
        const float* rrow = resP ? (row < mp ? resP + (size_t)row * 1024 : resS + (size_t)(row - mp) * 1024) : nullptr;
#pragma unroll
        for (int bj = 0; bj < 2; ++bj)
#pragma unroll
          for (int n = 0; n < 2; ++n) {
            const int col = u.pn * BM + bj * HALF + wc * 32 + n * 16 + 4 * fq;
            f32x4 v = acc[ai][bj][m][n]; if (rrow) v += *(const f32x4*)(rrow + col);
            *(f32x4*)(crow + col) = v;
          }
      }
  } };

struct EpiBf16S { static constexpr bool PERM = false, AFTER_DRAIN = false;
  bf16_t* C; int ldc; float* stP; float* stS; int nst, c0, c1, ldst; const float* RS;
  __device__ __forceinline__ void operator()(const f32x4 (&acc)[2][2][4][2], const Unit& u, int wr, int wc, int fr, int fq) const {
#pragma unroll
    for (int ai = 0; ai < 2; ++ai)
#pragma unroll
      for (int m = 0; m < 4; ++m) {
        const int row = u.pm * BM + ai * HALF + wr * 64 + m * 16 + fr;
        bf16_t* crow = C + (size_t)row * ldc; const float rs = RS ? 1.f / sqrtf(RS[row] * (1.f / 1024.f) + 1e-6f) : 1.f;
        float* srow = nullptr;
        if (stP) { if (row < MP) { const int t = row % SEQ; if (t >= SEQ - nst) srow = stP + ((size_t)(row / SEQ) * nst + (t - (SEQ - nst))) * ldst; }
                   else { const int t = (row - MP) % DEC_SEQ; if (t >= DEC_SEQ - nst) srow = stS + ((size_t)((row - MP) / DEC_SEQ) * nst + (t - (DEC_SEQ - nst))) * ldst; } }
#pragma unroll
        for (int bj = 0; bj < 2; ++bj)
#pragma unroll
          for (int n = 0; n < 2; ++n) {
            const int col = u.pn * BM + bj * HALF + wc * 32 + n * 16 + 4 * fq; const f32x4 v = acc[ai][bj][m][n] * rs;
            u32x2 w; w.x = cvt_pk_bf16_(v[0], v[1]); w.y = cvt_pk_bf16_(v[2], v[3]); *(u32x2*)(crow + col) = w;
            if (srow && col >= c0 && col < c1) *(f32x4*)(srow + col - c0) = v;
          }
      }
  } };

struct EpiF32N { static constexpr bool PERM = false, AFTER_DRAIN = false;
  float* C; const float* resP; const float* resS; int mp; bf16_t* A2; const float* w; float* RS;
  __device__ __forceinline__ void operator()(const f32x4 (&acc)[2][2][4][2], const Unit& u, int wr, int wc, int fr, int fq) const {
#pragma unroll
    for (int ai = 0; ai < 2; ++ai)
#pragma unroll
      for (int m = 0; m < 4; ++m) {
        const int row = u.pm * BM + ai * HALF + wr * 64 + m * 16 + fr;
        float* crow = C + (size_t)row * 1024; bf16_t* arow = A2 + (size_t)row * 1024;
        const float* rrow = row < mp ? resP + (size_t)row * 1024 : resS + (size_t)(row - mp) * 1024;
        float ss = 0.f;
#pragma unroll
        for (int bj = 0; bj < 2; ++bj)
#pragma unroll
          for (int n = 0; n < 2; ++n) {
            const int col = u.pn * BM + bj * HALF + wc * 32 + n * 16 + 4 * fq;
            const f32x4 v = acc[ai][bj][m][n] + *(const f32x4*)(rrow + col); *(f32x4*)(crow + col) = v;
            ss += (v[0] * v[0] + v[1] * v[1]) + (v[2] * v[2] + v[3] * v[3]);
            const f32x4 a = v * *(const f32x4*)(w + col); u32x2 pk; pk.x = cvt_pk_bf16_(a[0], a[1]); pk.y = cvt_pk_bf16_(a[2], a[3]); *(u32x2*)(arow + col) = pk;
          }
        ss += __shfl_xor(ss, 16); ss += __shfl_xor(ss, 32);
        if (fq == 0) atomicAdd(RS + row, ss);
      }
  } };
template <class Epi, class Sched, bool ALIGN_EPI = false, bool SP2 = false>
__device__ __forceinline__ void gemm_phase(PG8_LAS unsigned char* lds, const Gemm g, const Sched& S, const Epi& E) {
    const int tid = threadIdx.x, wid = __builtin_amdgcn_readfirstlane(tid >> 6), lane = tid & 63, wr = wid >> 2, wc = wid & 3, fr = lane & 15, fq = lane >> 4;
    const int K = g.K, nt = K / BK;
    unsigned voffA[2], voffB[2];
#pragma unroll
    for (int i = 0; i < 2; ++i) { int R, C; stage_rc(tid * 16 + i * 8192, R, C); const int Rb = Epi::PERM ? ((R & ~31) + perm32(R & 31)) : R;
        voffA[i] = (unsigned)(R * K + C) * 2u; voffB[i] = (unsigned)(Rb * K + C) * 2u; }
    const size_t kstep = (size_t)(BK * 2);
    const size_t hstep = (size_t)HALF * K * 2;
    const size_t tstep = 2 * hstep;
    const unsigned ldsw = (unsigned)wid * 1024u;
    const int aoff = lds_byte(wr * 64 + fr, fq * 8), boff = lds_byte(wc * 32 + fr, fq * 8);
#define PG8_SA(b, h) (((b) * 2 + (h)) * HTB)
#define PG8_SB(b, h) ((4 + (b) * 2 + (h)) * HTB)
#define PG8_STAGE(bufoff, gbase, voff) do { _Pragma("unroll") for (int _i = 0; _i < 2; ++_i) \
        __builtin_amdgcn_global_load_lds((const unsigned*)((const char*)(gbase) + (voff)[_i]), (PG8_LAS unsigned*)(lds + (bufoff) + ldsw + _i * 8192), 16, 0, 0); } while (0)
#define PG8_LDA(dst, b, h) do { _Pragma("unroll") for (int m = 0; m < 4; ++m) _Pragma("unroll") for (int k = 0; k < 2; ++k) dst[m][k] = *(const PG8_LAS bf16x8*)(lds + PG8_SA(b, h) + aoff + m * 2048 + k * 1024); } while (0)
#define PG8_LDB(dst, b, h) do { _Pragma("unroll") for (int n = 0; n < 2; ++n) _Pragma("unroll") for (int k = 0; k < 2; ++k) dst[n][k] = *(const PG8_LAS bf16x8*)(lds + PG8_SB(b, h) + boff + n * 2048 + k * 1024); } while (0)
#define PG8_MMA(ai, bj, At, Bt) do { __builtin_amdgcn_s_setprio(1); _Pragma("unroll") for (int m = 0; m < 4; ++m) _Pragma("unroll") for (int n = 0; n < 2; ++n) _Pragma("unroll") for (int k = 0; k < 2; ++k) \
        acc[ai][bj][m][n] = __builtin_amdgcn_mfma_f32_16x16x32_bf16(Bt[n][k], At[m][k], acc[ai][bj][m][n], 0, 0, 0); __builtin_amdgcn_s_setprio(0); } while (0)
#define PG8_WAIT_V(n) asm volatile("s_waitcnt vmcnt(" #n ")" ::: "memory")
#define PG8_WAIT_L(n) asm volatile("s_waitcnt lgkmcnt(" #n ")" ::: "memory")
#define PG8_BAR __builtin_amdgcn_s_barrier()
#define PG8_SCHED __builtin_amdgcn_sched_barrier(0)
    Unit cur, nxt; int ui = 0;
    if (!S.next(0, cur)) return;
    f32x4 acc[2][2][4][2];
#pragma unroll
    for (int a = 0; a < 2; ++a)
#pragma unroll
        for (int b = 0; b < 2; ++b)
#pragma unroll
            for (int m = 0; m < 4; ++m)
#pragma unroll
                for (int n = 0; n < 2; ++n) acc[a][b][m][n] = (f32x4){0.f, 0.f, 0.f, 0.f};
    bf16x8 At[4][2], B0[2][2], B1[2][2];
    const char* cA = (const char*)g.A + (size_t)cur.pm * tstep; const char* cB = (const char*)g.Bt + (size_t)cur.pn * tstep;
    S.a_ready(cur);
    if constexpr (SP2) {
        PG8_STAGE(PG8_SB(0, 0), cB, voffB); PG8_STAGE(PG8_SB(0, 1), cB + hstep, voffB); PG8_STAGE(PG8_SA(0, 0), cA, voffA); PG8_STAGE(PG8_SA(0, 1), cA + hstep, voffA);
        if (wr == 1) PG8_BAR;
        PG8_WAIT_V(2); PG8_BAR;
        PG8_STAGE(PG8_SB(1, 0), cB + kstep, voffB); PG8_STAGE(PG8_SA(1, 0), cA + kstep, voffA); PG8_STAGE(PG8_SB(1, 1), cB + hstep + kstep, voffB);
        PG8_WAIT_V(6); PG8_BAR;
    } else {
        PG8_STAGE(PG8_SB(0, 0), cB, voffB); PG8_STAGE(PG8_SA(0, 0), cA, voffA); PG8_STAGE(PG8_SB(0, 1), cB + hstep, voffB); PG8_STAGE(PG8_SA(0, 1), cA + hstep, voffA);
        if (wr == 1) PG8_BAR;
        PG8_WAIT_V(4); PG8_BAR;
        PG8_STAGE(PG8_SB(1, 0), cB + kstep, voffB); PG8_STAGE(PG8_SA(1, 0), cA + kstep, voffA); PG8_STAGE(PG8_SB(1, 1), cB + hstep + kstep, voffB);
        PG8_WAIT_V(6); PG8_BAR;
    }
    for (;;) {
        const bool has_next = S.next(ui + 1, nxt);
        const char* nA = has_next ? (const char*)g.A + (size_t)nxt.pm * tstep : cA; const char* nB = has_next ? (const char*)g.Bt + (size_t)nxt.pn * tstep : cB;
        for (int t = 0; t < nt; t += 2) {
            const bool last = (t == nt - 2);
            const char* a1 = cA + (size_t)(t + 1) * kstep;
            const char* a2 = last ? nA : cA + (size_t)(t + 2) * kstep; const char* b2 = last ? nB : cB + (size_t)(t + 2) * kstep;
            const char* a3 = a2 + kstep; const char* b3 = b2 + kstep;
            if (last && has_next) S.a_ready(nxt);
            if constexpr (SP2) {
            PG8_LDB(B0, 0, 0); PG8_LDB(B1, 0, 1); PG8_SCHED; PG8_LDA(At, 0, 0); PG8_STAGE(PG8_SA(1, 1), a1 + hstep, voffA);
            PG8_WAIT_V(8); PG8_WAIT_L(0); PG8_BAR; PG8_MMA(0, 0, At, B0); PG8_MMA(0, 1, At, B1); PG8_BAR; PG8_SCHED;
            PG8_LDA(At, 0, 1); PG8_STAGE(PG8_SB(0, 0), b2, voffB); PG8_STAGE(PG8_SB(0, 1), b2 + hstep, voffB); PG8_STAGE(PG8_SA(0, 0), a2, voffA);
            PG8_WAIT_V(8); PG8_WAIT_L(0); PG8_BAR; PG8_MMA(1, 0, At, B0); PG8_MMA(1, 1, At, B1); PG8_BAR; PG8_SCHED;
            PG8_LDB(B0, 1, 0); PG8_LDB(B1, 1, 1); PG8_SCHED; PG8_LDA(At, 1, 0); PG8_STAGE(PG8_SA(0, 1), a2 + hstep, voffA);
            PG8_WAIT_V(8); PG8_WAIT_L(0); PG8_BAR; PG8_MMA(0, 0, At, B0); PG8_MMA(0, 1, At, B1); PG8_BAR; PG8_SCHED;
            PG8_LDA(At, 1, 1); PG8_STAGE(PG8_SB(1, 0), b3, voffB); PG8_STAGE(PG8_SB(1, 1), b3 + hstep, voffB); PG8_STAGE(PG8_SA(1, 0), a3, voffA);
            PG8_WAIT_V(8); PG8_WAIT_L(0); PG8_BAR; PG8_MMA(1, 0, At, B0); PG8_MMA(1, 1, At, B1); PG8_BAR; PG8_SCHED;
            } else {
            PG8_LDB(B0, 0, 0); PG8_SCHED; PG8_LDA(At, 0, 0); PG8_STAGE(PG8_SA(1, 1), a1 + hstep, voffA);
            PG8_WAIT_L(8); PG8_BAR; PG8_WAIT_L(0); PG8_MMA(0, 0, At, B0); PG8_BAR; PG8_SCHED;
            PG8_LDB(B1, 0, 1); PG8_STAGE(PG8_SB(0, 0), b2, voffB);
            PG8_BAR; PG8_WAIT_L(0); PG8_MMA(0, 1, At, B1); PG8_BAR;
            PG8_LDA(At, 0, 1); PG8_STAGE(PG8_SA(0, 0), a2, voffA);
            PG8_BAR; PG8_WAIT_L(0); PG8_MMA(1, 0, At, B0); PG8_BAR; PG8_SCHED;
            PG8_STAGE(PG8_SB(0, 1), b2 + hstep, voffB);
            PG8_WAIT_V(6); PG8_BAR; PG8_MMA(1, 1, At, B1); PG8_BAR;
            PG8_LDB(B0, 1, 0); PG8_SCHED; PG8_LDA(At, 1, 0); PG8_STAGE(PG8_SA(0, 1), a2 + hstep, voffA);
            PG8_WAIT_L(8); PG8_BAR; PG8_WAIT_L(0); PG8_MMA(0, 0, At, B0); PG8_BAR; PG8_SCHED;
            PG8_LDB(B1, 1, 1); PG8_STAGE(PG8_SB(1, 0), b3, voffB);
            PG8_BAR; PG8_WAIT_L(0); PG8_MMA(0, 1, At, B1); PG8_BAR;
            PG8_LDA(At, 1, 1); PG8_STAGE(PG8_SA(1, 0), a3, voffA);
            PG8_BAR; PG8_WAIT_L(0); PG8_MMA(1, 0, At, B0); PG8_BAR; PG8_SCHED;
            PG8_STAGE(PG8_SB(1, 1), b3 + hstep, voffB);
            PG8_WAIT_V(6); PG8_BAR; PG8_MMA(1, 1, At, B1); PG8_BAR;
            }
        }
        if constexpr (ALIGN_EPI) { if (wr == 0) PG8_BAR; }
        if constexpr (!Epi::AFTER_DRAIN) { E(acc, cur, wr, wc, fr, fq); S.done(cur); }
        if (!has_next) break;
#pragma unroll
        for (int a = 0; a < 2; ++a)
#pragma unroll
            for (int b = 0; b < 2; ++b)
#pragma unroll
                for (int m = 0; m < 4; ++m)
#pragma unroll
                    for (int n = 0; n < 2; ++n) acc[a][b][m][n] = (f32x4){0.f, 0.f, 0.f, 0.f};
        cur = nxt; cA = nA; cB = nB; ++ui;
        if constexpr (ALIGN_EPI) { if (wr == 1) PG8_BAR; }
    }
    PG8_WAIT_V(0);
    if constexpr (!ALIGN_EPI) { if (wr == 0) PG8_BAR; }
    PG8_BAR;
    if constexpr (Epi::AFTER_DRAIN) { E.fused(acc, cur, wr, wc, fr, fq, lds, wid, lane); S.done(cur); }
#undef PG8_SA
#undef PG8_SB
#undef PG8_STAGE
#undef PG8_LDA
#undef PG8_LDB
#undef PG8_MMA
#undef PG8_WAIT_V
#undef PG8_WAIT_L
#undef PG8_BAR
#undef PG8_SCHED
}
}
#define GAS __attribute__((address_space(1)))
#define LAS __attribute__((address_space(3)))
typedef unsigned v4u __attribute__((ext_vector_type(4)));
#define LDS_WAIT() asm volatile("s_waitcnt lgkmcnt(0)" ::: "memory")
__device__ __forceinline__ unsigned pk2(float lo, float hi) { return f2bf_u(lo) | (f2bf_u(hi) << 16); }
constexpr int LDS_BYTES = 147456 + 256;
constexpr int NWAVES = 8;
__device__ __forceinline__ void p0_transpose_item(const float* W, int K, int N, bf16_t* WT, int row_off, LAS float* scr, int item, int lane) {
    const int nblk = N / 32, kb = item / nblk, nb = item % nblk, k0 = 64 * kb, n0 = 32 * nb;
#pragma unroll 8
    for (int i = 0; i < 32; ++i) { const int kk = 2 * i + (lane >> 5); scr[kk * 33 + (lane & 31)] = W[(size_t)(k0 + kk) * N + n0 + (lane & 31)]; }
    LDS_WAIT(); asm volatile("" ::: "memory");
    const int c = lane & 7;
#pragma unroll
    for (int j = 0; j < 4; ++j) { const int n = (lane >> 3) + 8 * j; const LAS float* s = scr + (8 * c) * 33 + n;
        v4u o; o.x = pk2(s[0 * 33], s[1 * 33]); o.y = pk2(s[2 * 33], s[3 * 33]); o.z = pk2(s[4 * 33], s[5 * 33]); o.w = pk2(s[6 * 33], s[7 * 33]);
        *(GAS v4u*)(WT + (size_t)(row_off + n0 + n) * K + k0 + 8 * c) = o; }
    LDS_WAIT(); asm volatile("" ::: "memory");
}
#define XB_TMO      128
#define XB_XCNT(j)  (256  + 64 * (j))
#define XB_XSUB(j)  (1280 + 64 * (j))
#define XB_XGEN(j)  (2304 + 64 * (j))
#define XB_TOP      3328
#define XB_TOPGEN   3392
#define XCD_BAR_WORDS 3456
#define XB_SPIN_CAP (1u << 18)

__device__ __forceinline__ unsigned xb_ld(unsigned* p)              { return __hip_atomic_load(p, __ATOMIC_RELAXED, __HIP_MEMORY_SCOPE_AGENT); }
__device__ __forceinline__ unsigned xb_add(unsigned* p, unsigned v) { return __hip_atomic_fetch_add(p, v, __ATOMIC_RELAXED, __HIP_MEMORY_SCOPE_AGENT); }
__device__ __forceinline__ unsigned xb_xcc_id() { return (unsigned)__builtin_amdgcn_s_getreg((3 << 11) | 20) & 0xFu; }
#define XB_SPIN(cond, bar) do { unsigned _sp = 0; while (cond) { __builtin_amdgcn_s_sleep(1); \
    if ((++_sp & 255u) == 0u) { if (xb_ld(&(bar)[XB_TMO])) break; if (_sp > XB_SPIN_CAP) { atomicAdd(&(bar)[XB_TMO], 1u); break; } } } } while (0)

struct XcdBarrier {
    unsigned* bar; unsigned x;
    volatile LAS unsigned* st;
};

__device__ __forceinline__ XcdBarrier xcd_barrier_post(unsigned* bar, volatile LAS unsigned* st) {
    XcdBarrier b; b.bar = bar; b.x = xb_xcc_id(); b.st = st;
    if (threadIdx.x == 0) (void)xb_add(&bar[XB_XCNT(b.x)], 1u);
    return b;
}
__device__ __forceinline__ void xcd_barrier_complete(unsigned* bar, unsigned x, unsigned& nloc, unsigned& nx) {
    const unsigned G = gridDim.x * gridDim.y * gridDim.z;
    unsigned sum, cnt, mine, sp = 0u;
    for (;;) {
        sum = 0u; cnt = 0u; mine = 0u;
#pragma unroll
        for (unsigned j = 0; j < 16; ++j) { const unsigned c = xb_ld(&bar[XB_XCNT(j)]); sum += c; cnt += (c > 0u) ? 1u : 0u; mine = (j == x) ? c : mine; }
        if (sum == G) break;
        __builtin_amdgcn_s_sleep(1);
        if ((++sp & 255u) == 0u) { if (xb_ld(&bar[XB_TMO])) break; if (sp > XB_SPIN_CAP) { atomicAdd(&bar[XB_TMO], 1u); break; } }
    }
    nloc = mine > 0u ? mine : 1u; nx = cnt > 0u ? cnt : 1u;
}

__device__ __forceinline__ void xcd_barrier(const XcdBarrier& b) {
    asm volatile("s_waitcnt vmcnt(0)" ::: "memory");
    __syncthreads();
    if (threadIdx.x == 0) {
        unsigned* bar = b.bar;
        __builtin_amdgcn_s_waitcnt(0);
        unsigned nloc = b.st[0], nx = b.st[1];
        if (nloc == 0u) { xcd_barrier_complete(bar, b.x, nloc, nx); b.st[0] = nloc; b.st[1] = nx; }
        const unsigned old = xb_add(&bar[XB_XSUB(b.x)], 1u);
        const unsigned gen = old / nloc;
        if (old + 1u == (gen + 1u) * nloc) {
            __builtin_amdgcn_fence(__ATOMIC_RELEASE, "agent");
            asm volatile("s_waitcnt vmcnt(0)" ::: "memory");
            const unsigned og = xb_add(&bar[XB_TOP], 1u);
            const unsigned tg = og / nx;
            if (og + 1u == (tg + 1u) * nx) xb_add(&bar[XB_TOPGEN], 1u);
            else XB_SPIN(xb_ld(&bar[XB_TOPGEN]) == tg, bar);
            __builtin_amdgcn_fence(__ATOMIC_ACQUIRE, "agent");
            xb_add(&bar[XB_XGEN(b.x)], 1u);
            asm volatile("s_waitcnt vmcnt(0)" ::: "memory");
        } else {
            XB_SPIN(xb_ld(&bar[XB_XGEN(b.x)]) == gen, bar);
            __builtin_amdgcn_fence(__ATOMIC_ACQUIRE, "agent");
            asm volatile("s_waitcnt vmcnt(0)" ::: "memory");
        }
    }
    __syncthreads();
}

struct Args { Ctx c; bf16_t *WinT, *WkvT, *WoutT, *WxqT, *WxoT, *WupT, *WdownT; unsigned* ctr; unsigned* bar; float* RS1; float* RS2; int ph_lo, ph_hi; };
template <class F> __device__ __forceinline__ void run_stage(const F& f) {
  const long stride = (long)gridDim.x * 512;
  for (long i = (long)blockIdx.x * 512 + threadIdx.x; i < F::N; i += stride) f(i);
}
constexpr int N_PHASES = 18;
struct Args;
__device__ __forceinline__ const Args* phase_args() { unsigned long long p = (unsigned long long)__builtin_amdgcn_kernarg_segment_ptr(); asm volatile("" : "+s"(p)); return (const Args*)p; }
__global__ void __launch_bounds__(512, 2) mega(Args a0) {
  extern __shared__ __attribute__((aligned(16))) unsigned char lds_raw[];
  LAS unsigned char* lds = (LAS unsigned char*)lds_raw;
  const int ph_lo = a0.ph_lo, ph_hi = a0.ph_hi;
  volatile LAS unsigned* bst = (volatile LAS unsigned*)(lds + 147456);
  if (threadIdx.x < 2) bst[threadIdx.x] = 0u;
  __syncthreads();
  const XcdBarrier gbar = xcd_barrier_post(a0.bar, bst);
  const int tid = threadIdx.x, lane = tid & 63, wave = __builtin_amdgcn_readfirstlane(tid >> 6);
#define PH(k) if (ph_lo <= (k) && (k) < ph_hi) if (const Args* ap_ = phase_args()) if (const Args& a = *ap_; true) if (const Ctx& c = a.c; true)
#define WUNITS(n, expr) do { const int G8_ = (int)gridDim.x * NWAVES; for (int u = (int)blockIdx.x * NWAVES + wave; u < (n); u += G8_) { expr; } } while (0)
#define SYNC(k) do { if ((k) + 1 < ph_hi) xcd_barrier(gbar); } while (0)
#define GEMM(A_, B_, M_, N_, K_, C_, LDC_, RP_, RS_) do { __syncthreads(); pg8::Gemm g{A_, B_, M_, N_, K_}; pg8::StaticOrder S; S.init(M_, N_, (int)gridDim.x, (int)blockIdx.x); \
      pg8::EpiF32 E{C_, LDC_, RP_, RS_, MP}; pg8::gemm_phase<pg8::EpiF32, pg8::StaticOrder, true, true>(lds, g, S, E); } while (0)
  PH(0) {
    LAS float* scr = (LAS float*)(lds + wave * 16384);
    const int gw = blockIdx.x * NWAVES + wave, NGW = gridDim.x * NWAVES;
    constexpr int I_IN = (D_MODEL / 64) * (IN_COLS / 32), I_SQ = (D_MODEL / 64) * (D_MODEL / 32), I_UP = (D_MODEL / 64) * (2 * D_FF / 32), I_DN = (D_FF / 64) * (D_MODEL / 32);
    constexpr int NIT = I_IN + 5 * I_SQ + I_UP + I_DN;
    for (int it = gw; it < NIT; it += NGW) { int r = it;
      if (r < I_IN) { p0_transpose_item(c.w_in, D_MODEL, IN_COLS, a.WinT, 0, scr, r, lane); continue; } r -= I_IN;
      if (r < I_SQ) { p0_transpose_item(c.w_xk, D_MODEL, D_MODEL, a.WkvT, 0, scr, r, lane); continue; } r -= I_SQ;
      if (r < I_SQ) { p0_transpose_item(c.w_xv, D_MODEL, D_MODEL, a.WkvT, D_MODEL, scr, r, lane); continue; } r -= I_SQ;
      if (r < I_SQ) { p0_transpose_item(c.w_out, D_MODEL, D_MODEL, a.WoutT, 0, scr, r, lane); continue; } r -= I_SQ;
      if (r < I_SQ) { p0_transpose_item(c.w_xq, D_MODEL, D_MODEL, a.WxqT, 0, scr, r, lane); continue; } r -= I_SQ;
      if (r < I_SQ) { p0_transpose_item(c.w_xo, D_MODEL, D_MODEL, a.WxoT, 0, scr, r, lane); continue; } r -= I_SQ;
      if (r < I_UP) { p0_transpose_item(c.w_up, D_MODEL, 2 * D_FF, a.WupT, 0, scr, r, lane); continue; } r -= I_UP;
      p0_transpose_item(c.w_down, D_FF, D_MODEL, a.WdownT, 0, scr, r, lane); }
    run_stage(StCmpWT{c}); run_stage(StRope{c}); WUNITS(128, cmp_bias_unit(c, u));
    for (int i = (int)blockIdx.x * 512 + tid; i < MTOT; i += (int)gridDim.x * 512) { a.RS1[i] = 0.f; a.RS2[i] = 0.f; }
    if (blockIdx.x == 0 && tid < 8) a.ctr[64 * tid] = 0u;
    WUNITS(MTOT + MMEM, (u < MTOT ? rms_row_unit(x_row(c, u), c.attn_norm_w, c.XN + (size_t)u * D_MODEL) : rms_row_unit(c.mem_prompt + (size_t)(u - MTOT) * D_MODEL, c.mem_norm_w, c.MN + (size_t)(u - MTOT) * D_MODEL)));
    SYNC(0); }
  PH(1) { __syncthreads(); pg8::Gemm g{c.XN, a.WinT, MTOT, LDP, D_MODEL}; pg8::StaticOrder S; S.init(MTOT, LDP, (int)gridDim.x, (int)blockIdx.x);
    pg8::EpiBf16S E{c.Pb, LDP, c.out + O_GCP, c.out + O_GCS, 3, OFF_QKV, OFF_QKV + 1536, 1536, nullptr}; pg8::gemm_phase<pg8::EpiBf16S, pg8::StaticOrder, true, true>(lds, g, S, E); SYNC(1); }
  PH(2) { GEMM(c.MN, a.WkvT, MMEM, 2048, D_MODEL, c.MKV, 2048, nullptr, nullptr); SYNC(2); }
  PH(3) { WUNITS(MTOT, postproc_unit(c, u)); WUNITS(MTOT, gdn_conv_unit(c, u)); WUNITS(VT_UNITS, vt_unit(c, u));
    WUNITS(MMEM, memkv_unit(c, u)); WUNITS(DEC_BATCH * MEM_TOKENS, xk_pack_unit(c, u)); WUNITS(XVT_UNITS, xvt_unit(c, u)); SYNC(3); }
  PH(4) {
    { const int G8 = (int)gridDim.x * NWAVES, local = (int)blockIdx.x * NWAVES + wave; float* wscr = (float*)(lds_raw + (tid >> 6) * 18432);
      for (int u = local; u < GDN_PREP2_UNITS; u += G8) gdn_prep2_unit(c, u, wscr); }
    WUNITS(CMP_UNITS_S, compress_unit<true>(c, u)); WUNITS(CMP_UNITS_P, compress_unit<false>(c, u));
    WUNITS(WKS_UNITS, winks_unit(c, u)); WUNITS(WVS_UNITS, winvs_unit(c, u)); run_stage(StWinOut4{c}); SYNC(4); }
  PH(5) { run_stage(StPackCmp2{c}); SYNC(5); }
  PH(6) {
    if (wave == 0) { if (blockIdx.x < BATCH * 16) gdn_scan_unit(c, (int)blockIdx.x); }
    else if (wave <= 2) { const int u = BATCH * 16 + (int)blockIdx.x * 2 + (wave - 1); if (u < GDN_SCAN_UNITS) gdn_scan_unit(c, u); }
    else if (wave == 3) { if ((int)blockIdx.x < NSA_UNITS_S) nsa_unit<true>(c, (int)blockIdx.x, (float*)(lds_raw + 3 * 18432)); }
    const int xq = (int)blockIdx.x & 7; constexpr int PERQ = NSA_UNITS_P / 8;
    for (;;) { int k = 0; if (lane == 0) k = (int)atomicAdd(a.ctr + 64 * xq, 1u); k = __builtin_amdgcn_readfirstlane(k); if (k >= PERQ) break;
      const int tile = (SEQ / 8 - 1) - (k >> 1), bk = 2 * xq + (k & 1); nsa_unit<false>(c, bk * (SEQ / 8) + tile, nullptr); }
    SYNC(6); }
  PH(7) { WUNITS(NSA_COMB_UNITS, nsa_combine_unit(c, u)); WUNITS(MTOT, gdn_norm_unit(c, u)); SYNC(7); }
  PH(8) { __syncthreads(); pg8::Gemm g{c.CAT, a.WoutT, MTOT, D_MODEL, D_MODEL}; pg8::StaticOrder S; S.init(MTOT, D_MODEL, (int)gridDim.x, (int)blockIdx.x);
    pg8::EpiF32N E{c.H1, c.x_prompt, c.x_sample, MP, c.XN, c.xattn_norm_w, a.RS1}; pg8::gemm_phase<pg8::EpiF32N, pg8::StaticOrder, true, true>(lds, g, S, E); SYNC(8); }
  PH(9) { }
  PH(10) { __syncthreads(); pg8::Gemm g{c.XN, a.WxqT, MTOT, D_MODEL, D_MODEL}; pg8::StaticOrder S; S.init(MTOT, D_MODEL, (int)gridDim.x, (int)blockIdx.x);
    pg8::EpiBf16S E{c.Q2b, D_MODEL, nullptr, nullptr, 0, 0, 0, 0, a.RS1}; pg8::gemm_phase<pg8::EpiBf16S, pg8::StaticOrder, true, true>(lds, g, S, E); SYNC(10); }
  PH(11) { }
  PH(12) {
    const int G8 = (int)gridDim.x * NWAVES, local = (int)blockIdx.x * NWAVES + wave;
    for (int u = local; u < XA_UNITS_P; u += G8) xattn_unit<false>(c, u);
    for (int u = local; u < XA_UNITS_S; u += G8) xattn_unit<true>(c, u);
    SYNC(12); }
  PH(13) { __syncthreads(); pg8::Gemm g{c.OX, a.WxoT, MTOT, D_MODEL, D_MODEL}; pg8::StaticOrder S; S.init(MTOT, D_MODEL, (int)gridDim.x, (int)blockIdx.x);
    pg8::EpiF32N E{c.H2, c.H1, c.H1 + (size_t)MP * D_MODEL, MP, c.XN, c.ffn_norm_w, a.RS2}; pg8::gemm_phase<pg8::EpiF32N, pg8::StaticOrder, true, true>(lds, g, S, E); SYNC(13); }
  PH(14) { }
  PH(15) { __syncthreads(); pg8::Gemm g{c.XN, a.WupT, MTOT, 2 * D_FF, D_MODEL}; pg8::StaticOrder S; S.init(MTOT, 2 * D_FF, (int)gridDim.x, (int)blockIdx.x);
    pg8::EpiBf16S E{c.UPb, 2 * D_FF, c.out + O_FCP, c.out + O_FCS, 2, 0, 2 * D_FF, 2 * D_FF, a.RS2}; pg8::gemm_phase<pg8::EpiBf16S, pg8::StaticOrder, true, true>(lds, g, S, E); SYNC(15); }
  PH(16) { WUNITS(FFN_UNITS8, ffn_act8_unit(c, u)); SYNC(16); }
#ifdef EXTRA_LO
  PH(20) { if (wave == 3) { if ((int)blockIdx.x < NSA_UNITS_S) nsa_unit<true>(c, (int)blockIdx.x, (float*)(lds_raw + 3 * 18432)); } }
  PH(21) { if (wave == 0) { if (blockIdx.x < BATCH * 16) gdn_scan_unit(c, (int)blockIdx.x); } }
  PH(22) { const int G8 = (int)gridDim.x * NWAVES, local = (int)blockIdx.x * NWAVES + wave; float* wscr = (float*)(lds_raw + (tid >> 6) * 18432);
      for (int u = local; u < GDN_PREP2_UNITS; u += G8) gdn_prep2_unit(c, u, wscr); }
  PH(23) { WUNITS(CMP_UNITS_S, compress_unit<true>(c, u)); WUNITS(CMP_UNITS_P, compress_unit<false>(c, u)); }
  PH(24) { WUNITS(WKS_UNITS, winks_unit(c, u)); WUNITS(WVS_UNITS, winvs_unit(c, u)); run_stage(StWinOut4{c}); }
  PH(25) { WUNITS(MTOT, postproc_unit(c, u)); }
  PH(26) { WUNITS(MTOT, gdn_conv_unit(c, u)); }
  PH(27) { WUNITS(VT_UNITS, vt_unit(c, u)); }
  PH(28) { WUNITS(MMEM, memkv_unit(c, u)); WUNITS(DEC_BATCH * MEM_TOKENS, xk_pack_unit(c, u)); WUNITS(XVT_UNITS, xvt_unit(c, u)); }
  PH(29) { if (blockIdx.x == 0 && tid < 8) a.ctr[64 * tid] = 0u; SYNC(29); }
  PH(30) { const int xq = (int)blockIdx.x & 7; constexpr int PERQ = NSA_UNITS_P / 8;
    for (;;) { int k = 0; if (lane == 0) k = (int)atomicAdd(a.ctr + 64 * xq, 1u); k = __builtin_amdgcn_readfirstlane(k); if (k >= PERQ) break;
      const int tile = (SEQ / 8 - 1) - (k >> 1), bk = 2 * xq + (k & 1); nsa_unit<false>(c, bk * (SEQ / 8) + tile, nullptr); } }
  PH(31) { for (int r_ = 0; r_ < 20; ++r_) xcd_barrier(gbar); }
  PH(32) { }
#endif
  PH(17) { GEMM(c.ACT, a.WdownT, MTOT, D_MODEL, D_FF, c.out + O_YP, D_MODEL, c.H2, c.H2 + (size_t)MP * D_MODEL); }
}
#ifndef MK_MULTI
#define MK_MULTI 0
#endif
extern "C" void kernel_launch(void* const* d_in, const int* in_sizes, int n_in, void* d_out, int out_size, void* d_ws, size_t ws_size, hipStream_t stream) {
  static int grid = 0;
  if (grid == 0) {
    int dev = 0, cus = 0, per_cu = 0;
    if (hipGetDevice(&dev) != hipSuccess || hipDeviceGetAttribute(&cus, hipDeviceAttributeMultiprocessorCount, dev) != hipSuccess) { fprintf(stderr, "kernel_launch: device query failed\n"); grid = -1; return; }
    if (hipFuncSetAttribute((const void*)mega, hipFuncAttributeMaxDynamicSharedMemorySize, LDS_BYTES) != hipSuccess) { fprintf(stderr, "kernel_launch: hipFuncSetAttribute failed\n"); grid = -1; return; }
    if (hipOccupancyMaxActiveBlocksPerMultiprocessor(&per_cu, (const void*)mega, 512, LDS_BYTES) != hipSuccess || per_cu < 1) { fprintf(stderr, "kernel_launch: occupancy query says %d blocks/CU\n", per_cu); (void)hipGetLastError(); }
    grid = cus;
    if (n_in != 34 || (size_t)out_size != O_END) fprintf(stderr, "kernel_launch: unexpected n_in %d / out_size %d (want 34 / %zu)\n", n_in, out_size, (size_t)O_END);
  }
  if (grid < 0) return;
  Args a{}; Ctx& c = a.c; int k = 0;
  c.x_prompt = (const float*)d_in[k++]; c.x_sample = (const float*)d_in[k++]; c.mem_prompt = (const float*)d_in[k++]; c.cache_nsa_kv = (const float*)d_in[k++]; c.cache_nsa_win = (const float*)d_in[k++];
  c.state_gdn = (const float*)d_in[k++]; c.cache_gdn_conv = (const float*)d_in[k++]; c.cache_ffn_conv = (const float*)d_in[k++]; c.cache_mem_kv = (const float*)d_in[k++]; c.page_table = (const int*)d_in[k++];
  c.attn_norm_w = (const float*)d_in[k++]; c.w_in = (const float*)d_in[k++]; c.nsa_q_norm_w = (const float*)d_in[k++]; c.nsa_k_norm_w = (const float*)d_in[k++]; c.cmp_pe = (const float*)d_in[k++]; c.cmp_w = (const float*)d_in[k++];
  c.gdn_conv_w = (const float*)d_in[k++]; c.gdn_a_log = (const float*)d_in[k++]; c.gdn_dt_bias = (const float*)d_in[k++]; c.gdn_norm_w = (const float*)d_in[k++]; c.w_out = (const float*)d_in[k++];
  c.mem_norm_w = (const float*)d_in[k++]; c.w_xk = (const float*)d_in[k++]; c.w_xv = (const float*)d_in[k++]; c.xk_norm_w = (const float*)d_in[k++]; c.xattn_norm_w = (const float*)d_in[k++]; c.w_xq = (const float*)d_in[k++];
  c.xq_norm_w = (const float*)d_in[k++]; c.w_xo = (const float*)d_in[k++]; c.ffn_norm_w = (const float*)d_in[k++]; c.w_up = (const float*)d_in[k++]; c.ffn_conv_w = (const float*)d_in[k++]; c.ffn_conv_b = (const float*)d_in[k++]; c.w_down = (const float*)d_in[k++];
  c.out = (float*)d_out;
  unsigned char* ws = (unsigned char*)d_ws; WsMap w{0};
  a.ctr = (unsigned*)(ws + w.take(4096));
  a.RS1 = (float*)(ws + w.take((size_t)MTOT * 4)); a.RS2 = (float*)(ws + w.take((size_t)MTOT * 4));
  unsigned* bar0 = (unsigned*)(ws + w.take((size_t)2 * XCD_BAR_WORDS * 4));
  if (hipMemsetAsync(bar0, 0, (size_t)2 * XCD_BAR_WORDS * 4, stream) != hipSuccess) { fprintf(stderr, "kernel_launch: memset of the barrier words failed\n"); return; }
  a.bar = bar0;
  a.WinT = (bf16_t*)(ws + w.take((size_t)LDP * D_MODEL * 2)); a.WkvT = (bf16_t*)(ws + w.take((size_t)2048 * D_MODEL * 2));
  a.WoutT = (bf16_t*)(ws + w.take((size_t)D_MODEL * D_MODEL * 2)); a.WxqT = (bf16_t*)(ws + w.take((size_t)D_MODEL * D_MODEL * 2)); a.WxoT = (bf16_t*)(ws + w.take((size_t)D_MODEL * D_MODEL * 2));
  a.WupT = (bf16_t*)(ws + w.take((size_t)2 * D_FF * D_MODEL * 2)); a.WdownT = (bf16_t*)(ws + w.take((size_t)D_MODEL * D_FF * 2));
  const size_t need = ws_carve(c, ws, w.off);
  if (need > ws_size) { fprintf(stderr, "kernel_launch: workspace too small: need %zu, have %zu\n", need, ws_size); return; }
#if MK_MULTI
  for (int ph = 0; ph < N_PHASES; ++ph) { a.ph_lo = ph; a.ph_hi = ph + 1; void* args[] = {&a};
    hipError_t e = hipLaunchCooperativeKernel((const void*)mega, dim3(grid), dim3(512), args, LDS_BYTES, stream);
    if (e != hipSuccess) { fprintf(stderr, "kernel_launch: cooperative launch failed: %s\n", hipGetErrorString(e)); return; } }
#else
  a.ph_lo = 0; a.ph_hi = N_PHASES; void* args[] = {&a};
  hipError_t e = hipLaunchCooperativeKernel((const void*)mega, dim3(grid), dim3(512), args, LDS_BYTES, stream);
  if (e != hipSuccess) fprintf(stderr, "kernel_launch: cooperative launch failed: %s (grid %d)\n", hipGetErrorString(e), grid);
#ifdef EXTRA_LO
  a.ph_lo = EXTRA_LO; a.ph_hi = EXTRA_HI; a.bar = bar0 + XCD_BAR_WORDS; (void)hipLaunchCooperativeKernel((const void*)mega, dim3(grid), dim3(512), args, LDS_BYTES, stream);
#endif
#endif
}
```

```cpp
#include <hip/hip_runtime.h>
#include <hip/hip_cooperative_groups.h>
#include <cstdio>
#include <cstdint>
namespace cg = cooperative_groups;
#define HD __host__ __device__ __forceinline__
#ifdef CFG_SMALL
constexpr int BATCH = 1, SEQ = 1024, DEC_BATCH = 2, PAST_LEN = 1024, MEM_TOKENS = 64, D_FF = 256;
#else
constexpr int BATCH = 8, SEQ = 2048, DEC_BATCH = 32, PAST_LEN = 8192, MEM_TOKENS = 256, D_FF = 2816;
#endif
constexpr int D_MODEL = 1024, DEC_SEQ = 8, PAGE_SIZE = 128;
constexpr int NSA_HEADS = 8, NSA_KVH = 2, NSA_HD = 64, NSA_G = 4;
constexpr int CMP_BLOCK = 32, CMP_STRIDE = 16, SEL_BLOCK = 64, SEL_TOPN = 8, WINDOW = 512;
constexpr int GDN_HEADS = 4, GDN_HD = 128, GDN_CONV = 4;
constexpr int XA_HEADS = 4, XA_HD = 256, FFN_CONV = 3;
constexpr float EPS = 1e-6f, NEGF = -1e30f, FORCED_BONUS = 1e4f;
constexpr int NSA_Q_W = 512, NSA_KV_W = 768, NSA_GATE_W = 24, GDN_W = 512;
constexpr int IN_COLS = 3360, LDP = 3584;
constexpr int OFF_Q = 0, OFF_KV = 512, OFF_GATE = 1280, OFF_QKV = 1304, OFF_Z = 2840, OFF_B = 3352, OFF_A = 3356;
constexpr int MP = BATCH * SEQ, MS = DEC_BATCH * DEC_SEQ, MTOT = MP + MS;
constexpr int MMEM = BATCH * MEM_TOKENS;
constexpr int NPAGES = PAST_LEN / PAGE_SIZE;
constexpr int NCP = SEQ / CMP_STRIDE - 1;
constexpr int NCS = PAST_LEN / CMP_STRIDE - 1;
constexpr int NCPS = 128, NCSS = 512;
constexpr int NSELP = SEQ / SEL_BLOCK;
constexpr int NSELS = PAST_LEN / SEL_BLOCK + 1;
constexpr int NSELMAX = 160;
constexpr int WINP = (WINDOW < SEQ ? WINDOW : SEQ);
constexpr int WBUF = (WINDOW < PAST_LEN ? WINDOW : PAST_LEN);
constexpr int WINS = (WINDOW < WBUF + DEC_SEQ ? WINDOW : WBUF + DEC_SEQ);
static_assert(NCP <= NCPS && NCS <= NCSS && NSELS <= NSELMAX && NSELP <= NSELMAX, "strides");
static_assert(WBUF == WINDOW && WINP == WINDOW && WINS == WINDOW, "window assumptions");

constexpr size_t O_YP = 0;
constexpr size_t O_YS = O_YP + (size_t)MP * D_MODEL;
constexpr size_t O_KVP = O_YS + (size_t)MS * D_MODEL;
constexpr size_t O_WINP = O_KVP + (size_t)MP * 512;
constexpr size_t O_STP = O_WINP + (size_t)BATCH * WINP * 256;
constexpr size_t O_GCP = O_STP + (size_t)BATCH * 4 * 128 * 128;
constexpr size_t O_FCP = O_GCP + (size_t)BATCH * 3 * 1536;
constexpr size_t O_MKVP = O_FCP + (size_t)BATCH * 2 * 2 * D_FF;
constexpr size_t O_KVS = O_MKVP + (size_t)MMEM * 2048;
constexpr size_t O_WINS = O_KVS + (size_t)MS * 512;
constexpr size_t O_STS = O_WINS + (size_t)DEC_BATCH * WINS * 256;
constexpr size_t O_GCS = O_STS + (size_t)DEC_BATCH * 4 * 128 * 128;
constexpr size_t O_FCS = O_GCS + (size_t)DEC_BATCH * 3 * 1536;
constexpr size_t O_END = O_FCS + (size_t)DEC_BATCH * 2 * 2 * D_FF;

typedef unsigned short bf16_t;
HD unsigned f2bf_u(float f) { unsigned u = __builtin_bit_cast(unsigned, f); return (u + 0x7fffu + ((u >> 16) & 1u)) >> 16; }
HD bf16_t f2bf(float f) { return (bf16_t)f2bf_u(f); }
HD float bf2f(bf16_t b) { return __builtin_bit_cast(float, (unsigned)b << 16); }
HD float sigmoidf_(float x) { return 1.f / (1.f + expf(-x)); }
HD float siluf_(float x) { return x / (1.f + expf(-x)); }
HD float softplusf_(float x) { return x > 20.f ? x : log1pf(expf(x)); }

struct Ctx {
  const float *x_prompt, *x_sample, *mem_prompt, *cache_nsa_kv, *cache_nsa_win, *state_gdn, *cache_gdn_conv, *cache_ffn_conv, *cache_mem_kv;
  const int* page_table;
  const float *attn_norm_w, *w_in, *nsa_q_norm_w, *nsa_k_norm_w, *cmp_pe, *cmp_w, *gdn_conv_w, *gdn_a_log, *gdn_dt_bias, *gdn_norm_w, *w_out,
      *mem_norm_w, *w_xk, *w_xv, *xk_norm_w, *xattn_norm_w, *w_xq, *xq_norm_w, *w_xo, *ffn_norm_w, *w_up, *ffn_conv_w, *ffn_conv_b, *w_down;
  float* out;
  bf16_t *XN, *MN, *CAT, *OX, *ACT;
  float *P, *MKV, *QC, *QR, *WR, *GATE, *GQ, *GK, *GV, *GB, *GG, *KCMP, *VCMP, *SCP, *SCS, *SCORE, *SS, *SW, *OG, *H1, *Q2, *SX, *H2, *UP;
  int* SIDX;
  bf16_t *Pb, *UPb, *QCb, *QRb, *KSb, *VSTb, *KWb, *VWTb, *KWsb, *VWTsb, *KCb, *VCTb, *KXb, *VXTb, *Q2b, *GWp, *GQKp, *GQDp, *GKDTp, *WcT, *GQP, *GKP;
  float *GS, *GSW, *GL, *PP, *CBIAS, *GKt, *GVt, *ROPE, *NPART;
};

HD int row_b(int m) { return m < MP ? m / SEQ : (m - MP) / DEC_SEQ; }
HD int row_t(int m) { return m < MP ? m % SEQ : (m - MP) % DEC_SEQ; }
HD int row_pos(int m) { return m < MP ? m % SEQ : PAST_LEN + (m - MP) % DEC_SEQ; }
HD const float* x_row(const Ctx& c, int m) { return m < MP ? c.x_prompt + (size_t)m * D_MODEL : c.x_sample + (size_t)(m - MP) * D_MODEL; }
HD float* kvrow_out(const Ctx& c, int m) { return m < MP ? c.out + O_KVP + (size_t)m * 512 : c.out + O_KVS + (size_t)(m - MP) * 512; }

struct StRms0 { const Ctx& c; static constexpr long N = MTOT + MMEM;
  HD void operator()(long i) const {
    const float* src; const float* w; bf16_t* dst;
    if (i < MTOT) { src = x_row(c, (int)i); w = c.attn_norm_w; dst = c.XN + (size_t)i * D_MODEL; }
    else { const long mm = i - MTOT; src = c.mem_prompt + (size_t)mm * D_MODEL; w = c.mem_norm_w; dst = c.MN + (size_t)mm * D_MODEL; }
    float ss = 0.f; for (int d = 0; d < D_MODEL; ++d) ss += src[d] * src[d];
    const float r = 1.f / sqrtf(ss / D_MODEL + EPS);
    for (int d = 0; d < D_MODEL; ++d) dst[d] = f2bf(src[d] * r * w[d]);
  } };
struct StRmsRows { const float* src; const float* w; bf16_t* dst; static constexpr long N = MTOT;
  HD void operator()(long i) const {
    const float* s = src + (size_t)i * D_MODEL; bf16_t* o = dst + (size_t)i * D_MODEL;
    float ss = 0.f; for (int d = 0; d < D_MODEL; ++d) ss += s[d] * s[d];
    const float r = 1.f / sqrtf(ss / D_MODEL + EPS);
    for (int d = 0; d < D_MODEL; ++d) o[d] = f2bf(s[d] * r * w[d]);
  } };
HD void rope_pair(float x1, float x2, int i, int pos, float& o1, float& o2) {
  const float inv = powf(10000.f, -(float)i / 32.f); const float ang = (float)pos * inv;
  const float cs = cosf(ang), sn = sinf(ang); o1 = x1 * cs - x2 * sn; o2 = x1 * sn + x2 * cs;
}
struct StQ { const Ctx& c; static constexpr long N = (long)MTOT * NSA_HEADS;
  HD void operator()(long i) const {
    const int m = (int)(i / NSA_HEADS), h = (int)(i % NSA_HEADS); const float* p = c.P + (size_t)m * LDP + OFF_Q + h * 64;
    float ss = 0.f; for (int d = 0; d < 64; ++d) ss += p[d] * p[d];
    const float r = 1.f / sqrtf(ss / 64.f + EPS); const int pos = row_pos(m);
    float* qc = c.QC + (size_t)m * 512 + h * 64; float* qr = c.QR + (size_t)m * 512 + h * 64;
    for (int d = 0; d < 32; ++d) { const float a = p[d] * r * c.nsa_q_norm_w[d], b = p[d + 32] * r * c.nsa_q_norm_w[d + 32];
      qc[d] = a; qc[d + 32] = b; float o1, o2; rope_pair(a, b, d, pos, o1, o2); qr[d] = o1; qr[d + 32] = o2; }
  } };
struct StKV { const Ctx& c; static constexpr long N = (long)MTOT * 6;
  HD void operator()(long i) const {
    const int m = (int)(i / 6), br = (int)(i % 6) / 2, kvh = (int)(i % 2); const float* pk = c.P + (size_t)m * LDP + OFF_KV + ((br * 2 + 0) * 2 + kvh) * 64;
    const float* pv = c.P + (size_t)m * LDP + OFF_KV + ((br * 2 + 1) * 2 + kvh) * 64;
    float ss = 0.f; for (int d = 0; d < 64; ++d) ss += pk[d] * pk[d];
    const float r = 1.f / sqrtf(ss / 64.f + EPS); const int pos = row_pos(m); const float* w = c.nsa_k_norm_w + br * 64;
    float *ko, *vo;
    if (br < 2) { float* ro = kvrow_out(c, m); ko = ro + ((br * 2 + 0) * 2 + kvh) * 64; vo = ro + ((br * 2 + 1) * 2 + kvh) * 64; }
    else { float* wo = c.WR + (size_t)m * 256; ko = wo + (0 * 2 + kvh) * 64; vo = wo + (1 * 2 + kvh) * 64; }
    for (int d = 0; d < 32; ++d) { const float a = pk[d] * r * w[d], b = pk[d + 32] * r * w[d + 32];
      if (br == 0) { ko[d] = a; ko[d + 32] = b; } else { float o1, o2; rope_pair(a, b, d, pos, o1, o2); ko[d] = o1; ko[d + 32] = o2; } }
    for (int d = 0; d < 64; ++d) vo[d] = pv[d];
  } };
struct StWinOut { const Ctx& c; static constexpr long N = (long)(BATCH + DEC_BATCH) * WINDOW * 256;
  HD void operator()(long i) const {
    const int e = (int)(i % 256); const long r = i / 256; const int j = (int)(r % WINDOW), bb = (int)(r / WINDOW);
    if (bb < BATCH) c.out[O_WINP + ((size_t)bb * WINDOW + j) * 256 + e] = c.WR[((size_t)bb * SEQ + SEQ - WINDOW + j) * 256 + e];
    else { const int b = bb - BATCH; const int w = j + DEC_SEQ;
      const float v = w < WBUF ? c.cache_nsa_win[((size_t)b * WBUF + w) * 256 + e] : c.WR[((size_t)MP + b * DEC_SEQ + (w - WBUF)) * 256 + e];
      c.out[O_WINS + ((size_t)b * WINDOW + j) * 256 + e] = v; }
  } };
struct StGate { const Ctx& c; static constexpr long N = (long)MTOT * 24;
  HD void operator()(long i) const { const int m = (int)(i / 24), e = (int)(i % 24); c.GATE[(size_t)m * 24 + e] = sigmoidf_(c.P[(size_t)m * LDP + OFF_GATE + e]); } };
HD float gdn_pre(const Ctx& c, int m, int dt_back, int ch) {
  const int t = row_t(m) - dt_back;
  if (t >= 0) return c.P[(size_t)(m - dt_back) * LDP + OFF_QKV + ch];
  if (m < MP) return 0.f;
  const int b = (m - MP) / DEC_SEQ; return c.cache_gdn_conv[((size_t)b * 3 + (3 + t)) * 1536 + ch];
}
struct StGdnConv { const Ctx& c; static constexpr long N = (long)MTOT * 12;
  HD void operator()(long i) const {
    const int m = (int)(i / 12), part = (int)(i % 12), which = part / 4, h = part % 4; const int ch0 = which * 512 + h * 128;
    float* dst = (which == 0 ? c.GQ : which == 1 ? c.GK : c.GV) + (size_t)m * 512 + h * 128;
    float ss = 0.f;
    for (int d = 0; d < 128; ++d) { const int ch = ch0 + d; float y = 0.f;
      for (int k = 0; k < 4; ++k) y += c.gdn_conv_w[k * 1536 + ch] * gdn_pre(c, m, 3 - k, ch);
      y = siluf_(y); dst[d] = y; ss += y * y; }
    if (which < 2) { const float r = (1.f / sqrtf(ss + EPS)) * (which == 0 ? 0.08838834764831845f : 1.f); for (int d = 0; d < 128; ++d) dst[d] *= r; }
  } };
struct StGdnMisc { const Ctx& c; static constexpr long N = (long)MTOT * 4;
  HD void operator()(long i) const {
    const int m = (int)(i / 4), h = (int)(i % 4); const float* p = c.P + (size_t)m * LDP;
    c.GB[i] = sigmoidf_(p[OFF_B + h]); c.GG[i] = -expf(c.gdn_a_log[h]) * softplusf_(p[OFF_A + h] + c.gdn_dt_bias[h]);
  } };
struct StGdnConvOut { const Ctx& c; static constexpr long N = (long)(BATCH + DEC_BATCH) * 3 * 1536;
  HD void operator()(long i) const {
    const int ch = (int)(i % 1536); const int r = (int)((i / 1536) % 3), bb = (int)(i / (3 * 1536));
    if (bb < BATCH) c.out[O_GCP + i] = c.P[((size_t)bb * SEQ + SEQ - 3 + r) * LDP + OFF_QKV + ch];
    else { const int b = bb - BATCH; c.out[O_GCS + ((size_t)b * 3 + r) * 1536 + ch] = c.P[((size_t)MP + b * DEC_SEQ + DEC_SEQ - 3 + r) * LDP + OFF_QKV + ch]; }
  } };
HD const float* nsa_row(const Ctx& c, bool sample, int b, int pos, int r, int kvh) {
  if (!sample) return c.out + O_KVP + ((size_t)b * SEQ + pos) * 512 + (r * 2 + kvh) * 64;
  if (pos < PAST_LEN) { const int pg = c.page_table[b * NPAGES + pos / PAGE_SIZE]; return c.cache_nsa_kv + ((size_t)pg * PAGE_SIZE + pos % PAGE_SIZE) * 512 + (r * 2 + kvh) * 64; }
  return c.out + O_KVS + ((size_t)b * DEC_SEQ + (pos - PAST_LEN)) * 512 + (r * 2 + kvh) * 64;
}
constexpr long NCMP_ITEMS_P = (long)BATCH * NCP * 2 * 2 * 64, NCMP_ITEMS_S = (long)DEC_BATCH * NCS * 2 * 2 * 64;
struct StCompress { const Ctx& c; static constexpr long N = NCMP_ITEMS_P + NCMP_ITEMS_S;
  HD void operator()(long i) const {
    const bool sample = i >= NCMP_ITEMS_P; long r = sample ? i - NCMP_ITEMS_P : i; const int nc = sample ? NCS : NCP;
    const int e = (int)(r % 64); r /= 64; const int kv = (int)(r % 2); r /= 2; const int kvh = (int)(r % 2); r /= 2; const int cb = (int)(r % nc), b = (int)(r / nc);
    const float* W = c.cmp_w + (size_t)kv * 32 * 64 * 64; const float* pe = c.cmp_pe + (size_t)kv * 32 * 64;
    float acc = 0.f;
    for (int j = 0; j < 32; ++j) { const float* x = nsa_row(c, sample, b, 16 * cb + j, kv, kvh);
      for (int d = 0; d < 64; ++d) acc += (x[d] + pe[j * 64 + d]) * W[((size_t)j * 64 + d) * 64 + e]; }
    float* dst = (kv == 0 ? c.KCMP : c.VCMP) + (sample ? (size_t)BATCH * NCP * 128 : 0) + (((size_t)b * nc + cb) * 2 + kvh) * 64 + e;
    *dst = acc;
  } };
HD const float* cmp_ptr(const Ctx& c, const float* base, bool sample, int b, int cb, int kvh) {
  return base + (sample ? (size_t)BATCH * NCP * 128 : 0) + (((size_t)b * (sample ? NCS : NCP) + cb) * 2 + kvh) * 64; }
HD float* scmp_ptr(const Ctx& c, int m, int h) { return m < MP ? c.SCP + ((size_t)m * 8 + h) * NCPS : c.SCS + ((size_t)(m - MP) * 8 + h) * NCSS; }
constexpr long NSC_P = (long)MP * 8 * NCPS, NSC_S = (long)MS * 8 * NCSS;
struct StCmpScore { const Ctx& c; static constexpr long N = NSC_P + NSC_S;
  HD void operator()(long i) const {
    const bool sample = i >= NSC_P; const long r = sample ? i - NSC_P : i; const int st = sample ? NCSS : NCPS, nc = sample ? NCS : NCP;
    const int cb = (int)(r % st), h = (int)((r / st) % 8); const int m = (int)(r / st / 8) + (sample ? MP : 0);
    float* dst = scmp_ptr(c, m, h) + cb; const int pos = row_pos(m);
    if (cb >= nc || 16 * cb + 31 > pos) { *dst = -3e38f; return; }
    const float* q = c.QC + (size_t)m * 512 + h * 64; const float* k = cmp_ptr(c, c.KCMP, sample, row_b(m), cb, h / 4);
    float s = 0.f; for (int d = 0; d < 64; ++d) s += q[d] * k[d];
    *dst = s * 0.125f;
  } };
HD void softmax_inplace(float* s, int n) {
  float mx = -3e38f; for (int j = 0; j < n; ++j) mx = fmaxf(mx, s[j]);
  if (mx < -1e38f) { for (int j = 0; j < n; ++j) s[j] = 0.f; return; }
  float sum = 0.f; for (int j = 0; j < n; ++j) { const float v = s[j]; if (v > -1e38f) sum += expf(v - mx); }
  const float inv = 1.f / fmaxf(sum, 1e-30f);
  for (int j = 0; j < n; ++j) { const float v = s[j]; s[j] = v > -1e38f ? expf(v - mx) * inv : 0.f; }
}
struct StCmpSoftmax { const Ctx& c; static constexpr long N = (long)MTOT * 8;
  HD void operator()(long i) const { const int m = (int)(i / 8), h = (int)(i % 8); softmax_inplace(scmp_ptr(c, m, h), m < MP ? NCPS : NCSS); } };
struct StTopk { const Ctx& c; static constexpr long N = (long)MTOT * 2;
  HD void operator()(long i) const {
    const int m = (int)(i / 2), kvh = (int)(i % 2); const bool sample = m >= MP; const int nsel = sample ? NSELS : NSELP, nc = sample ? NCS : NCP;
    const int pos = row_pos(m), qblk = pos / SEL_BLOCK; float* sc = c.SCORE + (size_t)i * NSELMAX;
    for (int s = 0; s < nsel; ++s) {
      float imp = 0.f;
      for (int g = 0; g < 4; ++g) { const float* p = scmp_ptr(c, m, kvh * 4 + g);
        for (int cb = 4 * s - 1; cb <= 4 * s + 3; ++cb) if (cb >= 0 && cb < nc) imp += p[cb]; }
      const bool visible = s <= qblk, forced = (s == 0) || (s == qblk) || (s == qblk - 1);
      sc[s] = visible ? imp + (forced ? FORCED_BONUS : 0.f) : NEGF;
    }
    const int ntop = nsel < SEL_TOPN ? nsel : SEL_TOPN;
    for (int n = 0; n < SEL_TOPN; ++n) {
      int best = -1; float bv = -3e38f;
      if (n < ntop) { for (int s = 0; s < nsel; ++s) if (sc[s] > bv) { bv = sc[s]; best = s; } }
      if (best >= 0) sc[best] = -3.2e38f;
      c.SIDX[i * 8 + n] = (best >= 0 && bv > 0.5f * NEGF) ? best : -1;
    }
  } };
struct StSelScore { const Ctx& c; static constexpr long N = (long)MTOT * 8 * 512;
  HD void operator()(long i) const {
    const int j = (int)(i % 64), n = (int)((i / 64) % 8), h = (int)((i / 512) % 8), m = (int)(i / 4096); const bool sample = m >= MP;
    const int blk = c.SIDX[((size_t)m * 2 + h / 4) * 8 + n]; const int pos = row_pos(m), key = blk * 64 + j;
    if (blk < 0 || key > pos) { c.SS[i] = -3e38f; return; }
    const float* q = c.QR + (size_t)m * 512 + h * 64; const float* k = nsa_row(c, sample, row_b(m), key, 2, h / 4);
    float s = 0.f; for (int d = 0; d < 64; ++d) s += q[d] * k[d];
    c.SS[i] = s * 0.125f;
  } };
HD const float* win_row(const Ctx& c, int m, int j, int which, int kvh) {
  const int pos = row_pos(m), kp = pos - (WINDOW - 1) + j; if (kp < 0) return nullptr;
  if (m < MP) return c.WR + ((size_t)(m / SEQ) * SEQ + kp) * 256 + (which * 2 + kvh) * 64;
  const int b = (m - MP) / DEC_SEQ;
  if (kp < PAST_LEN) return c.cache_nsa_win + ((size_t)b * WBUF + (kp - (PAST_LEN - WBUF))) * 256 + (which * 2 + kvh) * 64;
  return c.WR + ((size_t)MP + b * DEC_SEQ + (kp - PAST_LEN)) * 256 + (which * 2 + kvh) * 64;
}
struct StWinScore { const Ctx& c; static constexpr long N = (long)MTOT * 8 * 512;
  HD void operator()(long i) const {
    const int j = (int)(i % 512), h = (int)((i / 512) % 8), m = (int)(i / 4096);
    const float* k = win_row(c, m, j, 0, h / 4); if (!k) { c.SW[i] = -3e38f; return; }
    const float* q = c.QR + (size_t)m * 512 + h * 64; float s = 0.f; for (int d = 0; d < 64; ++d) s += q[d] * k[d];
    c.SW[i] = s * 0.125f;
  } };
struct StSoftmax512 { float* buf; static constexpr long N = (long)MTOT * 8;
  HD void operator()(long i) const { softmax_inplace(buf + (size_t)i * 512, 512); } };
struct StNsaOut { const Ctx& c; static constexpr long N = (long)MTOT * 512;
  HD void operator()(long i) const {
    const int d = (int)(i % 64), h = (int)((i / 64) % 8), m = (int)(i / 512), kvh = h / 4; const bool sample = m >= MP; const int b = row_b(m);
    const float* pc = scmp_ptr(c, m, h); const int nc = sample ? NCS : NCP;
    float oc = 0.f; for (int cb = 0; cb < nc; ++cb) { const float p = pc[cb]; if (p != 0.f) oc += p * cmp_ptr(c, c.VCMP, sample, b, cb, kvh)[d]; }
    const float* ps = c.SS + ((size_t)m * 8 + h) * 512; float os = 0.f;
    for (int n = 0; n < 8; ++n) { const int blk = c.SIDX[((size_t)m * 2 + kvh) * 8 + n]; if (blk < 0) continue;
      for (int j = 0; j < 64; ++j) { const float p = ps[n * 64 + j]; if (p != 0.f) os += p * nsa_row(c, sample, b, blk * 64 + j, 3, kvh)[d]; } }
    const float* pw = c.SW + ((size_t)m * 8 + h) * 512; float ow = 0.f;
    for (int j = 0; j < 512; ++j) { const float p = pw[j]; if (p != 0.f) ow += p * win_row(c, m, j, 1, kvh)[d]; }
    const float* g = c.GATE + (size_t)m * 24 + h * 3;
    c.CAT[(size_t)m * D_MODEL + h * 64 + d] = f2bf(oc * g[0] + os * g[1] + ow * g[2]);
  } };
#if defined(__HIP_DEVICE_COMPILE__)
#define GDN_FENCE() asm volatile("" ::: "memory")
#else
#define GDN_FENCE() do {} while (0)
#endif
struct StGdnScan { const Ctx& c; static constexpr long N = (long)(BATCH + DEC_BATCH) * 4 * 128;
  HD void operator()(long i) const {
    const int dv = (int)(i % 128), h = (int)((i / 128) % 4), bb = (int)(i / 512); const bool sample = bb >= BATCH; const int b = sample ? bb - BATCH : bb;
    const int T = sample ? DEC_SEQ : SEQ; const int m0 = sample ? MP + b * DEC_SEQ : b * SEQ;
    float S[128];
#pragma unroll
    for (int k = 0; k < 128; ++k) S[k] = sample ? c.state_gdn[(((size_t)b * 4 + h) * 128 + k) * 128 + dv] : 0.f;
    for (int t = 0; t < T; ++t) { const int m = m0 + t;
      const float* kk = c.GK + (size_t)m * 512 + h * 128; const float* qq = c.GQ + (size_t)m * 512 + h * 128;
      const float v = c.GV[(size_t)m * 512 + h * 128 + dv], beta = c.GB[(size_t)m * 4 + h], a = expf(c.GG[(size_t)m * 4 + h]);
      float ks = 0.f;
#pragma unroll
      for (int k0 = 0; k0 < 128; k0 += 16) {
#pragma unroll
        for (int k = 0; k < 16; ++k) ks += kk[k0 + k] * S[k0 + k];
        GDN_FENCE(); }
      const float coef = beta * (v - a * ks); float o = 0.f;
#pragma unroll
      for (int k0 = 0; k0 < 128; k0 += 16) {
#pragma unroll
        for (int k = 0; k < 16; ++k) { S[k0 + k] = a * S[k0 + k] + kk[k0 + k] * coef; o += qq[k0 + k] * S[k0 + k]; }
        GDN_FENCE(); }
      c.OG[(size_t)m * 512 + h * 128 + dv] = o; }
    float* so = c.out + (sample ? O_STS : O_STP) + (((size_t)b * 4 + h) * 128) * 128 + dv;
#pragma unroll
    for (int k = 0; k < 128; ++k) so[(size_t)k * 128] = S[k];
  } };
struct StGdnNorm { const Ctx& c; static constexpr long N = (long)MTOT * 4;
  HD void operator()(long i) const {
    const int m = (int)(i / 4), h = (int)(i % 4); const float* o = c.OG + (size_t)m * 512 + h * 128; const float* z = c.P + (size_t)m * LDP + OFF_Z + h * 128;
    float ss = 0.f; for (int d = 0; d < 128; ++d) ss += o[d] * o[d];
    const float r = 1.f / sqrtf(ss / 128.f + EPS);
    for (int d = 0; d < 128; ++d) c.CAT[(size_t)m * D_MODEL + 512 + h * 128 + d] = f2bf(o[d] * r * c.gdn_norm_w[d] * siluf_(z[d]));
  } };
struct StMemKV { const Ctx& c; static constexpr long N = (long)MMEM * 4;
  HD void operator()(long i) const {
    const int mm = (int)(i / 4), h = (int)(i % 4); const float* k = c.MKV + (size_t)mm * 2048 + h * 256; const float* v = c.MKV + (size_t)mm * 2048 + 1024 + h * 256;
    float ss = 0.f; for (int d = 0; d < 256; ++d) ss += k[d] * k[d];
    const float r = 1.f / sqrtf(ss / 256.f + EPS); float* o = c.out + O_MKVP + (size_t)mm * 2048;
    for (int d = 0; d < 256; ++d) { o[h * 256 + d] = k[d] * r * c.xk_norm_w[d]; o[1024 + h * 256 + d] = v[d]; }
  } };
struct StXqNorm { const Ctx& c; static constexpr long N = (long)MTOT * 4;
  HD void operator()(long i) const {
    float* q = c.Q2 + (size_t)(i / 4) * D_MODEL + (i % 4) * 256; float ss = 0.f; for (int d = 0; d < 256; ++d) ss += q[d] * q[d];
    const float r = 1.f / sqrtf(ss / 256.f + EPS); for (int d = 0; d < 256; ++d) q[d] = q[d] * r * c.xq_norm_w[d];
  } };
HD const float* memkv_row(const Ctx& c, int m, int j, int which, int h) {
  if (m < MP) return c.out + O_MKVP + ((size_t)(m / SEQ) * MEM_TOKENS + j) * 2048 + which * 1024 + h * 256;
  return c.cache_mem_kv + ((size_t)((m - MP) / DEC_SEQ) * MEM_TOKENS + j) * 2048 + which * 1024 + h * 256;
}
struct StXScore { const Ctx& c; static constexpr long N = (long)MTOT * 4 * MEM_TOKENS;
  HD void operator()(long i) const {
    const int j = (int)(i % MEM_TOKENS), h = (int)((i / MEM_TOKENS) % 4), m = (int)(i / MEM_TOKENS / 4);
    const float* q = c.Q2 + (size_t)m * D_MODEL + h * 256; const float* k = memkv_row(c, m, j, 0, h);
    float s = 0.f; for (int d = 0; d < 256; ++d) s += q[d] * k[d];
    c.SX[i] = s * 0.0625f;
  } };
struct StXSoftmax { const Ctx& c; static constexpr long N = (long)MTOT * 4;
  HD void operator()(long i) const { softmax_inplace(c.SX + (size_t)i * MEM_TOKENS, MEM_TOKENS); } };
struct StXOut { const Ctx& c; static constexpr long N = (long)MTOT * D_MODEL;
  HD void operator()(long i) const {
    const int d = (int)(i % 256), h = (int)((i / 256) % 4), m = (int)(i / D_MODEL); const float* p = c.SX + ((size_t)m * 4 + h) * MEM_TOKENS;
    float o = 0.f; for (int j = 0; j < MEM_TOKENS; ++j) o += p[j] * memkv_row(c, m, j, 1, h)[d];
    c.OX[i] = f2bf(o);
  } };
HD float up_at(const Ctx& c, int m, int back, int col) {
  const int t = row_t(m) - back; if (t >= 0) return c.UP[(size_t)(m - back) * (2 * D_FF) + col];
  if (m < MP) return 0.f;
  return c.cache_ffn_conv[((size_t)((m - MP) / DEC_SEQ) * 2 + (2 + t)) * (2 * D_FF) + col];
}
struct StFfnAct { const Ctx& c; static constexpr long N = (long)MTOT * D_FF;
  HD void operator()(long i) const {
    const int col = (int)(i % D_FF), m = (int)(i / D_FF); float a = c.ffn_conv_b[col], u = c.ffn_conv_b[D_FF + col];
    for (int k = 0; k < 3; ++k) { a += c.ffn_conv_w[k * 2 * D_FF + col] * up_at(c, m, 2 - k, col); u += c.ffn_conv_w[k * 2 * D_FF + D_FF + col] * up_at(c, m, 2 - k, D_FF + col); }
    c.ACT[i] = f2bf(siluf_(a) * u);
  } };
struct StFfnConvOut { const Ctx& c; static constexpr long N = (long)(BATCH + DEC_BATCH) * 2 * 2 * D_FF;
  HD void operator()(long i) const {
    const int col = (int)(i % (2 * D_FF)), r = (int)((i / (2 * D_FF)) % 2), bb = (int)(i / (4 * D_FF));
    if (bb < BATCH) c.out[O_FCP + i] = c.UP[((size_t)bb * SEQ + SEQ - 2 + r) * (2 * D_FF) + col];
    else { const int b = bb - BATCH; c.out[O_FCS + ((size_t)b * 2 + r) * (2 * D_FF) + col] = c.UP[((size_t)MP + b * DEC_SEQ + DEC_SEQ - 2 + r) * (2 * D_FF) + col]; }
  } };

struct WsMap { size_t off; HD size_t take(size_t bytes) { const size_t o = off; off += (bytes + 255) & ~(size_t)255; return o; } };
inline size_t ws_carve(Ctx& c, unsigned char* ws, size_t base) {
  WsMap w{base};
  c.XN = (bf16_t*)(ws + w.take((size_t)MTOT * D_MODEL * 2)); c.MN = (bf16_t*)(ws + w.take((size_t)MMEM * D_MODEL * 2));
  c.CAT = (bf16_t*)(ws + w.take((size_t)MTOT * D_MODEL * 2)); c.OX = (bf16_t*)(ws + w.take((size_t)MTOT * D_MODEL * 2));
  c.ACT = (bf16_t*)(ws + w.take((size_t)MTOT * D_FF * 2));
  c.P = (float*)(ws + w.take((size_t)MTOT * LDP * 4)); c.Pb = (bf16_t*)c.P;   c.MKV = (float*)(ws + w.take((size_t)MMEM * 2048 * 4));
  c.QC = (float*)(ws + w.take((size_t)MTOT * 512 * 4)); c.QR = (float*)(ws + w.take((size_t)MTOT * 512 * 4));
  c.WR = (float*)(ws + w.take((size_t)MTOT * 256 * 4)); c.GATE = (float*)(ws + w.take((size_t)MTOT * 24 * 4));
  c.GQ = (float*)(ws + w.take((size_t)MTOT * 512 * 4)); c.GK = (float*)(ws + w.take((size_t)MTOT * 512 * 4)); c.GV = (float*)(ws + w.take((size_t)MTOT * 512 * 4));
  c.GB = (float*)(ws + w.take((size_t)MTOT * 4 * 4)); c.GG = (float*)(ws + w.take((size_t)MTOT * 4 * 4));
  const size_t ncmp = ((size_t)BATCH * NCP + (size_t)DEC_BATCH * NCS) * 128 * 4;
  c.KCMP = (float*)(ws + w.take(ncmp)); c.VCMP = (float*)(ws + w.take(ncmp));
  c.SCP = (float*)(ws + w.take((size_t)MP * 8 * NCPS * 4)); c.SCS = (float*)(ws + w.take((size_t)MS * 8 * NCSS * 4));
  c.SCORE = (float*)(ws + w.take((size_t)MTOT * 2 * NSELMAX * 4)); c.SIDX = (int*)(ws + w.take((size_t)MTOT * 2 * 8 * 4));
  c.OG = (float*)(ws + w.take(((size_t)BATCH * 4 * (SEQ / 64) + (size_t)DEC_BATCH * 4) * 64 * 128 * 4 > (size_t)MTOT * 512 * 4 ? ((size_t)BATCH * 4 * (SEQ / 64) + (size_t)DEC_BATCH * 4) * 64 * 128 * 4 : (size_t)MTOT * 512 * 4)); c.H1 = (float*)(ws + w.take((size_t)MTOT * D_MODEL * 4));
  c.Q2 = (float*)(ws + w.take((size_t)MTOT * D_MODEL * 4)); c.SX = (float*)(ws + w.take((size_t)MTOT * 4 * MEM_TOKENS * 4));
  c.H2 = (float*)(ws + w.take((size_t)MTOT * D_MODEL * 4));
  c.QCb = (bf16_t*)(ws + w.take((size_t)MTOT * 512 * 2)); c.QRb = (bf16_t*)(ws + w.take((size_t)MTOT * 512 * 2));
  c.KSb = (bf16_t*)(ws + w.take((size_t)BATCH * 2 * SEQ * 64 * 2)); c.VSTb = (bf16_t*)(ws + w.take((size_t)BATCH * 2 * SEQ * 64 * 2));
  c.KWb = (bf16_t*)(ws + w.take((size_t)BATCH * 2 * SEQ * 64 * 2)); c.VWTb = (bf16_t*)(ws + w.take((size_t)BATCH * 2 * SEQ * 64 * 2));
  c.KWsb = (bf16_t*)(ws + w.take((size_t)DEC_BATCH * 2 * 544 * 64 * 2)); c.VWTsb = (bf16_t*)(ws + w.take((size_t)DEC_BATCH * 2 * 544 * 64 * 2));
  { const size_t nb = ((size_t)BATCH * 2 * 128 + (size_t)DEC_BATCH * 2 * 512) * 64 * 2; c.KCb = (bf16_t*)(ws + w.take(nb)); c.VCTb = (bf16_t*)(ws + w.take(nb)); }
  { const size_t nb = (size_t)(BATCH + DEC_BATCH) * 4 * MEM_TOKENS * 256 * 2; c.KXb = (bf16_t*)(ws + w.take(nb)); c.VXTb = (bf16_t*)(ws + w.take(nb)); c.Q2b = (bf16_t*)(ws + w.take((size_t)MTOT * D_MODEL * 2)); }
  { constexpr size_t nchunk = (size_t)BATCH * 4 * (SEQ / 64) + (size_t)DEC_BATCH * 4;
    c.GS = (float*)(ws + w.take(nchunk * 64 * 128 * 4)); c.GSW = (float*)(ws + w.take(nchunk * 64 * 128 * 4)); c.GKt = (float*)(ws + w.take(nchunk * 64 * 128 * 4)); c.GVt = (float*)(ws + w.take(nchunk * 64 * 128 * 4)); c.GQP = (bf16_t*)(ws + w.take(nchunk * 64 * 128 * 2)); c.GKP = (bf16_t*)(ws + w.take(nchunk * 64 * 128 * 2)); c.GWp = (bf16_t*)(ws + w.take(nchunk * 64 * 128 * 2)); c.GQKp = (bf16_t*)(ws + w.take(nchunk * 64 * 64 * 2));
    c.GQDp = (bf16_t*)(ws + w.take(nchunk * 64 * 128 * 2)); c.GKDTp = (bf16_t*)(ws + w.take(nchunk * 128 * 64 * 2)); c.GL = (float*)(ws + w.take(nchunk * 4)); }
  c.ROPE = (float*)(ws + w.take((size_t)(SEQ + DEC_SEQ) * 64 * 4)); c.NPART = (float*)(ws + w.take((size_t)DEC_BATCH * 2 * 4 * 3 * 64 * 34 * 4));
  c.WcT = (bf16_t*)(ws + w.take((size_t)2 * 2 * 64 * 1024 * 2)); c.CBIAS = (float*)(ws + w.take(128 * 4));
  c.PP = (float*)(ws + w.take(((size_t)2 * BATCH * 2 * (SEQ / 16) + (size_t)2 * DEC_BATCH * 2 * (PAST_LEN / 16)) * 128 * 4));
  const size_t ssb = (size_t)MTOT * 8 * 512 * 4, upb = (size_t)MTOT * 2 * D_FF * 4; const size_t big = w.take(2 * ssb > upb ? 2 * ssb : upb);
  c.SS = (float*)(ws + big); c.SW = (float*)(ws + big + ssb); c.UP = (float*)(ws + big); c.UPb = (bf16_t*)(ws + big);
  return w.off;
}
typedef short bf16x8 __attribute__((ext_vector_type(8)));
typedef float f32x16 __attribute__((ext_vector_type(16)));
typedef float f32x4v __attribute__((ext_vector_type(4)));
typedef unsigned u32x4v __attribute__((ext_vector_type(4)));
typedef unsigned u32x2v __attribute__((ext_vector_type(2)));
#ifdef HOST_TEST
#include <ucontext.h>
struct EmuSlot { short a[8]; short b[8]; float c[16]; unsigned u; };
struct EmuWave {
  ucontext_t main_ctx; ucontext_t ctx[64]; char* stacks; int cur; int ndone; bool done[64]; int gen[64];
  EmuSlot slot[2][64]; void (*fn)(void*, int); void* arg;
};
static thread_local EmuWave* tl_emu = nullptr;
static void emu_trampoline(int lane) { EmuWave* e = tl_emu; e->fn(e->arg, lane); e->done[lane] = true; e->ndone++; swapcontext(&e->ctx[lane], &e->main_ctx); }
static void emu_run_wave(void (*fn)(void*, int), void* arg) {
  static thread_local EmuWave* e = nullptr; constexpr size_t STK = 256 * 1024;
  if (!e) { e = new EmuWave; e->stacks = (char*)malloc(64 * STK); }
  tl_emu = e; e->fn = fn; e->arg = arg; e->ndone = 0;
  for (int l = 0; l < 64; ++l) { e->done[l] = false; e->gen[l] = 0; getcontext(&e->ctx[l]); e->ctx[l].uc_stack.ss_sp = e->stacks + l * STK; e->ctx[l].uc_stack.ss_size = STK; e->ctx[l].uc_link = nullptr;
    makecontext(&e->ctx[l], (void (*)())emu_trampoline, 1, l); }
  while (e->ndone < 64) for (int l = 0; l < 64; ++l) if (!e->done[l]) { e->cur = l; swapcontext(&e->main_ctx, &e->ctx[l]); }
}
static inline EmuSlot* emu_my_slot() { EmuWave* e = tl_emu; return &e->slot[e->gen[e->cur] & 1][e->cur]; }
static inline EmuSlot* emu_exchange() { EmuWave* e = tl_emu; const int l = e->cur; swapcontext(&e->ctx[l], &e->main_ctx); e = tl_emu; EmuSlot* s = e->slot[e->gen[l] & 1]; e->gen[l]++; return s; }
static inline int wv_lane() { return tl_emu->cur; }
static inline int wv_lane_opaque() { return tl_emu->cur; }
static inline float bfbits2f(short s) { return __builtin_bit_cast(float, (unsigned)(unsigned short)s << 16); }
static inline f32x16 wv_mfma32(bf16x8 a, bf16x8 b, f32x16 c) {
  EmuSlot* m = emu_my_slot(); for (int j = 0; j < 8; ++j) { m->a[j] = a[j]; m->b[j] = b[j]; }
  EmuSlot* s = emu_exchange(); const int l = wv_lane(), col = l & 31, hi = l >> 5; f32x16 d;
  for (int r = 0; r < 16; ++r) { const int row = (r & 3) + 8 * (r >> 2) + 4 * hi; float acc = c[r];
    for (int k = 0; k < 16; ++k) acc += bfbits2f(s[row + 32 * (k >> 3)].a[k & 7]) * bfbits2f(s[col + 32 * (k >> 3)].b[k & 7]);
    d[r] = acc; }
  return d;
}
static inline unsigned wv_shfl_xor_u(unsigned v, int mask) { emu_my_slot()->u = v; EmuSlot* s = emu_exchange(); return s[wv_lane() ^ mask].u; }
static inline unsigned wv_shfl_u(unsigned v, int src) { emu_my_slot()->u = v; EmuSlot* s = emu_exchange(); return s[src & 63].u; }
static inline unsigned long long wv_ballot(bool p) { emu_my_slot()->u = p ? 1u : 0u; EmuSlot* s = emu_exchange(); unsigned long long r = 0; for (int l = 0; l < 64; ++l) if (s[l].u) r |= 1ull << l; return r; }
static inline float wv_exp2(float x) { return exp2f(x); }
static inline float wv_rcp(float x) { return 1.f / x; }
static inline unsigned wv_pk_bf16(float lo, float hi) { return f2bf_u(lo) | (f2bf_u(hi) << 16); }
#define WV_DEV inline
#define WV_SCHED_BARRIER() do {} while (0)
static inline void wv_fence() { emu_my_slot()->u = 0; (void)emu_exchange(); }
static inline void wv_fence_lds() { emu_my_slot()->u = 0; (void)emu_exchange(); }
#else
#define WV_DEV __device__ __forceinline__
#define WV_SCHED_BARRIER() __builtin_amdgcn_sched_barrier(0)
WV_DEV int wv_lane() { return (int)(threadIdx.x & 63); }
WV_DEV int wv_lane_opaque() { int l = (int)(threadIdx.x & 63); asm volatile("" : "+v"(l)); return l; }
WV_DEV void wv_fence() { asm volatile("s_waitcnt vmcnt(0) lgkmcnt(0)" ::: "memory"); }
WV_DEV void wv_fence_lds() { asm volatile("s_waitcnt lgkmcnt(0)" ::: "memory"); }
WV_DEV f32x16 wv_mfma32(bf16x8 a, bf16x8 b, f32x16 c) { return __builtin_amdgcn_mfma_f32_32x32x16_bf16(a, b, c, 0, 0, 0); }
WV_DEV unsigned wv_shfl_xor_u(unsigned v, int mask) { return (unsigned)__shfl_xor((int)v, mask); }
WV_DEV unsigned wv_shfl_u(unsigned v, int src) { return (unsigned)__shfl((int)v, src); }
WV_DEV unsigned long long wv_ballot(bool p) { return __ballot(p); }
WV_DEV float wv_exp2(float x) { return __builtin_amdgcn_exp2f(x); }
WV_DEV float wv_rcp(float x) { return __builtin_amdgcn_rcpf(x); }
typedef float wv_f32x2 __attribute__((ext_vector_type(2))); typedef __bf16 wv_bf16x2 __attribute__((ext_vector_type(2)));
WV_DEV unsigned wv_pk_bf16(float lo, float hi) { wv_f32x2 v = {lo, hi}; wv_bf16x2 b = __builtin_convertvector(v, wv_bf16x2); return __builtin_bit_cast(unsigned, b); }
#endif
#ifdef HOST_TEST
constexpr bool PBF = false;
#else
constexpr bool PBF = true;
#endif
WV_DEV float bfu2f(unsigned short b) { return __builtin_bit_cast(float, (unsigned)b << 16); }
WV_DEV float wv_shfl_xor_f(float v, int mask) { return __builtin_bit_cast(float, wv_shfl_xor_u(__builtin_bit_cast(unsigned, v), mask)); }
WV_DEV bf16x8 wv_pack8(float a0, float a1, float a2, float a3, float a4, float a5, float a6, float a7) {
  u32x4v w; w.x = wv_pk_bf16(a0, a1); w.y = wv_pk_bf16(a2, a3); w.z = wv_pk_bf16(a4, a5); w.w = wv_pk_bf16(a6, a7); return __builtin_bit_cast(bf16x8, w); }
WV_DEV bf16x8 wv_ld8(const bf16_t* p) { return *(const bf16x8*)p; }
WV_DEV bf16x8 wv_ld8_f32(const float* p) { const f32x4v a = *(const f32x4v*)p, b = *(const f32x4v*)(p + 4); return wv_pack8(a.x, a.y, a.z, a.w, b.x, b.y, b.z, b.w); }
constexpr int WKS = 544;
HD int vperm16(int k) { const int w = k & 15; return (k & ~15) | ((((w >> 2) & 1) << 3) + ((w >> 3) << 2) + (w & 3)); }
HD size_t frag_idx(int r, int k, int K) { return ((size_t)(r >> 5) * (K >> 4) + (k >> 4)) * 512 + (size_t)(((((k >> 3) & 1) << 5) + (r & 31)) << 3) + (k & 7); }
HD size_t kc_off(bool sample, int b, int kvh) { return sample ? (size_t)BATCH * 2 * 128 * 64 + ((size_t)b * 2 + kvh) * 512 * 64 : ((size_t)b * 2 + kvh) * 128 * 64; }
struct StPackQ { const Ctx& c; static constexpr long N = (long)MTOT * 512;
  HD void operator()(long i) const { c.QCb[i] = f2bf(c.QC[i]); c.QRb[i] = f2bf(c.QR[i]); } };
struct StPackKV { const Ctx& c; static constexpr long N = (long)BATCH * 2 * SEQ * 64;
  HD void operator()(long i) const {
    const int d = (int)(i % 64), t = (int)((i / 64) % SEQ), kvh = (int)((i / 64 / SEQ) % 2), b = (int)(i / 64 / SEQ / 2);
    const float* row = c.out + O_KVP + ((size_t)b * SEQ + t) * 512; const float* wr = c.WR + ((size_t)b * SEQ + t) * 256;
    const size_t bk = (size_t)b * 2 + kvh;
    c.KSb[bk * SEQ * 64 + frag_idx(t, d, 64)] = f2bf(row[(2 * 2 + kvh) * 64 + d]); c.VSTb[bk * 64 * SEQ + frag_idx(d, vperm16(t), SEQ)] = f2bf(row[(3 * 2 + kvh) * 64 + d]);
    c.KWb[bk * SEQ * 64 + frag_idx(t, d, 64)] = f2bf(wr[(0 * 2 + kvh) * 64 + d]); c.VWTb[bk * 64 * SEQ + frag_idx(d, vperm16(t), SEQ)] = f2bf(wr[(1 * 2 + kvh) * 64 + d]);
  } };
struct StPackWinS { const Ctx& c; static constexpr long N = (long)DEC_BATCH * 2 * WKS * 64;
  HD void operator()(long i) const {
    const int d = (int)(i % 64), w = (int)((i / 64) % WKS), kvh = (int)((i / 64 / WKS) % 2), b = (int)(i / 64 / WKS / 2);
    float k = 0.f, v = 0.f;
    if (w < WBUF) { const float* r = c.cache_nsa_win + ((size_t)b * WBUF + w) * 256; k = r[(0 * 2 + kvh) * 64 + d]; v = r[(1 * 2 + kvh) * 64 + d]; }
    else if (w < WBUF + DEC_SEQ) { const float* r = c.WR + ((size_t)MP + b * DEC_SEQ + (w - WBUF)) * 256; k = r[(0 * 2 + kvh) * 64 + d]; v = r[(1 * 2 + kvh) * 64 + d]; }
    const size_t bk = (size_t)b * 2 + kvh;
    c.KWsb[bk * WKS * 64 + frag_idx(w, d, 64)] = f2bf(k); c.VWTsb[bk * 64 * WKS + frag_idx(d, vperm16(w), WKS)] = f2bf(v);
  } };
constexpr long NPC_P = (long)BATCH * 2 * 128 * 64, NPC_S = (long)DEC_BATCH * 2 * 512 * 64;
struct StPackCmp { const Ctx& c; static constexpr long N = NPC_P + NPC_S;
  HD void operator()(long i) const {
    const bool sample = i >= NPC_P; long r = sample ? i - NPC_P : i; const int cpad = sample ? 512 : 128, nc = sample ? NCS : NCP;
    const int d = (int)(r % 64); r /= 64; const int cb = (int)(r % cpad); r /= cpad; const int kvh = (int)(r % 2), b = (int)(r / 2);
    float k = 0.f, v = 0.f; if (cb < nc) { k = cmp_ptr(c, c.KCMP, sample, b, cb, kvh)[d]; v = cmp_ptr(c, c.VCMP, sample, b, cb, kvh)[d]; }
    const size_t o = kc_off(sample, b, kvh);
    c.KCb[o + frag_idx(cb, d, 64)] = f2bf(k); c.VCTb[o + frag_idx(d, vperm16(cb), cpad)] = f2bf(v);
  } };

HD int crow16(int r, int hi) { return (r & 3) + 8 * (r >> 2) + 4 * hi; }
struct SoftSt { float m, l; f32x16 o[2]; };
constexpr float NSA_SCL = 0.125f * 1.4426950408889634f;
WV_DEV void soft_step(SoftSt& st, const f32x16& S, unsigned vm, bf16x8 v00, bf16x8 v01, bf16x8 v10, bf16x8 v11) {
  float sc[16]; float mx = -3e38f;
#pragma unroll
  for (int r = 0; r < 16; ++r) { sc[r] = ((vm >> r) & 1u) ? S[r] * NSA_SCL : -3e38f; mx = fmaxf(mx, sc[r]); }
  mx = fmaxf(mx, wv_shfl_xor_f(mx, 32));
  const float mn = fmaxf(st.m, mx), alpha = wv_exp2(st.m - mn); st.m = mn;
  float p[16]; float sum = 0.f;
#pragma unroll
  for (int r = 0; r < 16; ++r) { p[r] = ((vm >> r) & 1u) ? wv_exp2(sc[r] - mn) : 0.f; sum += p[r]; }
  st.l = st.l * alpha + sum; st.o[0] = st.o[0] * alpha; st.o[1] = st.o[1] * alpha;
  const bf16x8 p0 = wv_pack8(p[0], p[1], p[2], p[3], p[4], p[5], p[6], p[7]), p1 = wv_pack8(p[8], p[9], p[10], p[11], p[12], p[13], p[14], p[15]);
  st.o[0] = wv_mfma32(v00, p0, st.o[0]); st.o[0] = wv_mfma32(v01, p1, st.o[0]);
  st.o[1] = wv_mfma32(v10, p0, st.o[1]); st.o[1] = wv_mfma32(v11, p1, st.o[1]);
}
WV_DEV void soft_finish(SoftSt& st, float gate, f32x16 (&ot)[2]) {
  const float l = st.l + wv_shfl_xor_f(st.l, 32); const float f = l > 0.f ? gate * wv_rcp(l) : 0.f;
  ot[0] = ot[0] + st.o[0] * f; ot[1] = ot[1] + st.o[1] * f;
}
WV_DEV f32x16 qk_tile(const bf16_t* ktile  , const bf16x8 (&q)[4]) {
  f32x16 S = {};
#pragma unroll
  for (int ks = 0; ks < 4; ++ks) S = wv_mfma32(wv_ld8(ktile + ks * 512), q[ks], S);
  return S;
}
WV_DEV void cmp_tile2(const bf16_t* kcb, const bf16_t* vcb, int cpad, int tile, int r32, int hi, int ncv, float mc, float invc, const bf16x8 (&qc)[4], f32x16 (&oc)[2],
                      bool need_imp, float& prevLp, float (&v4)[4]) {
  const f32x16 S = qk_tile(kcb + (size_t)tile * 2048 + (hi * 32 + r32) * 8, qc);
  float p[16];
#pragma unroll
  for (int r = 0; r < 16; ++r) p[r] = (tile * 32 + crow16(r, hi) < ncv) ? wv_exp2(S[r] * NSA_SCL - mc) * invc : 0.f;
  if (need_imp) {
#pragma unroll
    for (int u = 0; u < 4; ++u) {
      const float lp = wv_shfl_xor_f(p[4 * u + 3], 32); float v = (p[4 * u] + p[4 * u + 1]) + (p[4 * u + 2] + p[4 * u + 3]) + (hi ? lp : prevLp); prevLp = lp;
      v += wv_shfl_xor_f(v, 1); v += wv_shfl_xor_f(v, 2); v4[u] = v; }
  }
  const bf16x8 p0 = wv_pack8(p[0], p[1], p[2], p[3], p[4], p[5], p[6], p[7]), p1 = wv_pack8(p[8], p[9], p[10], p[11], p[12], p[13], p[14], p[15]);
  const bf16_t* vb = vcb + (size_t)(tile * 2) * 512 + (hi * 32 + r32) * 8; const size_t dbs = (size_t)(cpad >> 4) * 512;
  oc[0] = wv_mfma32(wv_ld8(vb), p0, oc[0]); oc[0] = wv_mfma32(wv_ld8(vb + 512), p1, oc[0]);
  oc[1] = wv_mfma32(wv_ld8(vb + dbs), p0, oc[1]); oc[1] = wv_mfma32(wv_ld8(vb + dbs + 512), p1, oc[1]);
}
HD const float* sample_row(const Ctx& c, int b, int kp) {
  if (kp < PAST_LEN) { const int pg = c.page_table[b * NPAGES + kp / PAGE_SIZE]; return c.cache_nsa_kv + ((size_t)pg * PAGE_SIZE + kp % PAGE_SIZE) * 512; }
  int j = kp - PAST_LEN; if (j > DEC_SEQ - 1) j = DEC_SEQ - 1; return c.out + O_KVS + ((size_t)b * DEC_SEQ + j) * 512;
}
constexpr int NSA_SUB = 4, NSA_PART = 34;
template <bool SAMPLE> WV_DEV void nsa_unit(const Ctx& c, int unit, float* wscr  ) {
  constexpr int NC = SAMPLE ? NCS : NCP, CPAD = SAMPLE ? 512 : 128, NCT = CPAD / 32, NI = NCT * 4;
  const int lane = wv_lane(), r32 = lane & 31, hi = lane >> 5, tt = r32 >> 2, g = r32 & 3;
  int b, kvh, t0;
  int sub = 0;
  if (SAMPLE) { sub = unit % NSA_SUB; unit /= NSA_SUB; b = unit >> 1; kvh = unit & 1; t0 = 0; } else { const int tile = unit % (SEQ / 8), bk = unit / (SEQ / 8); t0 = tile * 8; kvh = bk & 1; b = bk >> 1; }
  const int m = (SAMPLE ? MP + b * DEC_SEQ : b * SEQ + t0) + tt, pos = (SAMPLE ? PAST_LEN : t0) + tt, h = kvh * 4 + g;
  const int pos_last = (SAMPLE ? PAST_LEN : t0) + 7;
  bf16x8 qc[4], qr[4];
#pragma unroll
  for (int ks = 0; ks < 4; ++ks) { qc[ks] = wv_ld8(c.QCb + (size_t)m * 512 + h * 64 + 16 * ks + 8 * hi); qr[ks] = wv_ld8(c.QRb + (size_t)m * 512 + h * 64 + 16 * ks + 8 * hi); }
  const float* gate = c.GATE + (size_t)m * 24 + h * 3;
  f32x16 ot[2]; ot[0] = f32x16{}; ot[1] = f32x16{};
  const bf16_t* kcb = c.KCb + kc_off(SAMPLE, b, kvh); const bf16_t* vcb = c.VCTb + kc_off(SAMPLE, b, kvh);
  const int ncv = pos >= 31 ? ((pos - 31) / 16 + 1 < NC ? (pos - 31) / 16 + 1 : NC) : 0;
  const int ncv_last = pos_last >= 31 ? ((pos_last - 31) / 16 + 1 < NC ? (pos_last - 31) / 16 + 1 : NC) : 0;
  const int ntc = (ncv_last + 31) / 32;
  float mc = -3e38f, lc = 0.f;
  for (int tile = 0; tile < ntc; ++tile) {
    const f32x16 S = qk_tile(kcb + (size_t)tile * 2048 + lane * 8, qc);
    float sc[16]; float mx = -3e38f;
#pragma unroll
    for (int r = 0; r < 16; ++r) { const bool v = tile * 32 + crow16(r, hi) < ncv; sc[r] = v ? S[r] * NSA_SCL : -3e38f; mx = fmaxf(mx, sc[r]); }
    mx = fmaxf(mx, wv_shfl_xor_f(mx, 32));
    const float mn = fmaxf(mc, mx); float sum = 0.f;
#pragma unroll
    for (int r = 0; r < 16; ++r) sum += (tile * 32 + crow16(r, hi) < ncv) ? wv_exp2(sc[r] - mn) : 0.f;
    lc = lc * wv_exp2(mc - mn) + sum; mc = mn;
  }
  lc = lc + wv_shfl_xor_f(lc, 32);
  const float invc = lc > 0.f ? wv_rcp(lc) : 0.f;
  const int qblk = pos >> 6;
  const bool need_imp = SAMPLE || qblk > 7;
  unsigned long long sel0 = 0ull, sel1 = 0ull;
  float prevLp = 0.f; f32x16 oc[2]; oc[0] = f32x16{}; oc[1] = f32x16{};
  if constexpr (!SAMPLE) {
    float imp[NI];
#pragma unroll
    for (int i = 0; i < NI; ++i) imp[i] = -1.f;
#pragma unroll
    for (int tile = 0; tile < NCT; ++tile) {
      if (tile < ntc) { float v4[4] = {0.f, 0.f, 0.f, 0.f};
        cmp_tile2(kcb, vcb, CPAD, tile, r32, hi, ncv, mc, invc, qc, oc, need_imp, prevLp, v4);
#pragma unroll
        for (int u = 0; u < 4; ++u) { const int s = 2 * (tile * 4 + u) + hi; imp[tile * 4 + u] = (need_imp && s >= 1 && s <= qblk - 2) ? v4[u] : -1.f; } }
    }
    if (!need_imp) sel0 = (2ull << qblk) - 1ull;
    else {
      for (int round = 0; round < 5; ++round) {
        float bv = -1.f; int bs = 1 << 20;
#pragma unroll
        for (int i = 0; i < NI; ++i) if (imp[i] > bv) { bv = imp[i]; bs = 2 * i + hi; }
        const float pv = wv_shfl_xor_f(bv, 32); const int ps = (int)wv_shfl_xor_u((unsigned)bs, 32);
        const int ws = (pv > bv || (pv == bv && ps < bs)) ? ps : bs;
        sel0 |= 1ull << ws;
#pragma unroll
        for (int i = 0; i < NI; ++i) if (2 * i + hi == ws) imp[i] = -1.f;
      }
      sel0 |= 1ull | (1ull << qblk) | (1ull << (qblk - 1));
    }
  } else {
    for (int tile = 0; tile < ntc; ++tile) { float v4[4] = {0.f, 0.f, 0.f, 0.f};
      cmp_tile2(kcb, vcb, CPAD, tile, r32, hi, ncv, mc, invc, qc, oc, true, prevLp, v4);
      if (g == 0) {
#pragma unroll
        for (int u = 0; u < 4; ++u) wscr[tt * 128 + 2 * (tile * 4 + u) + hi] = v4[u]; }
    }
    wv_fence();
    const int sl = (g * 2 + hi) * 16; int w0 = -1, w1 = -1, w2 = -1, w3 = -1;
    for (int round = 0; round < 5; ++round) {
      float bv = -1.f; int bs = 1 << 20;
      for (int j = 0; j < 16; ++j) { const int s = sl + j; const float v = wscr[tt * 128 + s];
        const bool cand = s >= 1 && s <= qblk - 2 && s != w0 && s != w1 && s != w2 && s != w3;
        if (cand && v > bv) { bv = v; bs = s; } }
#pragma unroll
      for (int sh = 0; sh < 3; ++sh) { const int msk = sh == 0 ? 1 : sh == 1 ? 2 : 32;
        const float pv = wv_shfl_xor_f(bv, msk); const int ps = (int)wv_shfl_xor_u((unsigned)bs, msk);
        if (pv > bv || (pv == bv && ps < bs)) { bv = pv; bs = ps; } }
      if (bs < 64) sel0 |= 1ull << bs; else if (bs < 128) sel1 |= 1ull << (bs - 64);
      w3 = w2; w2 = w1; w1 = w0; w0 = bs;
    }
    sel0 |= 1ull;
    if (qblk < 64) sel0 |= 1ull << qblk; else if (qblk < 128) sel1 |= 1ull << (qblk - 64);
    if (qblk - 1 < 64) sel0 |= 1ull << (qblk - 1); else if (qblk - 1 < 128) sel1 |= 1ull << (qblk - 1 - 64);
  }
  { const float g0 = gate[0]; ot[0] = oc[0] * g0; ot[1] = oc[1] * g0; }
  unsigned long long un0 = sel0, un1 = sel1;
#pragma unroll
  for (int sh = 4; sh <= 16; sh <<= 1) {
    un0 |= (unsigned long long)wv_shfl_xor_u((unsigned)un0, sh) | ((unsigned long long)wv_shfl_xor_u((unsigned)(un0 >> 32), sh) << 32);
    if (SAMPLE) un1 |= (unsigned long long)wv_shfl_xor_u((unsigned)un1, sh) | ((unsigned long long)wv_shfl_xor_u((unsigned)(un1 >> 32), sh) << 32);
  }
  if constexpr (!SAMPLE) {
    SoftSt st; st.m = -3e38f; st.l = 0.f; st.o[0] = f32x16{}; st.o[1] = f32x16{};
    const size_t bk = (size_t)b * 2 + kvh; const bf16_t* kbase = c.KSb + bk * SEQ * 64 + lane * 8; const bf16_t* vbase = c.VSTb + bk * 64 * SEQ + lane * 8;
    unsigned long long um = un0; int s = __builtin_ctzll(um), half = 0, kb = s * 64;
    bf16x8 kf[4], vf[4];
#define NSA_ISSUE(KB) do { const bf16_t* kp_ = kbase + (size_t)((KB) >> 5) * 2048; const bf16_t* vp_ = vbase + (size_t)((KB) >> 4) * 512; \
      kf[0] = wv_ld8(kp_); kf[1] = wv_ld8(kp_ + 512); kf[2] = wv_ld8(kp_ + 1024); kf[3] = wv_ld8(kp_ + 1536); \
      vf[0] = wv_ld8(vp_); vf[1] = wv_ld8(vp_ + 512); vf[2] = wv_ld8(vp_ + (size_t)(SEQ >> 4) * 512); vf[3] = wv_ld8(vp_ + (size_t)(SEQ >> 4) * 512 + 512); } while (0)
    NSA_ISSUE(kb);
    for (;;) {
      int ns = s, nhalf = half; bool has_next;
      if (half == 0 && s * 64 + 32 <= pos_last) { nhalf = 1; has_next = true; } else { um &= um - 1ull; has_next = um != 0ull; if (has_next) { ns = __builtin_ctzll(um); nhalf = 0; } }
      const int nkb = ns * 64 + nhalf * 32;
      const bf16x8 ck0 = kf[0], ck1 = kf[1], ck2 = kf[2], ck3 = kf[3], cv0 = vf[0], cv1 = vf[1], cv2 = vf[2], cv3 = vf[3];
      if (has_next) NSA_ISSUE(nkb);
      const bool mine = (sel0 >> s) & 1ull; unsigned vm = 0u;
#pragma unroll
      for (int r = 0; r < 16; ++r) if (mine && kb + crow16(r, hi) <= pos) vm |= 1u << r;
      f32x16 S = {}; S = wv_mfma32(ck0, qr[0], S); S = wv_mfma32(ck1, qr[1], S); S = wv_mfma32(ck2, qr[2], S); S = wv_mfma32(ck3, qr[3], S);
      soft_step(st, S, vm, cv0, cv1, cv2, cv3);
      if (!has_next) break;
      s = ns; half = nhalf; kb = nkb;
    }
    soft_finish(st, gate[1], ot);
    SoftSt sw; sw.m = -3e38f; sw.l = 0.f; sw.o[0] = f32x16{}; sw.o[1] = f32x16{};
    kbase = c.KWb + bk * SEQ * 64 + lane * 8; vbase = c.VWTb + bk * 64 * SEQ + lane * 8;
    const int lo = t0 - (WINDOW - 1) > 0 ? t0 - (WINDOW - 1) : 0; kb = lo & ~31;
    NSA_ISSUE(kb);
    for (;;) {
      const int nkb = kb + 32; const bool has_next = nkb <= pos_last;
      const bf16x8 ck0 = kf[0], ck1 = kf[1], ck2 = kf[2], ck3 = kf[3], cv0 = vf[0], cv1 = vf[1], cv2 = vf[2], cv3 = vf[3];
      if (has_next) NSA_ISSUE(nkb);
      unsigned vm = 0u;
#pragma unroll
      for (int r = 0; r < 16; ++r) { const int key = kb + crow16(r, hi); if (key <= pos && key > pos - WINDOW) vm |= 1u << r; }
      f32x16 S = {}; S = wv_mfma32(ck0, qr[0], S); S = wv_mfma32(ck1, qr[1], S); S = wv_mfma32(ck2, qr[2], S); S = wv_mfma32(ck3, qr[3], S);
      soft_step(sw, S, vm, cv0, cv1, cv2, cv3);
      if (!has_next) break;
      kb = nkb;
    }
    soft_finish(sw, gate[2], ot);
#undef NSA_ISSUE
  } else
  { SoftSt st; st.m = -3e38f; st.l = 0.f; st.o[0] = f32x16{}; st.o[1] = f32x16{};
    const int nblk = SAMPLE ? NSELS : qblk + 1; int dealt = 0;
    for (int s = 0; s < nblk; ++s) {
      const bool in_union = SAMPLE ? (s == NSELS - 1 || (s < 64 ? (un0 >> s) & 1ull : (un1 >> (s - 64)) & 1ull)) : ((un0 >> s) & 1ull);
      if (!in_union) continue;
      if (SAMPLE) { const bool take = (dealt % NSA_SUB) == sub; ++dealt; if (!take) continue; }
      const bool mine = SAMPLE ? (s == NSELS - 1 || (s < 64 ? (sel0 >> s) & 1ull : (sel1 >> (s - 64)) & 1ull)) : ((sel0 >> s) & 1ull);
      for (int half = 0; half < 2; ++half) {
        const int kb = s * 64 + half * 32; if (kb > pos_last) break;
        unsigned vm = 0u;
#pragma unroll
        for (int r = 0; r < 16; ++r) if (mine && kb + crow16(r, hi) <= pos) vm |= 1u << r;
        if (!SAMPLE) {
          const size_t bk = (size_t)b * 2 + kvh;
          const f32x16 S = qk_tile(c.KSb + bk * SEQ * 64 + (size_t)(kb >> 5) * 2048 + lane * 8, qr);
          const bf16_t* vb = c.VSTb + bk * 64 * SEQ + (size_t)(kb >> 4) * 512 + lane * 8;
          soft_step(st, S, vm, wv_ld8(vb), wv_ld8(vb + 512), wv_ld8(vb + (size_t)(SEQ >> 4) * 512), wv_ld8(vb + (size_t)(SEQ >> 4) * 512 + 512));
        } else {
          const float* blk; int rmax;
          if (s < NSELS - 1) { const int pg = c.page_table[b * NPAGES + (s >> 1)]; blk = c.cache_nsa_kv + ((size_t)pg * PAGE_SIZE + (s & 1) * 64) * 512; rmax = 63; }
          else { blk = c.out + O_KVS + (size_t)b * DEC_SEQ * 512; rmax = DEC_SEQ - 1; }
          const int kr = half * 32 + r32; const float* krow = blk + (size_t)(kr < rmax ? kr : rmax) * 512 + (2 * 2 + kvh) * 64 + 8 * hi;
          f32x16 S = {};
#pragma unroll
          for (int ks = 0; ks < 4; ++ks) S = wv_mfma32(wv_ld8_f32(krow + 16 * ks), qr[ks], S);
          bf16x8 vf[2][2];
#pragma unroll
          for (int ks = 0; ks < 2; ++ks) { float v0[8], v1[8];
#pragma unroll
            for (int j = 0; j < 8; ++j) { const int vr = half * 32 + 16 * ks + 8 * (j >> 2) + 4 * hi + (j & 3); const float* vp = blk + (size_t)(vr < rmax ? vr : rmax) * 512 + (3 * 2 + kvh) * 64; v0[j] = vp[r32]; v1[j] = vp[32 + r32]; }
            vf[0][ks] = wv_pack8(v0[0], v0[1], v0[2], v0[3], v0[4], v0[5], v0[6], v0[7]); vf[1][ks] = wv_pack8(v1[0], v1[1], v1[2], v1[3], v1[4], v1[5], v1[6], v1[7]); }
          soft_step(st, S, vm, vf[0][0], vf[0][1], vf[1][0], vf[1][1]);
        }
      }
    }
    if (!SAMPLE) soft_finish(st, gate[1], ot);
    else { float* pr = c.NPART + (((size_t)unit * NSA_SUB + sub) * 3 + 0) * 64 * NSA_PART + lane; pr[0] = st.m; pr[64] = st.l;
#pragma unroll
      for (int r = 0; r < 16; ++r) { pr[(2 + r) * 64] = st.o[0][r]; pr[(18 + r) * 64] = st.o[1][r]; } } }
  if constexpr (SAMPLE)
  { SoftSt st; st.m = -3e38f; st.l = 0.f; st.o[0] = f32x16{}; st.o[1] = f32x16{};
    if (!SAMPLE) {
      const size_t bk = (size_t)b * 2 + kvh; const int lo = t0 - (WINDOW - 1) > 0 ? t0 - (WINDOW - 1) : 0;
      for (int kb = lo & ~31; kb <= pos_last; kb += 32) {
        unsigned vm = 0u;
#pragma unroll
        for (int r = 0; r < 16; ++r) { const int key = kb + crow16(r, hi); if (key <= pos && key > pos - WINDOW) vm |= 1u << r; }
        const f32x16 S = qk_tile(c.KWb + bk * SEQ * 64 + (size_t)(kb >> 5) * 2048 + lane * 8, qr);
        const bf16_t* vb = c.VWTb + bk * 64 * SEQ + (size_t)(kb >> 4) * 512 + lane * 8;
        soft_step(st, S, vm, wv_ld8(vb), wv_ld8(vb + 512), wv_ld8(vb + (size_t)(SEQ >> 4) * 512), wv_ld8(vb + (size_t)(SEQ >> 4) * 512 + 512));
      }
    } else {
      const size_t bk = (size_t)b * 2 + kvh;
      for (int kb = 0; kb < WKS; kb += 32) {
        if (((kb >> 5) % NSA_SUB) != sub) continue;
        unsigned vm = 0u;
#pragma unroll
        for (int r = 0; r < 16; ++r) { const int i = kb + crow16(r, hi); if (i >= tt + 1 && i <= WBUF + tt) vm |= 1u << r; }
        const f32x16 S = qk_tile(c.KWsb + bk * WKS * 64 + (size_t)(kb >> 5) * 2048 + lane * 8, qr);
        const bf16_t* vb = c.VWTsb + bk * 64 * WKS + (size_t)(kb >> 4) * 512 + lane * 8;
        soft_step(st, S, vm, wv_ld8(vb), wv_ld8(vb + 512), wv_ld8(vb + (size_t)(WKS >> 4) * 512), wv_ld8(vb + (size_t)(WKS >> 4) * 512 + 512));
      }
    }
    if (!SAMPLE) soft_finish(st, gate[2], ot);
    else { float* pr = c.NPART + (((size_t)unit * NSA_SUB + sub) * 3 + 1) * 64 * NSA_PART + lane; pr[0] = st.m; pr[64] = st.l;
#pragma unroll
      for (int r = 0; r < 16; ++r) { pr[(2 + r) * 64] = st.o[0][r]; pr[(18 + r) * 64] = st.o[1][r]; } } }
  if (SAMPLE) {
    float* pr = c.NPART + (((size_t)unit * NSA_SUB + sub) * 3 + 2) * 64 * NSA_PART + lane;
#pragma unroll
    for (int r = 0; r < 16; ++r) { pr[(2 + r) * 64] = sub == 0 ? ot[0][r] : 0.f; pr[(18 + r) * 64] = sub == 0 ? ot[1][r] : 0.f; }
    return; }
  bf16_t* orow = c.CAT + (size_t)m * D_MODEL + h * 64 + 4 * hi;
#pragma unroll
  for (int db = 0; db < 2; ++db)
#pragma unroll
    for (int u = 0; u < 4; ++u) { u32x2v w; w.x = wv_pk_bf16(ot[db][4 * u], ot[db][4 * u + 1]); w.y = wv_pk_bf16(ot[db][4 * u + 2], ot[db][4 * u + 3]); *(u32x2v*)(orow + db * 32 + 8 * u) = w; }
}
constexpr int NSA_UNITS_P = BATCH * 2 * (SEQ / 8), NSA_UNITS_S = DEC_BATCH * 2 * NSA_SUB, NSA_COMB_UNITS = DEC_BATCH * 2;
WV_DEV void nsa_combine_unit(const Ctx& c, int unit) {
  const int lane = wv_lane(), r32 = lane & 31, hi = lane >> 5, tt = r32 >> 2, g = r32 & 3; const int b = unit >> 1, kvh = unit & 1, h = kvh * 4 + g, m = MP + b * DEC_SEQ + tt;
  const float* gate = c.GATE + (size_t)m * 24 + h * 3; float ot[32];
  { const float* pr = c.NPART + (((size_t)unit * NSA_SUB + 0) * 3 + 2) * 64 * NSA_PART + lane;
#pragma unroll
    for (int r = 0; r < 32; ++r) ot[r] = pr[(2 + r) * 64]; }
#pragma unroll 1
  for (int br = 0; br < 2; ++br) { float M = -3e38f;
#pragma unroll
    for (int s = 0; s < NSA_SUB; ++s) M = fmaxf(M, c.NPART[(((size_t)unit * NSA_SUB + s) * 3 + br) * 64 * NSA_PART + lane]);
    float l = 0.f, o[32];
#pragma unroll
    for (int r = 0; r < 32; ++r) o[r] = 0.f;
#pragma unroll
    for (int s = 0; s < NSA_SUB; ++s) { const float* pr = c.NPART + (((size_t)unit * NSA_SUB + s) * 3 + br) * 64 * NSA_PART + lane; const float f = wv_exp2(pr[0] - M); l += f * pr[64];
#pragma unroll
      for (int r = 0; r < 32; ++r) o[r] += f * pr[(2 + r) * 64]; }
    l += wv_shfl_xor_f(l, 32); const float f = l > 0.f ? gate[1 + br] * wv_rcp(l) : 0.f;
#pragma unroll
    for (int r = 0; r < 32; ++r) ot[r] += o[r] * f; }
  bf16_t* orow = c.CAT + (size_t)m * D_MODEL + h * 64 + 4 * hi;
#pragma unroll
  for (int db = 0; db < 2; ++db)
#pragma unroll
    for (int u = 0; u < 4; ++u) { u32x2v w; w.x = wv_pk_bf16(ot[db * 16 + 4 * u], ot[db * 16 + 4 * u + 1]); w.y = wv_pk_bf16(ot[db * 16 + 4 * u + 2], ot[db * 16 + 4 * u + 3]); *(u32x2v*)(orow + db * 32 + 8 * u) = w; }
}
constexpr int XNT = MEM_TOKENS / 32;
HD int bb_row0(int bb) { return bb < BATCH ? bb * SEQ : MP + (bb - BATCH) * DEC_SEQ; }
struct StPackX { const Ctx& c; static constexpr long N = (long)(BATCH + DEC_BATCH) * 4 * MEM_TOKENS * 256;
  HD void operator()(long i) const {
    const int d = (int)(i % 256), j = (int)((i / 256) % MEM_TOKENS), h = (int)((i / 256 / MEM_TOKENS) % 4), bb = (int)(i / 256 / MEM_TOKENS / 4);
    const int m = bb_row0(bb); const size_t bh = (size_t)bb * 4 + h;
    c.KXb[bh * MEM_TOKENS * 256 + frag_idx(j, d, 256)] = f2bf(memkv_row(c, m, j, 0, h)[d] * c.xq_norm_w[d]); c.VXTb[bh * 256 * MEM_TOKENS + frag_idx(d, vperm16(j), MEM_TOKENS)] = f2bf(memkv_row(c, m, j, 1, h)[d]);
  } };
struct StXqNormB { const Ctx& c; static constexpr long N = (long)MTOT * 4;
  HD void operator()(long i) const {
    const float* q = c.Q2 + (size_t)(i / 4) * D_MODEL + (i % 4) * 256; bf16_t* o = c.Q2b + (size_t)(i / 4) * D_MODEL + (i % 4) * 256;
    float ss = 0.f; for (int d = 0; d < 256; ++d) ss += q[d] * q[d];
    const float r = 1.f / sqrtf(ss / 256.f + EPS); for (int d = 0; d < 256; ++d) o[d] = f2bf(q[d] * r * c.xq_norm_w[d]);
  } };
struct StXqRawB { const Ctx& c; static constexpr long N = (long)MTOT * D_MODEL;
  HD void operator()(long i) const { c.Q2b[i] = f2bf(c.Q2[i]); } };
constexpr int XA_UNITS_P = BATCH * 4 * (SEQ / 32), XA_UNITS_S = DEC_BATCH * 4;
template <bool SAMPLE> WV_DEV void xattn_unit(const Ctx& c, int unit) {
  const int lane = wv_lane(), r32 = lane & 31, hi = lane >> 5;
  int h, bb, m; bool valid = true;
  if (!SAMPLE) { const int tile = unit % (SEQ / 32), bh = unit / (SEQ / 32); h = bh & 3; bb = bh >> 2; m = bb * SEQ + tile * 32 + r32; }
  else { h = unit & 3; const int b = unit >> 2; bb = BATCH + b; m = MP + b * DEC_SEQ + (r32 & (DEC_SEQ - 1)); valid = r32 < DEC_SEQ; }
  const bf16_t* qrow = c.Q2b + (size_t)m * D_MODEL + h * 256 + 8 * hi;
  const bf16_t* kb = c.KXb + ((size_t)bb * 4 + h) * MEM_TOKENS * 256 + lane * 8;
  const bf16_t* vb = c.VXTb + ((size_t)bb * 4 + h) * 256 * MEM_TOKENS + lane * 8;
  f32x16 S[XNT];
#pragma unroll
  for (int t = 0; t < XNT; ++t) S[t] = f32x16{};
  float qss = 0.f;
  { bf16x8 kf[2][XNT], qf[2];
    qf[0] = wv_ld8(qrow);
#pragma unroll
    for (int t = 0; t < XNT; ++t) kf[0][t] = wv_ld8(kb + (size_t)(t * 16) * 512);
#pragma unroll
    for (int ks = 0; ks < 16; ++ks) { const int cur = ks & 1, nxt = cur ^ 1;
      if (ks + 1 < 16) { qf[nxt] = wv_ld8(qrow + 16 * (ks + 1));
#pragma unroll
        for (int t = 0; t < XNT; ++t) kf[nxt][t] = wv_ld8(kb + (size_t)(t * 16 + ks + 1) * 512); }
#pragma unroll
      for (int t = 0; t < XNT; ++t) S[t] = wv_mfma32(kf[cur][t], qf[cur], S[t]);
#pragma unroll
      for (int e = 0; e < 8; ++e) { const float qv = bfu2f((unsigned short)qf[cur][e]); qss += qv * qv; }
      WV_SCHED_BARRIER(); } }
  qss += wv_shfl_xor_f(qss, 32); const float qr_ = 1.f / sqrtf(qss / 256.f + EPS);
  const float SC = 0.0625f * 1.4426950408889634f * qr_;
  float mx = -3e38f;
#pragma unroll
  for (int t = 0; t < XNT; ++t)
#pragma unroll
    for (int r = 0; r < 16; ++r) mx = fmaxf(mx, S[t][r]);
  mx = fmaxf(mx, wv_shfl_xor_f(mx, 32));
  float sum = 0.f; bf16x8 pf[XNT][2];
#pragma unroll
  for (int t = 0; t < XNT; ++t) { float p[16];
#pragma unroll
    for (int r = 0; r < 16; ++r) { p[r] = wv_exp2((S[t][r] - mx) * SC); sum += p[r]; }
    pf[t][0] = wv_pack8(p[0], p[1], p[2], p[3], p[4], p[5], p[6], p[7]); pf[t][1] = wv_pack8(p[8], p[9], p[10], p[11], p[12], p[13], p[14], p[15]); }
  sum += wv_shfl_xor_f(sum, 32);
  const float inv = wv_rcp(sum);
  bf16_t* orow = c.OX + (size_t)m * D_MODEL + h * 256 + 4 * hi;
  bf16x8 vf[2][2 * XNT];
#pragma unroll
  for (int q = 0; q < 2 * XNT; ++q) vf[0][q] = wv_ld8(vb + (size_t)q * 512);
#pragma unroll
  for (int db = 0; db < 8; ++db) { f32x16 o = {}; const int cur = db & 1, nxt = cur ^ 1;
    if (db + 1 < 8) {
#pragma unroll
      for (int q = 0; q < 2 * XNT; ++q) vf[nxt][q] = wv_ld8(vb + (size_t)((db + 1) * (MEM_TOKENS / 16) + q) * 512); }
#pragma unroll
    for (int t = 0; t < XNT; ++t) { o = wv_mfma32(vf[cur][2 * t], pf[t][0], o); o = wv_mfma32(vf[cur][2 * t + 1], pf[t][1], o); }
    WV_SCHED_BARRIER();
    if (valid) {
#pragma unroll
      for (int u = 0; u < 4; ++u) { u32x2v w; w.x = wv_pk_bf16(o[4 * u] * inv, o[4 * u + 1] * inv); w.y = wv_pk_bf16(o[4 * u + 2] * inv, o[4 * u + 3] * inv); *(u32x2v*)(orow + db * 32 + 8 * u) = w; } }
  }
}
constexpr int NCH = SEQ / 64;
constexpr int NCHUNK_P = BATCH * 4 * NCH, NCHUNK = NCHUNK_P + DEC_BATCH * 4;
constexpr int GDN_PREP_UNITS = NCHUNK * 4, GDN_SCAN_UNITS = (BATCH + DEC_BATCH) * 4 * 4;
constexpr int GDN_WSCR_FLOATS = 64 * 64 + 128;
HD void chunk_decode(int ch, int& b, int& h, int& m0, int& nvalid) {
  if (ch < NCHUNK_P) { const int n = ch % NCH, bh = ch / NCH; h = bh & 3; b = bh >> 2; m0 = b * SEQ + n * 64; nvalid = 64; }
  else { const int r = ch - NCHUNK_P; h = r & 3; b = r >> 2; m0 = MP + b * DEC_SEQ; nvalid = DEC_SEQ; }
}
HD size_t acc_idx(int ch, int i, int col) { const int il = i & 31; return ((((size_t)ch * 4 + (col >> 5)) * 2 + (i >> 5)) * 64 + ((il >> 2) & 1) * 32 + (col & 31)) * 16 + (il & 3) + 4 * (il >> 3); }
HD size_t og_idx(int ch, int i, int col) { const int il = i & 31; return (((((size_t)ch * 4 + (col >> 5)) * 2 + (i >> 5)) * 16 + (il & 3) + 4 * (il >> 3)) * 64) + ((il >> 2) & 1) * 32 + (col & 31); }
WV_DEV bf16x8 ldrow8(const float* buf, int m0, int i, int nvalid, int off) {
  return wv_ld8_f32(buf + (size_t)(m0 + (i < nvalid ? i : nvalid - 1)) * 512 + off);
}
WV_DEV void gdn_prep_unit(const Ctx& c, int unit, float* wscr) {
  const int lane = wv_lane(), r32 = lane & 31, hi = lane >> 5, ch = unit >> 2, quarter = unit & 3;
  int b, h, m0, nvalid; chunk_decode(ch, b, h, m0, nvalid);
  float* At = wscr; float* gcs = wscr + 4096; float* bts = wscr + 4160;
  const float gi = lane < nvalid ? c.GG[(size_t)(m0 + lane) * 4 + h] : 0.f, bi = lane < nvalid ? c.GB[(size_t)(m0 + lane) * 4 + h] : 0.f;
  float gc = gi;
#pragma unroll
  for (int off = 1; off < 64; off <<= 1) { const float t = __builtin_bit_cast(float, wv_shfl_u(__builtin_bit_cast(unsigned, gc), lane - off)); if (lane >= off) gc += t; }
  gcs[lane] = gc; bts[lane] = bi;
  const float g_last = __builtin_bit_cast(float, wv_shfl_u(__builtin_bit_cast(unsigned, gc), 63));
  wv_fence();
#pragma unroll 1
  for (int bp = 0; bp < 3; ++bp) { const int ib = bp == 0 ? 0 : 1, jb = bp == 2 ? 1 : 0;
    f32x16 S = {};
#pragma unroll 2
    for (int ks = 0; ks < 8; ++ks) S = wv_mfma32(ldrow8(c.GK, m0, ib * 32 + r32, nvalid, h * 128 + 16 * ks + 8 * hi), ldrow8(c.GK, m0, jb * 32 + r32, nvalid, h * 128 + 16 * ks + 8 * hi), S);
    const int j = jb * 32 + r32; const float gcj = gcs[j];
#pragma unroll
    for (int r = 0; r < 16; ++r) { const int i = ib * 32 + crow16(r, hi); At[j * 64 + i] = (j < i) ? bts[i] * S[r] * expf(gcs[i] - gcj) : 0.f; }
  }
#pragma unroll
  for (int r = 0; r < 16; ++r) At[(32 + r32) * 64 + crow16(r, hi)] = 0.f;
  wv_fence();
  { const int col = quarter * 64 + lane; const bool isu = col < 128; const int dcol = isu ? col : col - 128; const float* src = isu ? c.GV : c.GK;
    const int slot = vperm16(dcol);
#pragma unroll 1
    for (int rb = 0; rb < 4; ++rb) {
      float acc[16];
#pragma unroll
      for (int i = 0; i < 16; ++i) { const int row = rb * 16 + i; const float x = row < nvalid ? src[(size_t)(m0 + row) * 512 + h * 128 + dcol] : 0.f; acc[i] = x * bts[row] * (isu ? 1.f : expf(gcs[row])); }
      for (int j = 0; j < rb * 16; ++j) { const float sj = isu ? c.GS[acc_idx(ch, j, dcol)] : c.GSW[((size_t)ch * 64 + j) * 128 + dcol]; const float* at = At + j * 64 + rb * 16;
#pragma unroll
        for (int i = 0; i < 16; ++i) acc[i] -= at[i] * sj; }
#pragma unroll
      for (int j = 0; j < 16; ++j) { const float sj = acc[j]; const float* at = At + (rb * 16 + j) * 64 + rb * 16;
#pragma unroll
        for (int i = 0; i < 16; ++i) if (i > j) acc[i] -= at[i] * sj; }
#pragma unroll
      for (int i = 0; i < 16; ++i) { if (isu) c.GS[acc_idx(ch, rb * 16 + i, dcol)] = acc[i]; else { c.GSW[((size_t)ch * 64 + rb * 16 + i) * 128 + dcol] = acc[i]; c.GWp[(size_t)ch * 8192 + frag_idx(rb * 16 + i, slot, 128)] = f2bf(-acc[i]); } }
      wv_fence();
    }
  }
  if (quarter == 0) {
#pragma unroll 1
    for (int bp = 0; bp < 3; ++bp) { const int ib = bp == 0 ? 0 : 1, jb = bp == 2 ? 1 : 0;
      f32x16 S = {};
#pragma unroll 2
      for (int ks = 0; ks < 8; ++ks) S = wv_mfma32(ldrow8(c.GQ, m0, ib * 32 + r32, nvalid, h * 128 + 16 * ks + 8 * hi), ldrow8(c.GK, m0, jb * 32 + r32, nvalid, h * 128 + 16 * ks + 8 * hi), S);
      const int j = jb * 32 + r32; const float gcj = gcs[j]; const int slot = vperm16(j);
#pragma unroll
      for (int r = 0; r < 16; ++r) { const int i = ib * 32 + crow16(r, hi); c.GQKp[(size_t)ch * 4096 + frag_idx(i, slot, 64)] = f2bf((j <= i) ? S[r] * expf(gcs[i] - gcj) : 0.f); }
    }
  } else if (quarter == 1) {
    const float e = expf(gc); const float* q = c.GQ + (size_t)(m0 + lane) * 512 + h * 128;
#pragma unroll
    for (int g16 = 0; g16 < 8; ++g16)
#pragma unroll
      for (int h2 = 0; h2 < 2; ++h2) { f32x4v lo = {0.f, 0.f, 0.f, 0.f}, hv = {0.f, 0.f, 0.f, 0.f};
        if (lane < nvalid) { lo = *(const f32x4v*)(q + g16 * 16 + 4 * h2); hv = *(const f32x4v*)(q + g16 * 16 + 8 + 4 * h2); }
        *(bf16x8*)(c.GQDp + (size_t)ch * 8192 + frag_idx(lane, g16 * 16 + h2 * 8, 128)) = wv_pack8(lo.x * e, lo.y * e, lo.z * e, lo.w * e, hv.x * e, hv.y * e, hv.z * e, hv.w * e); }
  } else if (quarter == 2) {
#pragma unroll 1
    for (int pass = 0; pass < 2; ++pass) { const int dk = lane + 64 * pass; const float* kcol = c.GK + (size_t)m0 * 512 + h * 128 + 64 * pass;
#pragma unroll 1
      for (int g8 = 0; g8 < 8; ++g8) { const int g16 = g8 >> 1, h2 = g8 & 1; float v[8];
#pragma unroll
        for (int j = 0; j < 8; ++j) { const int i = g16 * 16 + 8 * (j >> 2) + 4 * h2 + (j & 3); v[j] = (kcol + (i < nvalid ? i : nvalid - 1) * 512)[(unsigned)lane] * expf(g_last - gcs[i]); }
        *(bf16x8*)(c.GKDTp + (size_t)ch * 8192 + frag_idx(dk, g16 * 16 + h2 * 8, 64)) = wv_pack8(v[0], v[1], v[2], v[3], v[4], v[5], v[6], v[7]); } }
  } else { if (lane == 0) c.GL[ch] = g_last; }
  wv_fence();
}
WV_DEV void tri_solve32(float (&acc)[32], const float* At, int base) {
#pragma unroll
  for (int j = 0; j < 31; ++j) { const float xj = acc[j]; const f32x4v* at = (const f32x4v*)(At + (base + j) * 64 + base);
#pragma unroll
    for (int i4 = (j + 1) / 4; i4 < 8; ++i4) { const f32x4v a = at[i4];
      if (4 * i4 + 0 > j) acc[4 * i4 + 0] -= a.x * xj; if (4 * i4 + 1 > j) acc[4 * i4 + 1] -= a.y * xj; if (4 * i4 + 2 > j) acc[4 * i4 + 2] -= a.z * xj; if (4 * i4 + 3 > j) acc[4 * i4 + 3] -= a.w * xj; }
    if ((j & 3) == 3) GDN_FENCE(); }
}
constexpr int GDN_PREP2_UNITS = NCHUNK * 4;
WV_DEV void gdn_prep2_unit(const Ctx& c, int unit, float* wscr) {
  const int ch = unit >> 2, quarter = unit & 3;
  const int lane = wv_lane_opaque(), r32 = lane & 31, hi = lane >> 5;
  int b, h, m0, nvalid; chunk_decode(ch, b, h, m0, nvalid);
  float* At = wscr; float* gcs = wscr + 4096; float* bts = wscr + 4160;
  const float gi = lane < nvalid ? c.GG[(size_t)(m0 + lane) * 4 + h] : 0.f, bi = lane < nvalid ? c.GB[(size_t)(m0 + lane) * 4 + h] : 0.f;
  float gc = gi;
#pragma unroll
  for (int off = 1; off < 64; off <<= 1) { const float t = __builtin_bit_cast(float, wv_shfl_u(__builtin_bit_cast(unsigned, gc), lane - off)); if (lane >= off) gc += t; }
  gcs[lane] = gc; bts[lane] = bi;
  const float g_last = __builtin_bit_cast(float, wv_shfl_u(__builtin_bit_cast(unsigned, gc), 63));
  if (lane == 0 && quarter == 3) c.GL[ch] = g_last;
  wv_fence();
#pragma unroll 1
  for (int bp = 0; bp < 3; ++bp) { const int ib = bp == 0 ? 0 : 1, jb = bp == 2 ? 1 : 0;
    f32x16 Sk = {}, Sq = {};
#pragma unroll
    for (int ks = 0; ks < 8; ++ks) { const bf16x8 kj = wv_ld8(c.GKP + (size_t)ch * 8192 + (size_t)((jb * 8 + ks) * 64 + lane) * 8);
      Sk = wv_mfma32(wv_ld8(c.GKP + (size_t)ch * 8192 + (size_t)((ib * 8 + ks) * 64 + lane) * 8), kj, Sk); if (quarter == 0) Sq = wv_mfma32(wv_ld8(c.GQP + (size_t)ch * 8192 + (size_t)((ib * 8 + ks) * 64 + lane) * 8), kj, Sq); }
    const int j = jb * 32 + r32; const float gcj = gcs[j]; const int slot = vperm16(j);
#pragma unroll
    for (int r = 0; r < 16; ++r) { const int i = ib * 32 + crow16(r, hi); const float dec = expf(gcs[i] - gcj);
      At[j * 64 + i] = (j < i) ? bts[i] * Sk[r] * dec : 0.f; if (quarter == 0) c.GQKp[(size_t)ch * 4096 + frag_idx(i, slot, 64)] = f2bf((j <= i) ? Sq[r] * dec : 0.f); }
  }
  if (quarter == 1) {
#pragma unroll
    for (int rb = 0; rb < 2; ++rb) { const float e = expf(gcs[rb * 32 + r32]);
#pragma unroll
      for (int ks = 0; ks < 8; ++ks) { const size_t idx = (size_t)ch * 8192 + (size_t)((rb * 8 + ks) * 64 + lane) * 8; const u32x4v w = __builtin_bit_cast(u32x4v, wv_ld8(c.GQP + idx));
        *(bf16x8*)(c.GQDp + idx) = wv_pack8(__builtin_bit_cast(float, w.x << 16) * e, __builtin_bit_cast(float, w.x & 0xffff0000u) * e, __builtin_bit_cast(float, w.y << 16) * e, __builtin_bit_cast(float, w.y & 0xffff0000u) * e,
                                            __builtin_bit_cast(float, w.z << 16) * e, __builtin_bit_cast(float, w.z & 0xffff0000u) * e, __builtin_bit_cast(float, w.w << 16) * e, __builtin_bit_cast(float, w.w & 0xffff0000u) * e); } } }
  if (quarter >= 2) { const int pass = quarter - 2; const int dk = lane + 64 * pass; const float* kc = c.GKt + ((size_t)ch * 128 + dk) * 64;
#pragma unroll 2
    for (int g8 = 0; g8 < 8; ++g8) { const int g16 = g8 >> 1, h2 = g8 & 1; const f32x4v lo = *(const f32x4v*)(kc + g16 * 16 + 4 * h2), hv = *(const f32x4v*)(kc + g16 * 16 + 8 + 4 * h2);
      const int i0 = g16 * 16 + 4 * h2;
      *(bf16x8*)(c.GKDTp + (size_t)ch * 8192 + frag_idx(dk, g16 * 16 + h2 * 8, 64)) = wv_pack8(lo.x * expf(g_last - gcs[i0]), lo.y * expf(g_last - gcs[i0 + 1]), lo.z * expf(g_last - gcs[i0 + 2]), lo.w * expf(g_last - gcs[i0 + 3]),
                                                                                                hv.x * expf(g_last - gcs[i0 + 8]), hv.y * expf(g_last - gcs[i0 + 9]), hv.z * expf(g_last - gcs[i0 + 10]), hv.w * expf(g_last - gcs[i0 + 11])); } }
  wv_fence();
  bf16x8 a10[2];
#pragma unroll
  for (int s = 0; s < 2; ++s) { float t[8];
#pragma unroll
    for (int jj = 0; jj < 8; ++jj) t[jj] = At[(16 * s + 8 * hi + jj) * 64 + 32 + r32];
    a10[s] = wv_pack8(t[0], t[1], t[2], t[3], t[4], t[5], t[6], t[7]); }
#pragma unroll 1
  for (int cg = 2 * quarter; cg < 2 * quarter + 2; ++cg) { const bool isu = cg < 4; const int dcol = (cg & 3) * 32 + r32; const float* colp = (isu ? c.GVt : c.GKt) + ((size_t)ch * 128 + dcol) * 64;
    float x0[32], x1[32];
#pragma unroll
    for (int i4 = 0; i4 < 8; ++i4) { const f32x4v t = *(const f32x4v*)(colp + 4 * i4); x0[4 * i4] = t.x; x0[4 * i4 + 1] = t.y; x0[4 * i4 + 2] = t.z; x0[4 * i4 + 3] = t.w; }
#pragma unroll
    for (int i = 0; i < 32; ++i) x0[i] = x0[i] * bts[i] * (isu ? 1.f : expf(gcs[i]));
    tri_solve32(x0, At, 0);
    GDN_FENCE();
    f32x16 D = {};
#pragma unroll
    for (int s = 0; s < 2; ++s) { const bf16x8 bfr = hi ? wv_pack8(x0[16 * s + 8], x0[16 * s + 9], x0[16 * s + 10], x0[16 * s + 11], x0[16 * s + 12], x0[16 * s + 13], x0[16 * s + 14], x0[16 * s + 15])
                                                        : wv_pack8(x0[16 * s], x0[16 * s + 1], x0[16 * s + 2], x0[16 * s + 3], x0[16 * s + 4], x0[16 * s + 5], x0[16 * s + 6], x0[16 * s + 7]);
      D = wv_mfma32(a10[s], bfr, D); }
#pragma unroll
    for (int i4 = 0; i4 < 8; ++i4) { const f32x4v t = *(const f32x4v*)(colp + 32 + 4 * i4); x1[4 * i4] = t.x; x1[4 * i4 + 1] = t.y; x1[4 * i4 + 2] = t.z; x1[4 * i4 + 3] = t.w; }
#pragma unroll
    for (int i = 0; i < 32; ++i) x1[i] = x1[i] * bts[32 + i] * (isu ? 1.f : expf(gcs[32 + i]));
#pragma unroll
    for (int r = 0; r < 16; ++r) { const float oth = wv_shfl_xor_f(D[r], 32);
      const int rme = (r & 3) + 8 * (r >> 2); x1[rme + 4] -= hi ? D[r] : oth; x1[rme] -= hi ? oth : D[r]; }
    GDN_FENCE();
    tri_solve32(x1, At, 32);
    if (isu) { float* gu = c.GS + (((size_t)ch * 4 + (cg & 3)) * 2) * 1024 + lane * 16;
#pragma unroll
      for (int r4 = 0; r4 < 4; ++r4) { const int rb_ = 8 * r4;
        *(f32x4v*)(gu + 4 * r4) = hi ? f32x4v{x0[rb_ + 4], x0[rb_ + 5], x0[rb_ + 6], x0[rb_ + 7]} : f32x4v{x0[rb_], x0[rb_ + 1], x0[rb_ + 2], x0[rb_ + 3]};
        *(f32x4v*)(gu + 1024 + 4 * r4) = hi ? f32x4v{x1[rb_ + 4], x1[rb_ + 5], x1[rb_ + 6], x1[rb_ + 7]} : f32x4v{x1[rb_], x1[rb_ + 1], x1[rb_ + 2], x1[rb_ + 3]}; }
    } else { const int slot = vperm16(dcol); bf16_t* wq = c.GWp + (size_t)ch * 8192;
      const unsigned lpart = (unsigned)frag_idx(4 * hi, slot, 128);
#pragma unroll
      for (int r = 0; r < 16; ++r) { const int row = (r & 3) + 8 * (r >> 2); const float a0 = hi ? x0[row + 4] : x0[row], a1 = hi ? x1[row + 4] : x1[row];
        wq[lpart + (unsigned)(row * 8)] = f2bf(-a0); wq[lpart + (unsigned)(row * 8 + 8 * 512)] = f2bf(-a1); }
    }
  }
  wv_fence();
}
WV_DEV float warm_lines(const void* base, int nlines, size_t pitch, int lane) { float acc = 0.f; for (int k = lane; k < nlines; k += 64) acc += *(const float*)((const char*)base + (size_t)k * pitch); return acc; }
WV_DEV void gdn_scan_unit(const Ctx& c, int unit) {
  const int lane = wv_lane(), r32 = lane & 31, hi = lane >> 5, bbh = unit >> 2, dv0 = (unit & 3) * 32;
  const bool sample = bbh >= BATCH * 4; const int idx = sample ? bbh - BATCH * 4 : bbh, b = idx >> 2, h = idx & 3;
  const int nch = sample ? 1 : NCH, chunk0 = sample ? NCHUNK_P + idx : idx * NCH, nvalid = sample ? DEC_SEQ : 64;
  f32x16 S[4]; const unsigned lst = (unsigned)(hi * 4 * 128 + r32);
#pragma unroll
  for (int kb = 0; kb < 4; ++kb)
#pragma unroll
    for (int r = 0; r < 16; ++r) S[kb][r] = sample ? (c.state_gdn + (((size_t)b * 4 + h) * 128 + kb * 32 + crow16(r, 0)) * 128 + dv0)[lst] : 0.f;
  f32x16 vn[2]; bf16x8 fa[16]; const unsigned l8 = (unsigned)lane * 8u, l16 = (unsigned)lane * 16u;
#define GDN_LOAD_B1(CH) do { const size_t ch_ = (size_t)(CH); \
    _Pragma("unroll") for (int cb = 0; cb < 2; ++cb) { \
      { const float* gu_ = c.GS + ((ch_ * 4 + (dv0 >> 5)) * 2 + cb) * 1024; _Pragma("unroll") for (int r4 = 0; r4 < 4; ++r4) { const f32x4v t_ = *(const f32x4v*)(gu_ + l16 + 4 * r4); vn[cb][4 * r4] = t_.x; vn[cb][4 * r4 + 1] = t_.y; vn[cb][4 * r4 + 2] = t_.z; vn[cb][4 * r4 + 3] = t_.w; } } \
      _Pragma("unroll") for (int q = 0; q < 8; ++q) fa[cb * 8 + q] = wv_ld8(c.GWp + ch_ * 8192 + (cb * 8 + q) * 512 + l8); } } while (0)
  GDN_LOAD_B1(chunk0);
  for (int n = 0; n < nch; ++n) { const int ch = chunk0 + n;
#define GDN_SF(KB, SS) wv_pack8(S[KB][8 * (SS)], S[KB][8 * (SS) + 1], S[KB][8 * (SS) + 2], S[KB][8 * (SS) + 3], S[KB][8 * (SS) + 4], S[KB][8 * (SS) + 5], S[KB][8 * (SS) + 6], S[KB][8 * (SS) + 7])
#pragma unroll
    for (int kb = 0; kb < 4; ++kb) { const bf16x8 s0 = GDN_SF(kb, 0), s1 = GDN_SF(kb, 1);
#pragma unroll
      for (int cb = 0; cb < 2; ++cb) { vn[cb] = wv_mfma32(fa[cb * 8 + kb * 2], s0, vn[cb]); vn[cb] = wv_mfma32(fa[cb * 8 + kb * 2 + 1], s1, vn[cb]); } }
    WV_SCHED_BARRIER();
#pragma unroll
    for (int cb = 0; cb < 2; ++cb)
#pragma unroll
      for (int q = 0; q < 8; ++q) fa[cb * 8 + q] = wv_ld8(c.GQDp + (size_t)ch * 8192 + (cb * 8 + q) * 512 + l8);
    WV_SCHED_BARRIER();
    f32x16 o[2]; o[0] = f32x16{}; o[1] = f32x16{};
#pragma unroll
    for (int kb = 0; kb < 4; ++kb) { const bf16x8 s0 = GDN_SF(kb, 0), s1 = GDN_SF(kb, 1);
#pragma unroll
      for (int cb = 0; cb < 2; ++cb) { o[cb] = wv_mfma32(fa[cb * 8 + kb * 2], s0, o[cb]); o[cb] = wv_mfma32(fa[cb * 8 + kb * 2 + 1], s1, o[cb]); } }
    WV_SCHED_BARRIER();
#undef GDN_SF
    bf16x8 vf[2][2];
#pragma unroll
    for (int kc = 0; kc < 2; ++kc)
#pragma unroll
      for (int s = 0; s < 2; ++s) vf[kc][s] = wv_pack8(vn[kc][8 * s], vn[kc][8 * s + 1], vn[kc][8 * s + 2], vn[kc][8 * s + 3], vn[kc][8 * s + 4], vn[kc][8 * s + 5], vn[kc][8 * s + 6], vn[kc][8 * s + 7]);
    WV_SCHED_BARRIER();
    bf16x8 fq[6];
#pragma unroll
    for (int bp = 0; bp < 3; ++bp) { const int cb = bp == 0 ? 0 : 1, kc = bp == 2 ? 1 : 0; const bf16_t* arow = c.GQKp + (size_t)ch * 4096 + (cb * 4 + kc * 2) * 512; fq[2 * bp] = wv_ld8(arow + l8); fq[2 * bp + 1] = wv_ld8(arow + 512 + l8); }
#pragma unroll
    for (int kb = 0; kb < 4; ++kb)
#pragma unroll
      for (int q = 0; q < 4; ++q) fa[kb * 4 + q] = wv_ld8(c.GKDTp + (size_t)ch * 8192 + (kb * 4 + q) * 512 + l8);
    const float e = expf(c.GL[ch]);
    WV_SCHED_BARRIER();
#pragma unroll
    for (int bp = 0; bp < 3; ++bp) { const int cb = bp == 0 ? 0 : 1, kc = bp == 2 ? 1 : 0; o[cb] = wv_mfma32(fq[2 * bp], vf[kc][0], o[cb]); o[cb] = wv_mfma32(fq[2 * bp + 1], vf[kc][1], o[cb]); }
#pragma unroll
    for (int cb = 0; cb < 2; ++cb) { float* ou = c.OG + (((size_t)ch * 4 + (dv0 >> 5)) * 2 + cb) * 1024;
#pragma unroll
      for (int r = 0; r < 16; ++r) (ou + r * 64)[(unsigned)lane] = o[cb][r]; }
    WV_SCHED_BARRIER();
#pragma unroll
    for (int kb = 0; kb < 4; ++kb) { S[kb] = S[kb] * e;
#pragma unroll
      for (int q = 0; q < 4; ++q) S[kb] = wv_mfma32(fa[kb * 4 + q], vf[q >> 1][q & 1], S[kb]); }
    WV_SCHED_BARRIER();
    if (n + 1 < nch) GDN_LOAD_B1(ch + 1);
  }
#undef GDN_LOAD_B1
  float* so = c.out + (sample ? O_STS : O_STP) + ((size_t)b * 4 + h) * 128 * 128;
#pragma unroll
  for (int kb = 0; kb < 4; ++kb)
#pragma unroll
    for (int r = 0; r < 16; ++r) (so + (size_t)(kb * 32 + crow16(r, 0)) * 128 + dv0)[lst] = S[kb][r];
}
WV_DEV float wv_allsum(float v) {
#pragma unroll
  for (int o = 1; o < 64; o <<= 1) v += wv_shfl_xor_f(v, o);
  return v;
}
WV_DEV void st_pk4(bf16_t* p, f32x4v v) { u32x2v w; w.x = wv_pk_bf16(v.x, v.y); w.y = wv_pk_bf16(v.z, v.w); *(u32x2v*)p = w; }
WV_DEV void ldP8(const Ctx& c, size_t row, int col, float (&x)[8]) {
  if (PBF) { const u32x4v w = *(const u32x4v*)(c.Pb + row * LDP + col);
    x[0] = __builtin_bit_cast(float, w.x << 16); x[1] = __builtin_bit_cast(float, w.x & 0xffff0000u); x[2] = __builtin_bit_cast(float, w.y << 16); x[3] = __builtin_bit_cast(float, w.y & 0xffff0000u);
    x[4] = __builtin_bit_cast(float, w.z << 16); x[5] = __builtin_bit_cast(float, w.z & 0xffff0000u); x[6] = __builtin_bit_cast(float, w.w << 16); x[7] = __builtin_bit_cast(float, w.w & 0xffff0000u); }
  else { const f32x4v a = *(const f32x4v*)(c.P + row * LDP + col), b = *(const f32x4v*)(c.P + row * LDP + col + 4); x[0] = a.x; x[1] = a.y; x[2] = a.z; x[3] = a.w; x[4] = b.x; x[5] = b.y; x[6] = b.z; x[7] = b.w; }
}
WV_DEV float ldP1(const Ctx& c, size_t row, int col) { return PBF ? bfu2f(c.Pb[row * LDP + col]) : c.P[row * LDP + col]; }
WV_DEV void rms_row_unit(const float* src, const float* w, bf16_t* dst) {
  const int lane = wv_lane(); f32x4v v[4]; float ss = 0.f;
#pragma unroll
  for (int j = 0; j < 4; ++j) { v[j] = *(const f32x4v*)(src + lane * 4 + 256 * j); ss += (v[j].x * v[j].x + v[j].y * v[j].y) + (v[j].z * v[j].z + v[j].w * v[j].w); }
  ss = wv_allsum(ss); const float r = 1.f / sqrtf(ss / D_MODEL + EPS);
#pragma unroll
  for (int j = 0; j < 4; ++j) { const f32x4v ww = *(const f32x4v*)(w + lane * 4 + 256 * j); st_pk4(dst + lane * 4 + 256 * j, v[j] * ww * r); }
}
WV_DEV void rms_row4_unit(const float* s0, const float* s1, const float* s2, const float* s3, const float* w, bf16_t* d0, bf16_t* d1, bf16_t* d2, bf16_t* d3) {
  const int lane = wv_lane(); const float* src[4] = {s0, s1, s2, s3}; bf16_t* dst[4] = {d0, d1, d2, d3}; f32x4v v[4][4]; float ss[4];
#pragma unroll
  for (int r = 0; r < 4; ++r)
#pragma unroll
    for (int j = 0; j < 4; ++j) v[r][j] = *(const f32x4v*)(src[r] + lane * 4 + 256 * j);
#pragma unroll
  for (int r = 0; r < 4; ++r) { ss[r] = 0.f;
#pragma unroll
    for (int j = 0; j < 4; ++j) ss[r] += (v[r][j].x * v[r][j].x + v[r][j].y * v[r][j].y) + (v[r][j].z * v[r][j].z + v[r][j].w * v[r][j].w); }
#pragma unroll
  for (int o = 1; o < 64; o <<= 1) {
#pragma unroll
    for (int r = 0; r < 4; ++r) ss[r] += wv_shfl_xor_f(ss[r], o); }
  f32x4v ww[4];
#pragma unroll
  for (int j = 0; j < 4; ++j) ww[j] = *(const f32x4v*)(w + lane * 4 + 256 * j);
#pragma unroll
  for (int r = 0; r < 4; ++r) { const float rr = 1.f / sqrtf(ss[r] / D_MODEL + EPS);
#pragma unroll
    for (int j = 0; j < 4; ++j) st_pk4(dst[r] + lane * 4 + 256 * j, v[r][j] * ww[j] * rr); }
}
WV_DEV void xq_norm_unit(const Ctx& c, int m) {
  const int lane = wv_lane(); const float* q = c.Q2 + (size_t)m * D_MODEL + lane * 16; f32x4v v[4]; float ss = 0.f;
#pragma unroll
  for (int j = 0; j < 4; ++j) { v[j] = *(const f32x4v*)(q + 4 * j); ss += (v[j].x * v[j].x + v[j].y * v[j].y) + (v[j].z * v[j].z + v[j].w * v[j].w); }
  ss += wv_shfl_xor_f(ss, 1); ss += wv_shfl_xor_f(ss, 2); ss += wv_shfl_xor_f(ss, 4); ss += wv_shfl_xor_f(ss, 8);
  const float r = 1.f / sqrtf(ss / 256.f + EPS); const float* w = c.xq_norm_w + (lane & 15) * 16;
#pragma unroll
  for (int j = 0; j < 4; ++j) { const f32x4v ww = *(const f32x4v*)(w + 4 * j); st_pk4(c.Q2b + (size_t)m * D_MODEL + lane * 16 + 4 * j, v[j] * ww * r); }
}
template <int NT> WV_DEV void gdn_norm_unit_t(const Ctx& c, int m0) {
  const int lane = wv_lane(); const int hh = lane >> 4, dv = (lane & 15) * 8; f32x4v a[NT], b[NT]; float z[NT][8];
#pragma unroll
  for (int t = 0; t < NT; ++t) { const int m = m0 + t; ldP8(c, (size_t)m, OFF_Z + lane * 8, z[t]);
    int ch, i; if (m < MP) { const int bq = m / SEQ, tk = m % SEQ; ch = (bq * 4 + hh) * (SEQ / 64) + tk / 64; i = tk % 64; } else { ch = BATCH * 4 * (SEQ / 64) + ((m - MP) / DEC_SEQ) * 4 + hh; i = (m - MP) % DEC_SEQ; }
    const float* og = c.OG + og_idx(ch, i, dv);
    a[t] = *(const f32x4v*)og; b[t] = *(const f32x4v*)(og + 4); }
  const float* w = c.gdn_norm_w + (lane & 15) * 8; const f32x4v wa = *(const f32x4v*)w, wb = *(const f32x4v*)(w + 4);
#pragma unroll
  for (int t = 0; t < NT; ++t) { float ss = (a[t].x * a[t].x + a[t].y * a[t].y) + (a[t].z * a[t].z + a[t].w * a[t].w) + (b[t].x * b[t].x + b[t].y * b[t].y) + (b[t].z * b[t].z + b[t].w * b[t].w);
    ss += wv_shfl_xor_f(ss, 1); ss += wv_shfl_xor_f(ss, 2); ss += wv_shfl_xor_f(ss, 4); ss += wv_shfl_xor_f(ss, 8);
    const float r = 1.f / sqrtf(ss / 128.f + EPS);
    *(bf16x8*)(c.CAT + (size_t)(m0 + t) * D_MODEL + 512 + lane * 8) = wv_pack8(a[t].x * r * wa.x * siluf_(z[t][0]), a[t].y * r * wa.y * siluf_(z[t][1]), a[t].z * r * wa.z * siluf_(z[t][2]), a[t].w * r * wa.w * siluf_(z[t][3]),
                                                                                b[t].x * r * wb.x * siluf_(z[t][4]), b[t].y * r * wb.y * siluf_(z[t][5]), b[t].z * r * wb.z * siluf_(z[t][6]), b[t].w * r * wb.w * siluf_(z[t][7])); }
}
WV_DEV void gdn_norm_unit(const Ctx& c, int m) { gdn_norm_unit_t<1>(c, m); }
struct StRope { const Ctx& c; static constexpr long N = (long)(SEQ + DEC_SEQ) * 32;
  HD void operator()(long i) const { const int d = (int)(i % 32), r = (int)(i / 32); const int pos = r < SEQ ? r : PAST_LEN + (r - SEQ);
    const float inv = powf(10000.f, -(float)d / 32.f), ang = (float)pos * inv; c.ROPE[(size_t)r * 64 + d] = cosf(ang); c.ROPE[(size_t)r * 64 + 32 + d] = sinf(ang); } };
WV_DEV void postproc_unit(const Ctx& c, int m) {
  const int lane = wv_lane(), j = lane & 7; const int pos = row_pos(m);
  float cs[8], sn[8];
  { const float* rt = c.ROPE + (size_t)(m < MP ? pos : SEQ + (pos - PAST_LEN)) * 64 + (j & 3) * 8; const f32x4v c0 = *(const f32x4v*)rt, c1 = *(const f32x4v*)(rt + 4), s0 = *(const f32x4v*)(rt + 32), s1 = *(const f32x4v*)(rt + 36);
    cs[0] = c0.x; cs[1] = c0.y; cs[2] = c0.z; cs[3] = c0.w; cs[4] = c1.x; cs[5] = c1.y; cs[6] = c1.z; cs[7] = c1.w; sn[0] = s0.x; sn[1] = s0.y; sn[2] = s0.z; sn[3] = s0.w; sn[4] = s1.x; sn[5] = s1.y; sn[6] = s1.z; sn[7] = s1.w; }
  const bool lowhalf = j < 4;
  { const int h = lane >> 3; float x[8]; ldP8(c, (size_t)m, h * 64 + j * 8, x); float ss = 0.f;
#pragma unroll
    for (int i = 0; i < 8; ++i) ss += x[i] * x[i];
    ss += wv_shfl_xor_f(ss, 1); ss += wv_shfl_xor_f(ss, 2); ss += wv_shfl_xor_f(ss, 4);
    const float r = 1.f / sqrtf(ss / 64.f + EPS); float o[8];
#pragma unroll
    for (int i = 0; i < 8; ++i) x[i] = x[i] * r * c.nsa_q_norm_w[j * 8 + i];
#pragma unroll
    for (int i = 0; i < 8; ++i) { const float pa = wv_shfl_xor_f(x[i], 4); o[i] = lowhalf ? x[i] * cs[i] - pa * sn[i] : pa * sn[i] + x[i] * cs[i]; }
    *(bf16x8*)(c.QCb + (size_t)m * 512 + h * 64 + j * 8) = wv_pack8(x[0], x[1], x[2], x[3], x[4], x[5], x[6], x[7]);
    *(bf16x8*)(c.QRb + (size_t)m * 512 + h * 64 + j * 8) = wv_pack8(o[0], o[1], o[2], o[3], o[4], o[5], o[6], o[7]); }
#pragma unroll
  for (int pass = 0; pass < 2; ++pass) {
    const int s = pass * 8 + (lane >> 3); const bool act = s < 12; const int sc = act ? s : 11, kv = (sc >> 1) & 1, br = sc >> 2, kvh = sc & 1;
    float x[8]; ldP8(c, (size_t)m, OFF_KV + sc * 64 + j * 8, x); float ss = 0.f;
#pragma unroll
    for (int i = 0; i < 8; ++i) ss += x[i] * x[i];
    ss += wv_shfl_xor_f(ss, 1); ss += wv_shfl_xor_f(ss, 2); ss += wv_shfl_xor_f(ss, 4);
    const float r = 1.f / sqrtf(ss / 64.f + EPS);
    if (kv == 0) {
#pragma unroll
      for (int i = 0; i < 8; ++i) x[i] = x[i] * r * c.nsa_k_norm_w[br * 64 + j * 8 + i]; }
    float o[8];
#pragma unroll
    for (int i = 0; i < 8; ++i) { const float pa = wv_shfl_xor_f(x[i], 4); o[i] = (kv == 0 && br >= 1) ? (lowhalf ? x[i] * cs[i] - pa * sn[i] : pa * sn[i] + x[i] * cs[i]) : x[i]; }
    if (act) {
      float* dst = sc < 8 ? kvrow_out(c, m) + sc * 64 + j * 8 : c.WR + (size_t)m * 256 + (sc - 8) * 64 + j * 8;
      *(f32x4v*)dst = f32x4v{o[0], o[1], o[2], o[3]}; *(f32x4v*)(dst + 4) = f32x4v{o[4], o[5], o[6], o[7]};
      if (kv == 0 && br >= 1 && m < MP) { bf16_t* kb = (br == 1 ? c.KSb : c.KWb) + ((size_t)(m / SEQ) * 2 + kvh) * SEQ * 64 + frag_idx(m % SEQ, j * 8, 64);
        *(bf16x8*)kb = wv_pack8(o[0], o[1], o[2], o[3], o[4], o[5], o[6], o[7]); }
    }
  }
  if (lane < 24) c.GATE[(size_t)m * 24 + lane] = sigmoidf_(ldP1(c, (size_t)m, OFF_GATE + lane));
  if (lane < 4) { c.GB[(size_t)m * 4 + lane] = sigmoidf_(ldP1(c, (size_t)m, OFF_B + lane)); c.GG[(size_t)m * 4 + lane] = -expf(c.gdn_a_log[lane]) * softplusf_(ldP1(c, (size_t)m, OFF_A + lane) + c.gdn_dt_bias[lane]); }
}
WV_DEV void gdn_conv_unit(const Ctx& c, int m) {
  const int lane = wv_lane(); const int t = row_t(m);
#pragma unroll
  for (int seg = 0; seg < 3; ++seg) { const int ch = seg * 512 + lane * 8; float y[8] = {0.f, 0.f, 0.f, 0.f, 0.f, 0.f, 0.f, 0.f};
#pragma unroll
    for (int k = 0; k < 4; ++k) { const int back = 3 - k; float xin[8]; bool have = true;
      if (t - back >= 0) ldP8(c, (size_t)(m - back), OFF_QKV + ch, xin);
      else if (m >= MP) { const float* src = c.cache_gdn_conv + ((size_t)((m - MP) / DEC_SEQ) * 3 + (3 + t - back)) * 1536 + ch; const f32x4v a = *(const f32x4v*)src, b = *(const f32x4v*)(src + 4); xin[0] = a.x; xin[1] = a.y; xin[2] = a.z; xin[3] = a.w; xin[4] = b.x; xin[5] = b.y; xin[6] = b.z; xin[7] = b.w; }
      else have = false;
      if (have) { const f32x4v wa = *(const f32x4v*)(c.gdn_conv_w + k * 1536 + ch), wb = *(const f32x4v*)(c.gdn_conv_w + k * 1536 + ch + 4);
        y[0] += wa.x * xin[0]; y[1] += wa.y * xin[1]; y[2] += wa.z * xin[2]; y[3] += wa.w * xin[3]; y[4] += wb.x * xin[4]; y[5] += wb.y * xin[5]; y[6] += wb.z * xin[6]; y[7] += wb.w * xin[7]; } }
    float ss = 0.f;
#pragma unroll
    for (int i = 0; i < 8; ++i) { y[i] = siluf_(y[i]); ss += y[i] * y[i]; }
    ss += wv_shfl_xor_f(ss, 1); ss += wv_shfl_xor_f(ss, 2); ss += wv_shfl_xor_f(ss, 4); ss += wv_shfl_xor_f(ss, 8);
    const float r = seg == 2 ? 1.f : (1.f / sqrtf(ss + EPS)) * (seg == 0 ? 0.08838834764831845f : 1.f);
    float* dst = (seg == 0 ? c.GQ : seg == 1 ? c.GK : c.GV) + (size_t)m * 512 + lane * 8;
    *(f32x4v*)dst = f32x4v{y[0] * r, y[1] * r, y[2] * r, y[3] * r}; *(f32x4v*)(dst + 4) = f32x4v{y[4] * r, y[5] * r, y[6] * r, y[7] * r};
    if (seg < 2) {
      const int hh = lane >> 4, g8 = lane & 15, s16 = g8 >> 1, nh = g8 & 1; int chk, ti; if (m < MP) { chk = ((m / SEQ) * 4 + hh) * (SEQ / 64) + (m % SEQ) / 64; ti = m % 64; } else { chk = BATCH * 4 * (SEQ / 64) + ((m - MP) / DEC_SEQ) * 4 + hh; ti = (m - MP) % DEC_SEQ; }
      bf16_t* img = (seg == 0 ? c.GQP : c.GKP) + (size_t)chk * 8192 + ((size_t)(ti >> 5) * 8 + s16) * 512 + (ti & 31) * 8 + 4 * nh;
      u32x2v lo, hv; lo.x = wv_pk_bf16(y[0] * r, y[1] * r); lo.y = wv_pk_bf16(y[2] * r, y[3] * r); hv.x = wv_pk_bf16(y[4] * r, y[5] * r); hv.y = wv_pk_bf16(y[6] * r, y[7] * r);
      *(u32x2v*)img = lo; *(u32x2v*)(img + 32 * 8) = hv; }
  }
}
constexpr int CONV4_UNITS = MTOT / 4;
WV_DEV void gdn_conv4_unit(const Ctx& c, int unit) {
  const int lane = wv_lane(), hh = lane >> 4, g8 = lane & 15, s16 = g8 >> 1, nh = g8 & 1; const int m0 = unit * 4, t0 = row_t(m0);
  int chk, ti; if (m0 < MP) { chk = ((m0 / SEQ) * 4 + hh) * (SEQ / 64) + (m0 % SEQ) / 64; ti = m0 % 64; } else { chk = BATCH * 4 * (SEQ / 64) + ((m0 - MP) / DEC_SEQ) * 4 + hh; ti = (m0 - MP) % DEC_SEQ; }
#pragma unroll 1
  for (int seg = 0; seg < 3; ++seg) { const int ch = seg * 512 + lane * 8; float xin[7][8];
#pragma unroll
    for (int r = 0; r < 7; ++r) { const int t = t0 - 3 + r;
      if (t >= 0) ldP8(c, (size_t)(m0 - 3 + r), OFF_QKV + ch, xin[r]);
      else if (m0 >= MP) { const float* src = c.cache_gdn_conv + ((size_t)((m0 - MP) / DEC_SEQ) * 3 + (3 + t)) * 1536 + ch; const f32x4v a = *(const f32x4v*)src, b = *(const f32x4v*)(src + 4); xin[r][0] = a.x; xin[r][1] = a.y; xin[r][2] = a.z; xin[r][3] = a.w; xin[r][4] = b.x; xin[r][5] = b.y; xin[r][6] = b.z; xin[r][7] = b.w; }
      else {
#pragma unroll
        for (int i = 0; i < 8; ++i) xin[r][i] = 0.f; } }
    float w[4][8];
#pragma unroll
    for (int k = 0; k < 4; ++k) { const f32x4v wa = *(const f32x4v*)(c.gdn_conv_w + k * 1536 + ch), wb = *(const f32x4v*)(c.gdn_conv_w + k * 1536 + ch + 4); w[k][0] = wa.x; w[k][1] = wa.y; w[k][2] = wa.z; w[k][3] = wa.w; w[k][4] = wb.x; w[k][5] = wb.y; w[k][6] = wb.z; w[k][7] = wb.w; }
    float y[4][8];
#pragma unroll
    for (int tk = 0; tk < 4; ++tk) { float ss = 0.f;
#pragma unroll
      for (int i = 0; i < 8; ++i) { float v = w[0][i] * xin[tk][i] + w[1][i] * xin[tk + 1][i] + w[2][i] * xin[tk + 2][i] + w[3][i] * xin[tk + 3][i]; v = siluf_(v); y[tk][i] = v; ss += v * v; }
      ss += wv_shfl_xor_f(ss, 1); ss += wv_shfl_xor_f(ss, 2); ss += wv_shfl_xor_f(ss, 4); ss += wv_shfl_xor_f(ss, 8);
      const float r = seg == 2 ? 1.f : (1.f / sqrtf(ss + EPS)) * (seg == 0 ? 0.08838834764831845f : 1.f);
#pragma unroll
      for (int i = 0; i < 8; ++i) y[tk][i] *= r; }
    if (seg < 2) {
#pragma unroll
      for (int tk = 0; tk < 4; ++tk) { const int tt = ti + tk; bf16_t* img = (seg == 0 ? c.GQP : c.GKP) + (size_t)chk * 8192 + ((size_t)(tt >> 5) * 8 + s16) * 512 + (tt & 31) * 8 + 4 * nh;
        u32x2v lo, hv; lo.x = wv_pk_bf16(y[tk][0], y[tk][1]); lo.y = wv_pk_bf16(y[tk][2], y[tk][3]); hv.x = wv_pk_bf16(y[tk][4], y[tk][5]); hv.y = wv_pk_bf16(y[tk][6], y[tk][7]);
        *(u32x2v*)img = lo; *(u32x2v*)(img + 32 * 8) = hv; } }
    if (seg >= 1) { float* tp = (seg == 1 ? c.GKt : c.GVt) + ((size_t)chk * 128 + g8 * 8) * 64 + ti;
#pragma unroll
      for (int i = 0; i < 8; ++i) *(f32x4v*)(tp + (size_t)i * 64) = f32x4v{y[0][i], y[1][i], y[2][i], y[3][i]}; }
  }
}
constexpr int VT_UNITS = 2 * BATCH * 2 * (SEQ / 16);
WV_DEV void vt_unit(const Ctx& c, int unit) {
  const int lane = wv_lane(); const int g16 = unit % (SEQ / 16); int r = unit / (SEQ / 16); const int kvh = r & 1; r >>= 1; const int b = r % BATCH, img = r / BATCH;
  const int col = OFF_KV + (((img + 1) * 2 + 1) * 2 + kvh) * 64 + lane; float v[16];
#pragma unroll
  for (int i = 0; i < 16; ++i) v[i] = ldP1(c, (size_t)b * SEQ + g16 * 16 + i, col);
  bf16_t* dst = (img == 0 ? c.VSTb : c.VWTb) + ((size_t)b * 2 + kvh) * 64 * SEQ;
  *(bf16x8*)(dst + frag_idx(lane, g16 * 16, SEQ)) = wv_pack8(v[0], v[1], v[2], v[3], v[8], v[9], v[10], v[11]); *(bf16x8*)(dst + frag_idx(lane, g16 * 16 + 8, SEQ)) = wv_pack8(v[4], v[5], v[6], v[7], v[12], v[13], v[14], v[15]);
}
constexpr int NCHK_P = SEQ / 16, NCHK_S = PAST_LEN / 16;
constexpr int CMP_UNITS_P = 2 * BATCH * 2 * (NCHK_P / 32), CMP_UNITS_S = 2 * DEC_BATCH * 2 * (NCHK_S / 32);
HD size_t pp_off(bool sample, int kv, int bk  , int n) {
  return sample ? ((size_t)2 * BATCH * 2 * NCHK_P + ((size_t)(kv * DEC_BATCH * 2 + bk)) * NCHK_S + n) * 128 : (((size_t)(kv * BATCH * 2 + bk)) * NCHK_P + n) * 128; }
struct StCmpWT { const Ctx& c; static constexpr long N = 2 * 2 * 64 * 1024;
  HD void operator()(long i) const { const int k = (int)(i % 1024), e = (int)((i / 1024) % 64), half = (int)((i / 65536) % 2), kv = (int)(i / 131072);
    c.WcT[(size_t)kv * 131072 + frag_idx(half * 64 + e, k, 1024)] = f2bf(c.cmp_w[(((size_t)kv * 32 + half * 16 + k / 64) * 64 + k % 64) * 64 + e]); } };
struct StCmpBias { const Ctx& c; static constexpr long N = 128;
  HD void operator()(long i) const { const int e = (int)(i % 64), kv = (int)(i / 64); float s = 0.f;
    for (int jd = 0; jd < 2048; ++jd) s += c.cmp_pe[(size_t)kv * 2048 + jd] * c.cmp_w[((size_t)kv * 2048 + jd) * 64 + e];
    c.CBIAS[i] = s; } };
WV_DEV void cmp_bias_unit(const Ctx& c, int unit) {
  const int lane = wv_lane(), e = unit & 63, kv = unit >> 6; float s = 0.f;
#pragma unroll 4
  for (int k = 0; k < 32; ++k) { const int jd = lane + 64 * k; s += c.cmp_pe[(size_t)kv * 2048 + jd] * c.cmp_w[((size_t)kv * 2048 + jd) * 64 + e]; }
  s = wv_allsum(s); if (lane == 0) c.CBIAS[unit] = s;
}
constexpr int CMP_LDS_ROW = 72;
template <bool SAMPLE> WV_DEV void compress_unit(const Ctx& c, int unit, bf16_t* wlds  ) {
  constexpr int NG = (SAMPLE ? NCHK_S : NCHK_P) / 32, NB = SAMPLE ? DEC_BATCH : BATCH;
  const int lane = wv_lane(), r32 = lane & 31, hi = lane >> 5;
  const int grp = unit % NG; int r = unit / NG; const int kvh = r & 1; r >>= 1; const int b = r % NB, kv = r / NB;
  const float* srow[8];
#pragma unroll
  for (int q = 0; q < 8; ++q) { const int n = grp * 32 + 4 * q + (lane >> 4);
    if (!SAMPLE) srow[q] = c.out + O_KVP + ((size_t)b * SEQ + 16 * n) * 512 + (kv * 2 + kvh) * 64 + (lane & 15) * 4;
    else { const int pos = 16 * n, pg = c.page_table[b * NPAGES + pos / PAGE_SIZE]; srow[q] = c.cache_nsa_kv + ((size_t)pg * PAGE_SIZE + pos % PAGE_SIZE) * 512 + (kv * 2 + kvh) * 64 + (lane & 15) * 4; } }
  const bf16_t* wt = c.WcT + (size_t)kv * 2 * 64 * 1024 + lane * 8;
  f32x16 acc[4];
#pragma unroll
  for (int t = 0; t < 4; ++t) acc[t] = f32x16{};
  f32x4v st[8];
#pragma unroll
  for (int q = 0; q < 8; ++q) st[q] = *(const f32x4v*)srow[q];
#pragma unroll 1
  for (int j = 0; j < 16; ++j) { bf16_t* buf = wlds + (j & 1) * 32 * CMP_LDS_ROW;
#pragma unroll
    for (int q = 0; q < 8; ++q) st_pk4(buf + (4 * q + (lane >> 4)) * CMP_LDS_ROW + (lane & 15) * 4, st[q]);
    if (j + 1 < 16) {
#pragma unroll
      for (int q = 0; q < 8; ++q) st[q] = *(const f32x4v*)(srow[q] + (size_t)(j + 1) * 512); }
    wv_fence_lds();
#pragma unroll
    for (int k4 = 0; k4 < 4; ++k4) { const bf16x8 af = wv_ld8(buf + r32 * CMP_LDS_ROW + k4 * 16 + hi * 8); const int ks = j * 4 + k4;
#pragma unroll
      for (int t = 0; t < 4; ++t) acc[t] = wv_mfma32(af, wv_ld8(wt + (size_t)(t * 64 + ks) * 512), acc[t]); }
  }
  float* pp = c.PP + pp_off(SAMPLE, kv, b * 2 + kvh, grp * 32);
#pragma unroll
  for (int t = 0; t < 4; ++t)
#pragma unroll
    for (int rr = 0; rr < 16; ++rr) pp[(size_t)crow16(rr, hi) * 128 + t * 32 + r32] = acc[t][rr];
}
struct StPackCmp2 { const Ctx& c; static constexpr long N = NPC_P + NPC_S;
  HD void operator()(long i) const {
    const bool sample = i >= NPC_P; long r = sample ? i - NPC_P : i; const int cpad = sample ? 512 : 128, nc = sample ? NCS : NCP;
    const int d = (int)(r % 64); r /= 64; const int cb = (int)(r % cpad); r /= cpad; const int kvh = (int)(r % 2), b = (int)(r / 2);
    float k = 0.f, v = 0.f;
    if (cb < nc) { k = c.PP[pp_off(sample, 0, b * 2 + kvh, cb) + d] + c.PP[pp_off(sample, 0, b * 2 + kvh, cb + 1) + 64 + d] + c.CBIAS[d];
                   v = c.PP[pp_off(sample, 1, b * 2 + kvh, cb) + d] + c.PP[pp_off(sample, 1, b * 2 + kvh, cb + 1) + 64 + d] + c.CBIAS[64 + d]; }
    const size_t o = kc_off(sample, b, kvh);
    c.KCb[o + frag_idx(cb, d, 64)] = f2bf(k); c.VCTb[o + frag_idx(d, vperm16(cb), cpad)] = f2bf(v);
  } };
WV_DEV void memkv_unit(const Ctx& c, int mm) {
  const int lane = wv_lane(), h = lane >> 4, dd = (lane & 15) * 16; const float* k = c.MKV + (size_t)mm * 2048 + lane * 16; const float* v = k + 1024;
  f32x4v kv[4], vv[4]; float ss = 0.f;
#pragma unroll
  for (int j = 0; j < 4; ++j) { kv[j] = *(const f32x4v*)(k + 4 * j); vv[j] = *(const f32x4v*)(v + 4 * j); ss += (kv[j].x * kv[j].x + kv[j].y * kv[j].y) + (kv[j].z * kv[j].z + kv[j].w * kv[j].w); }
  ss += wv_shfl_xor_f(ss, 1); ss += wv_shfl_xor_f(ss, 2); ss += wv_shfl_xor_f(ss, 4); ss += wv_shfl_xor_f(ss, 8);
  const float r = 1.f / sqrtf(ss / 256.f + EPS); float* o = c.out + O_MKVP + (size_t)mm * 2048 + lane * 16;
#pragma unroll
  for (int j = 0; j < 4; ++j) { kv[j] = kv[j] * *(const f32x4v*)(c.xk_norm_w + dd + 4 * j) * r; *(f32x4v*)(o + 4 * j) = kv[j]; *(f32x4v*)(o + 1024 + 4 * j) = vv[j]; }
  const int bb = mm / MEM_TOKENS, jj = mm % MEM_TOKENS; bf16_t* kb = c.KXb + ((size_t)bb * 4 + h) * MEM_TOKENS * 256;
#pragma unroll
  for (int j = 0; j < 4; ++j) kv[j] = kv[j] * *(const f32x4v*)(c.xq_norm_w + dd + 4 * j);
  *(bf16x8*)(kb + frag_idx(jj, dd, 256)) = wv_pack8(kv[0].x, kv[0].y, kv[0].z, kv[0].w, kv[1].x, kv[1].y, kv[1].z, kv[1].w); *(bf16x8*)(kb + frag_idx(jj, dd + 8, 256)) = wv_pack8(kv[2].x, kv[2].y, kv[2].z, kv[2].w, kv[3].x, kv[3].y, kv[3].z, kv[3].w);
}
WV_DEV void xk_pack_unit(const Ctx& c, int row  ) {
  const int lane = wv_lane(), h = lane >> 4, dd = (lane & 15) * 16; const float* k = c.cache_mem_kv + (size_t)row * 2048 + lane * 16;
  const float* wq = c.xq_norm_w + dd; const f32x4v a = *(const f32x4v*)k * *(const f32x4v*)wq, b = *(const f32x4v*)(k + 4) * *(const f32x4v*)(wq + 4), e = *(const f32x4v*)(k + 8) * *(const f32x4v*)(wq + 8), f = *(const f32x4v*)(k + 12) * *(const f32x4v*)(wq + 12);
  const int bb = BATCH + row / MEM_TOKENS, jj = row % MEM_TOKENS; bf16_t* kb = c.KXb + ((size_t)bb * 4 + h) * MEM_TOKENS * 256;
  *(bf16x8*)(kb + frag_idx(jj, dd, 256)) = wv_pack8(a.x, a.y, a.z, a.w, b.x, b.y, b.z, b.w); *(bf16x8*)(kb + frag_idx(jj, dd + 8, 256)) = wv_pack8(e.x, e.y, e.z, e.w, f.x, f.y, f.z, f.w);
}
constexpr int XVT_UNITS = (BATCH + DEC_BATCH) * 4 * (MEM_TOKENS / 16) * 4;
WV_DEV void xvt_unit(const Ctx& c, int unit) {
  const int lane = wv_lane(); const int dblk = unit & 3; int r = unit >> 2; const int g16 = r % (MEM_TOKENS / 16); r /= (MEM_TOKENS / 16); const int h = r & 3, bb = r >> 2;
  const int d = dblk * 64 + lane;
  const float* src = (bb < BATCH ? c.MKV + ((size_t)bb * MEM_TOKENS + g16 * 16) * 2048 : c.cache_mem_kv + ((size_t)(bb - BATCH) * MEM_TOKENS + g16 * 16) * 2048) + 1024 + h * 256 + d; float v[16];
#pragma unroll
  for (int i = 0; i < 16; ++i) v[i] = src[(size_t)i * 2048];
  bf16_t* dst = c.VXTb + ((size_t)bb * 4 + h) * 256 * MEM_TOKENS;
  *(bf16x8*)(dst + frag_idx(d, g16 * 16, MEM_TOKENS)) = wv_pack8(v[0], v[1], v[2], v[3], v[8], v[9], v[10], v[11]); *(bf16x8*)(dst + frag_idx(d, g16 * 16 + 8, MEM_TOKENS)) = wv_pack8(v[4], v[5], v[6], v[7], v[12], v[13], v[14], v[15]);
}
HD const float* wall_row(const Ctx& c, int b, int w) {
  if (w < WBUF) return c.cache_nsa_win + ((size_t)b * WBUF + w) * 256;
  if (w < WBUF + DEC_SEQ) return c.WR + ((size_t)MP + b * DEC_SEQ + (w - WBUF)) * 256;
  return nullptr;
}
constexpr int WKS_UNITS = DEC_BATCH * 2 * (WKS / 8), WVS_UNITS = DEC_BATCH * 2 * (WKS / 16);
WV_DEV void winks_unit(const Ctx& c, int unit) {
  const int lane = wv_lane(); const int g8 = unit % (WKS / 8); int r = unit / (WKS / 8); const int kvh = r & 1, b = r >> 1; const int w = g8 * 8 + (lane >> 3), j = lane & 7;
  const float* src = wall_row(c, b, w); f32x4v a = {0.f, 0.f, 0.f, 0.f}, e = {0.f, 0.f, 0.f, 0.f};
  if (src) { a = *(const f32x4v*)(src + (0 * 2 + kvh) * 64 + j * 8); e = *(const f32x4v*)(src + (0 * 2 + kvh) * 64 + j * 8 + 4); }
  *(bf16x8*)(c.KWsb + ((size_t)b * 2 + kvh) * WKS * 64 + frag_idx(w, j * 8, 64)) = wv_pack8(a.x, a.y, a.z, a.w, e.x, e.y, e.z, e.w);
}
WV_DEV void winvs_unit(const Ctx& c, int unit) {
  const int lane = wv_lane(); const int g16 = unit % (WKS / 16); int r = unit / (WKS / 16); const int kvh = r & 1, b = r >> 1; float v[16];
#pragma unroll
  for (int i = 0; i < 16; ++i) { const float* src = wall_row(c, b, g16 * 16 + i); v[i] = src ? src[(1 * 2 + kvh) * 64 + lane] : 0.f; }
  bf16_t* dst = c.VWTsb + ((size_t)b * 2 + kvh) * 64 * WKS;
  *(bf16x8*)(dst + frag_idx(lane, g16 * 16, WKS)) = wv_pack8(v[0], v[1], v[2], v[3], v[8], v[9], v[10], v[11]); *(bf16x8*)(dst + frag_idx(lane, g16 * 16 + 8, WKS)) = wv_pack8(v[4], v[5], v[6], v[7], v[12], v[13], v[14], v[15]);
}
struct StWinOut4 { const Ctx& c; static constexpr long N = (long)(BATCH + DEC_BATCH) * WINDOW * 64;
  HD void operator()(long i) const {
    const int e = (int)(i % 64) * 4; const long r = i / 64; const int j = (int)(r % WINDOW), bb = (int)(r / WINDOW);
    if (bb < BATCH) *(f32x4v*)(c.out + O_WINP + ((size_t)bb * WINDOW + j) * 256 + e) = *(const f32x4v*)(c.WR + ((size_t)bb * SEQ + SEQ - WINDOW + j) * 256 + e);
    else { const int b = bb - BATCH; *(f32x4v*)(c.out + O_WINS + ((size_t)b * WINDOW + j) * 256 + e) = *(const f32x4v*)(wall_row(c, b, j + DEC_SEQ) + e); }
  } };
constexpr int FFN_CB = D_FF / 256, FFN_UNITS = (BATCH * (SEQ / 8) + DEC_BATCH) * FFN_CB;
WV_DEV f32x4v ld4bf(const bf16_t* p) { const u32x2v w = *(const u32x2v*)p; return f32x4v{__builtin_bit_cast(float, w.x << 16), __builtin_bit_cast(float, w.x & 0xffff0000u), __builtin_bit_cast(float, w.y << 16), __builtin_bit_cast(float, w.y & 0xffff0000u)}; }
template <bool UPBF> WV_DEV void ffn_act_unit_t(const Ctx& c, int unit) {
  const int lane = wv_lane(); const int cb = unit % FFN_CB, sg = unit / FFN_CB; const int col = cb * 256 + lane * 4;
  const bool sample = sg >= BATCH * (SEQ / 8); const int m0 = sample ? MP + (sg - BATCH * (SEQ / 8)) * DEC_SEQ : sg * 8; const int t0 = sample ? 0 : (sg % (SEQ / 8)) * 8;
  f32x4v wa[3], wu[3];
#pragma unroll
  for (int k = 0; k < 3; ++k) { wa[k] = *(const f32x4v*)(c.ffn_conv_w + (size_t)k * 2 * D_FF + col); wu[k] = *(const f32x4v*)(c.ffn_conv_w + (size_t)k * 2 * D_FF + D_FF + col); }
  const f32x4v ba = *(const f32x4v*)(c.ffn_conv_b + col), bu = *(const f32x4v*)(c.ffn_conv_b + D_FF + col);
  auto ldup = [&](int m, int cc) -> f32x4v { if (UPBF) return ld4bf(c.UPb + (size_t)m * (2 * D_FF) + cc); return *(const f32x4v*)(c.UP + (size_t)m * (2 * D_FF) + cc); };
  f32x4v a2 = {0.f, 0.f, 0.f, 0.f}, a1 = a2, u2 = a2, u1 = a2;
  if (t0 >= 2) { a2 = ldup(m0 - 2, col); u2 = ldup(m0 - 2, D_FF + col); a1 = ldup(m0 - 1, col); u1 = ldup(m0 - 1, D_FF + col); }
  else if (sample) { const float* p2 = c.cache_ffn_conv + (size_t)(sg - BATCH * (SEQ / 8)) * 2 * (2 * D_FF) + col; a2 = *(const f32x4v*)p2; u2 = *(const f32x4v*)(p2 + D_FF); a1 = *(const f32x4v*)(p2 + 2 * D_FF); u1 = *(const f32x4v*)(p2 + 3 * D_FF); }
#pragma unroll
  for (int t = 0; t < 8; ++t) { const f32x4v a0 = ldup(m0 + t, col), u0 = ldup(m0 + t, D_FF + col);
    const f32x4v ya = ba + wa[0] * a2 + wa[1] * a1 + wa[2] * a0, yu = bu + wu[0] * u2 + wu[1] * u1 + wu[2] * u0;
    st_pk4(c.ACT + (size_t)(m0 + t) * D_FF + col, f32x4v{siluf_(ya.x) * yu.x, siluf_(ya.y) * yu.y, siluf_(ya.z) * yu.z, siluf_(ya.w) * yu.w});
    a2 = a1; a1 = a0; u2 = u1; u1 = u0; }
}
constexpr int FFN_CB8 = (D_FF + 511) / 512, FFN_UNITS8 = (BATCH * (SEQ / 8) + DEC_BATCH) * FFN_CB8;
WV_DEV void ld8bf(const bf16_t* p, float (&x)[8]) { const u32x4v w = *(const u32x4v*)p;
  x[0] = __builtin_bit_cast(float, w.x << 16); x[1] = __builtin_bit_cast(float, w.x & 0xffff0000u); x[2] = __builtin_bit_cast(float, w.y << 16); x[3] = __builtin_bit_cast(float, w.y & 0xffff0000u);
  x[4] = __builtin_bit_cast(float, w.z << 16); x[5] = __builtin_bit_cast(float, w.z & 0xffff0000u); x[6] = __builtin_bit_cast(float, w.w << 16); x[7] = __builtin_bit_cast(float, w.w & 0xffff0000u); }
WV_DEV void ffn_act8_unit(const Ctx& c, int unit) {
  const int lane = wv_lane(); const int cb = unit % FFN_CB8, sg = unit / FFN_CB8; const int col = cb * 512 + lane * 8; if (col >= D_FF) return;
  const bool sample = sg >= BATCH * (SEQ / 8); const int m0 = sample ? MP + (sg - BATCH * (SEQ / 8)) * DEC_SEQ : sg * 8; const int t0 = sample ? 0 : (sg % (SEQ / 8)) * 8;
  float wa[3][8], wu[3][8], ba[8], bu[8];
#pragma unroll
  for (int k = 0; k < 3; ++k)
#pragma unroll
    for (int i4 = 0; i4 < 2; ++i4) { const f32x4v x = *(const f32x4v*)(c.ffn_conv_w + (size_t)k * 2 * D_FF + col + 4 * i4), y = *(const f32x4v*)(c.ffn_conv_w + (size_t)k * 2 * D_FF + D_FF + col + 4 * i4);
      wa[k][4 * i4] = x.x; wa[k][4 * i4 + 1] = x.y; wa[k][4 * i4 + 2] = x.z; wa[k][4 * i4 + 3] = x.w; wu[k][4 * i4] = y.x; wu[k][4 * i4 + 1] = y.y; wu[k][4 * i4 + 2] = y.z; wu[k][4 * i4 + 3] = y.w; }
#pragma unroll
  for (int i4 = 0; i4 < 2; ++i4) { const f32x4v x = *(const f32x4v*)(c.ffn_conv_b + col + 4 * i4), y = *(const f32x4v*)(c.ffn_conv_b + D_FF + col + 4 * i4);
    ba[4 * i4] = x.x; ba[4 * i4 + 1] = x.y; ba[4 * i4 + 2] = x.z; ba[4 * i4 + 3] = x.w; bu[4 * i4] = y.x; bu[4 * i4 + 1] = y.y; bu[4 * i4 + 2] = y.z; bu[4 * i4 + 3] = y.w; }
  float a2[8], a1[8], u2[8], u1[8];
#pragma unroll
  for (int i = 0; i < 8; ++i) { a2[i] = 0.f; a1[i] = 0.f; u2[i] = 0.f; u1[i] = 0.f; }
  if (t0 >= 2) { ld8bf(c.UPb + (size_t)(m0 - 2) * (2 * D_FF) + col, a2); ld8bf(c.UPb + (size_t)(m0 - 2) * (2 * D_FF) + D_FF + col, u2); ld8bf(c.UPb + (size_t)(m0 - 1) * (2 * D_FF) + col, a1); ld8bf(c.UPb + (size_t)(m0 - 1) * (2 * D_FF) + D_FF + col, u1); }
  else if (sample) { const float* p2 = c.cache_ffn_conv + (size_t)(sg - BATCH * (SEQ / 8)) * 2 * (2 * D_FF) + col;
#pragma unroll
    for (int i = 0; i < 8; ++i) { a2[i] = p2[i]; u2[i] = p2[D_FF + i]; a1[i] = p2[2 * D_FF + i]; u1[i] = p2[3 * D_FF + i]; } }
#pragma unroll
  for (int t = 0; t < 8; ++t) { float a0[8], u0[8], o[8]; ld8bf(c.UPb + (size_t)(m0 + t) * (2 * D_FF) + col, a0); ld8bf(c.UPb + (size_t)(m0 + t) * (2 * D_FF) + D_FF + col, u0);
#pragma unroll
    for (int i = 0; i < 8; ++i) { const float ya = ba[i] + wa[0][i] * a2[i] + wa[1][i] * a1[i] + wa[2][i] * a0[i], yu = bu[i] + wu[0][i] * u2[i] + wu[1][i] * u1[i] + wu[2][i] * u0[i]; o[i] = siluf_(ya) * yu; a2[i] = a1[i]; a1[i] = a0[i]; u2[i] = u1[i]; u1[i] = u0[i]; }
    *(bf16x8*)(c.ACT + (size_t)(m0 + t) * D_FF + col) = wv_pack8(o[0], o[1], o[2], o[3], o[4], o[5], o[6], o[7]); }
}
WV_DEV void ffn_act_unit(const Ctx& c, int unit) { ffn_act_unit_t<false>(c, unit); }
namespace pg8 {
#define PG8_LAS __attribute__((address_space(3)))
typedef unsigned short bf16_t;
typedef short bf16x8 __attribute__((ext_vector_type(8)));
typedef float f32x4 __attribute__((ext_vector_type(4)));
typedef unsigned u32x4 __attribute__((ext_vector_type(4)));
constexpr int BM = 256, BK = 64, HALF = 128, HTB = HALF * BK * 2  , STAGE_BYTES = 8 * HTB, NXCD = 8, WGM = 8;

__host__ __device__ __forceinline__ int lds_byte(int r, int c) { const int st = (r >> 4) * 2 + (c >> 5), rr = r & 15, cc = c & 31, ob = rr * 64 + cc * 2; return st * 1024 + (ob ^ (((ob >> 9) & 1) << 5)); }
__host__ __device__ __forceinline__ void stage_rc(int b, int& R, int& C) { const int st = b / 1024, sb = b % 1024, swz = sb ^ (((sb >> 9) & 1) << 5); R = (st >> 1) * 16 + swz / 64; C = (st & 1) * 32 + (swz % 64) / 2; }
__host__ __device__ __forceinline__ int perm32(int rho) { const int n = rho >> 4, i = rho & 15; return 8 * (i >> 2) + 4 * n + (i & 3); }

struct Unit { int pm, pn; };
struct Gemm { const bf16_t* A; const bf16_t* Bt; int M, N, K; };

struct StaticOrder {
    int nM, nN, nwg, G, c;
    __host__ __device__ void init(int M, int N, int G_, int c_) { nM = M / BM; nN = N / BM; nwg = nM * nN; G = G_; c = c_; }
    __host__ __device__ bool next(int i, Unit& u) const {
        const long L = (long)i * G + c; if (L >= nwg) return false;
        int wgid = (int)L; { const int q = nwg / NXCD, r = nwg % NXCD, xcd = wgid % NXCD, off = wgid / NXCD; wgid = (xcd < r ? xcd * (q + 1) : r * (q + 1) + (xcd - r) * q) + off; }
        const int nig = WGM * nN, gid = wgid / nig, fm = gid * WGM, gsz = (nM - fm) < WGM ? (nM - fm) : WGM;
        u.pm = fm + ((wgid % nig) % gsz); u.pn = (wgid % nig) / gsz; return true;
    }
    __device__ __forceinline__ void a_ready(const Unit&) const {}
    __device__ __forceinline__ void done(const Unit&) const {}
};

typedef unsigned u32x2 __attribute__((ext_vector_type(2)));
__device__ __forceinline__ unsigned cvt_pk_bf16_(float lo, float hi) { typedef float f2_ __attribute__((ext_vector_type(2))); typedef __bf16 b2_ __attribute__((ext_vector_type(2))); f2_ v = {lo, hi}; b2_ b = __builtin_convertvector(v, b2_); return __builtin_bit_cast(unsigned, b); }
struct EpiF32 { static constexpr bool PERM = false, AFTER_DRAIN = false;
  float* C; int ldc; const float* resP; const float* resS; int mp;
  __device__ __forceinline__ void operator()(const f32x4 (&acc)[2][2][4][2], const Unit& u, int wr, int wc, int fr, int fq) const {
#pragma unroll
    for (int ai = 0; ai < 2; ++ai)
#pragma unroll
      for (int m = 0; m < 4; ++m) {
        const int row = u.pm * BM + ai * HALF + wr * 64 + m * 16 + fr;
        float* crow = C + (size_t)row * ldc;
        const float* rrow = resP ? (row < mp ? resP + (size_t)row * 1024 : resS + (size_t)(row - mp) * 1024) : nullptr;
#pragma unroll
        for (int bj = 0; bj < 2; ++bj)
#pragma unroll
          for (int n = 0; n < 2; ++n) {
            const int col = u.pn * BM + bj * HALF + wc * 32 + n * 16 + 4 * fq;
            f32x4 v = acc[ai][bj][m][n]; if (rrow) v += *(const f32x4*)(rrow + col);
            *(f32x4*)(crow + col) = v;
          }
      }
  } };

struct EpiBf16S { static constexpr bool PERM = false, AFTER_DRAIN = false;
  bf16_t* C; int ldc; float* stP; float* stS; int nst, c0, c1, ldst; const float* RS;
  __device__ __forceinline__ void operator()(const f32x4 (&acc)[2][2][4][2], const Unit& u, int wr, int wc, int fr, int fq) const {
#pragma unroll
    for (int ai = 0; ai < 2; ++ai)
#pragma unroll
      for (int m = 0; m < 4; ++m) {
        const int row = u.pm * BM + ai * HALF + wr * 64 + m * 16 + fr;
        bf16_t* crow = C + (size_t)row * ldc; const float rs = RS ? 1.f / sqrtf(RS[row] * (1.f / 1024.f) + 1e-6f) : 1.f;
        float* srow = nullptr;
        if (stP) { if (row < MP) { const int t = row % SEQ; if (t >= SEQ - nst) srow = stP + ((size_t)(row / SEQ) * nst + (t - (SEQ - nst))) * ldst; }
                   else { const int t = (row - MP) % DEC_SEQ; if (t >= DEC_SEQ - nst) srow = stS + ((size_t)((row - MP) / DEC_SEQ) * nst + (t - (DEC_SEQ - nst))) * ldst; } }
#pragma unroll
        for (int bj = 0; bj < 2; ++bj)
#pragma unroll
          for (int n = 0; n < 2; ++n) {
            const int col = u.pn * BM + bj * HALF + wc * 32 + n * 16 + 4 * fq; const f32x4 v = acc[ai][bj][m][n] * rs;
            u32x2 w; w.x = cvt_pk_bf16_(v[0], v[1]); w.y = cvt_pk_bf16_(v[2], v[3]); *(u32x2*)(crow + col) = w;
            if (srow && col >= c0 && col < c1) *(f32x4*)(srow + col - c0) = v;
          }
      }
  } };

struct EpiF32N { static constexpr bool PERM = false, AFTER_DRAIN = false;
  float* C; const float* resP; const float* resS; int mp; bf16_t* A2; const float* w; float* RS;
  __device__ __forceinline__ void operator()(const f32x4 (&acc)[2][2][4][2], const Unit& u, int wr, int wc, int fr, int fq) const {
#pragma unroll
    for (int ai = 0; ai < 2; ++ai)
#pragma unroll
      for (int m = 0; m < 4; ++m) {
        const int row = u.pm * BM + ai * HALF + wr * 64 + m * 16 + fr;
        float* crow = C + (size_t)row * 1024; bf16_t* arow = A2 + (size_t)row * 1024;
        const float* rrow = row < mp ? resP + (size_t)row * 1024 : resS + (size_t)(row - mp) * 1024;
        float ss = 0.f;
#pragma unroll
        for (int bj = 0; bj < 2; ++bj)
#pragma unroll
          for (int n = 0; n < 2; ++n) {
            const int col = u.pn * BM + bj * HALF + wc * 32 + n * 16 + 4 * fq;
            const f32x4 v = acc[ai][bj][m][n] + *(const f32x4*)(rrow + col); *(f32x4*)(crow + col) = v;
            ss += (v[0] * v[0] + v[1] * v[1]) + (v[2] * v[2] + v[3] * v[3]);
            const f32x4 a = v * *(const f32x4*)(w + col); u32x2 pk; pk.x = cvt_pk_bf16_(a[0], a[1]); pk.y = cvt_pk_bf16_(a[2], a[3]); *(u32x2*)(arow + col) = pk;
          }
        ss += __shfl_xor(ss, 16); ss += __shfl_xor(ss, 32);
        if (fq == 0) atomicAdd(RS + row, ss);
      }
  } };
template <class Epi, class Sched, bool ALIGN_EPI = false, bool SP2 = false>
__device__ __forceinline__ void gemm_phase(PG8_LAS unsigned char* lds, const Gemm g, const Sched& S, const Epi& E) {
    const int tid = threadIdx.x, wid = __builtin_amdgcn_readfirstlane(tid >> 6), lane = tid & 63, wr = wid >> 2, wc = wid & 3, fr = lane & 15, fq = lane >> 4;
    const int K = g.K, nt = K / BK;
    unsigned voffA[2], voffB[2];
#pragma unroll
    for (int i = 0; i < 2; ++i) { int R, C; stage_rc(tid * 16 + i * 8192, R, C); const int Rb = Epi::PERM ? ((R & ~31) + perm32(R & 31)) : R;
        voffA[i] = (unsigned)(R * K + C) * 2u; voffB[i] = (unsigned)(Rb * K + C) * 2u; }
    const size_t kstep = (size_t)(BK * 2);
    const size_t hstep = (size_t)HALF * K * 2;
    const size_t tstep = 2 * hstep;
    const unsigned ldsw = (unsigned)wid * 1024u;
    const int aoff = lds_byte(wr * 64 + fr, fq * 8), boff = lds_byte(wc * 32 + fr, fq * 8);
#define PG8_SA(b, h) (((b) * 2 + (h)) * HTB)
#define PG8_SB(b, h) ((4 + (b) * 2 + (h)) * HTB)
#define PG8_STAGE(bufoff, gbase, voff) do { _Pragma("unroll") for (int _i = 0; _i < 2; ++_i) \
        __builtin_amdgcn_global_load_lds((const unsigned*)((const char*)(gbase) + (voff)[_i]), (PG8_LAS unsigned*)(lds + (bufoff) + ldsw + _i * 8192), 16, 0, 0); } while (0)
#define PG8_LDA(dst, b, h) do { _Pragma("unroll") for (int m = 0; m < 4; ++m) _Pragma("unroll") for (int k = 0; k < 2; ++k) dst[m][k] = *(const PG8_LAS bf16x8*)(lds + PG8_SA(b, h) + aoff + m * 2048 + k * 1024); } while (0)
#define PG8_LDB(dst, b, h) do { _Pragma("unroll") for (int n = 0; n < 2; ++n) _Pragma("unroll") for (int k = 0; k < 2; ++k) dst[n][k] = *(const PG8_LAS bf16x8*)(lds + PG8_SB(b, h) + boff + n * 2048 + k * 1024); } while (0)
#define PG8_MMA(ai, bj, At, Bt) do { __builtin_amdgcn_s_setprio(1); _Pragma("unroll") for (int m = 0; m < 4; ++m) _Pragma("unroll") for (int n = 0; n < 2; ++n) _Pragma("unroll") for (int k = 0; k < 2; ++k) \
        acc[ai][bj][m][n] = __builtin_amdgcn_mfma_f32_16x16x32_bf16(Bt[n][k], At[m][k], acc[ai][bj][m][n], 0, 0, 0); __builtin_amdgcn_s_setprio(0); } while (0)
#define PG8_WAIT_V(n) asm volatile("s_waitcnt vmcnt(" #n ")" ::: "memory")
#define PG8_WAIT_L(n) asm volatile("s_waitcnt lgkmcnt(" #n ")" ::: "memory")
#define PG8_BAR __builtin_amdgcn_s_barrier()
#define PG8_SCHED __builtin_amdgcn_sched_barrier(0)
    Unit cur, nxt; int ui = 0;
    if (!S.next(0, cur)) return;
    f32x4 acc[2][2][4][2];
#pragma unroll
    for (int a = 0; a < 2; ++a)
#pragma unroll
        for (int b = 0; b < 2; ++b)
#pragma unroll
            for (int m = 0; m < 4; ++m)
#pragma unroll
                for (int n = 0; n < 2; ++n) acc[a][b][m][n] = (f32x4){0.f, 0.f, 0.f, 0.f};
    bf16x8 At[4][2], B0[2][2], B1[2][2];
    const char* cA = (const char*)g.A + (size_t)cur.pm * tstep; const char* cB = (const char*)g.Bt + (size_t)cur.pn * tstep;
    S.a_ready(cur);
    if constexpr (SP2) {
        PG8_STAGE(PG8_SB(0, 0), cB, voffB); PG8_STAGE(PG8_SB(0, 1), cB + hstep, voffB); PG8_STAGE(PG8_SA(0, 0), cA, voffA); PG8_STAGE(PG8_SA(0, 1), cA + hstep, voffA);
        if (wr == 1) PG8_BAR;
        PG8_WAIT_V(2); PG8_BAR;
        PG8_STAGE(PG8_SB(1, 0), cB + kstep, voffB); PG8_STAGE(PG8_SA(1, 0), cA + kstep, voffA); PG8_STAGE(PG8_SB(1, 1), cB + hstep + kstep, voffB);
        PG8_WAIT_V(6); PG8_BAR;
    } else {
        PG8_STAGE(PG8_SB(0, 0), cB, voffB); PG8_STAGE(PG8_SA(0, 0), cA, voffA); PG8_STAGE(PG8_SB(0, 1), cB + hstep, voffB); PG8_STAGE(PG8_SA(0, 1), cA + hstep, voffA);
        if (wr == 1) PG8_BAR;
        PG8_WAIT_V(4); PG8_BAR;
        PG8_STAGE(PG8_SB(1, 0), cB + kstep, voffB); PG8_STAGE(PG8_SA(1, 0), cA + kstep, voffA); PG8_STAGE(PG8_SB(1, 1), cB + hstep + kstep, voffB);
        PG8_WAIT_V(6); PG8_BAR;
    }
    for (;;) {
        const bool has_next = S.next(ui + 1, nxt);
        const char* nA = has_next ? (const char*)g.A + (size_t)nxt.pm * tstep : cA; const char* nB = has_next ? (const char*)g.Bt + (size_t)nxt.pn * tstep : cB;
        for (int t = 0; t < nt; t += 2) {
            const bool last = (t == nt - 2);
            const char* a1 = cA + (size_t)(t + 1) * kstep;
            const char* a2 = last ? nA : cA + (size_t)(t + 2) * kstep; const char* b2 = last ? nB : cB + (size_t)(t + 2) * kstep;
            const char* a3 = a2 + kstep; const char* b3 = b2 + kstep;
            if (last && has_next) S.a_ready(nxt);
            if constexpr (SP2) {
            PG8_LDB(B0, 0, 0); PG8_LDB(B1, 0, 1); PG8_SCHED; PG8_LDA(At, 0, 0); PG8_STAGE(PG8_SA(1, 1), a1 + hstep, voffA);
            PG8_WAIT_V(8); PG8_WAIT_L(0); PG8_BAR; PG8_MMA(0, 0, At, B0); PG8_MMA(0, 1, At, B1); PG8_BAR; PG8_SCHED;
            PG8_LDA(At, 0, 1); PG8_STAGE(PG8_SB(0, 0), b2, voffB); PG8_STAGE(PG8_SB(0, 1), b2 + hstep, voffB); PG8_STAGE(PG8_SA(0, 0), a2, voffA);
            PG8_WAIT_V(8); PG8_WAIT_L(0); PG8_BAR; PG8_MMA(1, 0, At, B0); PG8_MMA(1, 1, At, B1); PG8_BAR; PG8_SCHED;
            PG8_LDB(B0, 1, 0); PG8_LDB(B1, 1, 1); PG8_SCHED; PG8_LDA(At, 1, 0); PG8_STAGE(PG8_SA(0, 1), a2 + hstep, voffA);
            PG8_WAIT_V(8); PG8_WAIT_L(0); PG8_BAR; PG8_MMA(0, 0, At, B0); PG8_MMA(0, 1, At, B1); PG8_BAR; PG8_SCHED;
            PG8_LDA(At, 1, 1); PG8_STAGE(PG8_SB(1, 0), b3, voffB); PG8_STAGE(PG8_SB(1, 1), b3 + hstep, voffB); PG8_STAGE(PG8_SA(1, 0), a3, voffA);
            PG8_WAIT_V(8); PG8_WAIT_L(0); PG8_BAR; PG8_MMA(1, 0, At, B0); PG8_MMA(1, 1, At, B1); PG8_BAR; PG8_SCHED;
            } else {
            PG8_LDB(B0, 0, 0); PG8_SCHED; PG8_LDA(At, 0, 0); PG8_STAGE(PG8_SA(1, 1), a1 + hstep, voffA);
            PG8_WAIT_L(8); PG8_BAR; PG8_WAIT_L(0); PG8_MMA(0, 0, At, B0); PG8_BAR; PG8_SCHED;
            PG8_LDB(B1, 0, 1); PG8_STAGE(PG8_SB(0, 0), b2, voffB);
            PG8_BAR; PG8_WAIT_L(0); PG8_MMA(0, 1, At, B1); PG8_BAR;
            PG8_LDA(At, 0, 1); PG8_STAGE(PG8_SA(0, 0), a2, voffA);
            PG8_BAR; PG8_WAIT_L(0); PG8_MMA(1, 0, At, B0); PG8_BAR; PG8_SCHED;
            PG8_STAGE(PG8_SB(0, 1), b2 + hstep, voffB);
            PG8_WAIT_V(6); PG8_BAR; PG8_MMA(1, 1, At, B1); PG8_BAR;
            PG8_LDB(B0, 1, 0); PG8_SCHED; PG8_LDA(At, 1, 0); PG8_STAGE(PG8_SA(0, 1), a2 + hstep, voffA);
            PG8_WAIT_L(8); PG8_BAR; PG8_WAIT_L(0); PG8_MMA(0, 0, At, B0); PG8_BAR; PG8_SCHED;
            PG8_LDB(B1, 1, 1); PG8_STAGE(PG8_SB(1, 0), b3, voffB);
            PG8_BAR; PG8_WAIT_L(0); PG8_MMA(0, 1, At, B1); PG8_BAR;
            PG8_LDA(At, 1, 1); PG8_STAGE(PG8_SA(1, 0), a3, voffA);
            PG8_BAR; PG8_WAIT_L(0); PG8_MMA(1, 0, At, B0); PG8_BAR; PG8_SCHED;
            PG8_STAGE(PG8_SB(1, 1), b3 + hstep, voffB);
            PG8_WAIT_V(6); PG8_BAR; PG8_MMA(1, 1, At, B1); PG8_BAR;
            }
        }
        if constexpr (ALIGN_EPI) { if (wr == 0) PG8_BAR; }
        if constexpr (!Epi::AFTER_DRAIN) { E(acc, cur, wr, wc, fr, fq); S.done(cur); }
        if (!has_next) break;
#pragma unroll
        for (int a = 0; a < 2; ++a)
#pragma unroll
            for (int b = 0; b < 2; ++b)
#pragma unroll
                for (int m = 0; m < 4; ++m)
#pragma unroll
                    for (int n = 0; n < 2; ++n) acc[a][b][m][n] = (f32x4){0.f, 0.f, 0.f, 0.f};
        cur = nxt; cA = nA; cB = nB; ++ui;
        if constexpr (ALIGN_EPI) { if (wr == 1) PG8_BAR; }
    }
    PG8_WAIT_V(0);
    if constexpr (!ALIGN_EPI) { if (wr == 0) PG8_BAR; }
    PG8_BAR;
    if constexpr (Epi::AFTER_DRAIN) { E.fused(acc, cur, wr, wc, fr, fq, lds, wid, lane); S.done(cur); }
#undef PG8_SA
#undef PG8_SB
#undef PG8_STAGE
#undef PG8_LDA
#undef PG8_LDB
#undef PG8_MMA
#undef PG8_WAIT_V
#undef PG8_WAIT_L
#undef PG8_BAR
#undef PG8_SCHED
}
}
#define GAS __attribute__((address_space(1)))
#define LAS __attribute__((address_space(3)))
typedef unsigned v4u __attribute__((ext_vector_type(4)));
#define LDS_WAIT() asm volatile("s_waitcnt lgkmcnt(0)" ::: "memory")
__device__ __forceinline__ unsigned pk2(float lo, float hi) { return f2bf_u(lo) | (f2bf_u(hi) << 16); }
constexpr int LDS_BYTES = 147456 + 256;
constexpr int NWAVES = 8;
__device__ __forceinline__ void p0_transpose_item(const float* W, int K, int N, bf16_t* WT, int row_off, LAS float* scr, int item, int lane) {
    const int nblk = N / 32, kb = item / nblk, nb = item % nblk, k0 = 64 * kb, n0 = 32 * nb;
#pragma unroll 8
    for (int i = 0; i < 32; ++i) { const int kk = 2 * i + (lane >> 5); scr[kk * 33 + (lane & 31)] = W[(size_t)(k0 + kk) * N + n0 + (lane & 31)]; }
    LDS_WAIT(); asm volatile("" ::: "memory");
    const int c = lane & 7;
#pragma unroll
    for (int j = 0; j < 4; ++j) { const int n = (lane >> 3) + 8 * j; const LAS float* s = scr + (8 * c) * 33 + n;
        v4u o; o.x = pk2(s[0 * 33], s[1 * 33]); o.y = pk2(s[2 * 33], s[3 * 33]); o.z = pk2(s[4 * 33], s[5 * 33]); o.w = pk2(s[6 * 33], s[7 * 33]);
        *(GAS v4u*)(WT + (size_t)(row_off + n0 + n) * K + k0 + 8 * c) = o; }
    LDS_WAIT(); asm volatile("" ::: "memory");
}
#define XB_TMO      128
#define XB_XCNT(j)  (256  + 64 * (j))
#define XB_XSUB(j)  (1280 + 64 * (j))
#define XB_XGEN(j)  (2304 + 64 * (j))
#define XB_TOP      3328
#define XB_TOPGEN   3392
#define XCD_BAR_WORDS 3456
#define XB_SPIN_CAP (1u << 18)

__device__ __forceinline__ unsigned xb_ld(unsigned* p)              { return __hip_atomic_load(p, __ATOMIC_RELAXED, __HIP_MEMORY_SCOPE_AGENT); }
__device__ __forceinline__ unsigned xb_add(unsigned* p, unsigned v) { return __hip_atomic_fetch_add(p, v, __ATOMIC_RELAXED, __HIP_MEMORY_SCOPE_AGENT); }
__device__ __forceinline__ unsigned xb_xcc_id() { return (unsigned)__builtin_amdgcn_s_getreg((3 << 11) | 20) & 0xFu; }
#define XB_SPIN(cond, bar) do { unsigned _sp = 0; while (cond) { __builtin_amdgcn_s_sleep(1); \
    if ((++_sp & 255u) == 0u) { if (xb_ld(&(bar)[XB_TMO])) break; if (_sp > XB_SPIN_CAP) { atomicAdd(&(bar)[XB_TMO], 1u); break; } } } } while (0)

struct XcdBarrier {
    unsigned* bar; unsigned x;
    volatile LAS unsigned* st;
};

__device__ __forceinline__ XcdBarrier xcd_barrier_post(unsigned* bar, volatile LAS unsigned* st) {
    XcdBarrier b; b.bar = bar; b.x = xb_xcc_id(); b.st = st;
    if (threadIdx.x == 0) (void)xb_add(&bar[XB_XCNT(b.x)], 1u);
    return b;
}
__device__ __forceinline__ void xcd_barrier_complete(unsigned* bar, unsigned x, unsigned& nloc, unsigned& nx) {
    const unsigned G = gridDim.x * gridDim.y * gridDim.z;
    unsigned sum, cnt, mine, sp = 0u;
    for (;;) {
        sum = 0u; cnt = 0u; mine = 0u;
#pragma unroll
        for (unsigned j = 0; j < 16; ++j) { const unsigned c = xb_ld(&bar[XB_XCNT(j)]); sum += c; cnt += (c > 0u) ? 1u : 0u; mine = (j == x) ? c : mine; }
        if (sum == G) break;
        __builtin_amdgcn_s_sleep(1);
        if ((++sp & 255u) == 0u) { if (xb_ld(&bar[XB_TMO])) break; if (sp > XB_SPIN_CAP) { atomicAdd(&bar[XB_TMO], 1u); break; } }
    }
    nloc = mine > 0u ? mine : 1u; nx = cnt > 0u ? cnt : 1u;
}

__device__ __forceinline__ void xcd_barrier(const XcdBarrier& b) {
    asm volatile("s_waitcnt vmcnt(0)" ::: "memory");
    __syncthreads();
    if (threadIdx.x == 0) {
        unsigned* bar = b.bar;
        __builtin_amdgcn_s_waitcnt(0);
        unsigned nloc = b.st[0], nx = b.st[1];
        if (nloc == 0u) { xcd_barrier_complete(bar, b.x, nloc, nx); b.st[0] = nloc; b.st[1] = nx; }
        const unsigned old = xb_add(&bar[XB_XSUB(b.x)], 1u);
        const unsigned gen = old / nloc;
        if (old + 1u == (gen + 1u) * nloc) {
            __builtin_amdgcn_fence(__ATOMIC_RELEASE, "agent");
            asm volatile("s_waitcnt vmcnt(0)" ::: "memory");
            const unsigned og = xb_add(&bar[XB_TOP], 1u);
            const unsigned tg = og / nx;
            if (og + 1u == (tg + 1u) * nx) xb_add(&bar[XB_TOPGEN], 1u);
            else XB_SPIN(xb_ld(&bar[XB_TOPGEN]) == tg, bar);
            __builtin_amdgcn_fence(__ATOMIC_ACQUIRE, "agent");
            xb_add(&bar[XB_XGEN(b.x)], 1u);
            asm volatile("s_waitcnt vmcnt(0)" ::: "memory");
        } else {
            XB_SPIN(xb_ld(&bar[XB_XGEN(b.x)]) == gen, bar);
            __builtin_amdgcn_fence(__ATOMIC_ACQUIRE, "agent");
            asm volatile("s_waitcnt vmcnt(0)" ::: "memory");
        }
    }
    __syncthreads();
}

struct Args { Ctx c; bf16_t *WinT, *WkvT, *WoutT, *WxqT, *WxoT, *WupT, *WdownT; unsigned* ctr; unsigned* bar; float* RS1; float* RS2; int ph_lo, ph_hi; };
template <class F> __device__ __forceinline__ void run_stage(const F& f) {
  const long stride = (long)gridDim.x * 512;
  for (long i = (long)blockIdx.x * 512 + threadIdx.x; i < F::N; i += stride) f(i);
}
constexpr int N_PHASES = 18;
struct Args;
__device__ __forceinline__ const Args* phase_args() { unsigned long long p = (unsigned long long)__builtin_amdgcn_kernarg_segment_ptr(); asm volatile("" : "+s"(p)); return (const Args*)p; }
__global__ void __launch_bounds__(512, 2) mega(Args a0) {
  extern __shared__ __attribute__((aligned(16))) unsigned char lds_raw[];
  LAS unsigned char* lds = (LAS unsigned char*)lds_raw;
  const int ph_lo = a0.ph_lo, ph_hi = a0.ph_hi;
  volatile LAS unsigned* bst = (volatile LAS unsigned*)(lds + 147456);
  if (threadIdx.x < 2) bst[threadIdx.x] = 0u;
  __syncthreads();
  const XcdBarrier gbar = xcd_barrier_post(a0.bar, bst);
  const int tid = threadIdx.x, lane = tid & 63, wave = __builtin_amdgcn_readfirstlane(tid >> 6);
#define PH(k) if (ph_lo <= (k) && (k) < ph_hi) if (const Args* ap_ = phase_args()) if (const Args& a = *ap_; true) if (const Ctx& c = a.c; true)
#define WUNITS(n, expr) do { const int G8_ = (int)gridDim.x * NWAVES; for (int u = (int)blockIdx.x * NWAVES + wave; u < (n); u += G8_) { expr; } } while (0)
#define SYNC(k) do { if ((k) + 1 < ph_hi) xcd_barrier(gbar); } while (0)
#define GEMM(A_, B_, M_, N_, K_, C_, LDC_, RP_, RS_) do { __syncthreads(); pg8::Gemm g{A_, B_, M_, N_, K_}; pg8::StaticOrder S; S.init(M_, N_, (int)gridDim.x, (int)blockIdx.x); \
      pg8::EpiF32 E{C_, LDC_, RP_, RS_, MP}; pg8::gemm_phase<pg8::EpiF32, pg8::StaticOrder, true, true>(lds, g, S, E); } while (0)
  PH(0) {
    LAS float* scr = (LAS float*)(lds + wave * 16384);
    const int gw = blockIdx.x * NWAVES + wave, NGW = gridDim.x * NWAVES;
    constexpr int I_IN = (D_MODEL / 64) * (IN_COLS / 32), I_SQ = (D_MODEL / 64) * (D_MODEL / 32);
    constexpr int NIT = I_IN + 2 * I_SQ;
    for (int it = gw; it < NIT; it += NGW) { int r = it;
      if (r < I_IN) { p0_transpose_item(c.w_in, D_MODEL, IN_COLS, a.WinT, 0, scr, r, lane); continue; } r -= I_IN;
      if (r < I_SQ) { p0_transpose_item(c.w_xk, D_MODEL, D_MODEL, a.WkvT, 0, scr, r, lane); continue; } r -= I_SQ;
      p0_transpose_item(c.w_xv, D_MODEL, D_MODEL, a.WkvT, D_MODEL, scr, r, lane); }
    run_stage(StCmpWT{c}); run_stage(StRope{c}); WUNITS(128, cmp_bias_unit(c, u));
    for (int i = (int)blockIdx.x * 512 + tid; i < MTOT; i += (int)gridDim.x * 512) { a.RS1[i] = 0.f; a.RS2[i] = 0.f; }
    if (blockIdx.x == 0 && tid < 8) a.ctr[64 * tid] = 0u;
    WUNITS((MTOT + MMEM) / 4, ({ const int r0 = 4 * u;
      if (r0 < MTOT) { const float* s_ = x_row(c, r0); rms_row4_unit(s_, s_ + D_MODEL, s_ + 2 * D_MODEL, s_ + 3 * D_MODEL, c.attn_norm_w, c.XN + (size_t)r0 * D_MODEL, c.XN + (size_t)(r0 + 1) * D_MODEL, c.XN + (size_t)(r0 + 2) * D_MODEL, c.XN + (size_t)(r0 + 3) * D_MODEL); }
      else { const float* s_ = c.mem_prompt + (size_t)(r0 - MTOT) * D_MODEL; bf16_t* d_ = c.MN + (size_t)(r0 - MTOT) * D_MODEL; rms_row4_unit(s_, s_ + D_MODEL, s_ + 2 * D_MODEL, s_ + 3 * D_MODEL, c.mem_norm_w, d_, d_ + D_MODEL, d_ + 2 * D_MODEL, d_ + 3 * D_MODEL); } }));
    SYNC(0); }
  PH(1) { __syncthreads(); pg8::Gemm g{c.XN, a.WinT, MTOT, LDP, D_MODEL}; pg8::StaticOrder S; S.init(MTOT, LDP, (int)gridDim.x, (int)blockIdx.x);
    pg8::EpiBf16S E{c.Pb, LDP, c.out + O_GCP, c.out + O_GCS, 3, OFF_QKV, OFF_QKV + 1536, 1536, nullptr}; pg8::gemm_phase<pg8::EpiBf16S, pg8::StaticOrder, true, true>(lds, g, S, E); SYNC(1); }
  PH(2) {
    constexpr int MKV_UNITS = (MMEM / 256) * (2048 / 256);
    if ((int)blockIdx.x >= MKV_UNITS) {
      LAS float* scr = (LAS float*)(lds + wave * 16384);
      const int gw = ((int)blockIdx.x - MKV_UNITS) * NWAVES + wave, NGW = ((int)gridDim.x - MKV_UNITS) * NWAVES;
      constexpr int I_SQ = (D_MODEL / 64) * (D_MODEL / 32), I_UP = (D_MODEL / 64) * (2 * D_FF / 32), I_DN = (D_FF / 64) * (D_MODEL / 32);
      constexpr int NIT = 3 * I_SQ + I_UP + I_DN;
      for (int it = gw; it < NIT; it += NGW) { int r = it;
        if (r < I_SQ) { p0_transpose_item(c.w_out, D_MODEL, D_MODEL, a.WoutT, 0, scr, r, lane); continue; } r -= I_SQ;
        if (r < I_SQ) { p0_transpose_item(c.w_xq, D_MODEL, D_MODEL, a.WxqT, 0, scr, r, lane); continue; } r -= I_SQ;
        if (r < I_SQ) { p0_transpose_item(c.w_xo, D_MODEL, D_MODEL, a.WxoT, 0, scr, r, lane); continue; } r -= I_SQ;
        if (r < I_UP) { p0_transpose_item(c.w_up, D_MODEL, 2 * D_FF, a.WupT, 0, scr, r, lane); continue; } r -= I_UP;
        p0_transpose_item(c.w_down, D_FF, D_MODEL, a.WdownT, 0, scr, r, lane); }
    }
    GEMM(c.MN, a.WkvT, MMEM, 2048, D_MODEL, c.MKV, 2048, nullptr, nullptr); SYNC(2); }
  PH(3) { WUNITS(MTOT, postproc_unit(c, u)); WUNITS(CONV4_UNITS, gdn_conv4_unit(c, u)); WUNITS(VT_UNITS, vt_unit(c, u));
    WUNITS(MMEM, memkv_unit(c, u)); WUNITS(DEC_BATCH * MEM_TOKENS, xk_pack_unit(c, u)); WUNITS(XVT_UNITS, xvt_unit(c, u)); SYNC(3); }
  PH(4) {
    { const int G8 = (int)gridDim.x * NWAVES, local = (int)blockIdx.x * NWAVES + wave; float* wscr = (float*)(lds_raw + (tid >> 6) * 18432);
      for (int u = local; u < GDN_PREP2_UNITS; u += G8) gdn_prep2_unit(c, u, wscr); }
    { bf16_t* wl_ = (bf16_t*)(lds_raw + (tid >> 6) * 18432); const int G8r = (int)gridDim.x * NWAVES, lr = G8r - 1 - ((int)blockIdx.x * NWAVES + wave);
      for (int u = lr; u < CMP_UNITS_S + CMP_UNITS_P; u += G8r) { if (u < CMP_UNITS_S) compress_unit<true>(c, u, wl_); else compress_unit<false>(c, u - CMP_UNITS_S, wl_); } }
    WUNITS(WKS_UNITS, winks_unit(c, u)); WUNITS(WVS_UNITS, winvs_unit(c, u)); run_stage(StWinOut4{c}); SYNC(4); }
  PH(5) { run_stage(StPackCmp2{c}); SYNC(5); }
  PH(6) {
    if (wave == 0) { if (blockIdx.x < BATCH * 16) gdn_scan_unit(c, (int)blockIdx.x); }
    else if (wave <= 2) { const int u = BATCH * 16 + (int)blockIdx.x * 2 + (wave - 1); if (u < GDN_SCAN_UNITS) gdn_scan_unit(c, u); }
    else if (wave == 3) { if ((int)blockIdx.x < NSA_UNITS_S) nsa_unit<true>(c, (int)blockIdx.x, (float*)(lds_raw + 3 * 18432)); }
    const int xq = (int)blockIdx.x & 7; constexpr int PERQ = NSA_UNITS_P / 8;
    for (;;) { int k = 0; if (lane == 0) k = (int)atomicAdd(a.ctr + 64 * xq, 1u); k = __builtin_amdgcn_readfirstlane(k); if (k >= PERQ) break;
      const int tile = (SEQ / 8 - 1) - (k >> 1), bk = 2 * xq + (k & 1); nsa_unit<false>(c, bk * (SEQ / 8) + tile, nullptr); }
    SYNC(6); }
  PH(7) { WUNITS(NSA_COMB_UNITS, nsa_combine_unit(c, u)); WUNITS(MTOT / 4, gdn_norm_unit_t<4>(c, 4 * u)); SYNC(7); }
  PH(8) { __syncthreads(); pg8::Gemm g{c.CAT, a.WoutT, MTOT, D_MODEL, D_MODEL}; pg8::StaticOrder S; S.init(MTOT, D_MODEL, (int)gridDim.x, (int)blockIdx.x);
    pg8::EpiF32N E{c.H1, c.x_prompt, c.x_sample, MP, c.XN, c.xattn_norm_w, a.RS1}; pg8::gemm_phase<pg8::EpiF32N, pg8::StaticOrder, true, true>(lds, g, S, E); SYNC(8); }
  PH(9) { }
  PH(10) { __syncthreads(); pg8::Gemm g{c.XN, a.WxqT, MTOT, D_MODEL, D_MODEL}; pg8::StaticOrder S; S.init(MTOT, D_MODEL, (int)gridDim.x, (int)blockIdx.x);
    pg8::EpiBf16S E{c.Q2b, D_MODEL, nullptr, nullptr, 0, 0, 0, 0, a.RS1}; pg8::gemm_phase<pg8::EpiBf16S, pg8::StaticOrder, true, true>(lds, g, S, E); SYNC(10); }
  PH(11) { }
  PH(12) {
    const int G8 = (int)gridDim.x * NWAVES, local = (int)blockIdx.x * NWAVES + wave;
    for (int u = local; u < XA_UNITS_P; u += G8) xattn_unit<false>(c, u);
    for (int u = local; u < XA_UNITS_S; u += G8) xattn_unit<true>(c, u);
    SYNC(12); }
  PH(13) { __syncthreads(); pg8::Gemm g{c.OX, a.WxoT, MTOT, D_MODEL, D_MODEL}; pg8::StaticOrder S; S.init(MTOT, D_MODEL, (int)gridDim.x, (int)blockIdx.x);
    pg8::EpiF32N E{c.H2, c.H1, c.H1 + (size_t)MP * D_MODEL, MP, c.XN, c.ffn_norm_w, a.RS2}; pg8::gemm_phase<pg8::EpiF32N, pg8::StaticOrder, true, true>(lds, g, S, E); SYNC(13); }
  PH(14) { }
  PH(15) { __syncthreads(); pg8::Gemm g{c.XN, a.WupT, MTOT, 2 * D_FF, D_MODEL}; pg8::StaticOrder S; S.init(MTOT, 2 * D_FF, (int)gridDim.x, (int)blockIdx.x);
    pg8::EpiBf16S E{c.UPb, 2 * D_FF, c.out + O_FCP, c.out + O_FCS, 2, 0, 2 * D_FF, 2 * D_FF, a.RS2}; pg8::gemm_phase<pg8::EpiBf16S, pg8::StaticOrder, true, true>(lds, g, S, E); SYNC(15); }
  PH(16) { WUNITS(FFN_UNITS8, ffn_act8_unit(c, u)); SYNC(16); }
#ifdef EXTRA_LO
  PH(20) { if (wave == 3) { if ((int)blockIdx.x < NSA_UNITS_S) nsa_unit<true>(c, (int)blockIdx.x, (float*)(lds_raw + 3 * 18432)); } }
  PH(21) { if (wave == 0) { if (blockIdx.x < BATCH * 16) gdn_scan_unit(c, (int)blockIdx.x); } }
  PH(22) { const int G8 = (int)gridDim.x * NWAVES, local = (int)blockIdx.x * NWAVES + wave; float* wscr = (float*)(lds_raw + (tid >> 6) * 18432);
      for (int u = local; u < GDN_PREP2_UNITS; u += G8) gdn_prep2_unit(c, u, wscr); }
  PH(23) { { bf16_t* wl_ = (bf16_t*)(lds_raw + (tid >> 6) * 18432); const int G8r = (int)gridDim.x * NWAVES, lr = G8r - 1 - ((int)blockIdx.x * NWAVES + wave);
      for (int u = lr; u < CMP_UNITS_S + CMP_UNITS_P; u += G8r) { if (u < CMP_UNITS_S) compress_unit<true>(c, u, wl_); else compress_unit<false>(c, u - CMP_UNITS_S, wl_); } } }
  PH(24) { WUNITS(WKS_UNITS, winks_unit(c, u)); WUNITS(WVS_UNITS, winvs_unit(c, u)); run_stage(StWinOut4{c}); }
  PH(25) { WUNITS(MTOT, postproc_unit(c, u)); }
  PH(26) { WUNITS(CONV4_UNITS, gdn_conv4_unit(c, u)); }
  PH(27) { WUNITS(VT_UNITS, vt_unit(c, u)); }
  PH(28) { WUNITS(MMEM, memkv_unit(c, u)); WUNITS(DEC_BATCH * MEM_TOKENS, xk_pack_unit(c, u)); WUNITS(XVT_UNITS, xvt_unit(c, u)); }
  PH(29) { if (blockIdx.x == 0 && tid < 8) a.ctr[64 * tid] = 0u; SYNC(29); }
  PH(30) { const int xq = (int)blockIdx.x & 7; constexpr int PERQ = NSA_UNITS_P / 8;
    for (;;) { int k = 0; if (lane == 0) k = (int)atomicAdd(a.ctr + 64 * xq, 1u); k = __builtin_amdgcn_readfirstlane(k); if (k >= PERQ) break;
      const int tile = (SEQ / 8 - 1) - (k >> 1), bk = 2 * xq + (k & 1); nsa_unit<false>(c, bk * (SEQ / 8) + tile, nullptr); } }
  PH(31) { for (int r_ = 0; r_ < 20; ++r_) xcd_barrier(gbar); }
  PH(32) { }
#endif
  PH(17) { GEMM(c.ACT, a.WdownT, MTOT, D_MODEL, D_FF, c.out + O_YP, D_MODEL, c.H2, c.H2 + (size_t)MP * D_MODEL); }
}
#ifndef MK_MULTI
#define MK_MULTI 0
#endif
extern "C" void kernel_launch(void* const* d_in, const int* in_sizes, int n_in, void* d_out, int out_size, void* d_ws, size_t ws_size, hipStream_t stream) {
  static int grid = 0;
  if (grid == 0) {
    int dev = 0, cus = 0, per_cu = 0;
    if (hipGetDevice(&dev) != hipSuccess || hipDeviceGetAttribute(&cus, hipDeviceAttributeMultiprocessorCount, dev) != hipSuccess) { fprintf(stderr, "kernel_launch: device query failed\n"); grid = -1; return; }
    if (hipFuncSetAttribute((const void*)mega, hipFuncAttributeMaxDynamicSharedMemorySize, LDS_BYTES) != hipSuccess) { fprintf(stderr, "kernel_launch: hipFuncSetAttribute failed\n"); grid = -1; return; }
    if (hipOccupancyMaxActiveBlocksPerMultiprocessor(&per_cu, (const void*)mega, 512, LDS_BYTES) != hipSuccess || per_cu < 1) { fprintf(stderr, "kernel_launch: occupancy query says %d blocks/CU\n", per_cu); (void)hipGetLastError(); }
    grid = cus;
    if (n_in != 34 || (size_t)out_size != O_END) fprintf(stderr, "kernel_launch: unexpected n_in %d / out_size %d (want 34 / %zu)\n", n_in, out_size, (size_t)O_END);
  }
  if (grid < 0) return;
  Args a{}; Ctx& c = a.c; int k = 0;
  c.x_prompt = (const float*)d_in[k++]; c.x_sample = (const float*)d_in[k++]; c.mem_prompt = (const float*)d_in[k++]; c.cache_nsa_kv = (const float*)d_in[k++]; c.cache_nsa_win = (const float*)d_in[k++];
  c.state_gdn = (const float*)d_in[k++]; c.cache_gdn_conv = (const float*)d_in[k++]; c.cache_ffn_conv = (const float*)d_in[k++]; c.cache_mem_kv = (const float*)d_in[k++]; c.page_table = (const int*)d_in[k++];
  c.attn_norm_w = (const float*)d_in[k++]; c.w_in = (const float*)d_in[k++]; c.nsa_q_norm_w = (const float*)d_in[k++]; c.nsa_k_norm_w = (const float*)d_in[k++]; c.cmp_pe = (const float*)d_in[k++]; c.cmp_w = (const float*)d_in[k++];
  c.gdn_conv_w = (const float*)d_in[k++]; c.gdn_a_log = (const float*)d_in[k++]; c.gdn_dt_bias = (const float*)d_in[k++]; c.gdn_norm_w = (const float*)d_in[k++]; c.w_out = (const float*)d_in[k++];
  c.mem_norm_w = (const float*)d_in[k++]; c.w_xk = (const float*)d_in[k++]; c.w_xv = (const float*)d_in[k++]; c.xk_norm_w = (const float*)d_in[k++]; c.xattn_norm_w = (const float*)d_in[k++]; c.w_xq = (const float*)d_in[k++];
  c.xq_norm_w = (const float*)d_in[k++]; c.w_xo = (const float*)d_in[k++]; c.ffn_norm_w = (const float*)d_in[k++]; c.w_up = (const float*)d_in[k++]; c.ffn_conv_w = (const float*)d_in[k++]; c.ffn_conv_b = (const float*)d_in[k++]; c.w_down = (const float*)d_in[k++];
  c.out = (float*)d_out;
  unsigned char* ws = (unsigned char*)d_ws; WsMap w{0};
  a.ctr = (unsigned*)(ws + w.take(4096));
  a.RS1 = (float*)(ws + w.take((size_t)MTOT * 4)); a.RS2 = (float*)(ws + w.take((size_t)MTOT * 4));
  unsigned* bar0 = (unsigned*)(ws + w.take((size_t)2 * XCD_BAR_WORDS * 4));
  if (hipMemsetAsync(bar0, 0, (size_t)2 * XCD_BAR_WORDS * 4, stream) != hipSuccess) { fprintf(stderr, "kernel_launch: memset of the barrier words failed\n"); return; }
  a.bar = bar0;
  a.WinT = (bf16_t*)(ws + w.take((size_t)LDP * D_MODEL * 2)); a.WkvT = (bf16_t*)(ws + w.take((size_t)2048 * D_MODEL * 2));
  a.WoutT = (bf16_t*)(ws + w.take((size_t)D_MODEL * D_MODEL * 2)); a.WxqT = (bf16_t*)(ws + w.take((size_t)D_MODEL * D_MODEL * 2)); a.WxoT = (bf16_t*)(ws + w.take((size_t)D_MODEL * D_MODEL * 2));
  a.WupT = (bf16_t*)(ws + w.take((size_t)2 * D_FF * D_MODEL * 2)); a.WdownT = (bf16_t*)(ws + w.take((size_t)D_MODEL * D_FF * 2));
  const size_t need = ws_carve(c, ws, w.off);
  if (need > ws_size) { fprintf(stderr, "kernel_launch: workspace too small: need %zu, have %zu\n", need, ws_size); return; }
#if MK_MULTI
  for (int ph = 0; ph < N_PHASES; ++ph) { a.ph_lo = ph; a.ph_hi = ph + 1; void* args[] = {&a};
    hipError_t e = hipLaunchCooperativeKernel((const void*)mega, dim3(grid), dim3(512), args, LDS_BYTES, stream);
    if (e != hipSuccess) { fprintf(stderr, "kernel_launch: cooperative launch failed: %s\n", hipGetErrorString(e)); return; } }
#else
  a.ph_lo = 0; a.ph_hi = N_PHASES; void* args[] = {&a};
  hipError_t e = hipLaunchCooperativeKernel((const void*)mega, dim3(grid), dim3(512), args, LDS_BYTES, stream);
  if (e != hipSuccess) fprintf(stderr, "kernel_launch: cooperative launch failed: %s (grid %d)\n", hipGetErrorString(e), grid);
#ifdef EXTRA_LO
  a.ph_lo = EXTRA_LO; a.ph_hi = EXTRA_HI; a.bar = bar0 + XCD_BAR_WORDS; (void)hipLaunchCooperativeKernel((const void*)mega, dim3(grid), dim3(512), args, LDS_BYTES, stream);
#endif
#endif
}
```
